# Optimizing an MI355X kernel written in HIP

```python
import jax
import jax.numpy as jnp
from jax import lax
import numpy as np

D_MODEL = 1024
BATCH = 32
SEQ = 2048
DEPTH = 2

MEM_LEN = 256
HEAD_DIM = 64
N_HEADS_A = 6
N_HEADS_B = 6
N_HEADS_M = 4
WIDTH_A = N_HEADS_A * HEAD_DIM
WIDTH_B = N_HEADS_B * HEAD_DIM
WIDTH_M = N_HEADS_M * HEAD_DIM
MIX_WIDTH = WIDTH_A + WIDTH_B + WIDTH_M
IN_WIDTH = 3 * WIDTH_A + 3 * WIDTH_B + WIDTH_M
DILATED_PATTERNS = ((128, 1), (512, 4), (2048, 16))
DIL_BLOCK = 64
GRID_W = 64
NA_ROWS = 8
NA_COLS = 16
N_GROUPS = 4
EXPERTS_PER_GROUP = 8
N_EXPERTS = N_GROUPS * EXPERTS_PER_GROUP
TOP_K_IN_GROUP = 2
D_EXPERT = 512
EPS = 1e-6
NEG_INF = -1e30
ATTN_SCALE = HEAD_DIM ** -0.5

kernel_name = "hybrid_dilated_neighbourhood_memory_hmoe_encoder"


def rms_norm(x, gain):
    xf = x.astype(jnp.float32)
    y = xf * lax.rsqrt(jnp.mean(jnp.square(xf), axis=-1, keepdims=True) + EPS)
    return (y * gain.astype(jnp.float32)).astype(x.dtype)


def alibi_slopes(n):
    return (2.0 ** (-8.0 * np.arange(1, n + 1) / n)).astype(np.float32)


def dilated_window_attention(q, k, v, slopes, window, dilation):
    b, s, h, dh = q.shape
    radius = window // (2 * dilation)
    length = s // dilation
    n_blk = -(-length // DIL_BLOCK)
    pad = n_blk * DIL_BLOCK - length

    def to_strided(t):
        t = t.reshape(b, length, dilation, h, dh).transpose(0, 2, 3, 1, 4)
        return jnp.pad(t, ((0, 0), (0, 0), (0, 0), (0, pad), (0, 0)))

    def band(t):
        t = jnp.pad(t, ((0, 0), (0, 0), (0, 0), (DIL_BLOCK, DIL_BLOCK), (0, 0)))
        t = t.reshape(b, dilation, h, n_blk + 2, DIL_BLOCK, dh)
        return jnp.concatenate([t[:, :, :, :-2], t[:, :, :, 1:-1], t[:, :, :, 2:]], axis=4)

    q_blk = to_strided(q).reshape(b, dilation, h, n_blk, DIL_BLOCK, dh)
    k_blk = band(to_strided(k))
    v_blk = band(to_strided(v))
    q_pos = jnp.arange(n_blk * DIL_BLOCK).reshape(n_blk, DIL_BLOCK)
    k_pos = (jnp.arange(n_blk)[:, None] - 1) * DIL_BLOCK + jnp.arange(3 * DIL_BLOCK)[None, :]
    rel = jnp.abs(k_pos[:, None, :] - q_pos[:, :, None])
    valid = (rel <= radius) & (k_pos[:, None, :] >= 0) & (k_pos[:, None, :] < length)
    alibi = -slopes[:, None, None, None] * (rel * dilation).astype(jnp.float32)[None]
    scores = jnp.einsum("bdhnqc,bdhnkc->bdhnqk", q_blk, k_blk).astype(jnp.float32) * ATTN_SCALE + alibi
    scores = jnp.where(valid, scores, NEG_INF)
    m = jnp.max(scores, axis=-1, keepdims=True)
    e = jnp.exp(scores - m)
    den = jnp.sum(e, axis=-1, keepdims=True)
    lse = (m + jnp.log(den))[..., 0]
    out = jnp.einsum("bdhnqk,bdhnkc->bdhnqc", e / den, v_blk.astype(jnp.float32))
    out = out.reshape(b, dilation, h, n_blk * DIL_BLOCK, dh)[:, :, :, :length]
    out = out.transpose(0, 3, 1, 2, 4).reshape(b, s, h, dh)
    lse = lse.reshape(b, dilation, h, n_blk * DIL_BLOCK)[..., :length]
    lse = lse.transpose(0, 3, 1, 2).reshape(b, s, h)
    return out, lse


def dilated_mixture_attention(q, k, v, slopes):
    outs, lses = [], []
    for window, dilation in DILATED_PATTERNS:
        o, l = dilated_window_attention(q, k, v, slopes, window, dilation)
        outs.append(o)
        lses.append(l)
    weights = jax.nn.softmax(jnp.stack(lses, axis=0), axis=0)
    return jnp.sum(weights[..., None] * jnp.stack(outs, axis=0), axis=0)


def neighbourhood_attention(q, k, v, rpb):
    b, s, h, dh = q.shape
    rows = s // GRID_W
    kh = min(NA_ROWS, rows)

    def to_grid(t):
        return t.reshape(b, rows, GRID_W, h, dh).transpose(0, 3, 1, 2, 4)

    qg, kg, vg = to_grid(q), to_grid(k), to_grid(v)
    r = jnp.arange(rows)
    r0 = jnp.clip(r - kh // 2, 0, rows - kh)
    row_idx = r0[:, None] + jnp.arange(kh)[None, :]
    k_rows = kg[:, :, row_idx]
    v_rows = vg[:, :, row_idx]
    c = jnp.arange(GRID_W)
    c0 = jnp.clip(c - NA_COLS // 2, 0, GRID_W - NA_COLS)
    col_ok = (c[None, :] >= c0[:, None]) & (c[None, :] < c0[:, None] + NA_COLS)
    dr = row_idx - r[:, None]
    dc = jnp.clip(c[None, :] - c[:, None], -(NA_COLS - 1), NA_COLS - 1)
    bias = rpb[:, dr[:, :, None, None] + NA_ROWS - 1, dc[None, None] + NA_COLS - 1]
    bias = bias.astype(jnp.float32).transpose(0, 1, 3, 2, 4)
    scores = jnp.einsum("bhrqc,bhrjkc->bhrqjk", qg, k_rows).astype(jnp.float32) * ATTN_SCALE + bias[None]
    scores = jnp.where(col_ok[None, None, None, :, None, :], scores, NEG_INF)
    probs = jax.nn.softmax(scores.reshape(b, h, rows, GRID_W, kh * GRID_W), axis=-1).reshape(scores.shape)
    out = jnp.einsum("bhrqjk,bhrjkc->bhrqc", probs, v_rows.astype(jnp.float32))
    return out.transpose(0, 2, 3, 1, 4).reshape(b, s, h, dh)


def memory_attention(q, k, v):
    scores = jnp.einsum("bshc,bmhc->bhsm", q, k).astype(jnp.float32) * ATTN_SCALE
    probs = jax.nn.softmax(scores, axis=-1)
    return jnp.einsum("bhsm,bmhc->bshc", probs, v.astype(jnp.float32))


def hierarchical_moe(h, w_group, b_group, w_router, b_router, w_gate, w_up, w_down):
    b, s, d = h.shape
    t = h.reshape(b * s, d)
    group_logits = jnp.einsum("td,dg->tg", t, w_group).astype(jnp.float32) + b_group.astype(jnp.float32)
    group_prob = jax.nn.softmax(group_logits, axis=-1)
    g_top, g_idx = lax.top_k(group_prob, 1)
    exp_logits = jnp.einsum("td,de->te", t, w_router).astype(jnp.float32) + b_router.astype(jnp.float32)
    exp_logits = exp_logits.reshape(-1, N_GROUPS, EXPERTS_PER_GROUP)
    in_group = jnp.take_along_axis(exp_logits, g_idx[:, :, None], axis=1)[:, 0]
    e_val, e_idx = lax.top_k(in_group, TOP_K_IN_GROUP)
    e_w = jax.nn.softmax(e_val, axis=-1) * g_top
    global_idx = g_idx * EXPERTS_PER_GROUP + e_idx
    gates = jnp.sum(jax.nn.one_hot(global_idx, N_EXPERTS, dtype=jnp.float32) * e_w[..., None], axis=1)
    gates = gates.astype(t.dtype)
    out = jnp.zeros_like(t)
    for e in range(N_EXPERTS):
        hid = jax.nn.silu(t @ w_gate[e]) * (t @ w_up[e])
        out = out + gates[:, e:e + 1] * (hid @ w_down[e])
    return out.reshape(b, s, d)


def setup_inputs(seed: int = 0) -> dict:
    key = jax.random.key(seed)
    ks = jax.random.split(key, 18)
    f32 = jnp.float32

    def nrm(k, shape, scale):
        return scale * jax.random.normal(k, shape, f32)

    return {
        "x": nrm(ks[0], (BATCH, SEQ, D_MODEL), 1.0),
        "mem": nrm(ks[1], (BATCH, MEM_LEN, D_MODEL), 1.0),
        "norm_mix": 1.0 + nrm(ks[2], (DEPTH, D_MODEL), 0.05),
        "w_in": nrm(ks[3], (DEPTH, D_MODEL, IN_WIDTH), D_MODEL ** -0.5),
        "qk_gain": 1.0 + nrm(ks[4], (DEPTH, 6, HEAD_DIM), 0.05),
        "rpb": nrm(ks[5], (DEPTH, N_HEADS_B, 2 * NA_ROWS - 1, 2 * NA_COLS - 1), 0.5),
        "norm_mem": 1.0 + nrm(ks[6], (DEPTH, D_MODEL), 0.05),
        "w_mem_kv": nrm(ks[7], (DEPTH, D_MODEL, 2 * WIDTH_M), D_MODEL ** -0.5),
        "out_gain": 1.0 + nrm(ks[8], (DEPTH, MIX_WIDTH), 0.05),
        "w_out": nrm(ks[9], (DEPTH, MIX_WIDTH, D_MODEL), MIX_WIDTH ** -0.5),
        "norm_ffn": 1.0 + nrm(ks[10], (DEPTH, D_MODEL), 0.05),
        "w_group": nrm(ks[11], (DEPTH, D_MODEL, N_GROUPS), D_MODEL ** -0.5),
        "b_group": nrm(ks[12], (DEPTH, N_GROUPS), 0.01),
        "w_router": nrm(ks[13], (DEPTH, D_MODEL, N_EXPERTS), D_MODEL ** -0.5),
        "b_router": nrm(ks[14], (DEPTH, N_EXPERTS), 0.01),
        "w_gate": nrm(ks[15], (DEPTH, N_EXPERTS, D_MODEL, D_EXPERT), D_MODEL ** -0.5),
        "w_up": nrm(ks[16], (DEPTH, N_EXPERTS, D_MODEL, D_EXPERT), D_MODEL ** -0.5),
        "w_down": nrm(ks[17], (DEPTH, N_EXPERTS, D_EXPERT, D_MODEL), D_EXPERT ** -0.5),
    }


def reference(x, mem, norm_mix, w_in, qk_gain, rpb, norm_mem, w_mem_kv, out_gain, w_out,
              norm_ffn, w_group, b_group, w_router, b_router, w_gate, w_up, w_down):
    bsz, seq, _ = x.shape
    mem_len = mem.shape[1]
    slopes = jnp.asarray(alibi_slopes(N_HEADS_A))
    split_at = [3 * WIDTH_A, 3 * WIDTH_A + 3 * WIDTH_B]
    for l in range(DEPTH):
        h = rms_norm(x, norm_mix[l])
        proj = jnp.einsum("bsd,de->bse", h, w_in[l])
        a_qkv, b_qkv, m_q = jnp.split(proj, split_at, axis=-1)
        qa, ka, va = (t.reshape(bsz, seq, N_HEADS_A, HEAD_DIM) for t in jnp.split(a_qkv, 3, axis=-1))
        qn, kn, vn = (t.reshape(bsz, seq, N_HEADS_B, HEAD_DIM) for t in jnp.split(b_qkv, 3, axis=-1))
        qm = m_q.reshape(bsz, seq, N_HEADS_M, HEAD_DIM)
        mem_kv = jnp.einsum("bmd,de->bme", rms_norm(mem, norm_mem[l]), w_mem_kv[l])
        km, vm = (t.reshape(bsz, mem_len, N_HEADS_M, HEAD_DIM) for t in jnp.split(mem_kv, 2, axis=-1))

        o_a = dilated_mixture_attention(rms_norm(qa, qk_gain[l, 0]), rms_norm(ka, qk_gain[l, 1]), va, slopes)
        o_b = neighbourhood_attention(rms_norm(qn, qk_gain[l, 2]), rms_norm(kn, qk_gain[l, 3]), vn, rpb[l])
        o_m = memory_attention(rms_norm(qm, qk_gain[l, 4]), rms_norm(km, qk_gain[l, 5]), vm)

        gain = out_gain[l]
        mixed = jnp.concatenate([
            rms_norm(o_a.reshape(bsz, seq, WIDTH_A), gain[:WIDTH_A]).astype(x.dtype),
            rms_norm(o_b.reshape(bsz, seq, WIDTH_B), gain[WIDTH_A:WIDTH_A + WIDTH_B]).astype(x.dtype),
            rms_norm(o_m.reshape(bsz, seq, WIDTH_M), gain[WIDTH_A + WIDTH_B:]).astype(x.dtype),
        ], axis=-1)
        x = x + jnp.einsum("bse,ed->bsd", mixed, w_out[l])

        h = rms_norm(x, norm_ffn[l])
        x = x + hierarchical_moe(h, w_group[l], b_group[l], w_router[l], b_router[l],
                                 w_gate[l], w_up[l], w_down[l])
    return x
```

```cpp
#include <hip/hip_runtime.h>
#include <cstdio>
#include <cstdint>

#ifndef PROBE_ID
#define PROBE_ID (-1)
#endif
#ifndef SPARSE_A
#define SPARSE_A 1
#endif
#ifndef MK_ONE_LAUNCH
#define MK_ONE_LAUNCH 1
#endif

constexpr int D = 1024, BATCH = 32, SEQ = 2048, T = BATCH * SEQ, DEPTH = 2;
constexpr int MEM_LEN = 256, TM = BATCH * MEM_LEN;
constexpr int HD = 64, INW = 2560, NHS = 40;
constexpr int NE = 32, EPG = 8, NGRP = 4, DE = 512;
constexpr float EPS = 1e-6f, LOG2E = 1.4426950408889634f, ATTN_SCALE = 0.125f;
constexpr int YROWS = 2 * T + NE * 256;

constexpr size_t MiB = 1u << 20;
constexpr size_t WS_CTL = 0, CTL_ZERO_BYTES = 1 * MiB;
constexpr size_t WS_WIN = 1 * MiB;
constexpr size_t WS_WMEM = WS_WIN + 10 * MiB;
constexpr size_t WS_WOUT = WS_WMEM + 2 * MiB;
constexpr size_t WS_WR = WS_WOUT + 4 * MiB;
constexpr size_t WS_WGU = WS_WR + 1 * MiB;
constexpr size_t WS_X8 = WS_WGU + 64 * MiB;
constexpr size_t WS_WD = WS_WGU + 128 * MiB;
constexpr size_t WS_FAB = WS_WD + 32 * MiB;
constexpr size_t WS_RM = WS_WD + 33 * MiB;
constexpr size_t WS_XB = WS_WD + 64 * MiB;
constexpr size_t WS_RS = WS_XB + 128 * MiB;
constexpr size_t WS_SSQ1 = WS_RS + 1 * MiB;
constexpr size_t WS_SSQH = WS_SSQ1 + 4 * MiB;
constexpr size_t WS_MB = WS_SSQH + 4 * MiB;
constexpr size_t WS_RSM = WS_MB + 16 * MiB;
constexpr size_t WS_MEMKV = WS_RSM + 1 * MiB;
constexpr size_t WS_ROUTE = WS_MEMKV + 16 * MiB;
constexpr size_t WS_LIST = WS_ROUTE + 1 * MiB;
constexpr size_t WS_WL = WS_LIST + 8 * MiB;
constexpr size_t WS_RSL = WS_WL + 8 * MiB;
constexpr size_t WS_QKV = WS_RSL + 8 * MiB;
constexpr size_t WS_MIX = WS_QKV + 320 * MiB;
constexpr size_t WS_PO = WS_MIX + 136 * MiB;
constexpr size_t WS_PL = WS_PO + 144 * MiB;
constexpr size_t WS_END = WS_PL + 6 * MiB;
static_assert(WS_END <= 1024 * MiB, "workspace map exceeds 1 GiB");
static_assert((size_t)YROWS * 1024 * 2 <= 320 * MiB && (size_t)YROWS * 512 * 4 <= 320 * MiB && (size_t)YROWS * 512 * 2 <= 136 * MiB, "aliases");
constexpr int CW_BAR = 4096;
constexpr int CW_WQ = 40960;
constexpr int CW_ATQ = 32768;
constexpr int CW_CNT = 16384;

constexpr int LDS_BYTES = 163840;
constexpr int CTRL_BASE = 159744;
constexpr int MISC_OFF = CTRL_BASE + 2048;
constexpr int NWAVES = 8;

#define GAS __attribute__((address_space(1)))
#define LAS __attribute__((address_space(3)))
typedef unsigned short bf16_t;
typedef unsigned u32x4 __attribute__((ext_vector_type(4)));
typedef unsigned u32x2 __attribute__((ext_vector_type(2)));
typedef float f32x4 __attribute__((ext_vector_type(4)));
#define RLX_AGENT __ATOMIC_RELAXED, __HIP_MEMORY_SCOPE_AGENT

__device__ __forceinline__ float bf2f(unsigned v) { return __uint_as_float(v << 16); }
__device__ __forceinline__ unsigned f2bf(float f) { unsigned u = __float_as_uint(f); return (u + 0x7fffu + ((u >> 16) & 1u)) >> 16; }
__device__ __forceinline__ unsigned pk2(float lo, float hi) { return f2bf(lo) | (f2bf(hi) << 16); }
__device__ __forceinline__ float wave_sum(float v) {
#pragma unroll
    for (int o = 1; o < 64; o <<= 1) v += __shfl_xor(v, o);
    return v;
}
__device__ __forceinline__ float wave_max(float v) {
#pragma unroll
    for (int o = 1; o < 64; o <<= 1) v = fmaxf(v, __shfl_xor(v, o));
    return v;
}

#define XB_TMO      128
#define XB_XCNT(j)  (256  + 64 * (j))
#define XB_XSUB(j)  (1280 + 64 * (j))
#define XB_XGEN(j)  (2304 + 64 * (j))
#define XB_TOP      3328
#define XB_TOPGEN   3392
#define XCD_BAR_WORDS 3456
#define XB_SPIN_CAP (1u << 18)
__device__ __forceinline__ unsigned xb_ld(unsigned* p)              { return __hip_atomic_load(p, __ATOMIC_RELAXED, __HIP_MEMORY_SCOPE_AGENT); }
__device__ __forceinline__ unsigned xb_add(unsigned* p, unsigned v) { return __hip_atomic_fetch_add(p, v, __ATOMIC_RELAXED, __HIP_MEMORY_SCOPE_AGENT); }
__device__ __forceinline__ unsigned xb_xcc_id() { return (unsigned)__builtin_amdgcn_s_getreg((3 << 11) | 20) & 0xFu; }
#define XB_SPIN(cond, bar) do { unsigned _sp = 0; while (cond) { __builtin_amdgcn_s_sleep(1); \
    if ((++_sp & 255u) == 0u) { if (xb_ld(&(bar)[XB_TMO])) break; if (_sp > XB_SPIN_CAP) { atomicAdd(&(bar)[XB_TMO], 1u); break; } } } } while (0)
struct XcdBarrier { unsigned* bar; unsigned x; volatile LAS unsigned* st; };
__device__ __forceinline__ XcdBarrier xcd_barrier_post(unsigned* bar, volatile LAS unsigned* st) {
    XcdBarrier b; b.bar = bar; b.x = xb_xcc_id(); b.st = st;
    if (threadIdx.x == 0) (void)xb_add(&bar[XB_XCNT(b.x)], 1u);
    return b;
}
__device__ __forceinline__ void xcd_barrier_complete(unsigned* bar, unsigned x, unsigned& nloc, unsigned& nx) {
    const unsigned G = gridDim.x * gridDim.y * gridDim.z;
    unsigned sum, cnt, mine, sp = 0u;
    for (;;) {
        sum = 0u; cnt = 0u; mine = 0u;
#pragma unroll
        for (unsigned j = 0; j < 16; ++j) { const unsigned c = xb_ld(&bar[XB_XCNT(j)]); sum += c; cnt += (c > 0u) ? 1u : 0u; mine = (j == x) ? c : mine; }
        if (sum == G) break;
        __builtin_amdgcn_s_sleep(1);
        if ((++sp & 255u) == 0u) { if (xb_ld(&bar[XB_TMO])) break; if (sp > XB_SPIN_CAP) { atomicAdd(&bar[XB_TMO], 1u); break; } }
    }
    nloc = mine > 0u ? mine : 1u; nx = cnt > 0u ? cnt : 1u;
}
__device__ __forceinline__ void xcd_barrier(const XcdBarrier& b) {
    asm volatile("s_waitcnt vmcnt(0)" ::: "memory");
    __syncthreads();
    if (threadIdx.x == 0) {
        unsigned* bar = b.bar;
        __builtin_amdgcn_s_waitcnt(0);
        unsigned nloc = b.st[0], nx = b.st[1];
        if (nloc == 0u) { xcd_barrier_complete(bar, b.x, nloc, nx); b.st[0] = nloc; b.st[1] = nx; }
        const unsigned old = xb_add(&bar[XB_XSUB(b.x)], 1u);
        const unsigned gen = old / nloc;
        if (old + 1u == (gen + 1u) * nloc) {
            __builtin_amdgcn_fence(__ATOMIC_RELEASE, "agent");
            asm volatile("s_waitcnt vmcnt(0)" ::: "memory");
            const unsigned og = xb_add(&bar[XB_TOP], 1u);
            const unsigned tg = og / nx;
            if (og + 1u == (tg + 1u) * nx) xb_add(&bar[XB_TOPGEN], 1u);
            else XB_SPIN(xb_ld(&bar[XB_TOPGEN]) == tg, bar);
            __builtin_amdgcn_fence(__ATOMIC_ACQUIRE, "agent");
            xb_add(&bar[XB_XGEN(b.x)], 1u);
            asm volatile("s_waitcnt vmcnt(0)" ::: "memory");
        } else {
            XB_SPIN(xb_ld(&bar[XB_XGEN(b.x)]) == gen, bar);
            __builtin_amdgcn_fence(__ATOMIC_ACQUIRE, "agent");
            asm volatile("s_waitcnt vmcnt(0)" ::: "memory");
        }
    }
    __syncthreads();
}

struct Args {
    const float* in[18]; float* out; unsigned char* ws; int ph_lo, ph_hi;
};
__device__ __forceinline__ const float* in_ptr(int k) {
    const __attribute__((address_space(4))) char* ka = (const __attribute__((address_space(4))) char*)__builtin_amdgcn_kernarg_segment_ptr();
    asm volatile("" : "+s"(ka));
    return *(const float* const __attribute__((address_space(4)))*)(ka + 8 * k);
}
struct Frame {
    LAS unsigned char* lds; int tid, lane, wave, G, gw, ngw;
    float* out; unsigned char* ws; unsigned* ctl;
};

#define PHASE_IDS(F) do { (F).tid = opaque_tid0(); (F).lane = (F).tid & 63; (F).wave = __builtin_amdgcn_readfirstlane((F).tid >> 6); (F).gw = blockIdx.x * NWAVES + (F).wave; } while (0)
__device__ __forceinline__ int opaque_tid0() { int t = threadIdx.x; asm volatile("" : "+v"(t)); return t; }
__host__ __device__ __forceinline__ int inproj_gemm_col(int H, int dim) {
    const int pn = H >> 2, wc = H & 3, bj = dim >> 5, fq = (dim >> 3) & 3, nn = (dim >> 2) & 1, j = dim & 3;
    return 256 * pn + 128 * bj + 32 * wc + 16 * nn + 4 * fq + j;
}
__host__ __device__ __forceinline__ void inproj_head_dim(int c, int& H, int& dim) {
    const int pn = c >> 8, r = c & 255, bj = r >> 7, wc = (r >> 5) & 3, nn = (r >> 4) & 1, fq = (r >> 2) & 3, j = r & 3;
    H = 4 * pn + wc; dim = 32 * bj + 8 * fq + 4 * nn + j;
}

struct TrItem { const float* W; const float* kgain; bf16_t* WT; int K, N, kind, item; };
__device__ __forceinline__ void tr_load(const TrItem& d, int lane, float (&wv)[32]) {
    const int nblk = d.N / 32, kb = d.item / nblk, nb = d.item % nblk, k0 = 64 * kb, n0 = 32 * nb;
#pragma unroll
    for (int i = 0; i < 32; ++i) wv[i] = d.W[(size_t)(k0 + 2 * i + (lane >> 5)) * d.N + n0 + (lane & 31)];
}
__device__ __forceinline__ int tr_rowmap(int kind, int n);
__device__ __forceinline__ void tr_finish(const TrItem& d, int lane, const float (&wv)[32], LAS float* scr) {
    const int nblk = d.N / 32, kb = d.item / nblk, nb = d.item % nblk, k0 = 64 * kb, n0 = 32 * nb;
#pragma unroll
    for (int i = 0; i < 32; ++i) { const int kk = 2 * i + (lane >> 5); const float g = d.kgain ? d.kgain[k0 + kk] : 1.f; scr[kk * 33 + (lane & 31)] = wv[i] * g; }
    asm volatile("s_waitcnt lgkmcnt(0)" ::: "memory");
    const int c = lane & 7;
#pragma unroll
    for (int j = 0; j < 4; ++j) { const int n = (lane >> 3) + 8 * j; const LAS float* s = scr + (8 * c) * 33 + n;
        u32x4 o; o.x = pk2(s[0 * 33], s[1 * 33]); o.y = pk2(s[2 * 33], s[3 * 33]); o.z = pk2(s[4 * 33], s[5 * 33]); o.w = pk2(s[6 * 33], s[7 * 33]);
        if (d.kind >= 5) {
            int w0 = 0, w1 = 0;
            w0 = __builtin_amdgcn_cvt_pk_fp8_f32(32.f * s[0 * 33], 32.f * s[1 * 33], w0, false); w0 = __builtin_amdgcn_cvt_pk_fp8_f32(32.f * s[2 * 33], 32.f * s[3 * 33], w0, true);
            w1 = __builtin_amdgcn_cvt_pk_fp8_f32(32.f * s[4 * 33], 32.f * s[5 * 33], w1, false); w1 = __builtin_amdgcn_cvt_pk_fp8_f32(32.f * s[6 * 33], 32.f * s[7 * 33], w1, true);
            u32x2 o8; o8.x = (unsigned)w0; o8.y = (unsigned)w1;
            *(u32x2*)((unsigned char*)d.WT + (size_t)tr_rowmap(d.kind, n0 + n) * d.K + k0 + 8 * c) = o8;
        } else *(u32x4*)(d.WT + (size_t)tr_rowmap(d.kind, n0 + n) * d.K + k0 + 8 * c) = o; }
    asm volatile("s_waitcnt lgkmcnt(0)" ::: "memory");
}
struct RmId { __device__ __forceinline__ int operator()(int n) const { return n; } };
struct RmHead { __device__ __forceinline__ int operator()(int n) const { return inproj_gemm_col(n >> 6, n & 63); } };
__host__ __device__ __forceinline__ int perm_row32(int c) { const int o = c & 31; return (c & ~31) | (16 * ((o >> 2) & 1) + 4 * (o >> 3) + (o & 3)); }
__host__ __device__ __forceinline__ int gate_row(int c, int up) { return 256 * (c >> 7) + 128 * up + perm_row32(c & 127); }
struct RmGate { int up; __device__ __forceinline__ int operator()(int n) const { return gate_row(n, up); } };
struct RmPerm { __device__ __forceinline__ int operator()(int n) const { return perm_row32(n); } };
__device__ __forceinline__ int tr_rowmap(int kind, int n) { return kind == 0 ? n : (kind == 1 ? inproj_gemm_col(n >> 6, n & 63) : ((kind == 2 || kind == 6) ? gate_row(n, 0) : ((kind == 3 || kind == 7) ? gate_row(n, 1) : perm_row32(n)))); }

__device__ __forceinline__ TrItem tr_decode_small(int it) {
    constexpr int I_IN = 16 * 80, I_MEM = 16 * 16, I_OUT = 16 * 32, PER_L = I_IN + I_MEM + I_OUT;
    const int l = it / PER_L; int r = it % PER_L;
    if (r < I_IN) return TrItem{in_ptr(3) + (size_t)l * D * INW, in_ptr(2) + l * D, (bf16_t*)nullptr, D, INW, 100 + l, r};
    r -= I_IN;
    if (r < I_MEM) return TrItem{in_ptr(7) + (size_t)l * D * 512, in_ptr(6) + l * D, (bf16_t*)nullptr, D, 512, 200 + l, r};
    r -= I_MEM;
    return TrItem{in_ptr(9) + (size_t)l * D * D, in_ptr(8) + l * D, (bf16_t*)nullptr, D, D, 300 + l, r};
}
__device__ __forceinline__ void phase_weights(Frame& F) {
    PHASE_IDS(F);
    LAS float* scr = (LAS float*)(F.lds + F.wave * 16384);
    constexpr int PER_L = 16 * 80 + 16 * 16 + 16 * 32, NIT = DEPTH * PER_L;
    auto fix = [&](TrItem d) { const int l = d.kind % 100, w = d.kind / 100;
        if (w == 1) { d.WT = (bf16_t*)(F.ws + WS_WIN) + (size_t)l * INW * D; d.kind = 1; } else if (w == 2) { d.WT = (bf16_t*)(F.ws + WS_WMEM) + (size_t)l * 512 * D; d.kind = 1; } else { d.WT = (bf16_t*)(F.ws + WS_WOUT) + (size_t)l * D * D; d.kind = 4; }
        return d; };
    float wa[32], wb[32];
    int it = F.gw;
    if (it < NIT) { TrItem d = fix(tr_decode_small(it)); tr_load(d, F.lane, wa);
        for (;;) {
            const int it2 = it + F.ngw; TrItem d2 = d; const bool more = it2 < NIT;
            if (more) { d2 = fix(tr_decode_small(it2)); tr_load(d2, F.lane, wb); }
            tr_finish(d, F.lane, wa, scr);
            if (!more) break;
            const int it3 = it2 + F.ngw; const bool more3 = it3 < NIT; TrItem d3 = d2;
            if (more3) { d3 = fix(tr_decode_small(it3)); tr_load(d3, F.lane, wa); }
            tr_finish(d2, F.lane, wb, scr);
            if (!more3) break;
            it = it3; d = d3;
        } }
    for (int i = F.gw * 64 + F.lane; i < DEPTH * 256 * D; i += F.ngw * 64) {
        const int l = i / (256 * D), j = (i / D) % 256, k = i % D; float v = 0.f;
        if (j < 4) v = in_ptr(11)[((size_t)l * D + k) * NGRP + j] * in_ptr(10)[l * D + k]; else if (j < 36) v = in_ptr(13)[((size_t)l * D + k) * NE + (j - 4)] * in_ptr(10)[l * D + k];
        ((bf16_t*)(F.ws + WS_WR))[i] = (bf16_t)f2bf(v);
    }
}

__device__ __forceinline__ void row_to_bf16_rs(int lane, const float* xrow, bf16_t* orow, float* rs) {
    const f32x4* xr = (const f32x4*)xrow + lane; f32x4 v[4]; float s = 0.f;
#pragma unroll
    for (int j = 0; j < 4; ++j) { v[j] = xr[64 * j]; s += (v[j].x * v[j].x + v[j].y * v[j].y) + (v[j].z * v[j].z + v[j].w * v[j].w); }
    s = wave_sum(s);
    if (lane == 0) *rs = 1.0f / sqrtf(s * (1.f / D) + EPS);
    u32x2* o8 = (u32x2*)orow + lane;
#pragma unroll
    for (int j = 0; j < 4; ++j) { u32x2 w; w.x = pk2(v[j].x, v[j].y); w.y = pk2(v[j].z, v[j].w); o8[64 * j] = w; }
}
__device__ __forceinline__ void phase_x0(Frame& F) {
    PHASE_IDS(F);
    const float* xp = in_ptr(0); const float* mp = in_ptr(1); const int lane = F.lane;
    for (int m0 = F.gw * 2; m0 < T + TM; m0 += F.ngw * 2) {
        const bool isx = m0 < T; const int r0 = isx ? m0 : m0 - T;
        const float* src = (isx ? xp : mp) + (size_t)r0 * D; bf16_t* dst = (bf16_t*)(F.ws + (isx ? WS_XB : WS_MB)) + (size_t)r0 * D; float* rs = (float*)(F.ws + (isx ? WS_RS : WS_RSM)) + r0;
        f32x4 v[2][4];
#pragma unroll
        for (int k = 0; k < 2; ++k)
#pragma unroll
            for (int j = 0; j < 4; ++j) v[k][j] = ((const f32x4*)(src + (size_t)k * D) + lane)[64 * j];
#pragma unroll
        for (int k = 0; k < 2; ++k) { float s = 0.f;
#pragma unroll
            for (int j = 0; j < 4; ++j) s += (v[k][j].x * v[k][j].x + v[k][j].y * v[k][j].y) + (v[k][j].z * v[k][j].z + v[k][j].w * v[k][j].w);
            s = wave_sum(s);
            if (lane == 0) rs[k] = 1.0f / sqrtf(s * (1.f / D) + EPS);
            u32x2* o8 = (u32x2*)(dst + (size_t)k * D) + lane;
#pragma unroll
            for (int j = 0; j < 4; ++j) { u32x2 w; w.x = pk2(v[k][j].x, v[k][j].y); w.y = pk2(v[k][j].z, v[k][j].w); o8[64 * j] = w; } }
    }
}

__device__ __forceinline__ bf16_t* qkv_ptr(Frame& F, int H, int t) { return (bf16_t*)(F.ws + WS_QKV) + ((size_t)H * T + t) * HD; }
__device__ __forceinline__ bf16_t* memkv_ptr(Frame& F, int l, int H, int r) { return (bf16_t*)(F.ws + WS_MEMKV) + (((size_t)l * 8 + H) * TM + r) * HD; }

__device__ __forceinline__ void slice_kind(int H, int& gi, bool& isq) {
    gi = -1; isq = false;
    if (H < 6) { gi = 0; isq = true; } else if (H < 12) gi = 1; else if (H < 18) gi = -1;
    else if (H < 24) { gi = 2; isq = true; } else if (H < 30) gi = 3; else if (H < 36) gi = -1; else { gi = 4; isq = true; }
}
__device__ __forceinline__ void phase_groupnorm(Frame& F) {
    PHASE_IDS(F);
    const int lane = F.lane, half = lane >> 5, l32 = lane & 31, h = l32 >> 2; const bool act = l32 < 24;
    const bf16_t* PO = (const bf16_t*)(F.ws + WS_PO); const float* PL = (const float*)(F.ws + WS_PL); bf16_t* MX = (bf16_t*)(F.ws + WS_MIX);
    const float* SQ = (const float*)(F.ws + WS_SSQH); float* FAB = (float*)(F.ws + WS_FAB); float* RM = (float*)(F.ws + WS_RM);
    for (int t0 = F.gw * 8; t0 < T; t0 += F.ngw * 8) {
        u32x4 raw[4][3][2]; float den[4][3]; f32x4 sq[4][3];
#pragma unroll
        for (int u = 0; u < 4; ++u) { const int t = t0 + 2 * u + half;
            if (act) {
#pragma unroll
                for (int p = 0; p < 3; ++p) { const u32x4* pp = (const u32x4*)(PO + ((size_t)p * T + t) * 384 + l32 * 16); raw[u][p][0] = pp[0]; raw[u][p][1] = pp[1]; den[u][p] = PL[((size_t)p * T + t) * 8 + h]; }
            }
#pragma unroll
            for (int q = 0; q < 3; ++q) sq[u][q] = *(const f32x4*)(SQ + (size_t)t * 16 + 4 + 4 * q);
        }
#pragma unroll
        for (int u = 0; u < 4; ++u) { const int t = t0 + 2 * u + half; float v[16]; float s = 0.f;
            if (act) {
#pragma unroll
                for (int i = 0; i < 2; ++i) { const u32x4 w = raw[u][0][i]; v[8 * i + 0] = bf2f(w.x & 0xffffu); v[8 * i + 1] = bf2f(w.x >> 16); v[8 * i + 2] = bf2f(w.y & 0xffffu); v[8 * i + 3] = bf2f(w.y >> 16);
                    v[8 * i + 4] = bf2f(w.z & 0xffffu); v[8 * i + 5] = bf2f(w.z >> 16); v[8 * i + 6] = bf2f(w.w & 0xffffu); v[8 * i + 7] = bf2f(w.w >> 16); }
#pragma unroll
                for (int p = 1; p < 3; ++p)
#pragma unroll
                    for (int i = 0; i < 2; ++i) { const u32x4 w = raw[u][p][i]; v[8 * i + 0] += bf2f(w.x & 0xffffu); v[8 * i + 1] += bf2f(w.x >> 16); v[8 * i + 2] += bf2f(w.y & 0xffffu); v[8 * i + 3] += bf2f(w.y >> 16);
                        v[8 * i + 4] += bf2f(w.z & 0xffffu); v[8 * i + 5] += bf2f(w.z >> 16); v[8 * i + 6] += bf2f(w.w & 0xffffu); v[8 * i + 7] += bf2f(w.w >> 16); }
                const float rd = 1.0f / ((den[u][0] + den[u][1]) + den[u][2]);
                u32x4 o[2];
#pragma unroll
                for (int i = 0; i < 2; ++i) { o[i].x = pk2(v[8 * i + 0] * rd, v[8 * i + 1] * rd); o[i].y = pk2(v[8 * i + 2] * rd, v[8 * i + 3] * rd); o[i].z = pk2(v[8 * i + 4] * rd, v[8 * i + 5] * rd); o[i].w = pk2(v[8 * i + 6] * rd, v[8 * i + 7] * rd);
                    float a;
                    a = bf2f(o[i].x & 0xffffu); s += a * a; a = bf2f(o[i].x >> 16); s += a * a; a = bf2f(o[i].y & 0xffffu); s += a * a; a = bf2f(o[i].y >> 16); s += a * a;
                    a = bf2f(o[i].z & 0xffffu); s += a * a; a = bf2f(o[i].z >> 16); s += a * a; a = bf2f(o[i].w & 0xffffu); s += a * a; a = bf2f(o[i].w >> 16); s += a * a; }
                u32x4* mp = (u32x4*)(MX + (size_t)t * D + l32 * 16); mp[0] = o[0]; mp[1] = o[1];
            }
            s += __shfl_xor(s, 1); s += __shfl_xor(s, 2); s += __shfl_xor(s, 4); s += __shfl_xor(s, 8); s += __shfl_xor(s, 16);
            if (l32 == 0) {
                const float sb = ((sq[u][0][2] + sq[u][0][3]) + (sq[u][1][0] + sq[u][1][1])) + (sq[u][1][2] + sq[u][1][3]), sm = (sq[u][2][0] + sq[u][2][1]) + (sq[u][2][2] + sq[u][2][3]);
                const float ra = 1.f / sqrtf(s * (1.f / 384.f) + EPS), rb = 1.f / sqrtf(sb * (1.f / 384.f) + EPS), rmv = 1.f / sqrtf(sm * (1.f / 256.f) + EPS);
                FAB[(size_t)t * 2] = ra / rb; FAB[(size_t)t * 2 + 1] = rb / rmv; RM[t] = rmv; }
        }
    }
}
__device__ __forceinline__ void load_expert_table(LAS int* tab, const unsigned* cnt) {
    const int tid = opaque_tid0(), lane = tid & 63;
    if (tid < 64) {
        const int c = lane < NE ? (int)__hip_atomic_load(cnt + lane * 64, RLX_AGENT) : 0;
        int inc = (c + 255) >> 8;
#pragma unroll
        for (int o = 1; o < 64; o <<= 1) { const int v = __shfl_up(inc, o); if (lane >= o) inc += v; }
        tab[lane] = inc - ((c + 255) >> 8); tab[64 + lane] = c;
    }
    __syncthreads();
}
__device__ __forceinline__ void phase_combine(Frame& F, int l) {
    PHASE_IDS(F);
    LAS int* tab = (LAS int*)(F.lds + CTRL_BASE);
    load_expert_table(tab, F.ctl + CW_CNT + l * NE * 64);
    const unsigned char* Y = (const unsigned char*)(F.ws + WS_QKV); const int lane = F.lane;
    typedef float f32x2_t __attribute__((ext_vector_type(2)));
    typedef int i32x4_t __attribute__((ext_vector_type(4)));
    constexpr int TK = 2;
    for (int t0 = F.gw * TK; t0 < T; t0 += F.ngw * TK) {
        i32x4_t rt[TK];
#pragma unroll
        for (int k = 0; k < TK; ++k) rt[k] = *(const i32x4_t*)((const int*)(F.ws + WS_ROUTE) + (size_t)(t0 + k) * 4);
        u32x2 xv[TK][4]; unsigned ya[TK][4], yb[TK][4];
#pragma unroll
        for (int k = 0; k < TK; ++k) { int ea = rt[k][0], pa = rt[k][1], eb = rt[k][2], pb = rt[k][3];
            if (ea > eb) { int q = ea; ea = eb; eb = q; q = pa; pa = pb; pb = q; }
            const unsigned* pya = (const unsigned*)(Y + (size_t)(tab[ea] * 256 + pa) * D) + lane; const unsigned* pyb = (const unsigned*)(Y + (size_t)(tab[eb] * 256 + pb) * D) + lane;
            const u32x2* xr = (const u32x2*)((const bf16_t*)(F.ws + WS_XB) + (size_t)(t0 + k) * D) + lane;
#pragma unroll
            for (int j = 0; j < 4; ++j) { xv[k][j] = xr[64 * j]; ya[k][j] = pya[64 * j]; yb[k][j] = pyb[64 * j]; } }
#pragma unroll
        for (int k = 0; k < TK; ++k) { const int t = t0 + k; f32x4 v[4]; float s = 0.f;
#pragma unroll
            for (int j = 0; j < 4; ++j) { const u32x2 x = xv[k][j]; const int a = (int)ya[k][j], b2 = (int)yb[k][j];
                const f32x2_t a0 = __builtin_amdgcn_cvt_pk_f32_fp8(a, false), a1 = __builtin_amdgcn_cvt_pk_f32_fp8(a, true), b0 = __builtin_amdgcn_cvt_pk_f32_fp8(b2, false), b1 = __builtin_amdgcn_cvt_pk_f32_fp8(b2, true);
                v[j].x = (bf2f(x.x & 0xffffu) + 0.125f * a0[0]) + 0.125f * b0[0]; v[j].y = (bf2f(x.x >> 16) + 0.125f * a0[1]) + 0.125f * b0[1];
                v[j].z = (bf2f(x.y & 0xffffu) + 0.125f * a1[0]) + 0.125f * b1[0]; v[j].w = (bf2f(x.y >> 16) + 0.125f * a1[1]) + 0.125f * b1[1]; }
            if (l + 1 < DEPTH) {
                u32x2* o8 = (u32x2*)((bf16_t*)(F.ws + WS_XB) + (size_t)t * D) + lane;
#pragma unroll
                for (int j = 0; j < 4; ++j) { u32x2 w; w.x = pk2(v[j].x, v[j].y); w.y = pk2(v[j].z, v[j].w); o8[64 * j] = w;
                    const float o0 = bf2f(w.x & 0xffffu), o1 = bf2f(w.x >> 16), o2 = bf2f(w.y & 0xffffu), o3 = bf2f(w.y >> 16); s += (o0 * o0 + o1 * o1) + (o2 * o2 + o3 * o3); }
                s = wave_sum(s);
                if (lane == 0) ((float*)(F.ws + WS_RS))[t] = 1.0f / sqrtf(s * (1.f / D) + EPS);
            } else {
                f32x4* xo = (f32x4*)(F.out + (size_t)t * D) + lane;
#pragma unroll
                for (int j = 0; j < 4; ++j) xo[64 * j] = v[j];
            }
        }
    }
}

namespace g8 {
typedef short bf16x8 __attribute__((ext_vector_type(8)));
constexpr int BK = 64, HALF = 128, HTB = HALF * BK * 2, NXCD = 8, WGM = 8;
__device__ __forceinline__ int lds_byte(int r, int c) { const int st = (r >> 4) * 2 + (c >> 5), rr = r & 15, cc = c & 31, ob = rr * 64 + cc * 2; return st * 1024 + (ob ^ (((ob >> 9) & 1) << 5)); }
__device__ __forceinline__ void stage_rc(int b, int& R, int& C) { const int st = b / 1024, sb = b % 1024, swz = sb ^ (((sb >> 9) & 1) << 5); R = (st >> 1) * 16 + swz / 64; C = (st & 1) * 32 + (swz % 64) / 2; }
__device__ __forceinline__ unsigned cvt_pk_bf16(float lo, float hi) { unsigned r; asm volatile("v_cvt_pk_bf16_f32 %0, %1, %2" : "=v"(r) : "v"(lo), "v"(hi)); return r; }
__device__ __forceinline__ int opaque_tid() { int t = threadIdx.x; asm volatile("" : "+v"(t)); return t; }
__device__ __forceinline__ const char* uni(const char* p) { const unsigned long long v = (unsigned long long)p;
    return (const char*)(((unsigned long long)(unsigned)__builtin_amdgcn_readfirstlane((int)(v >> 32)) << 32) | (unsigned)__builtin_amdgcn_readfirstlane((int)v)); }
typedef int i32x8 __attribute__((ext_vector_type(8)));
typedef int i32x4v __attribute__((ext_vector_type(4)));
__device__ __forceinline__ float clamp8(float v) { return fminf(fmaxf(v, -440.f), 440.f); }
__device__ __forceinline__ i32x8 cat8(i32x4v a, i32x4v b) { return __builtin_shufflevector(a, b, 0, 1, 2, 3, 4, 5, 6, 7); }
__device__ __forceinline__ bf16x8 lo8(i32x8 v) { return __builtin_bit_cast(bf16x8, (i32x4v)__builtin_shufflevector(v, v, 0, 1, 2, 3)); }
__device__ __forceinline__ bf16x8 hi8(i32x8 v) { return __builtin_bit_cast(bf16x8, (i32x4v)__builtin_shufflevector(v, v, 4, 5, 6, 7)); }
struct Unit { const char* B; unsigned a00, a01, a10, a11; int pm, pn, e, ti, ce; };
struct DenseSched {
    int nM, nN, nwg, G, c, K; const char* Bbase;
    __device__ __forceinline__ void init(int M, int N, int K_, int G_, int c_, int tid, const void* Bt) { nM = M / 256; nN = N / 256; nwg = nM * nN; G = G_; c = c_; K = K_; Bbase = (const char*)Bt; }
    __device__ __forceinline__ bool next(int i, Unit& u) const {
        const long L = (long)i * G + c; if (L >= nwg) return false;
        int wgid = (int)L; { const int q = nwg / NXCD, r = nwg % NXCD, xcd = wgid % NXCD, off = wgid / NXCD; wgid = (xcd < r ? xcd * (q + 1) : r * (q + 1) + (xcd - r) * q) + off; }
        const int nig = WGM * nN, gid = wgid / nig, fm = gid * WGM, gsz = (nM - fm) < WGM ? (nM - fm) : WGM;
        u.pm = fm + ((wgid % nig) % gsz); u.pn = (wgid % nig) / gsz; u.e = 0; u.ti = 0; u.ce = 0;
        u.B = Bbase + (size_t)u.pn * 256 * K * 2;
        int R[2], C[2]; { const int tid = opaque_tid(); stage_rc(tid * 16, R[0], C[0]); stage_rc(tid * 16 + 8192, R[1], C[1]); }
        u.a00 = (unsigned)((u.pm * 256 + R[0]) * K + C[0]) * 2u; u.a01 = (unsigned)((u.pm * 256 + R[1]) * K + C[1]) * 2u;
        u.a10 = (unsigned)((u.pm * 256 + 128 + R[0]) * K + C[0]) * 2u; u.a11 = (unsigned)((u.pm * 256 + 128 + R[1]) * K + C[1]) * 2u;
        return true;
    }
};
struct GroupSched {
    int NP, total, G, vb, K; const char* Bbase; size_t Bstride; const int* list; bool gather; LAS int* tab;
    __device__ __forceinline__ void init(LAS int* tab_, const unsigned* cnt, int NP_, int K_, int G_, int bid, const void* Bt, size_t Bstride_, const int* list_, bool gather_) {
        const int tid = opaque_tid(), lane = tid & 63; NP = NP_; K = K_; G = G_; vb = (G_ % 8 == 0) ? (bid % 8) * (G_ / 8) + bid / 8 : bid; Bbase = (const char*)Bt; Bstride = Bstride_; list = list_; gather = gather_; tab = tab_;
        const int c = lane < NE ? (int)__hip_atomic_load(cnt + lane * 64, RLX_AGENT) : 0;
        int inc = (c + 255) >> 8;
#pragma unroll
        for (int o = 1; o < 64; o <<= 1) { const int v = __shfl_up(inc, o); if (lane >= o) inc += v; }
        total = __builtin_amdgcn_readfirstlane(__shfl(inc, 63)) * NP;
        if (tid < 64) { tab[lane] = inc - ((c + 255) >> 8); tab[64 + lane] = c; }
        __syncthreads();
    }
    __device__ __forceinline__ bool next(int i, Unit& u) const {
        const int L = i * G + vb; if (L >= total) return false;
        const int tid = opaque_tid(), g = L / NP, lane = tid & 63; u.pn = L % NP; u.pm = g;
        int R[2], C[2]; stage_rc(tid * 16, R[0], C[0]); stage_rc(tid * 16 + 8192, R[1], C[1]);
        const int e = __builtin_amdgcn_readfirstlane(__popcll(__ballot(lane < NE && tab[lane] <= g)) - 1);
        u.e = e; u.ti = g - __builtin_amdgcn_readfirstlane(tab[e]); u.ce = __builtin_amdgcn_readfirstlane(tab[64 + e]);
        u.B = Bbase + (size_t)e * Bstride + (size_t)u.pn * 256 * K * 2;
        if (gather) {
            const int* le = list + (size_t)e * T; const int b = u.ti * 256, mx = u.ce - 1;
            const int t00 = le[min(b + R[0], mx)], t01 = le[min(b + R[1], mx)], t10 = le[min(b + 128 + R[0], mx)], t11 = le[min(b + 128 + R[1], mx)];
            u.a00 = (unsigned)(t00 * K + C[0]) * 2u; u.a01 = (unsigned)(t01 * K + C[1]) * 2u; u.a10 = (unsigned)(t10 * K + C[0]) * 2u; u.a11 = (unsigned)(t11 * K + C[1]) * 2u;
        } else {
            u.a00 = (unsigned)((g * 256 + R[0]) * K + C[0]) * 2u; u.a01 = (unsigned)((g * 256 + R[1]) * K + C[1]) * 2u;
            u.a10 = (unsigned)((g * 256 + 128 + R[0]) * K + C[0]) * 2u; u.a11 = (unsigned)((g * 256 + 128 + R[1]) * K + C[1]) * 2u;
        }
        return true;
    }
};

template <class Epi, class Sched>
__device__ __forceinline__ void gemm_phase(LAS unsigned char* lds, const void* Abase_, int K, const Sched& S, const Epi& E) {
    const int tid = opaque_tid(), wid = __builtin_amdgcn_readfirstlane(tid >> 6), lane = tid & 63, wr = wid >> 2, wc = wid & 3, fr = lane & 15, fq = lane >> 4;
    int nt = K / BK; asm volatile("" : "+s"(nt)); const char* Abase = (const char*)Abase_;
    unsigned voffB[2];
#pragma unroll
    for (int i = 0; i < 2; ++i) { int R, C; stage_rc(tid * 16 + i * 8192, R, C); voffB[i] = (unsigned)(R * K + C) * 2u; }
    const size_t kstep = (size_t)(BK * 2), hstep = (size_t)HALF * K * 2;
    const unsigned ldsw = (unsigned)wid * 1024u;
    const int aoff = lds_byte(wr * 64 + fr, fq * 8), boff = lds_byte(wc * 32 + fr, fq * 8);
#define G8_SA(b, h) (((b) * 2 + (h)) * HTB)
#define G8_SB(b, h) ((4 + (b) * 2 + (h)) * HTB)
#define G8_STAGE(bufoff, gbase, voff) do { const char* _g = uni((const char*)(gbase)); _Pragma("unroll") for (int _i = 0; _i < 2; ++_i) \
        __builtin_amdgcn_global_load_lds((const unsigned*)(_g + (voff)[_i]), (LAS unsigned*)(lds + (bufoff) + ldsw + _i * 8192), 16, 0, 0); } while (0)
#define G8_STAGE_A(bufoff, gbase, o0, o1) do { const char* _g = uni((const char*)(gbase)); \
        __builtin_amdgcn_global_load_lds((const unsigned*)(_g + (o0)), (LAS unsigned*)(lds + (bufoff) + ldsw), 16, 0, 0); \
        __builtin_amdgcn_global_load_lds((const unsigned*)(_g + (o1)), (LAS unsigned*)(lds + (bufoff) + ldsw + 8192), 16, 0, 0); } while (0)
#define G8_LDA(dst, b, h) do { _Pragma("unroll") for (int m = 0; m < 4; ++m) dst[m] = cat8(*(const LAS i32x4v*)(lds + G8_SA(b, h) + aoff + m * 2048), *(const LAS i32x4v*)(lds + G8_SA(b, h) + aoff + m * 2048 + 1024)); } while (0)
#define G8_LDB(dst, b, h) do { _Pragma("unroll") for (int n = 0; n < 2; ++n) dst[n] = cat8(*(const LAS i32x4v*)(lds + G8_SB(b, h) + boff + n * 2048), *(const LAS i32x4v*)(lds + G8_SB(b, h) + boff + n * 2048 + 1024)); } while (0)
#define G8_MMA(ai, bj, At, Bt) do { __builtin_amdgcn_s_setprio(1); _Pragma("unroll") for (int m = 0; m < 4; ++m) _Pragma("unroll") for (int n = 0; n < 2; ++n) { \
        if constexpr (Epi::FP8) acc[ai][bj][m][n] = __builtin_amdgcn_mfma_scale_f32_16x16x128_f8f6f4(Bt[n], At[m], acc[ai][bj][m][n], 0, 0, 0, 0x7F7F7F7F, 0, 0x7F7F7F7F); \
        else { acc[ai][bj][m][n] = __builtin_amdgcn_mfma_f32_16x16x32_bf16(lo8(Bt[n]), lo8(At[m]), acc[ai][bj][m][n], 0, 0, 0); \
               acc[ai][bj][m][n] = __builtin_amdgcn_mfma_f32_16x16x32_bf16(hi8(Bt[n]), hi8(At[m]), acc[ai][bj][m][n], 0, 0, 0); } } __builtin_amdgcn_s_setprio(0); } while (0)
#define G8_WAIT_V(n) asm volatile("s_waitcnt vmcnt(" #n ")" ::: "memory")
#define G8_WAIT_L(n) asm volatile("s_waitcnt lgkmcnt(" #n ")" ::: "memory")
#define G8_BAR __builtin_amdgcn_s_barrier()
#define G8_SCHED __builtin_amdgcn_sched_barrier(0)
    Unit cur, nxt; int ui = 0;
    if (!S.next(0, cur)) return;
    constexpr int FACL = 131072;
#define G8_FAC(u_, par_) __builtin_amdgcn_global_load_lds((const unsigned*)(E.fab + (size_t)(u_).pm * 512 + tid), (LAS unsigned*)(lds + FACL + (par_) * 2048 + wid * 256), 4, 0, 0)
    if constexpr (Epi::RESCALE) G8_FAC(cur, 0);
    constexpr int ROWL = 131072 + 4096;
#define G8_ROWS(u_, par_) do { if (wid < 4) __builtin_amdgcn_global_load_lds((const unsigned*)E.rowsrc(u_, tid), (LAS unsigned*)(lds + ROWL + (par_) * 1024 + wid * 256), 4, 0, 0); } while (0)
    if constexpr (Epi::ROWS) G8_ROWS(cur, 0);
    f32x4 acc[2][2][4][2];
#pragma unroll
    for (int a = 0; a < 2; ++a)
#pragma unroll
        for (int b = 0; b < 2; ++b)
#pragma unroll
            for (int m = 0; m < 4; ++m)
#pragma unroll
                for (int n = 0; n < 2; ++n) acc[a][b][m][n] = (f32x4){0.f, 0.f, 0.f, 0.f};
    i32x8 At[4], B0[2], B1[2];
    unsigned a00 = cur.a00, a01 = cur.a01, a10 = cur.a10, a11 = cur.a11;
    G8_STAGE(G8_SB(0, 0), cur.B, voffB); G8_STAGE(G8_SB(0, 1), cur.B + hstep, voffB); G8_STAGE_A(G8_SA(0, 0), Abase, a00, a01); G8_STAGE_A(G8_SA(0, 1), Abase, a10, a11);
    if (wr == 1) G8_BAR;
    G8_WAIT_V(2); G8_BAR;
    G8_STAGE(G8_SB(1, 0), cur.B + kstep, voffB); G8_STAGE_A(G8_SA(1, 0), Abase + kstep, a00, a01); G8_STAGE(G8_SB(1, 1), cur.B + hstep + kstep, voffB);
    G8_WAIT_V(6); G8_BAR;
    for (;;) {
        bool has_next = false; const char* curB = cur.B; const char* nB = curB;
        for (int t = 0; t < nt; t += 2) {
            const bool last = (t == nt - 2);
            if (t == nt - 4) { has_next = S.next(ui + 1, nxt); if (has_next) nB = nxt.B;
                if constexpr (Epi::RESCALE) { if (has_next) G8_FAC(nxt, (ui + 1) & 1); }
                if constexpr (Epi::ROWS) { if (has_next) G8_ROWS(nxt, (ui + 1) & 1); } }
            if constexpr (Epi::RESCALE) {
                if (t == 6 || t == 12) { const LAS float* fl = (const LAS float*)(lds + FACL + (ui & 1) * 2048) + (t == 12 ? 1 : 0);
#pragma unroll
                    for (int ai = 0; ai < 2; ++ai)
#pragma unroll
                        for (int m = 0; m < 4; ++m) { const float f = fl[(ai * HALF + wr * 64 + m * 16 + fr) * 2];
#pragma unroll
                            for (int bj = 0; bj < 2; ++bj)
#pragma unroll
                                for (int n = 0; n < 2; ++n) acc[ai][bj][m][n] = acc[ai][bj][m][n] * f; } } }
            const char* a1 = Abase + (size_t)(t + 1) * kstep;
            const char* a2 = last ? Abase : Abase + (size_t)(t + 2) * kstep; const char* b2 = last ? nB : curB + (size_t)(t + 2) * kstep;
            const char* a3 = a2 + kstep; const char* b3 = b2 + kstep;
            G8_LDB(B0, 0, 0); G8_LDB(B1, 0, 1); G8_SCHED; G8_LDA(At, 0, 0); G8_STAGE_A(G8_SA(1, 1), a1, a10, a11);
            if (last && has_next) { a00 = nxt.a00; a01 = nxt.a01; a10 = nxt.a10; a11 = nxt.a11; }
            G8_WAIT_V(8); G8_WAIT_L(0); G8_BAR; G8_MMA(0, 0, At, B0); G8_MMA(0, 1, At, B1); G8_BAR; G8_SCHED;
            G8_LDA(At, 0, 1); G8_STAGE(G8_SB(0, 0), b2, voffB); G8_STAGE(G8_SB(0, 1), b2 + hstep, voffB); G8_STAGE_A(G8_SA(0, 0), a2, a00, a01);
            G8_WAIT_V(8); G8_WAIT_L(0); G8_BAR; G8_MMA(1, 0, At, B0); G8_MMA(1, 1, At, B1); G8_BAR; G8_SCHED;
            G8_LDB(B0, 1, 0); G8_LDB(B1, 1, 1); G8_SCHED; G8_LDA(At, 1, 0); G8_STAGE_A(G8_SA(0, 1), a2, a10, a11);
            G8_WAIT_V(8); G8_WAIT_L(0); G8_BAR; G8_MMA(0, 0, At, B0); G8_MMA(0, 1, At, B1); G8_BAR; G8_SCHED;
            G8_LDA(At, 1, 1); G8_STAGE(G8_SB(1, 0), b3, voffB); G8_STAGE(G8_SB(1, 1), b3 + hstep, voffB); G8_STAGE_A(G8_SA(1, 0), a3, a00, a01);
            G8_WAIT_V(8); G8_WAIT_L(0); G8_BAR; G8_MMA(1, 0, At, B0); G8_MMA(1, 1, At, B1); G8_BAR; G8_SCHED;
        }
        if (wr == 0) G8_BAR;
        if constexpr (!Epi::AFTER_DRAIN) { if constexpr (Epi::ROWS) E(acc, cur, wr, wc, fr, fq, (const LAS float*)(lds + ROWL + (ui & 1) * 1024)); else E(acc, cur, wr, wc, fr, fq); }
        if (!has_next) break;
#pragma unroll
        for (int a = 0; a < 2; ++a)
#pragma unroll
            for (int b = 0; b < 2; ++b)
#pragma unroll
                for (int m = 0; m < 4; ++m)
#pragma unroll
                    for (int n = 0; n < 2; ++n) acc[a][b][m][n] = (f32x4){0.f, 0.f, 0.f, 0.f};
        cur = nxt; ++ui;
        if (wr == 1) G8_BAR;
    }
    G8_WAIT_V(0);
    G8_BAR;
    if constexpr (Epi::AFTER_DRAIN) E.fused(acc, cur, wr, wc, fr, fq, lds);
#undef G8_FAC
#undef G8_ROWS
#undef G8_SA
#undef G8_SB
#undef G8_STAGE
#undef G8_STAGE_A
#undef G8_LDA
#undef G8_LDB
#undef G8_MMA
#undef G8_WAIT_V
#undef G8_WAIT_L
#undef G8_BAR
#undef G8_SCHED
}

struct EpiQKV {
    static constexpr bool AFTER_DRAIN = false, FP8 = false, RESCALE = false, ROWS = true;
    const float* rs; const float* qk_gain_l; bf16_t* base; int mode;
    __device__ __forceinline__ const float* rowsrc(const Unit& u, int r) const { return rs + u.pm * 256 + r; }
    __device__ __forceinline__ void operator()(const f32x4 (&acc)[2][2][4][2], const Unit& u, int wr, int wc, int fr_, int fq_, const LAS float* rowl) const {
        int fr = fr_, fq = fq_; asm volatile("" : "+v"(fr), "+v"(fq));
        int gi; bool isq; bf16_t* dst; const float* g;
        if (mode == 0) { const int H = 4 * u.pn + wc; slice_kind(H, gi, isq); dst = base + (size_t)H * T * HD; g = qk_gain_l + (gi < 0 ? 0 : gi) * HD; }
        else { const int lyr = u.pn >> 1, Hp = 4 * (u.pn & 1) + wc; gi = Hp < 4 ? 5 : -1; isq = false; dst = base + ((size_t)lyr * 8 + Hp) * TM * HD; g = qk_gain_l + (lyr * 6 + 5) * HD; }
        const float post = isq ? ATTN_SCALE * LOG2E : 1.0f;
        f32x4 gv[2][2];
#pragma unroll
        for (int bj = 0; bj < 2; ++bj)
#pragma unroll
            for (int n = 0; n < 2; ++n) gv[bj][n] = *(const f32x4*)(g + 32 * bj + 8 * fq + 4 * n) * post;
        float rs8[2][4];
#pragma unroll
        for (int ai = 0; ai < 2; ++ai)
#pragma unroll
            for (int m = 0; m < 4; ++m) rs8[ai][m] = rowl[ai * HALF + wr * 64 + m * 16 + fr];
#pragma unroll
        for (int ai = 0; ai < 2; ++ai)
#pragma unroll
            for (int m = 0; m < 4; ++m) {
                const int row = u.pm * 256 + ai * HALF + wr * 64 + m * 16 + fr; const float rsv = rs8[ai][m];
                f32x4 v[2][2]; float ss = 0.f;
#pragma unroll
                for (int bj = 0; bj < 2; ++bj)
#pragma unroll
                    for (int n = 0; n < 2; ++n) { v[bj][n] = acc[ai][bj][m][n] * rsv; ss += (v[bj][n][0] * v[bj][n][0] + v[bj][n][1] * v[bj][n][1]) + (v[bj][n][2] * v[bj][n][2] + v[bj][n][3] * v[bj][n][3]); }
                if (gi >= 0) {
                    ss += __shfl_xor(ss, 16); ss += __shfl_xor(ss, 32);
                    const float r = __builtin_amdgcn_rsqf(ss * (1.f / 64.f) + EPS);
#pragma unroll
                    for (int bj = 0; bj < 2; ++bj)
#pragma unroll
                        for (int n = 0; n < 2; ++n) v[bj][n] = v[bj][n] * r * gv[bj][n];
                }
#pragma unroll
                for (int bj = 0; bj < 2; ++bj) { u32x4 w; w.x = cvt_pk_bf16(v[bj][0][0], v[bj][0][1]); w.y = cvt_pk_bf16(v[bj][0][2], v[bj][0][3]); w.z = cvt_pk_bf16(v[bj][1][0], v[bj][1][1]); w.w = cvt_pk_bf16(v[bj][1][2], v[bj][1][3]);
                    *(u32x4*)(dst + (size_t)row * HD + 32 * bj + 8 * fq) = w; }
            }
    }
};
struct EpiOut {
    static constexpr bool AFTER_DRAIN = false, FP8 = false, RESCALE = true, ROWS = false;
    bf16_t* xb; float* ssq; unsigned char* x8; const float* fab; const float* rm;
    __device__ __forceinline__ void operator()(const f32x4 (&acc)[2][2][4][2], const Unit& u, int wr, int wc, int fr_, int fq_) const {
        int fr = fr_, fq = fq_; asm volatile("" : "+v"(fr), "+v"(fq));
        const int col0 = u.pn * 256 + wc * 32 + 8 * fq;
#pragma unroll
        for (int ai = 0; ai < 2; ++ai) {
        float fm8[2][4]; u32x4 xi8[2][4][2];
#pragma unroll
            for (int m = 0; m < 4; ++m) { const int row = u.pm * 256 + ai * HALF + wr * 64 + m * 16 + fr; fm8[ai][m] = rm[row];
#pragma unroll
                for (int bj = 0; bj < 2; ++bj) xi8[ai][m][bj] = *(const u32x4*)(xb + (size_t)row * D + col0 + bj * HALF); }
#pragma unroll
            for (int m = 0; m < 4; ++m) {
                const int row = u.pm * 256 + ai * HALF + wr * 64 + m * 16 + fr; bf16_t* p = xb + (size_t)row * D + col0; float s = 0.f; const float fm = fm8[ai][m];
                u32x4 xi[2];
#pragma unroll
                for (int bj = 0; bj < 2; ++bj) xi[bj] = xi8[ai][m][bj];
#pragma unroll
                for (int bj = 0; bj < 2; ++bj) { const f32x4 a = acc[ai][bj][m][0] * fm, b = acc[ai][bj][m][1] * fm; const u32x4 x = xi[bj];
                    u32x4 w; w.x = cvt_pk_bf16(bf2f(x.x & 0xffffu) + a[0], bf2f(x.x >> 16) + a[1]); w.y = cvt_pk_bf16(bf2f(x.y & 0xffffu) + a[2], bf2f(x.y >> 16) + a[3]);
                    w.z = cvt_pk_bf16(bf2f(x.z & 0xffffu) + b[0], bf2f(x.z >> 16) + b[1]); w.w = cvt_pk_bf16(bf2f(x.w & 0xffffu) + b[2], bf2f(x.w >> 16) + b[3]);
                    *(u32x4*)(p + bj * HALF) = w;
                    const float o0 = bf2f(w.x & 0xffffu), o1 = bf2f(w.x >> 16), o2 = bf2f(w.y & 0xffffu), o3 = bf2f(w.y >> 16), o4 = bf2f(w.z & 0xffffu), o5 = bf2f(w.z >> 16), o6 = bf2f(w.w & 0xffffu), o7 = bf2f(w.w >> 16);
                    s += ((o0 * o0 + o1 * o1) + (o2 * o2 + o3 * o3)) + ((o4 * o4 + o5 * o5) + (o6 * o6 + o7 * o7));
                    int q0 = 0, q1 = 0; q0 = __builtin_amdgcn_cvt_pk_fp8_f32(clamp8(16.f * o0), clamp8(16.f * o1), q0, false); q0 = __builtin_amdgcn_cvt_pk_fp8_f32(clamp8(16.f * o2), clamp8(16.f * o3), q0, true);
                    q1 = __builtin_amdgcn_cvt_pk_fp8_f32(clamp8(16.f * o4), clamp8(16.f * o5), q1, false); q1 = __builtin_amdgcn_cvt_pk_fp8_f32(clamp8(16.f * o6), clamp8(16.f * o7), q1, true);
                    u32x2 q; q.x = (unsigned)q0; q.y = (unsigned)q1;
                    *(u32x2*)(x8 + (size_t)row * D + col0 + bj * HALF) = q; }
                s += __shfl_xor(s, 16); s += __shfl_xor(s, 32);
                if (fq == 0) ssq[row * 16 + u.pn * 4 + wc] = s;
            }
        }
    }
};
struct EpiSwiGLU {
    static constexpr bool AFTER_DRAIN = false, FP8 = true, RESCALE = false, ROWS = true;
    const float* rsl; unsigned char* hid;
    __device__ __forceinline__ const float* rowsrc(const Unit& u, int r) const { return rsl + (size_t)u.e * T + min(u.ti * 256 + r, u.ce - 1); }
    __device__ __forceinline__ void operator()(const f32x4 (&acc)[2][2][4][2], const Unit& u, int wr, int wc, int fr_, int fq_, const LAS float* rowl) const {
        int fr = fr_, fq = fq_; asm volatile("" : "+v"(fr), "+v"(fq));
        float rs8[2][4];
#pragma unroll
        for (int ai = 0; ai < 2; ++ai)
#pragma unroll
            for (int m = 0; m < 4; ++m) rs8[ai][m] = rowl[ai * HALF + wr * 64 + m * 16 + fr];
#pragma unroll
        for (int ai = 0; ai < 2; ++ai)
#pragma unroll
            for (int m = 0; m < 4; ++m) {
                const int lr = ai * HALF + wr * 64 + m * 16 + fr; const float rsv = (1.0f / 512.0f) * rs8[ai][m];
                f32x4 h[2];
#pragma unroll
                for (int n = 0; n < 2; ++n) { const f32x4 gt = acc[ai][0][m][n] * rsv, up = acc[ai][1][m][n] * rsv;
#pragma unroll
                    for (int j = 0; j < 4; ++j) h[n][j] = gt[j] * up[j] * __builtin_amdgcn_rcpf(1.0f + __builtin_amdgcn_exp2f(-gt[j] * LOG2E)); }
#pragma unroll
                for (int n = 0; n < 2; ++n)
#pragma unroll
                    for (int j = 0; j < 4; ++j) h[n][j] = fminf(fmaxf(h[n][j] * 8.0f, -440.f), 440.f);
                int w0 = 0, w1 = 0;
                w0 = __builtin_amdgcn_cvt_pk_fp8_f32(h[0][0], h[0][1], w0, false); w0 = __builtin_amdgcn_cvt_pk_fp8_f32(h[0][2], h[0][3], w0, true);
                w1 = __builtin_amdgcn_cvt_pk_fp8_f32(h[1][0], h[1][1], w1, false); w1 = __builtin_amdgcn_cvt_pk_fp8_f32(h[1][2], h[1][3], w1, true);
                u32x2 w; w.x = (unsigned)w0; w.y = (unsigned)w1;
                *(u32x2*)(hid + (size_t)(u.pm * 256 + lr) * DE + u.pn * 128 + wc * 32 + 8 * fq) = w;
            }
    }
};
struct EpiDown {
    static constexpr bool AFTER_DRAIN = false, NB1 = false, FP8 = true, RESCALE = false, ROWS = true;
    const float* wl; unsigned char* Y;
    __device__ __forceinline__ const float* rowsrc(const Unit& u, int r) const { return wl + (size_t)u.e * T + min(u.ti * 256 + r, u.ce - 1); }
    __device__ __forceinline__ void operator()(const f32x4 (&acc)[2][2][4][2], const Unit& u, int wr, int wc, int fr_, int fq_, const LAS float* rowl) const {
        int fr = fr_, fq = fq_; asm volatile("" : "+v"(fr), "+v"(fq));
        float wl8[2][4];
#pragma unroll
        for (int ai = 0; ai < 2; ++ai)
#pragma unroll
            for (int m = 0; m < 4; ++m) wl8[ai][m] = rowl[ai * HALF + wr * 64 + m * 16 + fr];
#pragma unroll
        for (int ai = 0; ai < 2; ++ai)
#pragma unroll
            for (int m = 0; m < 4; ++m) {
                const int lr = ai * HALF + wr * 64 + m * 16 + fr; const float w8 = (8.0f / 256.0f) * wl8[ai][m];
#pragma unroll
                for (int bj = 0; bj < 2; ++bj) { f32x4 a = acc[ai][bj][m][0] * w8, b = acc[ai][bj][m][1] * w8;
#pragma unroll
                    for (int j = 0; j < 4; ++j) { a[j] = fminf(fmaxf(a[j], -400.f), 400.f); b[j] = fminf(fmaxf(b[j], -400.f), 400.f); }
                    int w0 = 0, w1 = 0;
                    w0 = __builtin_amdgcn_cvt_pk_fp8_f32(a[0], a[1], w0, false); w0 = __builtin_amdgcn_cvt_pk_fp8_f32(a[2], a[3], w0, true);
                    w1 = __builtin_amdgcn_cvt_pk_fp8_f32(b[0], b[1], w1, false); w1 = __builtin_amdgcn_cvt_pk_fp8_f32(b[2], b[3], w1, true);
                    u32x2 w; w.x = (unsigned)w0; w.y = (unsigned)w1;
                    *(u32x2*)(Y + (size_t)(u.pm * 256 + lr) * D + u.pn * 256 + bj * HALF + wc * 32 + 8 * fq) = w; }
            }
    }
};
struct EpiRouter {
    static constexpr bool AFTER_DRAIN = true, FP8 = false, RESCALE = false, ROWS = false;
    const float* ssq1; float* rs1; const float* b_group; const float* b_router; unsigned* cnt; int* list; float* wl; float* rsl; int* route;
    __device__ __forceinline__ void fused(const f32x4 (&acc)[2][2][4][2], const Unit& u, int wr, int wc, int fr_, int fq_, LAS unsigned char* lds) const {
        int fr = fr_, fq = fq_; asm volatile("" : "+v"(fr), "+v"(fq));
        LAS float* lg = (LAS float*)lds;
        LAS int* hist = (LAS int*)(lds + 256 * 65 * 4);
        const int tid = opaque_tid();
        if (tid < 64) hist[tid] = 0;
        if (wc < 2) {
#pragma unroll
            for (int ai = 0; ai < 2; ++ai)
#pragma unroll
                for (int m = 0; m < 4; ++m) { const int row = ai * HALF + wr * 64 + m * 16 + fr;
#pragma unroll
                    for (int n = 0; n < 2; ++n)
#pragma unroll
                        for (int j = 0; j < 4; ++j) lg[row * 65 + 32 * wc + 16 * n + 4 * fq + j] = acc[ai][0][m][n][j]; }
        }
        __syncthreads();
        int ex0 = 0, ex1 = 0, lp0 = 0, lp1 = 0; float w0 = 0.f, w1 = 0.f, rsv = 0.f; const int t = u.pm * 256 + tid;
        if (tid < 256) {
            const f32x4* sq = (const f32x4*)(ssq1 + (size_t)t * 16); const f32x4 a = sq[0], b = sq[1], c = sq[2], d = sq[3];
            const float ss = ((a[0] + a[1]) + (a[2] + a[3])) + ((b[0] + b[1]) + (b[2] + b[3])) + ((c[0] + c[1]) + (c[2] + c[3])) + ((d[0] + d[1]) + (d[2] + d[3]));
            rsv = 1.0f / sqrtf(ss * (1.f / D) + EPS); rs1[t] = rsv;
            const LAS float* my = lg + tid * 65;
            float g[4];
#pragma unroll
            for (int i = 0; i < 4; ++i) g[i] = my[i] * rsv + b_group[i];
            int gi = 0; float gm = g[0];
#pragma unroll
            for (int i = 1; i < 4; ++i) if (g[i] > gm) { gm = g[i]; gi = i; }
            float den = 0.f;
#pragma unroll
            for (int i = 0; i < 4; ++i) den += expf(g[i] - gm);
            const float gtop = 1.0f / den;
            float ev[8];
#pragma unroll
            for (int i = 0; i < 8; ++i) ev[i] = my[4 + gi * 8 + i] * rsv + b_router[gi * 8 + i];
            int i0 = 0; float v0 = ev[0];
#pragma unroll
            for (int i = 1; i < 8; ++i) if (ev[i] > v0) { v0 = ev[i]; i0 = i; }
            int i1 = -1; float v1 = -INFINITY;
#pragma unroll
            for (int i = 0; i < 8; ++i) if (i != i0 && ev[i] > v1) { v1 = ev[i]; i1 = i; }
            const float e1 = expf(v1 - v0); w0 = gtop / (1.f + e1); w1 = gtop * e1 / (1.f + e1);
            ex0 = gi * 8 + i0; ex1 = gi * 8 + i1;
            lp0 = __hip_atomic_fetch_add(hist + ex0, 1, __ATOMIC_RELAXED, __HIP_MEMORY_SCOPE_WORKGROUP);
            lp1 = __hip_atomic_fetch_add(hist + ex1, 1, __ATOMIC_RELAXED, __HIP_MEMORY_SCOPE_WORKGROUP);
        }
        __syncthreads();
        if (tid < NE) { const int c = hist[tid]; hist[32 + tid] = c ? (int)__hip_atomic_fetch_add(cnt + tid * 64, (unsigned)c, RLX_AGENT) : 0; }
        __syncthreads();
        if (tid < 256) {
            const int p0 = hist[32 + ex0] + lp0, p1 = hist[32 + ex1] + lp1;
            list[(size_t)ex0 * T + p0] = t; wl[(size_t)ex0 * T + p0] = w0; rsl[(size_t)ex0 * T + p0] = rsv;
            list[(size_t)ex1 * T + p1] = t; wl[(size_t)ex1 * T + p1] = w1; rsl[(size_t)ex1 * T + p1] = rsv;
            *(int4*)(route + (size_t)t * 4) = make_int4(ex0, p0, ex1, p1);
        }
    }
};
}

__device__ __forceinline__ void phase_memkv_fast(Frame& F) {
    PHASE_IDS(F);
    g8::DenseSched S; S.init(TM, 1024, D, F.G, (int)blockIdx.x, F.tid, F.ws + WS_WMEM);
    g8::EpiQKV E{(const float*)(F.ws + WS_RSM), in_ptr(4), (bf16_t*)(F.ws + WS_MEMKV), 1};
    g8::gemm_phase(F.lds, F.ws + WS_MB, D, S, E);
}
__device__ __forceinline__ void phase_inproj_fast(Frame& F, int l) {
    PHASE_IDS(F);
    g8::DenseSched S; S.init(T, INW, D, F.G, (int)blockIdx.x, F.tid, F.ws + WS_WIN + (size_t)l * INW * D * 2);
    g8::EpiQKV E{(const float*)(F.ws + WS_RS), in_ptr(4) + l * 6 * HD, (bf16_t*)(F.ws + WS_QKV), 0};
    g8::gemm_phase(F.lds, F.ws + WS_XB, D, S, E);
}
__device__ __forceinline__ void phase_outproj_fast(Frame& F, int l) {
    PHASE_IDS(F);
    g8::DenseSched S; S.init(T, D, D, F.G, (int)blockIdx.x, F.tid, F.ws + WS_WOUT + (size_t)l * D * D * 2);
    g8::EpiOut E{(bf16_t*)(F.ws + WS_XB), (float*)(F.ws + WS_SSQ1), (unsigned char*)(F.ws + WS_X8), (const float*)(F.ws + WS_FAB), (const float*)(F.ws + WS_RM)};
    g8::gemm_phase(F.lds, F.ws + WS_MIX, D, S, E);
}
__device__ __forceinline__ void phase_router_fast(Frame& F, int l) {
    PHASE_IDS(F);
    g8::DenseSched S; S.init(T, 256, D, F.G, (int)blockIdx.x, F.tid, F.ws + WS_WR + (size_t)l * 256 * D * 2);
    g8::EpiRouter E{(const float*)(F.ws + WS_SSQ1), (float*)(F.ws + WS_RS) + T, in_ptr(12) + l * NGRP, in_ptr(14) + l * NE, F.ctl + CW_CNT + l * NE * 64,
                    (int*)(F.ws + WS_LIST), (float*)(F.ws + WS_WL), (float*)(F.ws + WS_RSL), (int*)(F.ws + WS_ROUTE)};
    g8::gemm_phase(F.lds, F.ws + WS_XB, D, S, E);
}
__device__ __forceinline__ void phase_moe1_fast(Frame& F, int l) {
    PHASE_IDS(F);
    g8::GroupSched S; S.init((LAS int*)(F.lds + CTRL_BASE), F.ctl + CW_CNT + l * NE * 64, 4, D / 2, F.G, (int)blockIdx.x, F.ws + WS_WGU + (size_t)l * NE * 1024 * D, (size_t)1024 * D, (const int*)(F.ws + WS_LIST), true);
    g8::EpiSwiGLU E{(const float*)(F.ws + WS_RSL), (unsigned char*)(F.ws + WS_MIX)};
    g8::gemm_phase(F.lds, F.ws + WS_X8, D / 2, S, E);
}
__device__ __forceinline__ void phase_moe2_fast(Frame& F, int l) {
    PHASE_IDS(F);
    g8::GroupSched S; S.init((LAS int*)(F.lds + CTRL_BASE), F.ctl + CW_CNT + l * NE * 64, 4, DE / 2, F.G, (int)blockIdx.x, F.ws + WS_WD + (size_t)l * NE * D * DE, (size_t)D * DE, (const int*)(F.ws + WS_LIST), false);
    g8::EpiDown E{(const float*)(F.ws + WS_WL), (unsigned char*)(F.ws + WS_QKV)};
    g8::gemm_phase(F.lds, F.ws + WS_MIX, DE / 2, S, E);
}

namespace at {
typedef short bf16x8 __attribute__((ext_vector_type(8)));
typedef short s16x4 __attribute__((ext_vector_type(4)));
typedef short v4i16_t __attribute__((ext_vector_type(4)));
typedef float f32x16 __attribute__((ext_vector_type(16)));
typedef const LAS char* lds_cptr;
constexpr int NSLOT = 3, NPRE = NSLOT - 1, SLOTB = 8192, LDS_K = 0, LDS_V = NSLOT * SLOTB, TB_CS = 576, TB_ROW = 4 * TB_CS, LDS_TBB = 2 * NSLOT * SLOTB, LDS_TBM = LDS_TBB + 16 * TB_ROW, LDS_WS = LDS_TBM + TB_ROW, LDS_QW = LDS_WS + 2048;
static_assert(LDS_QW + 64 <= 131072, "attention LDS map");
constexpr float NEGBIG = -1.0e30f;
__device__ __forceinline__ int crow(int r, int hi) { return (r & 3) + 8 * (r >> 2) + 4 * hi; }
__device__ __forceinline__ void glds16(const void* gsrc, unsigned lds_dst) { unsigned keep;
    asm volatile("s_mov_b32 %0, m0\n\ts_mov_b32 m0, %2\n\ts_nop 0\n\tglobal_load_lds_dwordx4 %1, off\n\ts_mov_b32 m0, %0" : "=&s"(keep) : "v"(gsrc), "s"(lds_dst) : "memory"); }
typedef float f32x2_t __attribute__((ext_vector_type(2))); typedef __bf16 bf16x2_t __attribute__((ext_vector_type(2)));
__device__ __forceinline__ unsigned cvtpk(float lo, float hi) { f32x2_t v = {lo, hi}; bf16x2_t b = __builtin_convertvector(v, bf16x2_t); return __builtin_bit_cast(unsigned, b); }
__device__ __forceinline__ s16x4 vtr(lds_cptr p) { return __builtin_bit_cast(s16x4, __builtin_amdgcn_ds_read_tr16_b64_v4i16((LAS v4i16_t*)p)); }
#define AT_WAIT_BAR(N) asm volatile("s_waitcnt vmcnt(" #N ") lgkmcnt(0)\n\ts_barrier" ::: "memory")

__device__ __forceinline__ void at_dequeue(unsigned* qcnt, int nper, int xq, int pre, int& id_out, int& x_out) {
    int id = pre, x = xq;
    if (id == -2) id = (int)__hip_atomic_fetch_add(qcnt + xq * 64, 1u, RLX_AGENT);
    if (id >= nper) {
        id = -1;
        for (int tries = 0; tries < 8 && id < 0; ++tries) {
            unsigned hv[8];
#pragma unroll
            for (int k = 0; k < 8; ++k) hv[k] = __hip_atomic_load(qcnt + ((xq + k) & 7) * 64, RLX_AGENT);
            int pick = -1;
#pragma unroll
            for (int k = 7; k >= 0; --k) if ((int)hv[k] < nper) pick = k;
            if (pick < 0) break;
            x = (xq + pick) & 7; id = (int)__hip_atomic_fetch_add(qcnt + x * 64, 1u, RLX_AGENT); if (id >= nper) id = -1;
        }
    }
    id_out = id; x_out = x;
}
struct UnitDesc { const bf16_t* Q; const bf16_t* K; const bf16_t* V; int t0, hh16, qb, h, kt0, nt; };

template <int TYPE>
__device__ __forceinline__ void attn_unit(LAS unsigned char* lds, const UnitDesc& u, bf16_t* mixed, float* ssq) {
    const int tid = opaque_tid0(), lane = tid & 63, r32 = lane & 31, hi = lane >> 5; const int wid = __builtin_amdgcn_readfirstlane(tid >> 6);
    const unsigned lds0 = (unsigned)(size_t)lds;
    lds_cptr shm3 = (lds_cptr)lds;
    const int prow = 8 * wid + (lane >> 3);
    const bf16_t* ksrc = u.K + (size_t)(u.kt0 * 64 + prow) * HD + (((lane & 7) ^ ((4 * wid + (lane >> 4)) & 7)) * 8);
    const bf16_t* vsrc = u.V + (size_t)(u.kt0 * 64 + prow) * HD + ((((lane & 7) >> 1) ^ (prow & 2)) * 16) + (lane & 1) * 8;
    const unsigned kdst = lds0 + LDS_K + wid * 1024, vdst = lds0 + LDS_V + wid * 1024;
#define AT_DMA_K(t, slot) glds16(ksrc + (size_t)(t) * 64 * HD, (unsigned)__builtin_amdgcn_readfirstlane(kdst + (slot)))
#define AT_DMA_V(t, slot) glds16(vsrc + (size_t)(t) * 64 * HD, (unsigned)__builtin_amdgcn_readfirstlane(vdst + (slot)))
    lds_cptr ka[4], va[2];
    { const int sw = (r32 >> 1) & 7;
#pragma unroll
      for (int d0 = 0; d0 < 4; ++d0) ka[d0] = shm3 + LDS_K + r32 * 128 + (((2 * d0 + hi) ^ sw) * 16);
      const int q = (lane & 15) >> 2, gb = (lane >> 4) & 1;
#pragma unroll
      for (int d0 = 0; d0 < 2; ++d0) va[d0] = shm3 + LDS_V + (4 * hi + q) * 128 + ((2 * (d0 ^ (q >> 1)) + gb) * 32) + (lane & 3) * 8; }
    const int nt = u.nt;
    const bf16_t* Qw = u.Q + (size_t)(u.qb * 256 + wid * 32 + r32) * HD;
    bf16x8 qr[4];
#pragma unroll
    for (int d0 = 0; d0 < 4; ++d0) qr[d0] = *(const bf16x8*)(Qw + d0 * 16 + hi * 8);
#pragma unroll
    for (int j = 0; j < NPRE; ++j) if (j < nt) { AT_DMA_K(j, j * SLOTB); AT_DMA_V(j, j * SLOTB); }
    lds_cptr tb = shm3; int r0w = 0, qrw = 0;
    lds_cptr tbm = shm3;
    if (TYPE == 1) { const int qc = 32 * (wid & 1) + r32, c0 = min(max(qc - 8, 0), 48); qrw = 4 * u.qb + (wid >> 1); r0w = min(max(qrw - 4, 0), 24);
        const int ib = 4 * hi - qc + 63, cb = (-ib) & 3, im = 4 * hi - c0 + 63, cm = (-im) & 3;
        tb = shm3 + LDS_TBB + cb * TB_CS + (ib + cb) * 4; tbm = shm3 + LDS_TBM + cm * TB_CS + (im + cm) * 4; }
    float lsum = 0.f; f32x16 o[2]; o[0] = f32x16{}; o[1] = f32x16{};
    int sl_cur = 0, sl_n2 = NPRE * SLOTB;
    for (int i = 0; i < nt; ++i) {
        { const int rem = nt - 1 - i, yo = rem < NPRE - 1 ? rem : NPRE - 1; if (yo >= 3) AT_WAIT_BAR(6); else if (yo == 2) AT_WAIT_BAR(4); else if (yo == 1) AT_WAIT_BAR(2); else AT_WAIT_BAR(0); }
        static_assert(NPRE <= 4, "wait ladder");
        if (i + NPRE < nt) { AT_DMA_K(i + NPRE, sl_n2); AT_DMA_V(i + NPRE, sl_n2); }
        bool need = true;
        if (TYPE == 1) { const int kr = u.kt0 + i; need = (kr >= r0w) && (kr < r0w + 8); }
        if (need) {
#pragma unroll
            for (int hf = 0; hf < 2; ++hf) {
                f32x16 p;
                if (TYPE == 1) {
                    const lds_cptr tp = tb + (u.kt0 + i - qrw + 7) * TB_ROW;
#pragma unroll
                    for (int g = 0; g < 4; ++g) { const f32x4 a = *(const LAS f32x4*)(tp + 32 * (g + 4 * hf)) + *(const LAS f32x4*)(tbm + 32 * (g + 4 * hf)); p[4 * g] = a[0]; p[4 * g + 1] = a[1]; p[4 * g + 2] = a[2]; p[4 * g + 3] = a[3]; }
                } else p = f32x16{};
#pragma unroll
                for (int d0 = 0; d0 < 4; ++d0) p = __builtin_amdgcn_mfma_f32_32x32x16_bf16(*(const LAS bf16x8*)(ka[d0] + sl_cur + 4096 * hf), qr[d0], p, 0, 0, 0);
                float s0 = 0.f;
#pragma unroll
                for (int r = 0; r < 16; ++r) { p[r] = __builtin_amdgcn_exp2f(p[r]); s0 += p[r]; }
                lsum += s0;
                const u32x4 pwa = (u32x4){cvtpk(p[0], p[1]), cvtpk(p[2], p[3]), cvtpk(p[4], p[5]), cvtpk(p[6], p[7])}, pwb = (u32x4){cvtpk(p[8], p[9]), cvtpk(p[10], p[11]), cvtpk(p[12], p[13]), cvtpk(p[14], p[15])};
#pragma unroll
                for (int d0 = 0; d0 < 2; ++d0) { const lds_cptr vp = va[d0] + sl_cur + 4096 * hf; const s16x4 l0 = vtr(vp), h0 = vtr(vp + 1024), l1 = vtr(vp + 2048), h1 = vtr(vp + 2048 + 1024);
                    o[d0] = __builtin_amdgcn_mfma_f32_32x32x16_bf16(__builtin_bit_cast(bf16x8, pwa), (bf16x8){l0[0], l0[1], l0[2], l0[3], h0[0], h0[1], h0[2], h0[3]}, o[d0], 0, 0, 0);
                    o[d0] = __builtin_amdgcn_mfma_f32_32x32x16_bf16(__builtin_bit_cast(bf16x8, pwb), (bf16x8){l1[0], l1[1], l1[2], l1[3], h1[0], h1[1], h1[2], h1[3]}, o[d0], 0, 0, 0); }
            }
        }
        sl_n2 = sl_cur;
        sl_cur = (sl_cur == (NSLOT - 1) * SLOTB) ? 0 : sl_cur + SLOTB;
    }
    AT_WAIT_BAR(0);
    int lane2 = lane; asm volatile("" : "+v"(lane2)); const int r32e = lane2 & 31, hie = lane2 >> 5;
    lsum += __shfl_xor(lsum, 32);
    LAS float* wsf = (LAS float*)(lds + LDS_WS) + wid * 64;
    if (hie == 0) wsf[r32e] = lsum;
    asm volatile("s_waitcnt lgkmcnt(0)" ::: "memory");
    LAS bf16_t* stg = (LAS bf16_t*)(lds) + wid * 2048;
#pragma unroll
    for (int r = 0; r < 16; ++r) { const int orow = crow(r, hie); const float rl = __builtin_amdgcn_rcpf(wsf[orow]);
        stg[orow * 64 + r32e] = (bf16_t)f2bf(o[0][r] * rl); stg[orow * 64 + 32 + r32e] = (bf16_t)f2bf(o[1][r] * rl); }
    asm volatile("s_waitcnt lgkmcnt(0)" ::: "memory");
    const int trow0 = u.t0 + wid * 32;
#pragma unroll
    for (int i = 0; i < 4; ++i) { const int row = i * 8 + (lane2 >> 3), ch = lane2 & 7; const u32x4 v = *(const LAS u32x4*)(stg + row * 64 + ch * 8);
        *(u32x4*)(mixed + (size_t)(trow0 + row) * D + u.hh16 * 64 + ch * 8) = v;
        float s = 0.f; { float a;
            a = bf2f(v.x & 0xffffu); s += a * a; a = bf2f(v.x >> 16); s += a * a; a = bf2f(v.y & 0xffffu); s += a * a; a = bf2f(v.y >> 16); s += a * a;
            a = bf2f(v.z & 0xffffu); s += a * a; a = bf2f(v.z >> 16); s += a * a; a = bf2f(v.w & 0xffffu); s += a * a; a = bf2f(v.w >> 16); s += a * a; }
        s += __shfl_xor(s, 1); s += __shfl_xor(s, 2); s += __shfl_xor(s, 4);
        if (ch == 0) ssq[(size_t)(trow0 + row) * 16 + u.hh16] = s; }
    asm volatile("s_waitcnt lgkmcnt(0)\n\ts_barrier" ::: "memory");
#undef AT_DMA_K
#undef AT_DMA_V
}

template <int NQB>
__device__ __forceinline__ void mem_unit(LAS unsigned char* lds, const bf16_t* Qh, const bf16_t* Kh, const bf16_t* Vh, int t0, int hh16, bf16_t* mixed, float* ssq) {
    constexpr int MK = 0, MV = 32768, MSTG = 65536, MWS = 98304;
    const int tid = opaque_tid0(), lane = tid & 63, r32 = lane & 31, hi = lane >> 5; const int wid = __builtin_amdgcn_readfirstlane(tid >> 6);
    const unsigned lds0 = (unsigned)(size_t)lds; lds_cptr shm3 = (lds_cptr)lds;
    const int prow = 8 * wid + (lane >> 3);
    const bf16_t* ksrc = Kh + (size_t)prow * HD + (((lane & 7) ^ ((4 * wid + (lane >> 4)) & 7)) * 8);
    const bf16_t* vsrc = Vh + (size_t)prow * HD + ((((lane & 7) >> 1) ^ (prow & 2)) * 16) + (lane & 1) * 8;
    const bf16_t* Qw = Qh + (size_t)(wid * 32 + r32) * HD + hi * 8;
    bf16x8 qr[4], qn[4];
#pragma unroll
    for (int d0 = 0; d0 < 4; ++d0) { qr[d0] = *(const bf16x8*)(Qw + d0 * 16); qn[d0] = qr[d0]; }
#pragma unroll
    for (int j = 0; j < 4; ++j) { glds16(ksrc + (size_t)j * 64 * HD, (unsigned)__builtin_amdgcn_readfirstlane(lds0 + MK + j * 8192 + wid * 1024));
                                  glds16(vsrc + (size_t)j * 64 * HD, (unsigned)__builtin_amdgcn_readfirstlane(lds0 + MV + j * 8192 + wid * 1024)); }
    lds_cptr ka[4], va[2];
    { const int sw = (r32 >> 1) & 7;
#pragma unroll
      for (int d0 = 0; d0 < 4; ++d0) ka[d0] = shm3 + MK + r32 * 128 + (((2 * d0 + hi) ^ sw) * 16);
      const int q = (lane & 15) >> 2, gb = (lane >> 4) & 1;
#pragma unroll
      for (int d0 = 0; d0 < 2; ++d0) va[d0] = shm3 + MV + (4 * hi + q) * 128 + ((2 * (d0 ^ (q >> 1)) + gb) * 32) + (lane & 3) * 8; }
    LAS float* wsf = (LAS float*)(lds + MWS) + wid * 64;
    LAS bf16_t* stg = (LAS bf16_t*)(lds + MSTG) + wid * 2048;
#pragma unroll
    for (int qb = 0; qb < NQB; ++qb) {
        const bool has_next = qb + 1 < NQB;
        float lsum = 0.f; f32x16 o[2]; o[0] = f32x16{}; o[1] = f32x16{};
#pragma unroll
        for (int i = 0; i < 4; ++i) {
            if (qb == 0) {
                if (i == 0) AT_WAIT_BAR(6); else if (i == 1) AT_WAIT_BAR(4); else if (i == 2) { if (has_next) AT_WAIT_BAR(6); else AT_WAIT_BAR(2); } else { if (has_next) AT_WAIT_BAR(4); else AT_WAIT_BAR(0); }
            }
            if (i == 1 && has_next) {
#pragma unroll
                for (int d0 = 0; d0 < 4; ++d0) qn[d0] = *(const bf16x8*)(Qw + (size_t)(qb + 1) * 256 * HD + d0 * 16); }
#pragma unroll
            for (int hf = 0; hf < 2; ++hf) {
                f32x16 p = f32x16{};
#pragma unroll
                for (int d0 = 0; d0 < 4; ++d0) p = __builtin_amdgcn_mfma_f32_32x32x16_bf16(*(const LAS bf16x8*)(ka[d0] + i * 8192 + 4096 * hf), qr[d0], p, 0, 0, 0);
                float s0 = 0.f;
#pragma unroll
                for (int r = 0; r < 16; ++r) { p[r] = __builtin_amdgcn_exp2f(p[r]); s0 += p[r]; }
                lsum += s0;
                const u32x4 pwa = (u32x4){cvtpk(p[0], p[1]), cvtpk(p[2], p[3]), cvtpk(p[4], p[5]), cvtpk(p[6], p[7])}, pwb = (u32x4){cvtpk(p[8], p[9]), cvtpk(p[10], p[11]), cvtpk(p[12], p[13]), cvtpk(p[14], p[15])};
#pragma unroll
                for (int d0 = 0; d0 < 2; ++d0) { const lds_cptr vp = va[d0] + i * 8192 + 4096 * hf; const s16x4 l0 = vtr(vp), h0 = vtr(vp + 1024), l1 = vtr(vp + 2048), h1 = vtr(vp + 2048 + 1024);
                    o[d0] = __builtin_amdgcn_mfma_f32_32x32x16_bf16(__builtin_bit_cast(bf16x8, pwa), (bf16x8){l0[0], l0[1], l0[2], l0[3], h0[0], h0[1], h0[2], h0[3]}, o[d0], 0, 0, 0);
                    o[d0] = __builtin_amdgcn_mfma_f32_32x32x16_bf16(__builtin_bit_cast(bf16x8, pwb), (bf16x8){l1[0], l1[1], l1[2], l1[3], h1[0], h1[1], h1[2], h1[3]}, o[d0], 0, 0, 0); }
            }
        }
        lsum += __shfl_xor(lsum, 32);
        if (hi == 0) wsf[r32] = lsum;
        asm volatile("s_waitcnt lgkmcnt(0)" ::: "memory");
#pragma unroll
        for (int r = 0; r < 16; ++r) { const int orow = crow(r, hi); const float rl = __builtin_amdgcn_rcpf(wsf[orow]);
            stg[orow * 64 + r32] = (bf16_t)f2bf(o[0][r] * rl); stg[orow * 64 + 32 + r32] = (bf16_t)f2bf(o[1][r] * rl); }
        asm volatile("s_waitcnt lgkmcnt(0)" ::: "memory");
        const int trow0 = t0 + qb * 256 + wid * 32;
#pragma unroll
        for (int i = 0; i < 4; ++i) { const int row = i * 8 + (lane >> 3), ch = lane & 7; const u32x4 v = *(const LAS u32x4*)(stg + row * 64 + ch * 8);
            *(u32x4*)(mixed + (size_t)(trow0 + row) * D + hh16 * 64 + ch * 8) = v;
            { float s = 0.f, a;
              a = bf2f(v.x & 0xffffu); s += a * a; a = bf2f(v.x >> 16); s += a * a; a = bf2f(v.y & 0xffffu); s += a * a; a = bf2f(v.y >> 16); s += a * a;
              a = bf2f(v.z & 0xffffu); s += a * a; a = bf2f(v.z >> 16); s += a * a; a = bf2f(v.w & 0xffffu); s += a * a; a = bf2f(v.w >> 16); s += a * a;
              s += __shfl_xor(s, 1); s += __shfl_xor(s, 2); s += __shfl_xor(s, 4);
              if (ch == 0) ssq[(size_t)(trow0 + row) * 16 + hh16] = s; } }
        asm volatile("s_waitcnt lgkmcnt(0)" ::: "memory");
        if (has_next) {
#pragma unroll
            for (int d0 = 0; d0 < 4; ++d0) qr[d0] = qn[d0]; }
    }
    asm volatile("s_waitcnt lgkmcnt(0)\n\ts_barrier" ::: "memory");
}

__device__ __forceinline__ void nb_unit(LAS unsigned char* lds, const UnitDesc& u, bf16_t* mixed, float* ssq) {
    const int tid = opaque_tid0(), lane = tid & 63, r32 = lane & 31, hi = lane >> 5; const int wid = __builtin_amdgcn_readfirstlane(tid >> 6);
    const unsigned lds0 = (unsigned)(size_t)lds; lds_cptr shm3 = (lds_cptr)lds;
    const int prow = 8 * wid + (lane >> 3);
    const bf16_t* ksrc = u.K + (size_t)(u.kt0 * 64 + prow) * HD + (((lane & 7) ^ ((4 * wid + (lane >> 4)) & 7)) * 8);
    const bf16_t* vsrc = u.V + (size_t)(u.kt0 * 64 + prow) * HD + ((((lane & 7) >> 1) ^ (prow & 2)) * 16) + (lane & 1) * 8;
    const unsigned kdst = lds0 + LDS_K + wid * 1024, vdst = lds0 + LDS_V + wid * 1024;
#define AT_DMA_K(t, slot) glds16(ksrc + (size_t)(t) * 64 * HD, (unsigned)__builtin_amdgcn_readfirstlane(kdst + (slot)))
#define AT_DMA_V(t, slot) glds16(vsrc + (size_t)(t) * 64 * HD, (unsigned)__builtin_amdgcn_readfirstlane(vdst + (slot)))
    const int rp = wid >> 2, jb = wid & 3, cs = min(max(16 * jb - 8, 0), 32);
    const int qrl = 4 * u.qb + 2 * rp + (r32 >> 4), qc = 16 * jb + (r32 & 15), c0 = min(max(qc - 8, 0), 48), r0l = min(max(qrl - 4, 0), 24);
    const int rwa = min(max(4 * u.qb + 2 * rp - 4, 0), 24), rwb = min(max(4 * u.qb + 2 * rp + 1 - 4, 0), 24) + 8;
    lds_cptr ka[4], va[2];
    { const int key = cs + r32, sw = (key >> 1) & 7;
#pragma unroll
      for (int d0 = 0; d0 < 4; ++d0) ka[d0] = shm3 + LDS_K + key * 128 + (((2 * d0 + hi) ^ sw) * 16);
      const int q = (lane & 15) >> 2, gb = (lane >> 4) & 1;
#pragma unroll
      for (int d0 = 0; d0 < 2; ++d0) va[d0] = shm3 + LDS_V + (cs + 4 * hi + q) * 128 + ((2 * (d0 ^ (q >> 1)) + gb) * 32) + (lane & 3) * 8; }
    const int nt = u.nt;
    const bf16_t* Qw = u.Q + (size_t)(qrl * 64 + qc) * HD;
    bf16x8 qr[4];
#pragma unroll
    for (int d0 = 0; d0 < 4; ++d0) qr[d0] = *(const bf16x8*)(Qw + d0 * 16 + hi * 8);
#pragma unroll
    for (int j = 0; j < NPRE; ++j) if (j < nt) { AT_DMA_K(j, j * SLOTB); AT_DMA_V(j, j * SLOTB); }
    lds_cptr tb, tbm;
    { const int ib = cs + 4 * hi - qc + 63, cb = (-ib) & 3, im = cs + 4 * hi - c0 + 63, cm = (-im) & 3;
      tb = shm3 + LDS_TBB + cb * TB_CS + (ib + cb) * 4; tbm = shm3 + LDS_TBM + cm * TB_CS + (im + cm) * 4; }
    float lsum = 0.f; f32x16 o[2]; o[0] = f32x16{}; o[1] = f32x16{};
    int sl_cur = 0, sl_n2 = NPRE * SLOTB;
    for (int i = 0; i < nt; ++i) {
        { const int rem = nt - 1 - i, yo = rem < NPRE - 1 ? rem : NPRE - 1; if (yo >= 3) AT_WAIT_BAR(6); else if (yo == 2) AT_WAIT_BAR(4); else if (yo == 1) AT_WAIT_BAR(2); else AT_WAIT_BAR(0); }
        if (i + NPRE < nt) { AT_DMA_K(i + NPRE, sl_n2); AT_DMA_V(i + NPRE, sl_n2); }
        const int kr = u.kt0 + i;
        if (kr >= rwa && kr < rwb) {
            const int drow = (kr >= r0l && kr < r0l + 8) ? (kr - qrl + 7) : 15;
            const lds_cptr tp = tb + drow * TB_ROW;
            f32x16 p0;
#pragma unroll
            for (int g = 0; g < 4; ++g) { const f32x4 a = *(const LAS f32x4*)(tp + 32 * g) + *(const LAS f32x4*)(tbm + 32 * g); p0[4 * g] = a[0]; p0[4 * g + 1] = a[1]; p0[4 * g + 2] = a[2]; p0[4 * g + 3] = a[3]; }
            bf16x8 kf[4];
#pragma unroll
            for (int j = 0; j < 4; ++j) kf[j] = *(const LAS bf16x8*)(ka[j] + sl_cur);
#pragma unroll
            for (int d0 = 0; d0 < 4; ++d0) p0 = __builtin_amdgcn_mfma_f32_32x32x16_bf16(kf[d0], qr[d0], p0, 0, 0, 0);
            float s0 = 0.f;
#pragma unroll
            for (int r = 0; r < 16; ++r) { p0[r] = __builtin_amdgcn_exp2f(p0[r]); s0 += p0[r]; }
            lsum += s0;
            const u32x4 pw0 = (u32x4){cvtpk(p0[0], p0[1]), cvtpk(p0[2], p0[3]), cvtpk(p0[4], p0[5]), cvtpk(p0[6], p0[7])};
            const u32x4 pw1 = (u32x4){cvtpk(p0[8], p0[9]), cvtpk(p0[10], p0[11]), cvtpk(p0[12], p0[13]), cvtpk(p0[14], p0[15])};
#pragma unroll
            for (int d0 = 0; d0 < 2; ++d0) {
                s16x4 lo[2], hh[2]; const lds_cptr vp = va[d0] + sl_cur;
#pragma unroll
                for (int ks = 0; ks < 2; ++ks) { lo[ks] = vtr(vp + ks * 2048); hh[ks] = vtr(vp + ks * 2048 + 1024); }
                o[d0] = __builtin_amdgcn_mfma_f32_32x32x16_bf16(__builtin_bit_cast(bf16x8, pw0), (bf16x8){lo[0][0], lo[0][1], lo[0][2], lo[0][3], hh[0][0], hh[0][1], hh[0][2], hh[0][3]}, o[d0], 0, 0, 0);
                o[d0] = __builtin_amdgcn_mfma_f32_32x32x16_bf16(__builtin_bit_cast(bf16x8, pw1), (bf16x8){lo[1][0], lo[1][1], lo[1][2], lo[1][3], hh[1][0], hh[1][1], hh[1][2], hh[1][3]}, o[d0], 0, 0, 0);
            }
        }
        sl_n2 = sl_cur;
        sl_cur = (sl_cur == (NSLOT - 1) * SLOTB) ? 0 : sl_cur + SLOTB;
    }
    AT_WAIT_BAR(0);
    int lane2 = lane; asm volatile("" : "+v"(lane2)); const int r32e = lane2 & 31, hie = lane2 >> 5;
    lsum += __shfl_xor(lsum, 32);
    LAS float* wsf = (LAS float*)(lds + LDS_WS) + wid * 64;
    if (hie == 0) wsf[r32e] = lsum;
    asm volatile("s_waitcnt lgkmcnt(0)" ::: "memory");
    LAS bf16_t* stg = (LAS bf16_t*)(lds) + wid * 2048;
#pragma unroll
    for (int r = 0; r < 16; ++r) { const int orow = crow(r, hie); const float rl = __builtin_amdgcn_rcpf(wsf[orow]);
        stg[orow * 64 + r32e] = (bf16_t)f2bf(o[0][r] * rl); stg[orow * 64 + 32 + r32e] = (bf16_t)f2bf(o[1][r] * rl); }
    asm volatile("s_waitcnt lgkmcnt(0)" ::: "memory");
    const int tbase = u.t0 + 2 * rp * 64 + 16 * jb;
#pragma unroll
    for (int i = 0; i < 4; ++i) { const int row = i * 8 + (lane2 >> 3), ch = lane2 & 7; const u32x4 v = *(const LAS u32x4*)(stg + row * 64 + ch * 8);
        *(u32x4*)(mixed + (size_t)(tbase + (row >> 4) * 64 + (row & 15)) * D + u.hh16 * 64 + ch * 8) = v; const int hh16 = u.hh16;
            { float s = 0.f, a;
              a = bf2f(v.x & 0xffffu); s += a * a; a = bf2f(v.x >> 16); s += a * a; a = bf2f(v.y & 0xffffu); s += a * a; a = bf2f(v.y >> 16); s += a * a;
              a = bf2f(v.z & 0xffffu); s += a * a; a = bf2f(v.z >> 16); s += a * a; a = bf2f(v.w & 0xffffu); s += a * a; a = bf2f(v.w >> 16); s += a * a;
              s += __shfl_xor(s, 1); s += __shfl_xor(s, 2); s += __shfl_xor(s, 4);
              if (ch == 0) ssq[(size_t)(tbase + (row >> 4) * 64 + (row & 15)) * 16 + hh16] = s; } }
    asm volatile("s_waitcnt lgkmcnt(0)\n\ts_barrier" ::: "memory");
#undef AT_DMA_K
#undef AT_DMA_V
}
__device__ __forceinline__ void build_table_b(LAS unsigned char* lds, const float* rpb_lh) {
    const int tid = opaque_tid0();
    for (int e = tid; e < 15 * 127; e += 512) { const int dr = e / 127, idx = e - dr * 127, rel = idx - 63; const float v = (rel >= -15 && rel <= 15) ? rpb_lh[dr * 31 + rel + 15] * LOG2E : 0.f;
#pragma unroll
        for (int c = 0; c < 4; ++c) *(LAS float*)(lds + LDS_TBB + dr * TB_ROW + c * TB_CS + (idx + c) * 4) = v; }
    if (tid >= 256 && tid < 256 + 127) { const int idx = tid - 256;
#pragma unroll
        for (int c = 0; c < 4; ++c) *(LAS float*)(lds + LDS_TBB + 15 * TB_ROW + c * TB_CS + (idx + c) * 4) = NEGBIG; }
    if (tid < 127) { const int j = tid - 63; const float v = (j >= 0 && j < 16) ? 0.f : NEGBIG;
#pragma unroll
        for (int c = 0; c < 4; ++c) *(LAS float*)(lds + LDS_TBM + c * TB_CS + (tid + c) * 4) = v; }
}

template <int TYPE>
__device__ __forceinline__ void attn_type_loop(Frame& F, int l, unsigned xcc, int qset) {
    constexpr int MQB = 2, MUP = 8 / MQB;
    constexpr int NPER = (TYPE == 2) ? 16 * MUP : 192;
    unsigned* qcnt = F.ctl + CW_ATQ + ((qset * 3 + TYPE) * 8) * 64;
    LAS int* qw = (LAS int*)(F.lds + CTRL_BASE + 1024);
    const int tid = opaque_tid0();
    const int xq = (int)xcc & 7; int pre = -2;
    for (;;) {
        if (tid == 0) { int id, x; at_dequeue(qcnt, NPER, xq, pre, id, x); qw[0] = id; qw[1] = x; }
        __syncthreads();
        const int id = qw[0], x = qw[1];
        __syncthreads();
        if (id < 0) break;
        pre = -2; if (tid == 0 && x == xq) pre = (int)__hip_atomic_fetch_add(qcnt + xq * 64, 1u, RLX_AGENT);
        UnitDesc u; int h;
        if (TYPE == 2) { const int P = x * 16 + id / MUP, b = P >> 2, q0 = (id % MUP) * MQB; h = P & 3;
            mem_unit<MQB>(F.lds, qkv_ptr(F, 36 + h, b * SEQ + q0 * 256), memkv_ptr(F, l, h, b * MEM_LEN), memkv_ptr(F, l, 4 + h, b * MEM_LEN), b * SEQ + q0 * 256, 12 + h, (bf16_t*)(F.ws + WS_MIX), (float*)(F.ws + WS_SSQH));
            continue; }
        else { const int ord = (0x70615243 >> (4 * (id & 7))) & 7;
            const int P = x * 24 + (id >> 3), b = P / 6; h = P % 6; u.qb = ord; u.h = h; u.t0 = b * SEQ + ord * 256;
            if (TYPE == 0) { u.hh16 = h; u.Q = qkv_ptr(F, h, b * SEQ); u.K = qkv_ptr(F, 6 + h, b * SEQ); u.V = qkv_ptr(F, 12 + h, b * SEQ);
                const int lo = max(4 * ord - 16, 0), hi2 = min(4 * ord + 20, 32); u.kt0 = lo; u.nt = hi2 - lo; }
            else { u.hh16 = 6 + h; u.Q = qkv_ptr(F, 18 + h, b * SEQ); u.K = qkv_ptr(F, 24 + h, b * SEQ); u.V = qkv_ptr(F, 30 + h, b * SEQ);
                const int lo = min(max(4 * ord - 4, 0), 24), hi2 = min(max(4 * ord + 3 - 4, 0), 24) + 8; u.kt0 = lo; u.nt = hi2 - lo; } }
        if (TYPE == 1) build_table_b(F.lds, in_ptr(5) + (size_t)(l * 6 + h) * 15 * 31);
        if (TYPE == 1) nb_unit(F.lds, u, (bf16_t*)(F.ws + WS_MIX), (float*)(F.ws + WS_SSQH)); else attn_unit<TYPE>(F.lds, u, (bf16_t*)(F.ws + WS_MIX), (float*)(F.ws + WS_SSQH));
    }
}
constexpr int SW_TAB = 131072, SW_CS = 1088, SW_STG = SW_TAB + 4 * SW_CS;
static_assert(SW_STG + 8 * 2048 <= CTRL_BASE, "sliding-window LDS map");
__device__ __forceinline__ void sw_unit(LAS unsigned char* lds, int b, int h, int p, int half, const bf16_t* Qh, const bf16_t* Kh, const bf16_t* Vh, bf16_t* PO, float* PL) {
    const int tid = opaque_tid0(), lane = tid & 63, r32 = lane & 31, hi = lane >> 5; const int wid = __builtin_amdgcn_readfirstlane(tid >> 6), pair = wid >> 1, w2 = wid & 1;
    const int dsh = 2 * p, nbsh = 5 - dsh, nblk = 1 << nbsh;
    const unsigned lds0 = (unsigned)(size_t)lds; lds_cptr shm3 = (lds_cptr)lds;
    { const float sd = exp2f(-8.0f * (float)(h + 1) / 6.0f) * LOG2E * (float)(1 << dsh);
      if (tid < 255) { const int rel = tid - 127, a = rel < 0 ? -rel : rel; const float v = a <= 64 ? -sd * (float)a : NEGBIG;
#pragma unroll
          for (int c = 0; c < 4; ++c) *(LAS float*)(lds + SW_TAB + c * SW_CS + (tid + c) * 4) = v; } }
    lds_cptr ka[4], va[2];
    { const int sw = (r32 >> 1) & 7;
#pragma unroll
      for (int d0 = 0; d0 < 4; ++d0) ka[d0] = shm3 + r32 * 128 + (((2 * d0 + hi) ^ sw) * 16);
      const int q = (lane & 15) >> 2, gb = (lane >> 4) & 1;
#pragma unroll
      for (int d0 = 0; d0 < 2; ++d0) va[d0] = shm3 + 8192 + (4 * hi + q) * 128 + ((2 * (d0 ^ (q >> 1)) + gb) * 32) + (lane & 3) * 8; }
    lds_cptr tb0; { const int idx0 = 63 - 32 * w2 - r32 + 4 * hi, c = (-idx0) & 3; tb0 = shm3 + SW_TAB + c * SW_CS + (idx0 + c) * 4; }
    const int G0 = 16 * half;
    const int prow = 8 * wid + (lane >> 3);
    const int kcol = ((lane & 7) ^ ((4 * wid + (lane >> 4)) & 7)) * 8, vcol = ((((lane & 7) >> 1) ^ (prow & 2)) * 16) + (lane & 1) * 8;
#define SW_DMA(lam) do { int tau_ = G0 - 1 + (lam); tau_ = tau_ < 0 ? 0 : (tau_ > 31 ? 31 : tau_); const int r_ = tau_ >> nbsh, n_ = tau_ & (nblk - 1); \
        const size_t ro_ = (size_t)((((n_ * 64 + prow) << dsh) + r_)) * HD; const unsigned d_ = lds0 + ((lam) & 7) * 16384 + wid * 1024; \
        glds16(Kh + ro_ + kcol, (unsigned)__builtin_amdgcn_readfirstlane(d_)); glds16(Vh + ro_ + vcol, (unsigned)__builtin_amdgcn_readfirstlane(d_ + 8192)); } while (0)
#define SW_QLOAD(dst, s) do { const int G_ = G0 + 4 * (s) + pair, r_ = G_ >> nbsh, n_ = G_ & (nblk - 1); const bf16_t* qw_ = Qh + (size_t)((((n_ * 64 + 32 * w2 + r32) << dsh) + r_)) * HD; \
        _Pragma("unroll") for (int d0 = 0; d0 < 4; ++d0) dst[d0] = *(const bf16x8*)(qw_ + d0 * 16 + hi * 8); } while (0)
    bf16x8 qr[4], qn[4];
    SW_QLOAD(qr, 0);
#pragma unroll
    for (int d0 = 0; d0 < 4; ++d0) qn[d0] = qr[d0];
#pragma unroll
    for (int lam = 0; lam < 8; ++lam) SW_DMA(lam);
    float lsum = 0.f; f32x16 o[2]; o[0] = f32x16{}; o[1] = f32x16{};
#define SW_EPI(s) do { const int G_ = G0 + 4 * (s) + pair, r_ = G_ >> nbsh, n_ = G_ & (nblk - 1); \
        lsum += __shfl_xor(lsum, 32); \
        if (hi == 0) PL[((size_t)p * T + (size_t)b * SEQ + (((n_ * 64 + 32 * w2 + r32) << dsh) + r_)) * 8 + h] = lsum; \
        LAS bf16_t* stg_ = (LAS bf16_t*)(lds + SW_STG + wid * 2048); \
        _Pragma("unroll") for (int d0 = 0; d0 < 2; ++d0) { \
            _Pragma("unroll") for (int r = 0; r < 16; ++r) stg_[crow(r, hi) * 32 + r32] = (bf16_t)f2bf(o[d0][r]); \
            asm volatile("s_waitcnt lgkmcnt(0)" ::: "memory"); \
            _Pragma("unroll") for (int i2 = 0; i2 < 2; ++i2) { const int row = i2 * 16 + (lane >> 2), ch = lane & 3; const u32x4 v = *(const LAS u32x4*)(stg_ + row * 32 + ch * 8); \
                *(u32x4*)(PO + ((size_t)p * T + (size_t)b * SEQ + (((n_ * 64 + 32 * w2 + row) << dsh) + r_)) * 384 + h * 64 + d0 * 32 + ch * 8) = v; } \
            asm volatile("s_waitcnt lgkmcnt(0)" ::: "memory"); } \
        lsum = 0.f; o[0] = f32x16{}; o[1] = f32x16{}; } while (0)
#define SW_WAIT(sig) do { if ((sig) == 0) AT_WAIT_BAR(8); else if ((sig) == 3 || (sig) == 6 || (sig) == 9) AT_WAIT_BAR(4); else if ((sig) == 10) AT_WAIT_BAR(2); else if ((sig) == 11) AT_WAIT_BAR(0); else AT_WAIT_BAR(6); } while (0)
#pragma unroll
    for (int sig = 0; sig < 12; ++sig) {
        const int s = sig / 3, t = sig - 3 * s;
        SW_WAIT(sig);
        if (t == 0 && s > 0) { SW_EPI(s - 1);
#pragma unroll
            for (int d0 = 0; d0 < 4; ++d0) qr[d0] = qn[d0]; }
        if (t == 2 && s < 3) SW_QLOAD(qn, s + 1);
        if (t == 1) { if (4 * s + 8 <= 17) SW_DMA(4 * s + 8); }
        if (t == 2) { if (4 * s + 9 <= 17) SW_DMA(4 * s + 9); }
        if (t == 0 && s > 0) { if (4 * s + 6 <= 17) SW_DMA(4 * s + 6); if (4 * s + 7 <= 17) SW_DMA(4 * s + 7); }
        const int G = G0 + 4 * s + pair, n = G & (nblk - 1);
        if (!(t == 0 && n == 0) && !(t == 2 && n == nblk - 1)) {
            const int slo = ((4 * s + t + pair) & 7) * 16384;
            const bool do0 = !(t == 0 && w2 == 1), do1 = !(t == 2 && w2 == 0);
            const lds_cptr tp = tb0 + t * 256;
            if (do0) {
                f32x16 p0;
#pragma unroll
                for (int gq = 0; gq < 4; ++gq) { const f32x4 a = *(const LAS f32x4*)(tp + 32 * gq); p0[4 * gq] = a[0]; p0[4 * gq + 1] = a[1]; p0[4 * gq + 2] = a[2]; p0[4 * gq + 3] = a[3]; }
#pragma unroll
                for (int d0 = 0; d0 < 4; ++d0) p0 = __builtin_amdgcn_mfma_f32_32x32x16_bf16(*(const LAS bf16x8*)(ka[d0] + slo), qr[d0], p0, 0, 0, 0);
                float s0 = 0.f;
#pragma unroll
                for (int r = 0; r < 16; ++r) { p0[r] = __builtin_amdgcn_exp2f(p0[r]); s0 += p0[r]; }
                lsum += s0;
                const u32x4 pw0 = (u32x4){cvtpk(p0[0], p0[1]), cvtpk(p0[2], p0[3]), cvtpk(p0[4], p0[5]), cvtpk(p0[6], p0[7])}, pw1 = (u32x4){cvtpk(p0[8], p0[9]), cvtpk(p0[10], p0[11]), cvtpk(p0[12], p0[13]), cvtpk(p0[14], p0[15])};
#pragma unroll
                for (int d0 = 0; d0 < 2; ++d0) { const lds_cptr vp = va[d0] + slo; const s16x4 l0 = vtr(vp), h0 = vtr(vp + 1024), l1 = vtr(vp + 2048), h1 = vtr(vp + 2048 + 1024);
                    o[d0] = __builtin_amdgcn_mfma_f32_32x32x16_bf16(__builtin_bit_cast(bf16x8, pw0), (bf16x8){l0[0], l0[1], l0[2], l0[3], h0[0], h0[1], h0[2], h0[3]}, o[d0], 0, 0, 0);
                    o[d0] = __builtin_amdgcn_mfma_f32_32x32x16_bf16(__builtin_bit_cast(bf16x8, pw1), (bf16x8){l1[0], l1[1], l1[2], l1[3], h1[0], h1[1], h1[2], h1[3]}, o[d0], 0, 0, 0); }
            }
            if (do1) {
                f32x16 p1;
#pragma unroll
                for (int gq = 0; gq < 4; ++gq) { const f32x4 a = *(const LAS f32x4*)(tp + 32 * (gq + 4)); p1[4 * gq] = a[0]; p1[4 * gq + 1] = a[1]; p1[4 * gq + 2] = a[2]; p1[4 * gq + 3] = a[3]; }
#pragma unroll
                for (int d0 = 0; d0 < 4; ++d0) p1 = __builtin_amdgcn_mfma_f32_32x32x16_bf16(*(const LAS bf16x8*)(ka[d0] + slo + 4096), qr[d0], p1, 0, 0, 0);
                float s1 = 0.f;
#pragma unroll
                for (int r = 0; r < 16; ++r) { p1[r] = __builtin_amdgcn_exp2f(p1[r]); s1 += p1[r]; }
                lsum += s1;
                const u32x4 pw2 = (u32x4){cvtpk(p1[0], p1[1]), cvtpk(p1[2], p1[3]), cvtpk(p1[4], p1[5]), cvtpk(p1[6], p1[7])}, pw3 = (u32x4){cvtpk(p1[8], p1[9]), cvtpk(p1[10], p1[11]), cvtpk(p1[12], p1[13]), cvtpk(p1[14], p1[15])};
#pragma unroll
                for (int d0 = 0; d0 < 2; ++d0) { const lds_cptr vp = va[d0] + slo + 4096; const s16x4 l0 = vtr(vp), h0 = vtr(vp + 1024), l1 = vtr(vp + 2048), h1 = vtr(vp + 2048 + 1024);
                    o[d0] = __builtin_amdgcn_mfma_f32_32x32x16_bf16(__builtin_bit_cast(bf16x8, pw2), (bf16x8){l0[0], l0[1], l0[2], l0[3], h0[0], h0[1], h0[2], h0[3]}, o[d0], 0, 0, 0);
                    o[d0] = __builtin_amdgcn_mfma_f32_32x32x16_bf16(__builtin_bit_cast(bf16x8, pw3), (bf16x8){l1[0], l1[1], l1[2], l1[3], h1[0], h1[1], h1[2], h1[3]}, o[d0], 0, 0, 0); }
            }
        }
    }
    AT_WAIT_BAR(0);
    SW_EPI(3);
    asm volatile("s_waitcnt lgkmcnt(0)\n\ts_barrier" ::: "memory");
#undef SW_DMA
#undef SW_QLOAD
#undef SW_EPI
#undef SW_WAIT
}
__device__ __forceinline__ void sa_loop(Frame& F, int l, unsigned xcc, int qset) {
    constexpr int NPER = 144;
    unsigned* qcnt = F.ctl + CW_ATQ + ((qset * 3 + 0) * 8) * 64;
    LAS int* qw = (LAS int*)(F.lds + CTRL_BASE + 1024);
    const int tid = opaque_tid0();
    const int xq = (int)xcc & 7; int pre = -2;
    for (;;) {
        if (tid == 0) { int id, x; at_dequeue(qcnt, NPER, xq, pre, id, x); qw[0] = id; qw[1] = x; }
        __syncthreads();
        const int id = qw[0], x = qw[1];
        __syncthreads();
        if (id < 0) break;
        pre = -2; if (tid == 0 && x == xq) pre = (int)__hip_atomic_fetch_add(qcnt + xq * 64, 1u, RLX_AGENT);
        const int P = x * 24 + id / 6, b = P / 6, h = P % 6, p = (id % 6) >> 1, half = id & 1;
        sw_unit(F.lds, b, h, p, half, qkv_ptr(F, h, b * SEQ), qkv_ptr(F, 6 + h, b * SEQ), qkv_ptr(F, 12 + h, b * SEQ), (bf16_t*)(F.ws + WS_PO), (float*)(F.ws + WS_PL));
    }
}
}

__device__ __forceinline__ void moe_weights_beside(Frame& F, int l, int qset) {
    PHASE_IDS(F);
    if ((blockIdx.x & 31) >= 8) return;
    LAS float* scr = (LAS float*)(F.lds + F.wave * 16384);
    LAS int* qw = (LAS int*)(F.lds + CTRL_BASE + 1024);
    constexpr int I_G = 16 * 16, I_D = 8 * 32, PER_E = 2 * I_G + I_D, NIT = NE * PER_E, BATCH_IT = 64;
    unsigned* head = F.ctl + CW_WQ + qset * 64;
    for (;;) {
        if (F.tid == 0) qw[2] = (int)__hip_atomic_fetch_add(head, 1u, RLX_AGENT);
        __syncthreads();
        const int bt = qw[2];
        __syncthreads();
        if (bt * BATCH_IT >= NIT) break;
        auto dec = [&](int j) { const int it = bt * BATCH_IT + j; const int e = it / PER_E; int r = it % PER_E; const size_t le = (size_t)l * NE + e;
            if (r < I_G) return TrItem{in_ptr(15) + le * D * DE, in_ptr(10) + l * D, (bf16_t*)(F.ws + WS_WGU + le * 1024 * D), D, DE, 6, r};
            r -= I_G;
            if (r < I_G) return TrItem{in_ptr(16) + le * D * DE, in_ptr(10) + l * D, (bf16_t*)(F.ws + WS_WGU + le * 1024 * D), D, DE, 7, r};
            r -= I_G;
            return TrItem{in_ptr(17) + le * DE * D, (const float*)nullptr, (bf16_t*)(F.ws + WS_WD + le * D * DE), DE, D, 5, r}; };
        float wa[32], wb[32];
        TrItem d0 = dec(F.wave); tr_load(d0, F.lane, wa);
#pragma unroll
        for (int jj = 0; jj < BATCH_IT / NWAVES; jj += 2) {
            TrItem d1 = dec(F.wave + (jj + 1) * NWAVES); tr_load(d1, F.lane, wb);
            tr_finish(d0, F.lane, wa, scr);
            if (jj + 2 < BATCH_IT / NWAVES) { d0 = dec(F.wave + (jj + 2) * NWAVES); tr_load(d0, F.lane, wa); }
            tr_finish(d1, F.lane, wb, scr);
        }
    }
    __syncthreads();
}
__device__ __forceinline__ void phase_attn_fast(Frame& F, int l, int qset) {
    if (qset < 2) moe_weights_beside(F, l, qset);
    PHASE_IDS(F);
    const unsigned xcc = xb_xcc_id();
    at::sa_loop(F, l, xcc, qset);
    if (PROBE_ID == 100 && l == 0) { __syncthreads(); at::sa_loop(F, l, xcc, 2); }
    at::attn_type_loop<1>(F, l, xcc, qset);
    if (PROBE_ID == 101 && l == 0) { __syncthreads(); at::attn_type_loop<1>(F, l, xcc, 2); }
    at::attn_type_loop<2>(F, l, xcc, qset);
    if (PROBE_ID == 102 && l == 0) { __syncthreads(); at::attn_type_loop<2>(F, l, xcc, 2); }
}

__device__ __forceinline__ bool in_ph(int lo, int hi, int k) { asm volatile("" : "+s"(lo), "+s"(hi)); return lo <= k && k < hi; }
constexpr int PH_TOTAL = 2 + 8 * DEPTH - 1;
__global__ void __launch_bounds__(NWAVES * 64, 2) fwd(Args args) {
    extern __shared__ __attribute__((aligned(16))) unsigned char lds[];
    Frame F;
    F.lds = (LAS unsigned char*)lds; PHASE_IDS(F);
    F.G = gridDim.x; F.ngw = F.G * NWAVES;
    F.out = args.out; F.ws = args.ws; F.ctl = (unsigned*)(args.ws + WS_CTL);
    volatile LAS unsigned* MISC = (volatile LAS unsigned*)(F.lds + MISC_OFF);
    if (F.tid < 32) MISC[F.tid] = 0u;
    __syncthreads();
    const int lo = args.ph_lo, hi = args.ph_hi;
    XcdBarrier bar; bar.bar = F.ctl + CW_BAR; bar.x = 0; bar.st = nullptr;
    if (hi - lo > 1) bar = xcd_barrier_post(F.ctl + CW_BAR, MISC + 8);
#define IN(k) in_ph(lo, hi, (k))
#define SEAM(k) do { if (IN(k) && IN((k) + 1)) xcd_barrier(bar); else __syncthreads(); } while (0)
#define RUN(k, code) do { if (IN(k)) { code; if (PROBE_ID == (k)) { xcd_barrier(bar); code; } } SEAM(k); } while (0)
    RUN(0, { phase_weights(F); phase_x0(F); });
    RUN(1, { phase_memkv_fast(F); phase_inproj_fast(F, 0); });
    { const int l = 0, pb = 2;
      if (IN(pb + 0)) { phase_attn_fast(F, l, 0); if (PROBE_ID == pb + 0) { xcd_barrier(bar); phase_attn_fast(F, l, 2); } } SEAM(pb + 0);
      RUN(pb + 1, { phase_groupnorm(F); });
      RUN(pb + 2, { phase_outproj_fast(F, l); });
      RUN(pb + 3, { phase_router_fast(F, l); });
      RUN(pb + 4, { phase_moe1_fast(F, l); });
      RUN(pb + 5, { phase_moe2_fast(F, l); });
      RUN(pb + 6, { phase_combine(F, l); });
      RUN(pb + 7, { phase_inproj_fast(F, 1); });
    }
    { const int l = 1, pb = 10;
      if (IN(pb + 0)) { phase_attn_fast(F, l, 1); if (PROBE_ID == pb + 0) { xcd_barrier(bar); phase_attn_fast(F, l, 3); } } SEAM(pb + 0);
      RUN(pb + 1, { phase_groupnorm(F); });
      RUN(pb + 2, { phase_outproj_fast(F, l); });
      RUN(pb + 3, { phase_router_fast(F, l); });
      RUN(pb + 4, { phase_moe1_fast(F, l); });
      RUN(pb + 5, { phase_moe2_fast(F, l); });
      RUN(pb + 6, { phase_combine(F, l); });
    }
#undef IN
#undef SEAM
#undef RUN
}

extern "C" void kernel_launch(void* const* d_in, const int* in_sizes, int n_in, void* d_out, int out_size, void* d_ws, size_t ws_size, hipStream_t stream) {
    static int grid = 0;
    if (grid == 0) {
        if (n_in != 18 || in_sizes[0] != T * D || out_size != T * D || ws_size < WS_END) { fprintf(stderr, "kernel_launch: unexpected shapes (n_in %d, in0 %d, out %d, ws %zu < %zu); nothing launched\n", n_in, n_in > 0 ? in_sizes[0] : -1, out_size, ws_size, (size_t)WS_END); grid = -1; return; }
        int dev = 0, cus = 0, per_cu = 0;
        if (hipGetDevice(&dev) != hipSuccess || hipDeviceGetAttribute(&cus, hipDeviceAttributeMultiprocessorCount, dev) != hipSuccess) { grid = -1; return; }
        if (hipFuncSetAttribute((const void*)fwd, hipFuncAttributeMaxDynamicSharedMemorySize, LDS_BYTES) != hipSuccess) { fprintf(stderr, "kernel_launch: hipFuncSetAttribute failed\n"); grid = -1; return; }
        if (hipOccupancyMaxActiveBlocksPerMultiprocessor(&per_cu, (const void*)fwd, NWAVES * 64, LDS_BYTES) != hipSuccess || per_cu < 1) fprintf(stderr, "kernel_launch: occupancy query reports %d\n", per_cu);
        (void)hipGetLastError();
        grid = cus;
    }
    if (grid < 0) return;
    if (hipMemsetAsync((char*)d_ws + WS_CTL, 0, CTL_ZERO_BYTES, stream) != hipSuccess) { fprintf(stderr, "kernel_launch: memset failed\n"); return; }
    Args a{};
    for (int i = 0; i < 18; ++i) a.in[i] = (const float*)d_in[i];
    a.out = (float*)d_out; a.ws = (unsigned char*)d_ws;
#if MK_ONE_LAUNCH
    a.ph_lo = 0; a.ph_hi = PH_TOTAL;
    hipLaunchKernelGGL(fwd, dim3(grid), dim3(NWAVES * 64), LDS_BYTES, stream, a);
#else
    for (int p = 0; p < PH_TOTAL; ++p) { a.ph_lo = p; a.ph_hi = p + 1; hipLaunchKernelGGL(fwd, dim3(grid), dim3(NWAVES * 64), LDS_BYTES, stream, a); }
#endif
    const hipError_t le = hipPeekAtLastError();
    if (le != hipSuccess) fprintf(stderr, "kernel_launch: launch failed: %s\n", hipGetErrorName(le));
}
```

```cpp
#include <hip/hip_runtime.h>
#include <cstdio>
#include <cstdint>

#ifndef PROBE_ID
#define PROBE_ID (-1)
#endif
#ifndef SPARSE_A
#define SPARSE_A 1
#endif
#ifndef MK_ONE_LAUNCH
#define MK_ONE_LAUNCH 1
#endif

constexpr int D = 1024, BATCH = 32, SEQ = 2048, T = BATCH * SEQ, DEPTH = 2;
constexpr int MEM_LEN = 256, TM = BATCH * MEM_LEN;
constexpr int HD = 64, INW = 2560, NHS = 40;
constexpr int NE = 32, EPG = 8, NGRP = 4, DE = 512;
constexpr float EPS = 1e-6f, LOG2E = 1.4426950408889634f, ATTN_SCALE = 0.125f;
constexpr int YROWS = 2 * T + NE * 256;

constexpr size_t MiB = 1u << 20;
constexpr size_t WS_CTL = 0, CTL_ZERO_BYTES = 1 * MiB;
constexpr size_t WS_WIN = 1 * MiB;
constexpr size_t WS_WMEM = WS_WIN + 10 * MiB;
constexpr size_t WS_WOUT = WS_WMEM + 2 * MiB;
constexpr size_t WS_WR = WS_WOUT + 4 * MiB;
constexpr size_t WS_WGU = WS_WR + 1 * MiB;
constexpr size_t WS_X8 = WS_WGU + 64 * MiB;
constexpr size_t WS_WD = WS_WGU + 128 * MiB;
constexpr size_t WS_FAB = WS_WD + 32 * MiB;
constexpr size_t WS_RM = WS_WD + 33 * MiB;
constexpr size_t WS_XB = WS_WD + 64 * MiB;
constexpr size_t WS_RS = WS_XB + 128 * MiB;
constexpr size_t WS_SSQ1 = WS_RS + 1 * MiB;
constexpr size_t WS_SSQH = WS_SSQ1 + 4 * MiB;
constexpr size_t WS_MB = WS_SSQH + 4 * MiB;
constexpr size_t WS_RSM = WS_MB + 16 * MiB;
constexpr size_t WS_MEMKV = WS_RSM + 1 * MiB;
constexpr size_t WS_ROUTE = WS_MEMKV + 16 * MiB;
constexpr size_t WS_LIST = WS_ROUTE + 1 * MiB;
constexpr size_t WS_WL = WS_LIST + 8 * MiB;
constexpr size_t WS_RSL = WS_WL + 8 * MiB;
constexpr size_t WS_QKV = WS_RSL + 8 * MiB;
constexpr size_t WS_MIX = WS_QKV + 320 * MiB;
constexpr size_t WS_PO = WS_MIX + 136 * MiB;
constexpr size_t WS_PL = WS_PO + 144 * MiB;
constexpr size_t WS_END = WS_PL + 6 * MiB;
static_assert(WS_END <= 1024 * MiB, "workspace map exceeds 1 GiB");
static_assert((size_t)YROWS * 1024 * 2 <= 320 * MiB && (size_t)YROWS * 512 * 4 <= 320 * MiB && (size_t)YROWS * 512 * 2 <= 136 * MiB, "aliases");
constexpr int CW_BAR = 4096;
constexpr int CW_WQ = 40960;
constexpr int CW_ATQ = 32768;
constexpr int CW_CNT = 16384;

constexpr int LDS_BYTES = 163840;
constexpr int CTRL_BASE = 159744;
constexpr int MISC_OFF = CTRL_BASE + 2048;
constexpr int NWAVES = 8;

#define GAS __attribute__((address_space(1)))
#define LAS __attribute__((address_space(3)))
typedef unsigned short bf16_t;
typedef unsigned u32x4 __attribute__((ext_vector_type(4)));
typedef unsigned u32x2 __attribute__((ext_vector_type(2)));
typedef float f32x4 __attribute__((ext_vector_type(4)));
#define RLX_AGENT __ATOMIC_RELAXED, __HIP_MEMORY_SCOPE_AGENT

__device__ __forceinline__ float bf2f(unsigned v) { return __uint_as_float(v << 16); }
__device__ __forceinline__ unsigned f2bf(float f) { unsigned u = __float_as_uint(f); return (u + 0x7fffu + ((u >> 16) & 1u)) >> 16; }
__device__ __forceinline__ unsigned pk2(float lo, float hi) { return f2bf(lo) | (f2bf(hi) << 16); }
__device__ __forceinline__ float wave_sum(float v) {
#pragma unroll
    for (int o = 1; o < 64; o <<= 1) v += __shfl_xor(v, o);
    return v;
}
__device__ __forceinline__ float wave_max(float v) {
#pragma unroll
    for (int o = 1; o < 64; o <<= 1) v = fmaxf(v, __shfl_xor(v, o));
    return v;
}

#define XB_TMO      128
#define XB_XCNT(j)  (256  + 64 * (j))
#define XB_XSUB(j)  (1280 + 64 * (j))
#define XB_XGEN(j)  (2304 + 64 * (j))
#define XB_TOP      3328
#define XB_TOPGEN   3392
#define XCD_BAR_WORDS 3456
#define XB_SPIN_CAP (1u << 18)
__device__ __forceinline__ unsigned xb_ld(unsigned* p)              { return __hip_atomic_load(p, __ATOMIC_RELAXED, __HIP_MEMORY_SCOPE_AGENT); }
__device__ __forceinline__ unsigned xb_add(unsigned* p, unsigned v) { return __hip_atomic_fetch_add(p, v, __ATOMIC_RELAXED, __HIP_MEMORY_SCOPE_AGENT); }
__device__ __forceinline__ unsigned xb_xcc_id() { return (unsigned)__builtin_amdgcn_s_getreg((3 << 11) | 20) & 0xFu; }
#define XB_SPIN(cond, bar) do { unsigned _sp = 0; while (cond) { __builtin_amdgcn_s_sleep(1); \
    if ((++_sp & 255u) == 0u) { if (xb_ld(&(bar)[XB_TMO])) break; if (_sp > XB_SPIN_CAP) { atomicAdd(&(bar)[XB_TMO], 1u); break; } } } } while (0)
struct XcdBarrier { unsigned* bar; unsigned x; volatile LAS unsigned* st; };
__device__ __forceinline__ XcdBarrier xcd_barrier_post(unsigned* bar, volatile LAS unsigned* st) {
    XcdBarrier b; b.bar = bar; b.x = xb_xcc_id(); b.st = st;
    if (threadIdx.x == 0) (void)xb_add(&bar[XB_XCNT(b.x)], 1u);
    return b;
}
__device__ __forceinline__ void xcd_barrier_complete(unsigned* bar, unsigned x, unsigned& nloc, unsigned& nx) {
    const unsigned G = gridDim.x * gridDim.y * gridDim.z;
    unsigned sum, cnt, mine, sp = 0u;
    for (;;) {
        sum = 0u; cnt = 0u; mine = 0u;
#pragma unroll
        for (unsigned j = 0; j < 16; ++j) { const unsigned c = xb_ld(&bar[XB_XCNT(j)]); sum += c; cnt += (c > 0u) ? 1u : 0u; mine = (j == x) ? c : mine; }
        if (sum == G) break;
        __builtin_amdgcn_s_sleep(1);
        if ((++sp & 255u) == 0u) { if (xb_ld(&bar[XB_TMO])) break; if (sp > XB_SPIN_CAP) { atomicAdd(&bar[XB_TMO], 1u); break; } }
    }
    nloc = mine > 0u ? mine : 1u; nx = cnt > 0u ? cnt : 1u;
}
__device__ __forceinline__ void xcd_barrier(const XcdBarrier& b) {
    asm volatile("s_waitcnt vmcnt(0)" ::: "memory");
    __syncthreads();
    if (threadIdx.x == 0) {
        unsigned* bar = b.bar;
        __builtin_amdgcn_s_waitcnt(0);
        unsigned nloc = b.st[0], nx = b.st[1];
        if (nloc == 0u) { xcd_barrier_complete(bar, b.x, nloc, nx); b.st[0] = nloc; b.st[1] = nx; }
        const unsigned old = xb_add(&bar[XB_XSUB(b.x)], 1u);
        const unsigned gen = old / nloc;
        if (old + 1u == (gen + 1u) * nloc) {
            __builtin_amdgcn_fence(__ATOMIC_RELEASE, "agent");
            asm volatile("s_waitcnt vmcnt(0)" ::: "memory");
            const unsigned og = xb_add(&bar[XB_TOP], 1u);
            const unsigned tg = og / nx;
            if (og + 1u == (tg + 1u) * nx) xb_add(&bar[XB_TOPGEN], 1u);
            else XB_SPIN(xb_ld(&bar[XB_TOPGEN]) == tg, bar);
            __builtin_amdgcn_fence(__ATOMIC_ACQUIRE, "agent");
            xb_add(&bar[XB_XGEN(b.x)], 1u);
            asm volatile("s_waitcnt vmcnt(0)" ::: "memory");
        } else {
            XB_SPIN(xb_ld(&bar[XB_XGEN(b.x)]) == gen, bar);
            __builtin_amdgcn_fence(__ATOMIC_ACQUIRE, "agent");
            asm volatile("s_waitcnt vmcnt(0)" ::: "memory");
        }
    }
    __syncthreads();
}

struct Args {
    const float* in[18]; float* out; unsigned char* ws; int ph_lo, ph_hi;
};
__device__ __forceinline__ const float* in_ptr(int k) {
    const __attribute__((address_space(4))) char* ka = (const __attribute__((address_space(4))) char*)__builtin_amdgcn_kernarg_segment_ptr();
    asm volatile("" : "+s"(ka));
    return *(const float* const __attribute__((address_space(4)))*)(ka + 8 * k);
}
struct Frame {
    LAS unsigned char* lds; int tid, lane, wave, G, gw, ngw;
    float* out; unsigned char* ws; unsigned* ctl;
};

#define PHASE_IDS(F) do { (F).tid = opaque_tid0(); (F).lane = (F).tid & 63; (F).wave = __builtin_amdgcn_readfirstlane((F).tid >> 6); (F).gw = blockIdx.x * NWAVES + (F).wave; } while (0)
__device__ __forceinline__ int opaque_tid0() { int t = threadIdx.x; asm volatile("" : "+v"(t)); return t; }
__host__ __device__ __forceinline__ int inproj_gemm_col(int H, int dim) {
    const int pn = H >> 2, wc = H & 3, bj = dim >> 5, fq = (dim >> 3) & 3, nn = (dim >> 2) & 1, j = dim & 3;
    return 256 * pn + 128 * bj + 32 * wc + 16 * nn + 4 * fq + j;
}
__host__ __device__ __forceinline__ void inproj_head_dim(int c, int& H, int& dim) {
    const int pn = c >> 8, r = c & 255, bj = r >> 7, wc = (r >> 5) & 3, nn = (r >> 4) & 1, fq = (r >> 2) & 3, j = r & 3;
    H = 4 * pn + wc; dim = 32 * bj + 8 * fq + 4 * nn + j;
}

struct TrItem { const float* W; const float* kgain; bf16_t* WT; int K, N, kind, item; };
__device__ __forceinline__ void tr_load(const TrItem& d, int lane, float (&wv)[32]) {
    const int nblk = d.N / 32, kb = d.item / nblk, nb = d.item % nblk, k0 = 64 * kb, n0 = 32 * nb;
#pragma unroll
    for (int i = 0; i < 32; ++i) wv[i] = d.W[(size_t)(k0 + 2 * i + (lane >> 5)) * d.N + n0 + (lane & 31)];
}
__device__ __forceinline__ int tr_rowmap(int kind, int n);
__device__ __forceinline__ void tr_finish(const TrItem& d, int lane, const float (&wv)[32], LAS float* scr) {
    const int nblk = d.N / 32, kb = d.item / nblk, nb = d.item % nblk, k0 = 64 * kb, n0 = 32 * nb;
#pragma unroll
    for (int i = 0; i < 32; ++i) { const int kk = 2 * i + (lane >> 5); const float g = d.kgain ? d.kgain[k0 + kk] : 1.f; scr[kk * 33 + (lane & 31)] = wv[i] * g; }
    asm volatile("s_waitcnt lgkmcnt(0)" ::: "memory");
    const int c = lane & 7;
#pragma unroll
    for (int j = 0; j < 4; ++j) { const int n = (lane >> 3) + 8 * j; const LAS float* s = scr + (8 * c) * 33 + n;
        u32x4 o; o.x = pk2(s[0 * 33], s[1 * 33]); o.y = pk2(s[2 * 33], s[3 * 33]); o.z = pk2(s[4 * 33], s[5 * 33]); o.w = pk2(s[6 * 33], s[7 * 33]);
        if (d.kind >= 5) {
            int w0 = 0, w1 = 0;
            w0 = __builtin_amdgcn_cvt_pk_fp8_f32(32.f * s[0 * 33], 32.f * s[1 * 33], w0, false); w0 = __builtin_amdgcn_cvt_pk_fp8_f32(32.f * s[2 * 33], 32.f * s[3 * 33], w0, true);
            w1 = __builtin_amdgcn_cvt_pk_fp8_f32(32.f * s[4 * 33], 32.f * s[5 * 33], w1, false); w1 = __builtin_amdgcn_cvt_pk_fp8_f32(32.f * s[6 * 33], 32.f * s[7 * 33], w1, true);
            u32x2 o8; o8.x = (unsigned)w0; o8.y = (unsigned)w1;
            *(u32x2*)((unsigned char*)d.WT + (size_t)tr_rowmap(d.kind, n0 + n) * d.K + k0 + 8 * c) = o8;
        } else *(u32x4*)(d.WT + (size_t)tr_rowmap(d.kind, n0 + n) * d.K + k0 + 8 * c) = o; }
    asm volatile("s_waitcnt lgkmcnt(0)" ::: "memory");
}
struct RmId { __device__ __forceinline__ int operator()(int n) const { return n; } };
struct RmHead { __device__ __forceinline__ int operator()(int n) const { return inproj_gemm_col(n >> 6, n & 63); } };
__host__ __device__ __forceinline__ int perm_row32(int c) { const int o = c & 31; return (c & ~31) | (16 * ((o >> 2) & 1) + 4 * (o >> 3) + (o & 3)); }
__host__ __device__ __forceinline__ int gate_row(int c, int up) { return 256 * (c >> 7) + 128 * up + perm_row32(c & 127); }
struct RmGate { int up; __device__ __forceinline__ int operator()(int n) const { return gate_row(n, up); } };
struct RmPerm { __device__ __forceinline__ int operator()(int n) const { return perm_row32(n); } };
__device__ __forceinline__ int tr_rowmap(int kind, int n) { return kind == 0 ? n : (kind == 1 ? inproj_gemm_col(n >> 6, n & 63) : ((kind == 2 || kind == 6) ? gate_row(n, 0) : ((kind == 3 || kind == 7) ? gate_row(n, 1) : perm_row32(n)))); }

__device__ __forceinline__ TrItem tr_decode_small(int it) {
    constexpr int I_IN = 16 * 80, I_MEM = 16 * 16, I_OUT = 16 * 32, PER_L = I_IN + I_MEM + I_OUT;
    const int l = it / PER_L; int r = it % PER_L;
    if (r < I_IN) return TrItem{in_ptr(3) + (size_t)l * D * INW, in_ptr(2) + l * D, (bf16_t*)nullptr, D, INW, 100 + l, r};
    r -= I_IN;
    if (r < I_MEM) return TrItem{in_ptr(7) + (size_t)l * D * 512, in_ptr(6) + l * D, (bf16_t*)nullptr, D, 512, 200 + l, r};
    r -= I_MEM;
    return TrItem{in_ptr(9) + (size_t)l * D * D, in_ptr(8) + l * D, (bf16_t*)nullptr, D, D, 300 + l, r};
}
__device__ __forceinline__ void phase_weights(Frame& F) {
    PHASE_IDS(F);
    LAS float* scr = (LAS float*)(F.lds + F.wave * 16384);
    constexpr int PER_L = 16 * 80 + 16 * 16 + 16 * 32, NIT = DEPTH * PER_L;
    auto fix = [&](TrItem d) { const int l = d.kind % 100, w = d.kind / 100;
        if (w == 1) { d.WT = (bf16_t*)(F.ws + WS_WIN) + (size_t)l * INW * D; d.kind = 1; } else if (w == 2) { d.WT = (bf16_t*)(F.ws + WS_WMEM) + (size_t)l * 512 * D; d.kind = 1; } else { d.WT = (bf16_t*)(F.ws + WS_WOUT) + (size_t)l * D * D; d.kind = 4; }
        return d; };
    float wa[32], wb[32];
    int it = F.gw;
    if (it < NIT) { TrItem d = fix(tr_decode_small(it)); tr_load(d, F.lane, wa);
        for (;;) {
            const int it2 = it + F.ngw; TrItem d2 = d; const bool more = it2 < NIT;
            if (more) { d2 = fix(tr_decode_small(it2)); tr_load(d2, F.lane, wb); }
            tr_finish(d, F.lane, wa, scr);
            if (!more) break;
            const int it3 = it2 + F.ngw; const bool more3 = it3 < NIT; TrItem d3 = d2;
            if (more3) { d3 = fix(tr_decode_small(it3)); tr_load(d3, F.lane, wa); }
            tr_finish(d2, F.lane, wb, scr);
            if (!more3) break;
            it = it3; d = d3;
        } }
    for (int i = F.gw * 64 + F.lane; i < DEPTH * 256 * D; i += F.ngw * 64) {
        const int l = i / (256 * D), j = (i / D) % 256, k = i % D; float v = 0.f;
        if (j < 4) v = in_ptr(11)[((size_t)l * D + k) * NGRP + j] * in_ptr(10)[l * D + k]; else if (j < 36) v = in_ptr(13)[((size_t)l * D + k) * NE + (j - 4)] * in_ptr(10)[l * D + k];
        ((bf16_t*)(F.ws + WS_WR))[i] = (bf16_t)f2bf(v);
    }
}

__device__ __forceinline__ void row_to_bf16_rs(int lane, const float* xrow, bf16_t* orow, float* rs) {
    const f32x4* xr = (const f32x4*)xrow + lane; f32x4 v[4]; float s = 0.f;
#pragma unroll
    for (int j = 0; j < 4; ++j) { v[j] = xr[64 * j]; s += (v[j].x * v[j].x + v[j].y * v[j].y) + (v[j].z * v[j].z + v[j].w * v[j].w); }
    s = wave_sum(s);
    if (lane == 0) *rs = 1.0f / sqrtf(s * (1.f / D) + EPS);
    u32x2* o8 = (u32x2*)orow + lane;
#pragma unroll
    for (int j = 0; j < 4; ++j) { u32x2 w; w.x = pk2(v[j].x, v[j].y); w.y = pk2(v[j].z, v[j].w); o8[64 * j] = w; }
}
__device__ __forceinline__ void phase_x0(Frame& F) {
    PHASE_IDS(F);
    const float* xp = in_ptr(0); const float* mp = in_ptr(1); const int lane = F.lane;
    for (int m0 = F.gw * 2; m0 < T + TM; m0 += F.ngw * 2) {
        const bool isx = m0 < T; const int r0 = isx ? m0 : m0 - T;
        const float* src = (isx ? xp : mp) + (size_t)r0 * D; bf16_t* dst = (bf16_t*)(F.ws + (isx ? WS_XB : WS_MB)) + (size_t)r0 * D; float* rs = (float*)(F.ws + (isx ? WS_RS : WS_RSM)) + r0;
        f32x4 v[2][4];
#pragma unroll
        for (int k = 0; k < 2; ++k)
#pragma unroll
            for (int j = 0; j < 4; ++j) v[k][j] = ((const f32x4*)(src + (size_t)k * D) + lane)[64 * j];
#pragma unroll
        for (int k = 0; k < 2; ++k) { float s = 0.f;
#pragma unroll
            for (int j = 0; j < 4; ++j) s += (v[k][j].x * v[k][j].x + v[k][j].y * v[k][j].y) + (v[k][j].z * v[k][j].z + v[k][j].w * v[k][j].w);
            s = wave_sum(s);
            if (lane == 0) rs[k] = 1.0f / sqrtf(s * (1.f / D) + EPS);
            u32x2* o8 = (u32x2*)(dst + (size_t)k * D) + lane;
#pragma unroll
            for (int j = 0; j < 4; ++j) { u32x2 w; w.x = pk2(v[k][j].x, v[k][j].y); w.y = pk2(v[k][j].z, v[k][j].w); o8[64 * j] = w; } }
    }
}

__device__ __forceinline__ bf16_t* qkv_ptr(Frame& F, int H, int t) { return (bf16_t*)(F.ws + WS_QKV) + ((size_t)H * T + t) * HD; }
__device__ __forceinline__ bf16_t* memkv_ptr(Frame& F, int l, int H, int r) { return (bf16_t*)(F.ws + WS_MEMKV) + (((size_t)l * 8 + H) * TM + r) * HD; }

__device__ __forceinline__ void slice_kind(int H, int& gi, bool& isq) {
    gi = -1; isq = false;
    if (H < 6) { gi = 0; isq = true; } else if (H < 12) gi = 1; else if (H < 18) gi = -1;
    else if (H < 24) { gi = 2; isq = true; } else if (H < 30) gi = 3; else if (H < 36) gi = -1; else { gi = 4; isq = true; }
}
__device__ __forceinline__ void phase_groupnorm(Frame& F) {
    PHASE_IDS(F);
    const int lane = F.lane, half = lane >> 5, l32 = lane & 31, h = l32 >> 2; const bool act = l32 < 24;
    const bf16_t* PO = (const bf16_t*)(F.ws + WS_PO); const float* PL = (const float*)(F.ws + WS_PL); bf16_t* MX = (bf16_t*)(F.ws + WS_MIX);
    const float* SQ = (const float*)(F.ws + WS_SSQH); float* FAB = (float*)(F.ws + WS_FAB); float* RM = (float*)(F.ws + WS_RM);
    for (int t0 = F.gw * 8; t0 < T; t0 += F.ngw * 8) {
        u32x4 raw[4][3][2]; float den[4][3]; f32x4 sq[4][3];
#pragma unroll
        for (int u = 0; u < 4; ++u) { const int t = t0 + 2 * u + half;
            if (act) {
#pragma unroll
                for (int p = 0; p < 3; ++p) { const u32x4* pp = (const u32x4*)(PO + ((size_t)p * T + t) * 384 + l32 * 16); raw[u][p][0] = pp[0]; raw[u][p][1] = pp[1]; den[u][p] = PL[((size_t)p * T + t) * 8 + h]; }
            }
#pragma unroll
            for (int q = 0; q < 3; ++q) sq[u][q] = *(const f32x4*)(SQ + (size_t)t * 16 + 4 + 4 * q);
        }
#pragma unroll
        for (int u = 0; u < 4; ++u) { const int t = t0 + 2 * u + half; float v[16]; float s = 0.f;
            if (act) {
#pragma unroll
                for (int i = 0; i < 2; ++i) { const u32x4 w = raw[u][0][i]; v[8 * i + 0] = bf2f(w.x & 0xffffu); v[8 * i + 1] = bf2f(w.x >> 16); v[8 * i + 2] = bf2f(w.y & 0xffffu); v[8 * i + 3] = bf2f(w.y >> 16);
                    v[8 * i + 4] = bf2f(w.z & 0xffffu); v[8 * i + 5] = bf2f(w.z >> 16); v[8 * i + 6] = bf2f(w.w & 0xffffu); v[8 * i + 7] = bf2f(w.w >> 16); }
#pragma unroll
                for (int p = 1; p < 3; ++p)
#pragma unroll
                    for (int i = 0; i < 2; ++i) { const u32x4 w = raw[u][p][i]; v[8 * i + 0] += bf2f(w.x & 0xffffu); v[8 * i + 1] += bf2f(w.x >> 16); v[8 * i + 2] += bf2f(w.y & 0xffffu); v[8 * i + 3] += bf2f(w.y >> 16);
                        v[8 * i + 4] += bf2f(w.z & 0xffffu); v[8 * i + 5] += bf2f(w.z >> 16); v[8 * i + 6] += bf2f(w.w & 0xffffu); v[8 * i + 7] += bf2f(w.w >> 16); }
                const float rd = 1.0f / ((den[u][0] + den[u][1]) + den[u][2]);
                u32x4 o[2];
#pragma unroll
                for (int i = 0; i < 2; ++i) { o[i].x = pk2(v[8 * i + 0] * rd, v[8 * i + 1] * rd); o[i].y = pk2(v[8 * i + 2] * rd, v[8 * i + 3] * rd); o[i].z = pk2(v[8 * i + 4] * rd, v[8 * i + 5] * rd); o[i].w = pk2(v[8 * i + 6] * rd, v[8 * i + 7] * rd);
                    float a;
                    a = bf2f(o[i].x & 0xffffu); s += a * a; a = bf2f(o[i].x >> 16); s += a * a; a = bf2f(o[i].y & 0xffffu); s += a * a; a = bf2f(o[i].y >> 16); s += a * a;
                    a = bf2f(o[i].z & 0xffffu); s += a * a; a = bf2f(o[i].z >> 16); s += a * a; a = bf2f(o[i].w & 0xffffu); s += a * a; a = bf2f(o[i].w >> 16); s += a * a; }
                u32x4* mp = (u32x4*)(MX + (size_t)t * D + l32 * 16); mp[0] = o[0]; mp[1] = o[1];
            }
            s += __shfl_xor(s, 1); s += __shfl_xor(s, 2); s += __shfl_xor(s, 4); s += __shfl_xor(s, 8); s += __shfl_xor(s, 16);
            if (l32 == 0) {
                const float sb = ((sq[u][0][2] + sq[u][0][3]) + (sq[u][1][0] + sq[u][1][1])) + (sq[u][1][2] + sq[u][1][3]), sm = (sq[u][2][0] + sq[u][2][1]) + (sq[u][2][2] + sq[u][2][3]);
                const float ra = 1.f / sqrtf(s * (1.f / 384.f) + EPS), rb = 1.f / sqrtf(sb * (1.f / 384.f) + EPS), rmv = 1.f / sqrtf(sm * (1.f / 256.f) + EPS);
                FAB[(size_t)t * 2] = ra / rb; FAB[(size_t)t * 2 + 1] = rb / rmv; RM[t] = rmv; }
        }
    }
}
__device__ __forceinline__ void load_expert_table(LAS int* tab, const unsigned* cnt) {
    const int tid = opaque_tid0(), lane = tid & 63;
    if (tid < 64) {
        const int c = lane < NE ? (int)__hip_atomic_load(cnt + lane * 64, RLX_AGENT) : 0;
        int inc = (c + 255) >> 8;
#pragma unroll
        for (int o = 1; o < 64; o <<= 1) { const int v = __shfl_up(inc, o); if (lane >= o) inc += v; }
        tab[lane] = inc - ((c + 255) >> 8); tab[64 + lane] = c;
    }
    __syncthreads();
}
__device__ __forceinline__ void phase_combine(Frame& F, int l) {
    PHASE_IDS(F);
    LAS int* tab = (LAS int*)(F.lds + CTRL_BASE);
    load_expert_table(tab, F.ctl + CW_CNT + l * NE * 64);
    const unsigned char* Y = (const unsigned char*)(F.ws + WS_QKV); const int lane = F.lane;
    typedef float f32x2_t __attribute__((ext_vector_type(2)));
    typedef int i32x4_t __attribute__((ext_vector_type(4)));
    constexpr int TK = 2;
    for (int t0 = F.gw * TK; t0 < T; t0 += F.ngw * TK) {
        i32x4_t rt[TK];
#pragma unroll
        for (int k = 0; k < TK; ++k) rt[k] = *(const i32x4_t*)((const int*)(F.ws + WS_ROUTE) + (size_t)(t0 + k) * 4);
        u32x2 xv[TK][4]; unsigned ya[TK][4], yb[TK][4];
#pragma unroll
        for (int k = 0; k < TK; ++k) { int ea = rt[k][0], pa = rt[k][1], eb = rt[k][2], pb = rt[k][3];
            if (ea > eb) { int q = ea; ea = eb; eb = q; q = pa; pa = pb; pb = q; }
            const unsigned* pya = (const unsigned*)(Y + (size_t)(tab[ea] * 256 + pa) * D) + lane; const unsigned* pyb = (const unsigned*)(Y + (size_t)(tab[eb] * 256 + pb) * D) + lane;
            const u32x2* xr = (const u32x2*)((const bf16_t*)(F.ws + WS_XB) + (size_t)(t0 + k) * D) + lane;
#pragma unroll
            for (int j = 0; j < 4; ++j) { xv[k][j] = xr[64 * j]; ya[k][j] = pya[64 * j]; yb[k][j] = pyb[64 * j]; } }
#pragma unroll
        for (int k = 0; k < TK; ++k) { const int t = t0 + k; f32x4 v[4]; float s = 0.f;
#pragma unroll
            for (int j = 0; j < 4; ++j) { const u32x2 x = xv[k][j]; const int a = (int)ya[k][j], b2 = (int)yb[k][j];
                const f32x2_t a0 = __builtin_amdgcn_cvt_pk_f32_fp8(a, false), a1 = __builtin_amdgcn_cvt_pk_f32_fp8(a, true), b0 = __builtin_amdgcn_cvt_pk_f32_fp8(b2, false), b1 = __builtin_amdgcn_cvt_pk_f32_fp8(b2, true);
                v[j].x = (bf2f(x.x & 0xffffu) + 0.125f * a0[0]) + 0.125f * b0[0]; v[j].y = (bf2f(x.x >> 16) + 0.125f * a0[1]) + 0.125f * b0[1];
                v[j].z = (bf2f(x.y & 0xffffu) + 0.125f * a1[0]) + 0.125f * b1[0]; v[j].w = (bf2f(x.y >> 16) + 0.125f * a1[1]) + 0.125f * b1[1]; }
            if (l + 1 < DEPTH) {
                u32x2* o8 = (u32x2*)((bf16_t*)(F.ws + WS_XB) + (size_t)t * D) + lane;
#pragma unroll
                for (int j = 0; j < 4; ++j) { u32x2 w; w.x = pk2(v[j].x, v[j].y); w.y = pk2(v[j].z, v[j].w); o8[64 * j] = w;
                    const float o0 = bf2f(w.x & 0xffffu), o1 = bf2f(w.x >> 16), o2 = bf2f(w.y & 0xffffu), o3 = bf2f(w.y >> 16); s += (o0 * o0 + o1 * o1) + (o2 * o2 + o3 * o3); }
                s = wave_sum(s);
                if (lane == 0) ((float*)(F.ws + WS_RS))[t] = 1.0f / sqrtf(s * (1.f / D) + EPS);
            } else {
                f32x4* xo = (f32x4*)(F.out + (size_t)t * D) + lane;
#pragma unroll
                for (int j = 0; j < 4; ++j) xo[64 * j] = v[j];
            }
        }
    }
}

namespace g8 {
typedef short bf16x8 __attribute__((ext_vector_type(8)));
constexpr int BK = 64, HALF = 128, HTB = HALF * BK * 2, NXCD = 8, WGM = 8;
__device__ __forceinline__ int lds_byte(int r, int c) { const int st = (r >> 4) * 2 + (c >> 5), rr = r & 15, cc = c & 31, ob = rr * 64 + cc * 2; return st * 1024 + (ob ^ (((ob >> 9) & 1) << 5)); }
__device__ __forceinline__ void stage_rc(int b, int& R, int& C) { const int st = b / 1024, sb = b % 1024, swz = sb ^ (((sb >> 9) & 1) << 5); R = (st >> 1) * 16 + swz / 64; C = (st & 1) * 32 + (swz % 64) / 2; }
__device__ __forceinline__ unsigned cvt_pk_bf16(float lo, float hi) { unsigned r; asm volatile("v_cvt_pk_bf16_f32 %0, %1, %2" : "=v"(r) : "v"(lo), "v"(hi)); return r; }
__device__ __forceinline__ int opaque_tid() { int t = threadIdx.x; asm volatile("" : "+v"(t)); return t; }
__device__ __forceinline__ const char* uni(const char* p) { const unsigned long long v = (unsigned long long)p;
    return (const char*)(((unsigned long long)(unsigned)__builtin_amdgcn_readfirstlane((int)(v >> 32)) << 32) | (unsigned)__builtin_amdgcn_readfirstlane((int)v)); }
typedef int i32x8 __attribute__((ext_vector_type(8)));
typedef int i32x4v __attribute__((ext_vector_type(4)));
__device__ __forceinline__ float clamp8(float v) { return fminf(fmaxf(v, -440.f), 440.f); }
__device__ __forceinline__ i32x8 cat8(i32x4v a, i32x4v b) { return __builtin_shufflevector(a, b, 0, 1, 2, 3, 4, 5, 6, 7); }
__device__ __forceinline__ bf16x8 lo8(i32x8 v) { return __builtin_bit_cast(bf16x8, (i32x4v)__builtin_shufflevector(v, v, 0, 1, 2, 3)); }
__device__ __forceinline__ bf16x8 hi8(i32x8 v) { return __builtin_bit_cast(bf16x8, (i32x4v)__builtin_shufflevector(v, v, 4, 5, 6, 7)); }
__device__ __forceinline__ float allsum_rows(float v) {
    const unsigned a = __float_as_uint(v); const auto r = __builtin_amdgcn_permlane16_swap(a, a, false, false);
    const float s = __uint_as_float(r[0]) + __uint_as_float(r[1]);
    const unsigned b = __float_as_uint(s); const auto q = __builtin_amdgcn_permlane32_swap(b, b, false, false);
    return __uint_as_float(q[0]) + __uint_as_float(q[1]);
}
struct Unit { const char* B; unsigned a00, a01, a10, a11; int pm, pn, e, ti, ce; };
struct DenseSched {
    int nM, nN, nwg, G, c, K; const char* Bbase;
    __device__ __forceinline__ void init(int M, int N, int K_, int G_, int c_, int tid, const void* Bt) { nM = M / 256; nN = N / 256; nwg = nM * nN; G = G_; c = c_; K = K_; Bbase = (const char*)Bt; }
    __device__ __forceinline__ bool next(int i, Unit& u) const {
        const long L = (long)i * G + c; if (L >= nwg) return false;
        int wgid = (int)L; { const int q = nwg / NXCD, r = nwg % NXCD, xcd = wgid % NXCD, off = wgid / NXCD; wgid = (xcd < r ? xcd * (q + 1) : r * (q + 1) + (xcd - r) * q) + off; }
        const int nig = WGM * nN, gid = wgid / nig, fm = gid * WGM, gsz = (nM - fm) < WGM ? (nM - fm) : WGM;
        u.pm = fm + ((wgid % nig) % gsz); u.pn = (wgid % nig) / gsz; u.e = 0; u.ti = 0; u.ce = 0;
        u.B = Bbase + (size_t)u.pn * 256 * K * 2;
        int R[2], C[2]; { const int tid = opaque_tid(); stage_rc(tid * 16, R[0], C[0]); stage_rc(tid * 16 + 8192, R[1], C[1]); }
        u.a00 = (unsigned)((u.pm * 256 + R[0]) * K + C[0]) * 2u; u.a01 = (unsigned)((u.pm * 256 + R[1]) * K + C[1]) * 2u;
        u.a10 = (unsigned)((u.pm * 256 + 128 + R[0]) * K + C[0]) * 2u; u.a11 = (unsigned)((u.pm * 256 + 128 + R[1]) * K + C[1]) * 2u;
        return true;
    }
};
struct GroupSched {
    int NP, total, G, vb, K; const char* Bbase; size_t Bstride; const int* list; bool gather; LAS int* tab;
    __device__ __forceinline__ void init(LAS int* tab_, const unsigned* cnt, int NP_, int K_, int G_, int bid, const void* Bt, size_t Bstride_, const int* list_, bool gather_) {
        const int tid = opaque_tid(), lane = tid & 63; NP = NP_; K = K_; G = G_; vb = (G_ % 8 == 0) ? (bid % 8) * (G_ / 8) + bid / 8 : bid; Bbase = (const char*)Bt; Bstride = Bstride_; list = list_; gather = gather_; tab = tab_;
        const int c = lane < NE ? (int)__hip_atomic_load(cnt + lane * 64, RLX_AGENT) : 0;
        int inc = (c + 255) >> 8;
#pragma unroll
        for (int o = 1; o < 64; o <<= 1) { const int v = __shfl_up(inc, o); if (lane >= o) inc += v; }
        total = __builtin_amdgcn_readfirstlane(__shfl(inc, 63)) * NP;
        if (tid < 64) { tab[lane] = inc - ((c + 255) >> 8); tab[64 + lane] = c; }
        __syncthreads();
    }
    __device__ __forceinline__ bool next(int i, Unit& u) const {
        const int L = i * G + vb; if (L >= total) return false;
        const int tid = opaque_tid(), g = L / NP, lane = tid & 63; u.pn = L % NP; u.pm = g;
        int R[2], C[2]; stage_rc(tid * 16, R[0], C[0]); stage_rc(tid * 16 + 8192, R[1], C[1]);
        const int e = __builtin_amdgcn_readfirstlane(__popcll(__ballot(lane < NE && tab[lane] <= g)) - 1);
        u.e = e; u.ti = g - __builtin_amdgcn_readfirstlane(tab[e]); u.ce = __builtin_amdgcn_readfirstlane(tab[64 + e]);
        u.B = Bbase + (size_t)e * Bstride + (size_t)u.pn * 256 * K * 2;
        if (gather) {
            const int* le = list + (size_t)e * T; const int b = u.ti * 256, mx = u.ce - 1;
            const int t00 = le[min(b + R[0], mx)], t01 = le[min(b + R[1], mx)], t10 = le[min(b + 128 + R[0], mx)], t11 = le[min(b + 128 + R[1], mx)];
            u.a00 = (unsigned)(t00 * K + C[0]) * 2u; u.a01 = (unsigned)(t01 * K + C[1]) * 2u; u.a10 = (unsigned)(t10 * K + C[0]) * 2u; u.a11 = (unsigned)(t11 * K + C[1]) * 2u;
        } else {
            u.a00 = (unsigned)((g * 256 + R[0]) * K + C[0]) * 2u; u.a01 = (unsigned)((g * 256 + R[1]) * K + C[1]) * 2u;
            u.a10 = (unsigned)((g * 256 + 128 + R[0]) * K + C[0]) * 2u; u.a11 = (unsigned)((g * 256 + 128 + R[1]) * K + C[1]) * 2u;
        }
        return true;
    }
};

template <class Epi, class Sched>
__device__ __forceinline__ void gemm_phase(LAS unsigned char* lds, const void* Abase_, int K, const Sched& S, const Epi& E) {
    const int tid = opaque_tid(), wid = __builtin_amdgcn_readfirstlane(tid >> 6), lane = tid & 63, wr = wid >> 2, wc = wid & 3, fr = lane & 15, fq = lane >> 4;
    int nt = K / BK; asm volatile("" : "+s"(nt)); const char* Abase = (const char*)Abase_;
    unsigned voffB[2];
#pragma unroll
    for (int i = 0; i < 2; ++i) { int R, C; stage_rc(tid * 16 + i * 8192, R, C); voffB[i] = (unsigned)(R * K + C) * 2u; }
    const size_t kstep = (size_t)(BK * 2), hstep = (size_t)HALF * K * 2;
    const unsigned ldsw = (unsigned)wid * 1024u;
    const int aoff = lds_byte(wr * 64 + fr, fq * 8), boff = lds_byte(wc * 32 + fr, fq * 8);
#define G8_SA(b, h) (((b) * 2 + (h)) * HTB)
#define G8_SB(b, h) ((4 + (b) * 2 + (h)) * HTB)
#define G8_STAGE(bufoff, gbase, voff) do { const char* _g = uni((const char*)(gbase)); _Pragma("unroll") for (int _i = 0; _i < 2; ++_i) \
        __builtin_amdgcn_global_load_lds((const unsigned*)(_g + (voff)[_i]), (LAS unsigned*)(lds + (bufoff) + ldsw + _i * 8192), 16, 0, 0); } while (0)
#define G8_STAGE_A(bufoff, gbase, o0, o1) do { const char* _g = uni((const char*)(gbase)); \
        __builtin_amdgcn_global_load_lds((const unsigned*)(_g + (o0)), (LAS unsigned*)(lds + (bufoff) + ldsw), 16, 0, 0); \
        __builtin_amdgcn_global_load_lds((const unsigned*)(_g + (o1)), (LAS unsigned*)(lds + (bufoff) + ldsw + 8192), 16, 0, 0); } while (0)
#define G8_LDA(dst, b, h) do { _Pragma("unroll") for (int m = 0; m < 4; ++m) dst[m] = cat8(*(const LAS i32x4v*)(lds + G8_SA(b, h) + aoff + m * 2048), *(const LAS i32x4v*)(lds + G8_SA(b, h) + aoff + m * 2048 + 1024)); } while (0)
#define G8_LDB(dst, b, h) do { _Pragma("unroll") for (int n = 0; n < 2; ++n) dst[n] = cat8(*(const LAS i32x4v*)(lds + G8_SB(b, h) + boff + n * 2048), *(const LAS i32x4v*)(lds + G8_SB(b, h) + boff + n * 2048 + 1024)); } while (0)
#define G8_MMA(ai, bj, At, Bt) do { __builtin_amdgcn_s_setprio(1); _Pragma("unroll") for (int m = 0; m < 4; ++m) _Pragma("unroll") for (int n = 0; n < 2; ++n) { \
        if constexpr (Epi::FP8) acc[ai][bj][m][n] = __builtin_amdgcn_mfma_scale_f32_16x16x128_f8f6f4(Bt[n], At[m], acc[ai][bj][m][n], 0, 0, 0, 0x7F7F7F7F, 0, 0x7F7F7F7F); \
        else { acc[ai][bj][m][n] = __builtin_amdgcn_mfma_f32_16x16x32_bf16(lo8(Bt[n]), lo8(At[m]), acc[ai][bj][m][n], 0, 0, 0); \
               acc[ai][bj][m][n] = __builtin_amdgcn_mfma_f32_16x16x32_bf16(hi8(Bt[n]), hi8(At[m]), acc[ai][bj][m][n], 0, 0, 0); } } __builtin_amdgcn_s_setprio(0); } while (0)
#define G8_WAIT_V(n) asm volatile("s_waitcnt vmcnt(" #n ")" ::: "memory")
#define G8_WAIT_L(n) asm volatile("s_waitcnt lgkmcnt(" #n ")" ::: "memory")
#define G8_BAR __builtin_amdgcn_s_barrier()
#define G8_SCHED __builtin_amdgcn_sched_barrier(0)
    Unit cur, nxt; int ui = 0;
    if (!S.next(0, cur)) return;
    constexpr int FACL = 131072;
#define G8_FAC(u_, par_) __builtin_amdgcn_global_load_lds((const unsigned*)(E.fab + (size_t)(u_).pm * 512 + tid), (LAS unsigned*)(lds + FACL + (par_) * 2048 + wid * 256), 4, 0, 0)
    if constexpr (Epi::RESCALE) G8_FAC(cur, 0);
    f32x4 acc[2][2][4][2];
#pragma unroll
    for (int a = 0; a < 2; ++a)
#pragma unroll
        for (int b = 0; b < 2; ++b)
#pragma unroll
            for (int m = 0; m < 4; ++m)
#pragma unroll
                for (int n = 0; n < 2; ++n) acc[a][b][m][n] = (f32x4){0.f, 0.f, 0.f, 0.f};
    i32x8 At[4], B0[2], B1[2];
    unsigned a00 = cur.a00, a01 = cur.a01, a10 = cur.a10, a11 = cur.a11;
    G8_STAGE(G8_SB(0, 0), cur.B, voffB); G8_STAGE(G8_SB(0, 1), cur.B + hstep, voffB); G8_STAGE_A(G8_SA(0, 0), Abase, a00, a01); G8_STAGE_A(G8_SA(0, 1), Abase, a10, a11);
    if (wr == 1) G8_BAR;
    G8_WAIT_V(2); G8_BAR;
    G8_STAGE(G8_SB(1, 0), cur.B + kstep, voffB); G8_STAGE_A(G8_SA(1, 0), Abase + kstep, a00, a01); G8_STAGE(G8_SB(1, 1), cur.B + hstep + kstep, voffB);
    G8_WAIT_V(6); G8_BAR;
    for (;;) {
        bool has_next = false; const char* curB = cur.B; const char* nB = curB;
        for (int t = 0; t < nt; t += 2) {
            const bool last = (t == nt - 2);
            if (t == nt - 4) { has_next = S.next(ui + 1, nxt); if (has_next) nB = nxt.B;
                if constexpr (Epi::RESCALE) { if (has_next) G8_FAC(nxt, (ui + 1) & 1); } }
            if constexpr (Epi::RESCALE) {
                if (t == 6 || t == 12) { const LAS float* fl = (const LAS float*)(lds + FACL + (ui & 1) * 2048) + (t == 12 ? 1 : 0);
#pragma unroll
                    for (int ai = 0; ai < 2; ++ai)
#pragma unroll
                        for (int m = 0; m < 4; ++m) { const float f = fl[(ai * HALF + wr * 64 + m * 16 + fr) * 2];
#pragma unroll
                            for (int bj = 0; bj < 2; ++bj)
#pragma unroll
                                for (int n = 0; n < 2; ++n) acc[ai][bj][m][n] = acc[ai][bj][m][n] * f; } } }
            const char* a1 = Abase + (size_t)(t + 1) * kstep;
            const char* a2 = last ? Abase : Abase + (size_t)(t + 2) * kstep; const char* b2 = last ? nB : curB + (size_t)(t + 2) * kstep;
            const char* a3 = a2 + kstep; const char* b3 = b2 + kstep;
            G8_LDB(B0, 0, 0); G8_LDB(B1, 0, 1); G8_SCHED; G8_LDA(At, 0, 0); G8_STAGE_A(G8_SA(1, 1), a1, a10, a11);
            if (last && has_next) { a00 = nxt.a00; a01 = nxt.a01; a10 = nxt.a10; a11 = nxt.a11; }
            G8_WAIT_V(8); G8_WAIT_L(0); G8_BAR; G8_MMA(0, 0, At, B0); G8_MMA(0, 1, At, B1); G8_BAR; G8_SCHED;
            G8_LDA(At, 0, 1); G8_STAGE(G8_SB(0, 0), b2, voffB); G8_STAGE(G8_SB(0, 1), b2 + hstep, voffB); G8_STAGE_A(G8_SA(0, 0), a2, a00, a01);
            G8_WAIT_V(8); G8_WAIT_L(0); G8_BAR; G8_MMA(1, 0, At, B0); G8_MMA(1, 1, At, B1); G8_BAR; G8_SCHED;
            G8_LDB(B0, 1, 0); G8_LDB(B1, 1, 1); G8_SCHED; G8_LDA(At, 1, 0); G8_STAGE_A(G8_SA(0, 1), a2, a10, a11);
            G8_WAIT_V(8); G8_WAIT_L(0); G8_BAR; G8_MMA(0, 0, At, B0); G8_MMA(0, 1, At, B1); G8_BAR; G8_SCHED;
            G8_LDA(At, 1, 1); G8_STAGE(G8_SB(1, 0), b3, voffB); G8_STAGE(G8_SB(1, 1), b3 + hstep, voffB); G8_STAGE_A(G8_SA(1, 0), a3, a00, a01);
            G8_WAIT_V(8); G8_WAIT_L(0); G8_BAR; G8_MMA(1, 0, At, B0); G8_MMA(1, 1, At, B1); G8_BAR; G8_SCHED;
        }
        if (wr == 0) G8_BAR;
        if constexpr (!Epi::AFTER_DRAIN) E(acc, cur, wr, wc, fr, fq);
        if (!has_next) break;
#pragma unroll
        for (int a = 0; a < 2; ++a)
#pragma unroll
            for (int b = 0; b < 2; ++b)
#pragma unroll
                for (int m = 0; m < 4; ++m)
#pragma unroll
                    for (int n = 0; n < 2; ++n) acc[a][b][m][n] = (f32x4){0.f, 0.f, 0.f, 0.f};
        cur = nxt; ++ui;
        if (wr == 1) G8_BAR;
    }
    G8_WAIT_V(0);
    G8_BAR;
    if constexpr (Epi::AFTER_DRAIN) E.fused(acc, cur, wr, wc, fr, fq, lds);
#undef G8_FAC
#undef G8_SA
#undef G8_SB
#undef G8_STAGE
#undef G8_STAGE_A
#undef G8_LDA
#undef G8_LDB
#undef G8_MMA
#undef G8_WAIT_V
#undef G8_WAIT_L
#undef G8_BAR
#undef G8_SCHED
}

struct EpiQKV {
    static constexpr bool AFTER_DRAIN = false, FP8 = false, RESCALE = false;
    const float* rs; const float* qk_gain_l; bf16_t* base; int mode;
    __device__ __forceinline__ void operator()(const f32x4 (&acc)[2][2][4][2], const Unit& u, int wr, int wc, int fr_, int fq_) const {
        int fr = fr_, fq = fq_; asm volatile("" : "+v"(fr), "+v"(fq));
        int gi; bool isq; bf16_t* dst; const float* g;
        if (mode == 0) { const int H = 4 * u.pn + wc; slice_kind(H, gi, isq); dst = base + (size_t)H * T * HD; g = qk_gain_l + (gi < 0 ? 0 : gi) * HD; }
        else { const int lyr = u.pn >> 1, Hp = 4 * (u.pn & 1) + wc; gi = Hp < 4 ? 5 : -1; isq = false; dst = base + ((size_t)lyr * 8 + Hp) * TM * HD; g = qk_gain_l + (lyr * 6 + 5) * HD; }
        const float post = isq ? ATTN_SCALE * LOG2E : 1.0f;
        f32x4 gv[2][2];
#pragma unroll
        for (int bj = 0; bj < 2; ++bj)
#pragma unroll
            for (int n = 0; n < 2; ++n) gv[bj][n] = *(const f32x4*)(g + 32 * bj + 8 * fq + 4 * n) * post;
        float rs8[2][4];
#pragma unroll
        for (int ai = 0; ai < 2; ++ai)
#pragma unroll
            for (int m = 0; m < 4; ++m) rs8[ai][m] = rs[u.pm * 256 + ai * HALF + wr * 64 + m * 16 + fr];
#pragma unroll
        for (int ai = 0; ai < 2; ++ai)
#pragma unroll
            for (int m = 0; m < 4; ++m) {
                const int row = u.pm * 256 + ai * HALF + wr * 64 + m * 16 + fr; const float rsv = rs8[ai][m];
                f32x4 v[2][2]; float ss = 0.f;
#pragma unroll
                for (int bj = 0; bj < 2; ++bj)
#pragma unroll
                    for (int n = 0; n < 2; ++n) { v[bj][n] = acc[ai][bj][m][n] * rsv; ss += (v[bj][n][0] * v[bj][n][0] + v[bj][n][1] * v[bj][n][1]) + (v[bj][n][2] * v[bj][n][2] + v[bj][n][3] * v[bj][n][3]); }
                if (gi >= 0) {
                    ss = allsum_rows(ss);
                    const float r = __builtin_amdgcn_rsqf(ss * (1.f / 64.f) + EPS);
#pragma unroll
                    for (int bj = 0; bj < 2; ++bj)
#pragma unroll
                        for (int n = 0; n < 2; ++n) v[bj][n] = v[bj][n] * r * gv[bj][n];
                }
#pragma unroll
                for (int bj = 0; bj < 2; ++bj) { u32x4 w; w.x = cvt_pk_bf16(v[bj][0][0], v[bj][0][1]); w.y = cvt_pk_bf16(v[bj][0][2], v[bj][0][3]); w.z = cvt_pk_bf16(v[bj][1][0], v[bj][1][1]); w.w = cvt_pk_bf16(v[bj][1][2], v[bj][1][3]);
                    *(u32x4*)(dst + (size_t)row * HD + 32 * bj + 8 * fq) = w; }
            }
    }
};
struct EpiOut {
    static constexpr bool AFTER_DRAIN = false, FP8 = false, RESCALE = true;
    bf16_t* xb; float* ssq; unsigned char* x8; const float* fab; const float* rm;
    __device__ __forceinline__ void operator()(const f32x4 (&acc)[2][2][4][2], const Unit& u, int wr, int wc, int fr_, int fq_) const {
        int fr = fr_, fq = fq_; asm volatile("" : "+v"(fr), "+v"(fq));
        const int col0 = u.pn * 256 + wc * 32 + 8 * fq;
#pragma unroll
        for (int ai = 0; ai < 2; ++ai) {
        float fm8[2][4]; u32x4 xi8[2][4][2];
#pragma unroll
            for (int m = 0; m < 4; ++m) { const int row = u.pm * 256 + ai * HALF + wr * 64 + m * 16 + fr; fm8[ai][m] = rm[row];
#pragma unroll
                for (int bj = 0; bj < 2; ++bj) xi8[ai][m][bj] = *(const u32x4*)(xb + (size_t)row * D + col0 + bj * HALF); }
#pragma unroll
            for (int m = 0; m < 4; ++m) {
                const int row = u.pm * 256 + ai * HALF + wr * 64 + m * 16 + fr; bf16_t* p = xb + (size_t)row * D + col0; float s = 0.f; const float fm = fm8[ai][m];
                u32x4 xi[2];
#pragma unroll
                for (int bj = 0; bj < 2; ++bj) xi[bj] = xi8[ai][m][bj];
#pragma unroll
                for (int bj = 0; bj < 2; ++bj) { const f32x4 a = acc[ai][bj][m][0] * fm, b = acc[ai][bj][m][1] * fm; const u32x4 x = xi[bj];
                    u32x4 w; w.x = cvt_pk_bf16(bf2f(x.x & 0xffffu) + a[0], bf2f(x.x >> 16) + a[1]); w.y = cvt_pk_bf16(bf2f(x.y & 0xffffu) + a[2], bf2f(x.y >> 16) + a[3]);
                    w.z = cvt_pk_bf16(bf2f(x.z & 0xffffu) + b[0], bf2f(x.z >> 16) + b[1]); w.w = cvt_pk_bf16(bf2f(x.w & 0xffffu) + b[2], bf2f(x.w >> 16) + b[3]);
                    *(u32x4*)(p + bj * HALF) = w;
                    const float o0 = bf2f(w.x & 0xffffu), o1 = bf2f(w.x >> 16), o2 = bf2f(w.y & 0xffffu), o3 = bf2f(w.y >> 16), o4 = bf2f(w.z & 0xffffu), o5 = bf2f(w.z >> 16), o6 = bf2f(w.w & 0xffffu), o7 = bf2f(w.w >> 16);
                    s += ((o0 * o0 + o1 * o1) + (o2 * o2 + o3 * o3)) + ((o4 * o4 + o5 * o5) + (o6 * o6 + o7 * o7));
                    int q0 = 0, q1 = 0; q0 = __builtin_amdgcn_cvt_pk_fp8_f32(clamp8(16.f * o0), clamp8(16.f * o1), q0, false); q0 = __builtin_amdgcn_cvt_pk_fp8_f32(clamp8(16.f * o2), clamp8(16.f * o3), q0, true);
                    q1 = __builtin_amdgcn_cvt_pk_fp8_f32(clamp8(16.f * o4), clamp8(16.f * o5), q1, false); q1 = __builtin_amdgcn_cvt_pk_fp8_f32(clamp8(16.f * o6), clamp8(16.f * o7), q1, true);
                    u32x2 q; q.x = (unsigned)q0; q.y = (unsigned)q1;
                    *(u32x2*)(x8 + (size_t)row * D + col0 + bj * HALF) = q; }
                s = allsum_rows(s);
                if (fq == 0) ssq[row * 16 + u.pn * 4 + wc] = s;
            }
        }
    }
};
struct EpiSwiGLU {
    static constexpr bool AFTER_DRAIN = false, FP8 = true, RESCALE = false;
    const float* rsl; unsigned char* hid;
    __device__ __forceinline__ void operator()(const f32x4 (&acc)[2][2][4][2], const Unit& u, int wr, int wc, int fr_, int fq_) const {
        int fr = fr_, fq = fq_; asm volatile("" : "+v"(fr), "+v"(fq));
        float rs8[2][4];
#pragma unroll
        for (int ai = 0; ai < 2; ++ai)
#pragma unroll
            for (int m = 0; m < 4; ++m) rs8[ai][m] = rsl[(size_t)u.e * T + min(u.ti * 256 + ai * HALF + wr * 64 + m * 16 + fr, u.ce - 1)];
#pragma unroll
        for (int ai = 0; ai < 2; ++ai)
#pragma unroll
            for (int m = 0; m < 4; ++m) {
                const int lr = ai * HALF + wr * 64 + m * 16 + fr; const float rsv = (1.0f / 512.0f) * rs8[ai][m];
                f32x4 h[2];
#pragma unroll
                for (int n = 0; n < 2; ++n) { const f32x4 gt = acc[ai][0][m][n] * rsv, up = acc[ai][1][m][n] * rsv;
#pragma unroll
                    for (int j = 0; j < 4; ++j) h[n][j] = gt[j] * up[j] * __builtin_amdgcn_rcpf(1.0f + __builtin_amdgcn_exp2f(-gt[j] * LOG2E)); }
#pragma unroll
                for (int n = 0; n < 2; ++n)
#pragma unroll
                    for (int j = 0; j < 4; ++j) h[n][j] = fminf(fmaxf(h[n][j] * 8.0f, -440.f), 440.f);
                int w0 = 0, w1 = 0;
                w0 = __builtin_amdgcn_cvt_pk_fp8_f32(h[0][0], h[0][1], w0, false); w0 = __builtin_amdgcn_cvt_pk_fp8_f32(h[0][2], h[0][3], w0, true);
                w1 = __builtin_amdgcn_cvt_pk_fp8_f32(h[1][0], h[1][1], w1, false); w1 = __builtin_amdgcn_cvt_pk_fp8_f32(h[1][2], h[1][3], w1, true);
                u32x2 w; w.x = (unsigned)w0; w.y = (unsigned)w1;
                *(u32x2*)(hid + (size_t)(u.pm * 256 + lr) * DE + u.pn * 128 + wc * 32 + 8 * fq) = w;
            }
    }
};
struct EpiDown {
    static constexpr bool AFTER_DRAIN = false, NB1 = false, FP8 = true, RESCALE = false;
    const float* wl; unsigned char* Y;
    __device__ __forceinline__ void operator()(const f32x4 (&acc)[2][2][4][2], const Unit& u, int wr, int wc, int fr_, int fq_) const {
        int fr = fr_, fq = fq_; asm volatile("" : "+v"(fr), "+v"(fq));
        float wl8[2][4];
#pragma unroll
        for (int ai = 0; ai < 2; ++ai)
#pragma unroll
            for (int m = 0; m < 4; ++m) wl8[ai][m] = wl[(size_t)u.e * T + min(u.ti * 256 + ai * HALF + wr * 64 + m * 16 + fr, u.ce - 1)];
#pragma unroll
        for (int ai = 0; ai < 2; ++ai)
#pragma unroll
            for (int m = 0; m < 4; ++m) {
                const int lr = ai * HALF + wr * 64 + m * 16 + fr; const float w8 = (8.0f / 256.0f) * wl8[ai][m];
#pragma unroll
                for (int bj = 0; bj < 2; ++bj) { f32x4 a = acc[ai][bj][m][0] * w8, b = acc[ai][bj][m][1] * w8;
#pragma unroll
                    for (int j = 0; j < 4; ++j) { a[j] = fminf(fmaxf(a[j], -400.f), 400.f); b[j] = fminf(fmaxf(b[j], -400.f), 400.f); }
                    int w0 = 0, w1 = 0;
                    w0 = __builtin_amdgcn_cvt_pk_fp8_f32(a[0], a[1], w0, false); w0 = __builtin_amdgcn_cvt_pk_fp8_f32(a[2], a[3], w0, true);
                    w1 = __builtin_amdgcn_cvt_pk_fp8_f32(b[0], b[1], w1, false); w1 = __builtin_amdgcn_cvt_pk_fp8_f32(b[2], b[3], w1, true);
                    u32x2 w; w.x = (unsigned)w0; w.y = (unsigned)w1;
                    *(u32x2*)(Y + (size_t)(u.pm * 256 + lr) * D + u.pn * 256 + bj * HALF + wc * 32 + 8 * fq) = w; }
            }
    }
};
struct EpiRouter {
    static constexpr bool AFTER_DRAIN = true, FP8 = false, RESCALE = false;
    const float* ssq1; float* rs1; const float* b_group; const float* b_router; unsigned* cnt; int* list; float* wl; float* rsl; int* route;
    __device__ __forceinline__ void fused(const f32x4 (&acc)[2][2][4][2], const Unit& u, int wr, int wc, int fr_, int fq_, LAS unsigned char* lds) const {
        int fr = fr_, fq = fq_; asm volatile("" : "+v"(fr), "+v"(fq));
        LAS float* lg = (LAS float*)lds;
        LAS int* hist = (LAS int*)(lds + 256 * 65 * 4);
        const int tid = opaque_tid();
        if (tid < 64) hist[tid] = 0;
        if (wc < 2) {
#pragma unroll
            for (int ai = 0; ai < 2; ++ai)
#pragma unroll
                for (int m = 0; m < 4; ++m) { const int row = ai * HALF + wr * 64 + m * 16 + fr;
#pragma unroll
                    for (int n = 0; n < 2; ++n)
#pragma unroll
                        for (int j = 0; j < 4; ++j) lg[row * 65 + 32 * wc + 16 * n + 4 * fq + j] = acc[ai][0][m][n][j]; }
        }
        __syncthreads();
        int ex0 = 0, ex1 = 0, lp0 = 0, lp1 = 0; float w0 = 0.f, w1 = 0.f, rsv = 0.f; const int t = u.pm * 256 + tid;
        if (tid < 256) {
            const f32x4* sq = (const f32x4*)(ssq1 + (size_t)t * 16); const f32x4 a = sq[0], b = sq[1], c = sq[2], d = sq[3];
            const float ss = ((a[0] + a[1]) + (a[2] + a[3])) + ((b[0] + b[1]) + (b[2] + b[3])) + ((c[0] + c[1]) + (c[2] + c[3])) + ((d[0] + d[1]) + (d[2] + d[3]));
            rsv = 1.0f / sqrtf(ss * (1.f / D) + EPS); rs1[t] = rsv;
            const LAS float* my = lg + tid * 65;
            float g[4];
#pragma unroll
            for (int i = 0; i < 4; ++i) g[i] = my[i] * rsv + b_group[i];
            int gi = 0; float gm = g[0];
#pragma unroll
            for (int i = 1; i < 4; ++i) if (g[i] > gm) { gm = g[i]; gi = i; }
            float den = 0.f;
#pragma unroll
            for (int i = 0; i < 4; ++i) den += expf(g[i] - gm);
            const float gtop = 1.0f / den;
            float ev[8];
#pragma unroll
            for (int i = 0; i < 8; ++i) ev[i] = my[4 + gi * 8 + i] * rsv + b_router[gi * 8 + i];
            int i0 = 0; float v0 = ev[0];
#pragma unroll
            for (int i = 1; i < 8; ++i) if (ev[i] > v0) { v0 = ev[i]; i0 = i; }
            int i1 = -1; float v1 = -INFINITY;
#pragma unroll
            for (int i = 0; i < 8; ++i) if (i != i0 && ev[i] > v1) { v1 = ev[i]; i1 = i; }
            const float e1 = expf(v1 - v0); w0 = gtop / (1.f + e1); w1 = gtop * e1 / (1.f + e1);
            ex0 = gi * 8 + i0; ex1 = gi * 8 + i1;
            lp0 = __hip_atomic_fetch_add(hist + ex0, 1, __ATOMIC_RELAXED, __HIP_MEMORY_SCOPE_WORKGROUP);
            lp1 = __hip_atomic_fetch_add(hist + ex1, 1, __ATOMIC_RELAXED, __HIP_MEMORY_SCOPE_WORKGROUP);
        }
        __syncthreads();
        if (tid < NE) { const int c = hist[tid]; hist[32 + tid] = c ? (int)__hip_atomic_fetch_add(cnt + tid * 64, (unsigned)c, RLX_AGENT) : 0; }
        __syncthreads();
        if (tid < 256) {
            const int p0 = hist[32 + ex0] + lp0, p1 = hist[32 + ex1] + lp1;
            list[(size_t)ex0 * T + p0] = t; wl[(size_t)ex0 * T + p0] = w0; rsl[(size_t)ex0 * T + p0] = rsv;
            list[(size_t)ex1 * T + p1] = t; wl[(size_t)ex1 * T + p1] = w1; rsl[(size_t)ex1 * T + p1] = rsv;
            *(int4*)(route + (size_t)t * 4) = make_int4(ex0, p0, ex1, p1);
        }
    }
};
}

__device__ __forceinline__ void phase_memkv_fast(Frame& F) {
    PHASE_IDS(F);
    g8::DenseSched S; S.init(TM, 1024, D, F.G, (int)blockIdx.x, F.tid, F.ws + WS_WMEM);
    g8::EpiQKV E{(const float*)(F.ws + WS_RSM), in_ptr(4), (bf16_t*)(F.ws + WS_MEMKV), 1};
    g8::gemm_phase(F.lds, F.ws + WS_MB, D, S, E);
}
__device__ __forceinline__ void phase_inproj_fast(Frame& F, int l) {
    PHASE_IDS(F);
    g8::DenseSched S; S.init(T, INW, D, F.G, (int)blockIdx.x, F.tid, F.ws + WS_WIN + (size_t)l * INW * D * 2);
    g8::EpiQKV E{(const float*)(F.ws + WS_RS), in_ptr(4) + l * 6 * HD, (bf16_t*)(F.ws + WS_QKV), 0};
    g8::gemm_phase(F.lds, F.ws + WS_XB, D, S, E);
}
__device__ __forceinline__ void phase_outproj_fast(Frame& F, int l) {
    PHASE_IDS(F);
    g8::DenseSched S; S.init(T, D, D, F.G, (int)blockIdx.x, F.tid, F.ws + WS_WOUT + (size_t)l * D * D * 2);
    g8::EpiOut E{(bf16_t*)(F.ws + WS_XB), (float*)(F.ws + WS_SSQ1), (unsigned char*)(F.ws + WS_X8), (const float*)(F.ws + WS_FAB), (const float*)(F.ws + WS_RM)};
    g8::gemm_phase(F.lds, F.ws + WS_MIX, D, S, E);
}
__device__ __forceinline__ void phase_router_fast(Frame& F, int l) {
    PHASE_IDS(F);
    g8::DenseSched S; S.init(T, 256, D, F.G, (int)blockIdx.x, F.tid, F.ws + WS_WR + (size_t)l * 256 * D * 2);
    g8::EpiRouter E{(const float*)(F.ws + WS_SSQ1), (float*)(F.ws + WS_RS) + T, in_ptr(12) + l * NGRP, in_ptr(14) + l * NE, F.ctl + CW_CNT + l * NE * 64,
                    (int*)(F.ws + WS_LIST), (float*)(F.ws + WS_WL), (float*)(F.ws + WS_RSL), (int*)(F.ws + WS_ROUTE)};
    g8::gemm_phase(F.lds, F.ws + WS_XB, D, S, E);
}
__device__ __forceinline__ void phase_moe1_fast(Frame& F, int l) {
    PHASE_IDS(F);
    g8::GroupSched S; S.init((LAS int*)(F.lds + CTRL_BASE), F.ctl + CW_CNT + l * NE * 64, 4, D / 2, F.G, (int)blockIdx.x, F.ws + WS_WGU + (size_t)l * NE * 1024 * D, (size_t)1024 * D, (const int*)(F.ws + WS_LIST), true);
    g8::EpiSwiGLU E{(const float*)(F.ws + WS_RSL), (unsigned char*)(F.ws + WS_MIX)};
    g8::gemm_phase(F.lds, F.ws + WS_X8, D / 2, S, E);
}
__device__ __forceinline__ void phase_moe2_fast(Frame& F, int l) {
    PHASE_IDS(F);
    g8::GroupSched S; S.init((LAS int*)(F.lds + CTRL_BASE), F.ctl + CW_CNT + l * NE * 64, 4, DE / 2, F.G, (int)blockIdx.x, F.ws + WS_WD + (size_t)l * NE * D * DE, (size_t)D * DE, (const int*)(F.ws + WS_LIST), false);
    g8::EpiDown E{(const float*)(F.ws + WS_WL), (unsigned char*)(F.ws + WS_QKV)};
    g8::gemm_phase(F.lds, F.ws + WS_MIX, DE / 2, S, E);
}

namespace at {
typedef short bf16x8 __attribute__((ext_vector_type(8)));
typedef short s16x4 __attribute__((ext_vector_type(4)));
typedef short v4i16_t __attribute__((ext_vector_type(4)));
typedef float f32x16 __attribute__((ext_vector_type(16)));
typedef const LAS char* lds_cptr;
constexpr int NSLOT = 3, NPRE = NSLOT - 1, SLOTB = 8192, LDS_K = 0, LDS_V = NSLOT * SLOTB, TB_CS = 576, TB_ROW = 4 * TB_CS, LDS_TBB = 2 * NSLOT * SLOTB, LDS_TBM = LDS_TBB + 16 * TB_ROW, LDS_WS = LDS_TBM + TB_ROW, LDS_QW = LDS_WS + 2048;
static_assert(LDS_QW + 64 <= 131072, "attention LDS map");
constexpr float NEGBIG = -1.0e30f;
__device__ __forceinline__ int crow(int r, int hi) { return (r & 3) + 8 * (r >> 2) + 4 * hi; }
__device__ __forceinline__ void glds16(const void* gsrc, unsigned lds_dst) { unsigned keep;
    asm volatile("s_mov_b32 %0, m0\n\ts_mov_b32 m0, %2\n\ts_nop 0\n\tglobal_load_lds_dwordx4 %1, off\n\ts_mov_b32 m0, %0" : "=&s"(keep) : "v"(gsrc), "s"(lds_dst) : "memory"); }
typedef float f32x2_t __attribute__((ext_vector_type(2))); typedef __bf16 bf16x2_t __attribute__((ext_vector_type(2)));
__device__ __forceinline__ unsigned cvtpk(float lo, float hi) { f32x2_t v = {lo, hi}; bf16x2_t b = __builtin_convertvector(v, bf16x2_t); return __builtin_bit_cast(unsigned, b); }
__device__ __forceinline__ s16x4 vtr(lds_cptr p) { return __builtin_bit_cast(s16x4, __builtin_amdgcn_ds_read_tr16_b64_v4i16((LAS v4i16_t*)p)); }
#define AT_WAIT_BAR(N) asm volatile("s_waitcnt vmcnt(" #N ") lgkmcnt(0)\n\ts_barrier" ::: "memory")

__device__ __forceinline__ void at_dequeue(unsigned* qcnt, int nper, int xq, int pre, int& id_out, int& x_out) {
    int id = pre, x = xq;
    if (id == -2) id = (int)__hip_atomic_fetch_add(qcnt + xq * 64, 1u, RLX_AGENT);
    if (id >= nper) {
        id = -1;
        for (int tries = 0; tries < 8 && id < 0; ++tries) {
            unsigned hv[8];
#pragma unroll
            for (int k = 0; k < 8; ++k) hv[k] = __hip_atomic_load(qcnt + ((xq + k) & 7) * 64, RLX_AGENT);
            int pick = -1;
#pragma unroll
            for (int k = 7; k >= 0; --k) if ((int)hv[k] < nper) pick = k;
            if (pick < 0) break;
            x = (xq + pick) & 7; id = (int)__hip_atomic_fetch_add(qcnt + x * 64, 1u, RLX_AGENT); if (id >= nper) id = -1;
        }
    }
    id_out = id; x_out = x;
}
struct UnitDesc { const bf16_t* Q; const bf16_t* K; const bf16_t* V; int t0, hh16, qb, h, kt0, nt; };

template <int TYPE>
__device__ __forceinline__ void attn_unit(LAS unsigned char* lds, const UnitDesc& u, bf16_t* mixed, float* ssq) {
    const int tid = opaque_tid0(), lane = tid & 63, r32 = lane & 31, hi = lane >> 5; const int wid = __builtin_amdgcn_readfirstlane(tid >> 6);
    const unsigned lds0 = (unsigned)(size_t)lds;
    lds_cptr shm3 = (lds_cptr)lds;
    const int prow = 8 * wid + (lane >> 3);
    const bf16_t* ksrc = u.K + (size_t)(u.kt0 * 64 + prow) * HD + (((lane & 7) ^ ((4 * wid + (lane >> 4)) & 7)) * 8);
    const bf16_t* vsrc = u.V + (size_t)(u.kt0 * 64 + prow) * HD + ((((lane & 7) >> 1) ^ (prow & 2)) * 16) + (lane & 1) * 8;
    const unsigned kdst = lds0 + LDS_K + wid * 1024, vdst = lds0 + LDS_V + wid * 1024;
#define AT_DMA_K(t, slot) glds16(ksrc + (size_t)(t) * 64 * HD, (unsigned)__builtin_amdgcn_readfirstlane(kdst + (slot)))
#define AT_DMA_V(t, slot) glds16(vsrc + (size_t)(t) * 64 * HD, (unsigned)__builtin_amdgcn_readfirstlane(vdst + (slot)))
    lds_cptr ka[4], va[2];
    { const int sw = (r32 >> 1) & 7;
#pragma unroll
      for (int d0 = 0; d0 < 4; ++d0) ka[d0] = shm3 + LDS_K + r32 * 128 + (((2 * d0 + hi) ^ sw) * 16);
      const int q = (lane & 15) >> 2, gb = (lane >> 4) & 1;
#pragma unroll
      for (int d0 = 0; d0 < 2; ++d0) va[d0] = shm3 + LDS_V + (4 * hi + q) * 128 + ((2 * (d0 ^ (q >> 1)) + gb) * 32) + (lane & 3) * 8; }
    const int nt = u.nt;
    const bf16_t* Qw = u.Q + (size_t)(u.qb * 256 + wid * 32 + r32) * HD;
    bf16x8 qr[4];
#pragma unroll
    for (int d0 = 0; d0 < 4; ++d0) qr[d0] = *(const bf16x8*)(Qw + d0 * 16 + hi * 8);
#pragma unroll
    for (int j = 0; j < NPRE; ++j) if (j < nt) { AT_DMA_K(j, j * SLOTB); AT_DMA_V(j, j * SLOTB); }
    lds_cptr tb = shm3; int r0w = 0, qrw = 0;
    lds_cptr tbm = shm3;
    if (TYPE == 1) { const int qc = 32 * (wid & 1) + r32, c0 = min(max(qc - 8, 0), 48); qrw = 4 * u.qb + (wid >> 1); r0w = min(max(qrw - 4, 0), 24);
        const int ib = 4 * hi - qc + 63, cb = (-ib) & 3, im = 4 * hi - c0 + 63, cm = (-im) & 3;
        tb = shm3 + LDS_TBB + cb * TB_CS + (ib + cb) * 4; tbm = shm3 + LDS_TBM + cm * TB_CS + (im + cm) * 4; }
    float lsum = 0.f; f32x16 o[2]; o[0] = f32x16{}; o[1] = f32x16{};
    int sl_cur = 0, sl_n2 = NPRE * SLOTB;
    for (int i = 0; i < nt; ++i) {
        { const int rem = nt - 1 - i, yo = rem < NPRE - 1 ? rem : NPRE - 1; if (yo >= 3) AT_WAIT_BAR(6); else if (yo == 2) AT_WAIT_BAR(4); else if (yo == 1) AT_WAIT_BAR(2); else AT_WAIT_BAR(0); }
        static_assert(NPRE <= 4, "wait ladder");
        if (i + NPRE < nt) { AT_DMA_K(i + NPRE, sl_n2); AT_DMA_V(i + NPRE, sl_n2); }
        bool need = true;
        if (TYPE == 1) { const int kr = u.kt0 + i; need = (kr >= r0w) && (kr < r0w + 8); }
        if (need) {
#pragma unroll
            for (int hf = 0; hf < 2; ++hf) {
                f32x16 p;
                if (TYPE == 1) {
                    const lds_cptr tp = tb + (u.kt0 + i - qrw + 7) * TB_ROW;
#pragma unroll
                    for (int g = 0; g < 4; ++g) { const f32x4 a = *(const LAS f32x4*)(tp + 32 * (g + 4 * hf)) + *(const LAS f32x4*)(tbm + 32 * (g + 4 * hf)); p[4 * g] = a[0]; p[4 * g + 1] = a[1]; p[4 * g + 2] = a[2]; p[4 * g + 3] = a[3]; }
                } else p = f32x16{};
#pragma unroll
                for (int d0 = 0; d0 < 4; ++d0) p = __builtin_amdgcn_mfma_f32_32x32x16_bf16(*(const LAS bf16x8*)(ka[d0] + sl_cur + 4096 * hf), qr[d0], p, 0, 0, 0);
                float s0 = 0.f;
#pragma unroll
                for (int r = 0; r < 16; ++r) { p[r] = __builtin_amdgcn_exp2f(p[r]); s0 += p[r]; }
                lsum += s0;
                const u32x4 pwa = (u32x4){cvtpk(p[0], p[1]), cvtpk(p[2], p[3]), cvtpk(p[4], p[5]), cvtpk(p[6], p[7])}, pwb = (u32x4){cvtpk(p[8], p[9]), cvtpk(p[10], p[11]), cvtpk(p[12], p[13]), cvtpk(p[14], p[15])};
#pragma unroll
                for (int d0 = 0; d0 < 2; ++d0) { const lds_cptr vp = va[d0] + sl_cur + 4096 * hf; const s16x4 l0 = vtr(vp), h0 = vtr(vp + 1024), l1 = vtr(vp + 2048), h1 = vtr(vp + 2048 + 1024);
                    o[d0] = __builtin_amdgcn_mfma_f32_32x32x16_bf16(__builtin_bit_cast(bf16x8, pwa), (bf16x8){l0[0], l0[1], l0[2], l0[3], h0[0], h0[1], h0[2], h0[3]}, o[d0], 0, 0, 0);
                    o[d0] = __builtin_amdgcn_mfma_f32_32x32x16_bf16(__builtin_bit_cast(bf16x8, pwb), (bf16x8){l1[0], l1[1], l1[2], l1[3], h1[0], h1[1], h1[2], h1[3]}, o[d0], 0, 0, 0); }
            }
        }
        sl_n2 = sl_cur;
        sl_cur = (sl_cur == (NSLOT - 1) * SLOTB) ? 0 : sl_cur + SLOTB;
    }
    AT_WAIT_BAR(0);
    int lane2 = lane; asm volatile("" : "+v"(lane2)); const int r32e = lane2 & 31, hie = lane2 >> 5;
    lsum += __shfl_xor(lsum, 32);
    LAS float* wsf = (LAS float*)(lds + LDS_WS) + wid * 64;
    if (hie == 0) wsf[r32e] = lsum;
    asm volatile("s_waitcnt lgkmcnt(0)" ::: "memory");
    LAS bf16_t* stg = (LAS bf16_t*)(lds) + wid * 2048;
#pragma unroll
    for (int r = 0; r < 16; ++r) { const int orow = crow(r, hie); const float rl = __builtin_amdgcn_rcpf(wsf[orow]);
        stg[orow * 64 + r32e] = (bf16_t)f2bf(o[0][r] * rl); stg[orow * 64 + 32 + r32e] = (bf16_t)f2bf(o[1][r] * rl); }
    asm volatile("s_waitcnt lgkmcnt(0)" ::: "memory");
    const int trow0 = u.t0 + wid * 32;
#pragma unroll
    for (int i = 0; i < 4; ++i) { const int row = i * 8 + (lane2 >> 3), ch = lane2 & 7; const u32x4 v = *(const LAS u32x4*)(stg + row * 64 + ch * 8);
        *(u32x4*)(mixed + (size_t)(trow0 + row) * D + u.hh16 * 64 + ch * 8) = v;
        float s = 0.f; { float a;
            a = bf2f(v.x & 0xffffu); s += a * a; a = bf2f(v.x >> 16); s += a * a; a = bf2f(v.y & 0xffffu); s += a * a; a = bf2f(v.y >> 16); s += a * a;
            a = bf2f(v.z & 0xffffu); s += a * a; a = bf2f(v.z >> 16); s += a * a; a = bf2f(v.w & 0xffffu); s += a * a; a = bf2f(v.w >> 16); s += a * a; }
        s += __shfl_xor(s, 1); s += __shfl_xor(s, 2); s += __shfl_xor(s, 4);
        if (ch == 0) ssq[(size_t)(trow0 + row) * 16 + u.hh16] = s; }
    asm volatile("s_waitcnt lgkmcnt(0)\n\ts_barrier" ::: "memory");
#undef AT_DMA_K
#undef AT_DMA_V
}

template <int NQB>
__device__ __forceinline__ void mem_unit(LAS unsigned char* lds, const bf16_t* Qh, const bf16_t* Kh, const bf16_t* Vh, int t0, int hh16, bf16_t* mixed, float* ssq) {
    constexpr int MK = 0, MV = 32768, MSTG = 65536, MWS = 98304;
    const int tid = opaque_tid0(), lane = tid & 63, r32 = lane & 31, hi = lane >> 5; const int wid = __builtin_amdgcn_readfirstlane(tid >> 6);
    const unsigned lds0 = (unsigned)(size_t)lds; lds_cptr shm3 = (lds_cptr)lds;
    const int prow = 8 * wid + (lane >> 3);
    const bf16_t* ksrc = Kh + (size_t)prow * HD + (((lane & 7) ^ ((4 * wid + (lane >> 4)) & 7)) * 8);
    const bf16_t* vsrc = Vh + (size_t)prow * HD + ((((lane & 7) >> 1) ^ (prow & 2)) * 16) + (lane & 1) * 8;
    const bf16_t* Qw = Qh + (size_t)(wid * 32 + r32) * HD + hi * 8;
    bf16x8 qr[4], qn[4];
#pragma unroll
    for (int d0 = 0; d0 < 4; ++d0) { qr[d0] = *(const bf16x8*)(Qw + d0 * 16); qn[d0] = qr[d0]; }
#pragma unroll
    for (int j = 0; j < 4; ++j) { glds16(ksrc + (size_t)j * 64 * HD, (unsigned)__builtin_amdgcn_readfirstlane(lds0 + MK + j * 8192 + wid * 1024));
                                  glds16(vsrc + (size_t)j * 64 * HD, (unsigned)__builtin_amdgcn_readfirstlane(lds0 + MV + j * 8192 + wid * 1024)); }
    lds_cptr ka[4], va[2];
    { const int sw = (r32 >> 1) & 7;
#pragma unroll
      for (int d0 = 0; d0 < 4; ++d0) ka[d0] = shm3 + MK + r32 * 128 + (((2 * d0 + hi) ^ sw) * 16);
      const int q = (lane & 15) >> 2, gb = (lane >> 4) & 1;
#pragma unroll
      for (int d0 = 0; d0 < 2; ++d0) va[d0] = shm3 + MV + (4 * hi + q) * 128 + ((2 * (d0 ^ (q >> 1)) + gb) * 32) + (lane & 3) * 8; }
    LAS float* wsf = (LAS float*)(lds + MWS) + wid * 64;
    LAS bf16_t* stg = (LAS bf16_t*)(lds + MSTG) + wid * 2048;
#pragma unroll
    for (int qb = 0; qb < NQB; ++qb) {
        const bool has_next = qb + 1 < NQB;
        float lsum = 0.f; f32x16 o[2]; o[0] = f32x16{}; o[1] = f32x16{};
#pragma unroll
        for (int i = 0; i < 4; ++i) {
            if (qb == 0) {
                if (i == 0) AT_WAIT_BAR(6); else if (i == 1) AT_WAIT_BAR(4); else if (i == 2) { if (has_next) AT_WAIT_BAR(6); else AT_WAIT_BAR(2); } else { if (has_next) AT_WAIT_BAR(4); else AT_WAIT_BAR(0); }
            }
            if (i == 1 && has_next) {
#pragma unroll
                for (int d0 = 0; d0 < 4; ++d0) qn[d0] = *(const bf16x8*)(Qw + (size_t)(qb + 1) * 256 * HD + d0 * 16); }
#pragma unroll
            for (int hf = 0; hf < 2; ++hf) {
                f32x16 p = f32x16{};
#pragma unroll
                for (int d0 = 0; d0 < 4; ++d0) p = __builtin_amdgcn_mfma_f32_32x32x16_bf16(*(const LAS bf16x8*)(ka[d0] + i * 8192 + 4096 * hf), qr[d0], p, 0, 0, 0);
                float s0 = 0.f;
#pragma unroll
                for (int r = 0; r < 16; ++r) { p[r] = __builtin_amdgcn_exp2f(p[r]); s0 += p[r]; }
                lsum += s0;
                const u32x4 pwa = (u32x4){cvtpk(p[0], p[1]), cvtpk(p[2], p[3]), cvtpk(p[4], p[5]), cvtpk(p[6], p[7])}, pwb = (u32x4){cvtpk(p[8], p[9]), cvtpk(p[10], p[11]), cvtpk(p[12], p[13]), cvtpk(p[14], p[15])};
#pragma unroll
                for (int d0 = 0; d0 < 2; ++d0) { const lds_cptr vp = va[d0] + i * 8192 + 4096 * hf; const s16x4 l0 = vtr(vp), h0 = vtr(vp + 1024), l1 = vtr(vp + 2048), h1 = vtr(vp + 2048 + 1024);
                    o[d0] = __builtin_amdgcn_mfma_f32_32x32x16_bf16(__builtin_bit_cast(bf16x8, pwa), (bf16x8){l0[0], l0[1], l0[2], l0[3], h0[0], h0[1], h0[2], h0[3]}, o[d0], 0, 0, 0);
                    o[d0] = __builtin_amdgcn_mfma_f32_32x32x16_bf16(__builtin_bit_cast(bf16x8, pwb), (bf16x8){l1[0], l1[1], l1[2], l1[3], h1[0], h1[1], h1[2], h1[3]}, o[d0], 0, 0, 0); }
            }
        }
        lsum += __shfl_xor(lsum, 32);
        if (hi == 0) wsf[r32] = lsum;
        asm volatile("s_waitcnt lgkmcnt(0)" ::: "memory");
#pragma unroll
        for (int r = 0; r < 16; ++r) { const int orow = crow(r, hi); const float rl = __builtin_amdgcn_rcpf(wsf[orow]);
            stg[orow * 64 + r32] = (bf16_t)f2bf(o[0][r] * rl); stg[orow * 64 + 32 + r32] = (bf16_t)f2bf(o[1][r] * rl); }
        asm volatile("s_waitcnt lgkmcnt(0)" ::: "memory");
        const int trow0 = t0 + qb * 256 + wid * 32;
#pragma unroll
        for (int i = 0; i < 4; ++i) { const int row = i * 8 + (lane >> 3), ch = lane & 7; const u32x4 v = *(const LAS u32x4*)(stg + row * 64 + ch * 8);
            *(u32x4*)(mixed + (size_t)(trow0 + row) * D + hh16 * 64 + ch * 8) = v;
            { float s = 0.f, a;
              a = bf2f(v.x & 0xffffu); s += a * a; a = bf2f(v.x >> 16); s += a * a; a = bf2f(v.y & 0xffffu); s += a * a; a = bf2f(v.y >> 16); s += a * a;
              a = bf2f(v.z & 0xffffu); s += a * a; a = bf2f(v.z >> 16); s += a * a; a = bf2f(v.w & 0xffffu); s += a * a; a = bf2f(v.w >> 16); s += a * a;
              s += __shfl_xor(s, 1); s += __shfl_xor(s, 2); s += __shfl_xor(s, 4);
              if (ch == 0) ssq[(size_t)(trow0 + row) * 16 + hh16] = s; } }
        asm volatile("s_waitcnt lgkmcnt(0)" ::: "memory");
        if (has_next) {
#pragma unroll
            for (int d0 = 0; d0 < 4; ++d0) qr[d0] = qn[d0]; }
    }
    asm volatile("s_waitcnt lgkmcnt(0)\n\ts_barrier" ::: "memory");
}

__device__ __forceinline__ void nb_unit(LAS unsigned char* lds, const UnitDesc& u, bf16_t* mixed, float* ssq) {
    const int tid = opaque_tid0(), lane = tid & 63, r32 = lane & 31, hi = lane >> 5; const int wid = __builtin_amdgcn_readfirstlane(tid >> 6);
    const unsigned lds0 = (unsigned)(size_t)lds; lds_cptr shm3 = (lds_cptr)lds;
    const int prow = 8 * wid + (lane >> 3);
    const bf16_t* ksrc = u.K + (size_t)(u.kt0 * 64 + prow) * HD + (((lane & 7) ^ ((4 * wid + (lane >> 4)) & 7)) * 8);
    const bf16_t* vsrc = u.V + (size_t)(u.kt0 * 64 + prow) * HD + ((((lane & 7) >> 1) ^ (prow & 2)) * 16) + (lane & 1) * 8;
    const unsigned kdst = lds0 + LDS_K + wid * 1024, vdst = lds0 + LDS_V + wid * 1024;
#define AT_DMA_K(t, slot) glds16(ksrc + (size_t)(t) * 64 * HD, (unsigned)__builtin_amdgcn_readfirstlane(kdst + (slot)))
#define AT_DMA_V(t, slot) glds16(vsrc + (size_t)(t) * 64 * HD, (unsigned)__builtin_amdgcn_readfirstlane(vdst + (slot)))
    const int rp = wid >> 2, jb = wid & 3, cs = min(max(16 * jb - 8, 0), 32);
    const int qrl = 4 * u.qb + 2 * rp + (r32 >> 4), qc = 16 * jb + (r32 & 15), c0 = min(max(qc - 8, 0), 48), r0l = min(max(qrl - 4, 0), 24);
    const int rwa = min(max(4 * u.qb + 2 * rp - 4, 0), 24), rwb = min(max(4 * u.qb + 2 * rp + 1 - 4, 0), 24) + 8;
    lds_cptr ka[4], va[2];
    { const int key = cs + r32, sw = (key >> 1) & 7;
#pragma unroll
      for (int d0 = 0; d0 < 4; ++d0) ka[d0] = shm3 + LDS_K + key * 128 + (((2 * d0 + hi) ^ sw) * 16);
      const int q = (lane & 15) >> 2, gb = (lane >> 4) & 1;
#pragma unroll
      for (int d0 = 0; d0 < 2; ++d0) va[d0] = shm3 + LDS_V + (cs + 4 * hi + q) * 128 + ((2 * (d0 ^ (q >> 1)) + gb) * 32) + (lane & 3) * 8; }
    const int nt = u.nt;
    const bf16_t* Qw = u.Q + (size_t)(qrl * 64 + qc) * HD;
    bf16x8 qr[4];
#pragma unroll
    for (int d0 = 0; d0 < 4; ++d0) qr[d0] = *(const bf16x8*)(Qw + d0 * 16 + hi * 8);
#pragma unroll
    for (int j = 0; j < NPRE; ++j) if (j < nt) { AT_DMA_K(j, j * SLOTB); AT_DMA_V(j, j * SLOTB); }
    lds_cptr tb, tbm;
    { const int ib = cs + 4 * hi - qc + 63, cb = (-ib) & 3, im = cs + 4 * hi - c0 + 63, cm = (-im) & 3;
      tb = shm3 + LDS_TBB + cb * TB_CS + (ib + cb) * 4; tbm = shm3 + LDS_TBM + cm * TB_CS + (im + cm) * 4; }
    float lsum = 0.f; f32x16 o[2]; o[0] = f32x16{}; o[1] = f32x16{};
    int sl_cur = 0, sl_n2 = NPRE * SLOTB;
    for (int i = 0; i < nt; ++i) {
        { const int rem = nt - 1 - i, yo = rem < NPRE - 1 ? rem : NPRE - 1; if (yo >= 3) AT_WAIT_BAR(6); else if (yo == 2) AT_WAIT_BAR(4); else if (yo == 1) AT_WAIT_BAR(2); else AT_WAIT_BAR(0); }
        if (i + NPRE < nt) { AT_DMA_K(i + NPRE, sl_n2); AT_DMA_V(i + NPRE, sl_n2); }
        const int kr = u.kt0 + i;
        if (kr >= rwa && kr < rwb) {
            const int drow = (kr >= r0l && kr < r0l + 8) ? (kr - qrl + 7) : 15;
            const lds_cptr tp = tb + drow * TB_ROW;
            f32x16 p0;
#pragma unroll
            for (int g = 0; g < 4; ++g) { const f32x4 a = *(const LAS f32x4*)(tp + 32 * g) + *(const LAS f32x4*)(tbm + 32 * g); p0[4 * g] = a[0]; p0[4 * g + 1] = a[1]; p0[4 * g + 2] = a[2]; p0[4 * g + 3] = a[3]; }
            bf16x8 kf[4];
#pragma unroll
            for (int j = 0; j < 4; ++j) kf[j] = *(const LAS bf16x8*)(ka[j] + sl_cur);
#pragma unroll
            for (int d0 = 0; d0 < 4; ++d0) p0 = __builtin_amdgcn_mfma_f32_32x32x16_bf16(kf[d0], qr[d0], p0, 0, 0, 0);
            float s0 = 0.f;
#pragma unroll
            for (int r = 0; r < 16; ++r) { p0[r] = __builtin_amdgcn_exp2f(p0[r]); s0 += p0[r]; }
            lsum += s0;
            const u32x4 pw0 = (u32x4){cvtpk(p0[0], p0[1]), cvtpk(p0[2], p0[3]), cvtpk(p0[4], p0[5]), cvtpk(p0[6], p0[7])};
            const u32x4 pw1 = (u32x4){cvtpk(p0[8], p0[9]), cvtpk(p0[10], p0[11]), cvtpk(p0[12], p0[13]), cvtpk(p0[14], p0[15])};
#pragma unroll
            for (int d0 = 0; d0 < 2; ++d0) {
                s16x4 lo[2], hh[2]; const lds_cptr vp = va[d0] + sl_cur;
#pragma unroll
                for (int ks = 0; ks < 2; ++ks) { lo[ks] = vtr(vp + ks * 2048); hh[ks] = vtr(vp + ks * 2048 + 1024); }
                o[d0] = __builtin_amdgcn_mfma_f32_32x32x16_bf16(__builtin_bit_cast(bf16x8, pw0), (bf16x8){lo[0][0], lo[0][1], lo[0][2], lo[0][3], hh[0][0], hh[0][1], hh[0][2], hh[0][3]}, o[d0], 0, 0, 0);
                o[d0] = __builtin_amdgcn_mfma_f32_32x32x16_bf16(__builtin_bit_cast(bf16x8, pw1), (bf16x8){lo[1][0], lo[1][1], lo[1][2], lo[1][3], hh[1][0], hh[1][1], hh[1][2], hh[1][3]}, o[d0], 0, 0, 0);
            }
        }
        sl_n2 = sl_cur;
        sl_cur = (sl_cur == (NSLOT - 1) * SLOTB) ? 0 : sl_cur + SLOTB;
    }
    AT_WAIT_BAR(0);
    int lane2 = lane; asm volatile("" : "+v"(lane2)); const int r32e = lane2 & 31, hie = lane2 >> 5;
    lsum += __shfl_xor(lsum, 32);
    LAS float* wsf = (LAS float*)(lds + LDS_WS) + wid * 64;
    if (hie == 0) wsf[r32e] = lsum;
    asm volatile("s_waitcnt lgkmcnt(0)" ::: "memory");
    LAS bf16_t* stg = (LAS bf16_t*)(lds) + wid * 2048;
#pragma unroll
    for (int r = 0; r < 16; ++r) { const int orow = crow(r, hie); const float rl = __builtin_amdgcn_rcpf(wsf[orow]);
        stg[orow * 64 + r32e] = (bf16_t)f2bf(o[0][r] * rl); stg[orow * 64 + 32 + r32e] = (bf16_t)f2bf(o[1][r] * rl); }
    asm volatile("s_waitcnt lgkmcnt(0)" ::: "memory");
    const int tbase = u.t0 + 2 * rp * 64 + 16 * jb;
#pragma unroll
    for (int i = 0; i < 4; ++i) { const int row = i * 8 + (lane2 >> 3), ch = lane2 & 7; const u32x4 v = *(const LAS u32x4*)(stg + row * 64 + ch * 8);
        *(u32x4*)(mixed + (size_t)(tbase + (row >> 4) * 64 + (row & 15)) * D + u.hh16 * 64 + ch * 8) = v; const int hh16 = u.hh16;
            { float s = 0.f, a;
              a = bf2f(v.x & 0xffffu); s += a * a; a = bf2f(v.x >> 16); s += a * a; a = bf2f(v.y & 0xffffu); s += a * a; a = bf2f(v.y >> 16); s += a * a;
              a = bf2f(v.z & 0xffffu); s += a * a; a = bf2f(v.z >> 16); s += a * a; a = bf2f(v.w & 0xffffu); s += a * a; a = bf2f(v.w >> 16); s += a * a;
              s += __shfl_xor(s, 1); s += __shfl_xor(s, 2); s += __shfl_xor(s, 4);
              if (ch == 0) ssq[(size_t)(tbase + (row >> 4) * 64 + (row & 15)) * 16 + hh16] = s; } }
    asm volatile("s_waitcnt lgkmcnt(0)\n\ts_barrier" ::: "memory");
#undef AT_DMA_K
#undef AT_DMA_V
}
__device__ __forceinline__ void build_table_b(LAS unsigned char* lds, const float* rpb_lh) {
    const int tid = opaque_tid0();
    for (int e = tid; e < 15 * 127; e += 512) { const int dr = e / 127, idx = e - dr * 127, rel = idx - 63; const float v = (rel >= -15 && rel <= 15) ? rpb_lh[dr * 31 + rel + 15] * LOG2E : 0.f;
#pragma unroll
        for (int c = 0; c < 4; ++c) *(LAS float*)(lds + LDS_TBB + dr * TB_ROW + c * TB_CS + (idx + c) * 4) = v; }
    if (tid >= 256 && tid < 256 + 127) { const int idx = tid - 256;
#pragma unroll
        for (int c = 0; c < 4; ++c) *(LAS float*)(lds + LDS_TBB + 15 * TB_ROW + c * TB_CS + (idx + c) * 4) = NEGBIG; }
    if (tid < 127) { const int j = tid - 63; const float v = (j >= 0 && j < 16) ? 0.f : NEGBIG;
#pragma unroll
        for (int c = 0; c < 4; ++c) *(LAS float*)(lds + LDS_TBM + c * TB_CS + (tid + c) * 4) = v; }
}

template <int TYPE>
__device__ __forceinline__ void attn_type_loop(Frame& F, int l, unsigned xcc, int qset) {
    constexpr int MQB = 2, MUP = 8 / MQB;
    constexpr int NPER = (TYPE == 2) ? 16 * MUP : 192;
    unsigned* qcnt = F.ctl + CW_ATQ + ((qset * 3 + TYPE) * 8) * 64;
    LAS int* qw = (LAS int*)(F.lds + CTRL_BASE + 1024);
    const int tid = opaque_tid0();
    const int xq = (int)xcc & 7; int pre = -2;
    for (;;) {
        if (tid == 0) { int id, x; at_dequeue(qcnt, NPER, xq, pre, id, x); qw[0] = id; qw[1] = x; }
        __syncthreads();
        const int id = qw[0], x = qw[1];
        __syncthreads();
        if (id < 0) break;
        pre = -2; if (tid == 0 && x == xq) pre = (int)__hip_atomic_fetch_add(qcnt + xq * 64, 1u, RLX_AGENT);
        UnitDesc u; int h;
        if (TYPE == 2) { const int P = x * 16 + id / MUP, b = P >> 2, q0 = (id % MUP) * MQB; h = P & 3;
            mem_unit<MQB>(F.lds, qkv_ptr(F, 36 + h, b * SEQ + q0 * 256), memkv_ptr(F, l, h, b * MEM_LEN), memkv_ptr(F, l, 4 + h, b * MEM_LEN), b * SEQ + q0 * 256, 12 + h, (bf16_t*)(F.ws + WS_MIX), (float*)(F.ws + WS_SSQH));
            continue; }
        else { const int ord = (0x70615243 >> (4 * (id & 7))) & 7;
            const int P = x * 24 + (id >> 3), b = P / 6; h = P % 6; u.qb = ord; u.h = h; u.t0 = b * SEQ + ord * 256;
            if (TYPE == 0) { u.hh16 = h; u.Q = qkv_ptr(F, h, b * SEQ); u.K = qkv_ptr(F, 6 + h, b * SEQ); u.V = qkv_ptr(F, 12 + h, b * SEQ);
                const int lo = max(4 * ord - 16, 0), hi2 = min(4 * ord + 20, 32); u.kt0 = lo; u.nt = hi2 - lo; }
            else { u.hh16 = 6 + h; u.Q = qkv_ptr(F, 18 + h, b * SEQ); u.K = qkv_ptr(F, 24 + h, b * SEQ); u.V = qkv_ptr(F, 30 + h, b * SEQ);
                const int lo = min(max(4 * ord - 4, 0), 24), hi2 = min(max(4 * ord + 3 - 4, 0), 24) + 8; u.kt0 = lo; u.nt = hi2 - lo; } }
        if (TYPE == 1) build_table_b(F.lds, in_ptr(5) + (size_t)(l * 6 + h) * 15 * 31);
        if (TYPE == 1) nb_unit(F.lds, u, (bf16_t*)(F.ws + WS_MIX), (float*)(F.ws + WS_SSQH)); else attn_unit<TYPE>(F.lds, u, (bf16_t*)(F.ws + WS_MIX), (float*)(F.ws + WS_SSQH));
    }
}
constexpr int SW_TAB = 131072, SW_CS = 1088, SW_STG = SW_TAB + 4 * SW_CS;
static_assert(SW_STG + 8 * 2048 <= CTRL_BASE, "sliding-window LDS map");
__device__ __forceinline__ void sw_unit(LAS unsigned char* lds, int b, int h, int p, int half, const bf16_t* Qh, const bf16_t* Kh, const bf16_t* Vh, bf16_t* PO, float* PL) {
    const int tid = opaque_tid0(), lane = tid & 63, r32 = lane & 31, hi = lane >> 5; const int wid = __builtin_amdgcn_readfirstlane(tid >> 6), pair = wid >> 1, w2 = wid & 1;
    const int dsh = 2 * p, nbsh = 5 - dsh, nblk = 1 << nbsh;
    const unsigned lds0 = (unsigned)(size_t)lds; lds_cptr shm3 = (lds_cptr)lds;
    { const float sd = exp2f(-8.0f * (float)(h + 1) / 6.0f) * LOG2E * (float)(1 << dsh);
      if (tid < 255) { const int rel = tid - 127, a = rel < 0 ? -rel : rel; const float v = a <= 64 ? -sd * (float)a : NEGBIG;
#pragma unroll
          for (int c = 0; c < 4; ++c) *(LAS float*)(lds + SW_TAB + c * SW_CS + (tid + c) * 4) = v; } }
    lds_cptr ka[4], va[2];
    { const int sw = (r32 >> 1) & 7;
#pragma unroll
      for (int d0 = 0; d0 < 4; ++d0) ka[d0] = shm3 + r32 * 128 + (((2 * d0 + hi) ^ sw) * 16);
      const int q = (lane & 15) >> 2, gb = (lane >> 4) & 1;
#pragma unroll
      for (int d0 = 0; d0 < 2; ++d0) va[d0] = shm3 + 8192 + (4 * hi + q) * 128 + ((2 * (d0 ^ (q >> 1)) + gb) * 32) + (lane & 3) * 8; }
    lds_cptr tb0; { const int idx0 = 63 - 32 * w2 - r32 + 4 * hi, c = (-idx0) & 3; tb0 = shm3 + SW_TAB + c * SW_CS + (idx0 + c) * 4; }
    const int G0 = 16 * half;
    const int prow = 8 * wid + (lane >> 3);
    const int kcol = ((lane & 7) ^ ((4 * wid + (lane >> 4)) & 7)) * 8, vcol = ((((lane & 7) >> 1) ^ (prow & 2)) * 16) + (lane & 1) * 8;
#define SW_DMA(lam) do { int tau_ = G0 - 1 + (lam); tau_ = tau_ < 0 ? 0 : (tau_ > 31 ? 31 : tau_); const int r_ = tau_ >> nbsh, n_ = tau_ & (nblk - 1); \
        const size_t ro_ = (size_t)((((n_ * 64 + prow) << dsh) + r_)) * HD; const unsigned d_ = lds0 + ((lam) & 7) * 16384 + wid * 1024; \
        glds16(Kh + ro_ + kcol, (unsigned)__builtin_amdgcn_readfirstlane(d_)); glds16(Vh + ro_ + vcol, (unsigned)__builtin_amdgcn_readfirstlane(d_ + 8192)); } while (0)
#define SW_QLOAD(dst, s) do { const int G_ = G0 + 4 * (s) + pair, r_ = G_ >> nbsh, n_ = G_ & (nblk - 1); const bf16_t* qw_ = Qh + (size_t)((((n_ * 64 + 32 * w2 + r32) << dsh) + r_)) * HD; \
        _Pragma("unroll") for (int d0 = 0; d0 < 4; ++d0) dst[d0] = *(const bf16x8*)(qw_ + d0 * 16 + hi * 8); } while (0)
    bf16x8 qr[4], qn[4];
    SW_QLOAD(qr, 0);
#pragma unroll
    for (int d0 = 0; d0 < 4; ++d0) qn[d0] = qr[d0];
#pragma unroll
    for (int lam = 0; lam < 8; ++lam) SW_DMA(lam);
    float lsum = 0.f; f32x16 o[2]; o[0] = f32x16{}; o[1] = f32x16{};
#define SW_EPI(s) do { const int G_ = G0 + 4 * (s) + pair, r_ = G_ >> nbsh, n_ = G_ & (nblk - 1); \
        lsum += __shfl_xor(lsum, 32); \
        if (hi == 0) PL[((size_t)p * T + (size_t)b * SEQ + (((n_ * 64 + 32 * w2 + r32) << dsh) + r_)) * 8 + h] = lsum; \
        LAS bf16_t* stg_ = (LAS bf16_t*)(lds + SW_STG + wid * 2048); \
        _Pragma("unroll") for (int d0 = 0; d0 < 2; ++d0) { \
            _Pragma("unroll") for (int r = 0; r < 16; ++r) stg_[crow(r, hi) * 32 + r32] = (bf16_t)f2bf(o[d0][r]); \
            asm volatile("s_waitcnt lgkmcnt(0)" ::: "memory"); \
            _Pragma("unroll") for (int i2 = 0; i2 < 2; ++i2) { const int row = i2 * 16 + (lane >> 2), ch = lane & 3; const u32x4 v = *(const LAS u32x4*)(stg_ + row * 32 + ch * 8); \
                *(u32x4*)(PO + ((size_t)p * T + (size_t)b * SEQ + (((n_ * 64 + 32 * w2 + row) << dsh) + r_)) * 384 + h * 64 + d0 * 32 + ch * 8) = v; } \
            asm volatile("s_waitcnt lgkmcnt(0)" ::: "memory"); } \
        lsum = 0.f; o[0] = f32x16{}; o[1] = f32x16{}; } while (0)
#define SW_WAIT(sig) do { if ((sig) == 0) AT_WAIT_BAR(8); else if ((sig) == 3 || (sig) == 6 || (sig) == 9) AT_WAIT_BAR(4); else if ((sig) == 10) AT_WAIT_BAR(2); else if ((sig) == 11) AT_WAIT_BAR(0); else AT_WAIT_BAR(6); } while (0)
#pragma unroll
    for (int sig = 0; sig < 12; ++sig) {
        const int s = sig / 3, t = sig - 3 * s;
        SW_WAIT(sig);
        if (t == 0 && s > 0) { SW_EPI(s - 1);
#pragma unroll
            for (int d0 = 0; d0 < 4; ++d0) qr[d0] = qn[d0]; }
        if (t == 2 && s < 3) SW_QLOAD(qn, s + 1);
        if (t == 1) { if (4 * s + 8 <= 17) SW_DMA(4 * s + 8); }
        if (t == 2) { if (4 * s + 9 <= 17) SW_DMA(4 * s + 9); }
        if (t == 0 && s > 0) { if (4 * s + 6 <= 17) SW_DMA(4 * s + 6); if (4 * s + 7 <= 17) SW_DMA(4 * s + 7); }
        const int G = G0 + 4 * s + pair, n = G & (nblk - 1);
        if (!(t == 0 && n == 0) && !(t == 2 && n == nblk - 1)) {
            const int slo = ((4 * s + t + pair) & 7) * 16384;
            const bool do0 = !(t == 0 && w2 == 1), do1 = !(t == 2 && w2 == 0);
            const lds_cptr tp = tb0 + t * 256;
            if (do0) {
                f32x16 p0;
#pragma unroll
                for (int gq = 0; gq < 4; ++gq) { const f32x4 a = *(const LAS f32x4*)(tp + 32 * gq); p0[4 * gq] = a[0]; p0[4 * gq + 1] = a[1]; p0[4 * gq + 2] = a[2]; p0[4 * gq + 3] = a[3]; }
#pragma unroll
                for (int d0 = 0; d0 < 4; ++d0) p0 = __builtin_amdgcn_mfma_f32_32x32x16_bf16(*(const LAS bf16x8*)(ka[d0] + slo), qr[d0], p0, 0, 0, 0);
                float s0 = 0.f;
#pragma unroll
                for (int r = 0; r < 16; ++r) { p0[r] = __builtin_amdgcn_exp2f(p0[r]); s0 += p0[r]; }
                lsum += s0;
                const u32x4 pw0 = (u32x4){cvtpk(p0[0], p0[1]), cvtpk(p0[2], p0[3]), cvtpk(p0[4], p0[5]), cvtpk(p0[6], p0[7])}, pw1 = (u32x4){cvtpk(p0[8], p0[9]), cvtpk(p0[10], p0[11]), cvtpk(p0[12], p0[13]), cvtpk(p0[14], p0[15])};
#pragma unroll
                for (int d0 = 0; d0 < 2; ++d0) { const lds_cptr vp = va[d0] + slo; const s16x4 l0 = vtr(vp), h0 = vtr(vp + 1024), l1 = vtr(vp + 2048), h1 = vtr(vp + 2048 + 1024);
                    o[d0] = __builtin_amdgcn_mfma_f32_32x32x16_bf16(__builtin_bit_cast(bf16x8, pw0), (bf16x8){l0[0], l0[1], l0[2], l0[3], h0[0], h0[1], h0[2], h0[3]}, o[d0], 0, 0, 0);
                    o[d0] = __builtin_amdgcn_mfma_f32_32x32x16_bf16(__builtin_bit_cast(bf16x8, pw1), (bf16x8){l1[0], l1[1], l1[2], l1[3], h1[0], h1[1], h1[2], h1[3]}, o[d0], 0, 0, 0); }
            }
            if (do1) {
                f32x16 p1;
#pragma unroll
                for (int gq = 0; gq < 4; ++gq) { const f32x4 a = *(const LAS f32x4*)(tp + 32 * (gq + 4)); p1[4 * gq] = a[0]; p1[4 * gq + 1] = a[1]; p1[4 * gq + 2] = a[2]; p1[4 * gq + 3] = a[3]; }
#pragma unroll
                for (int d0 = 0; d0 < 4; ++d0) p1 = __builtin_amdgcn_mfma_f32_32x32x16_bf16(*(const LAS bf16x8*)(ka[d0] + slo + 4096), qr[d0], p1, 0, 0, 0);
                float s1 = 0.f;
#pragma unroll
                for (int r = 0; r < 16; ++r) { p1[r] = __builtin_amdgcn_exp2f(p1[r]); s1 += p1[r]; }
                lsum += s1;
                const u32x4 pw2 = (u32x4){cvtpk(p1[0], p1[1]), cvtpk(p1[2], p1[3]), cvtpk(p1[4], p1[5]), cvtpk(p1[6], p1[7])}, pw3 = (u32x4){cvtpk(p1[8], p1[9]), cvtpk(p1[10], p1[11]), cvtpk(p1[12], p1[13]), cvtpk(p1[14], p1[15])};
#pragma unroll
                for (int d0 = 0; d0 < 2; ++d0) { const lds_cptr vp = va[d0] + slo + 4096; const s16x4 l0 = vtr(vp), h0 = vtr(vp + 1024), l1 = vtr(vp + 2048), h1 = vtr(vp + 2048 + 1024);
                    o[d0] = __builtin_amdgcn_mfma_f32_32x32x16_bf16(__builtin_bit_cast(bf16x8, pw2), (bf16x8){l0[0], l0[1], l0[2], l0[3], h0[0], h0[1], h0[2], h0[3]}, o[d0], 0, 0, 0);
                    o[d0] = __builtin_amdgcn_mfma_f32_32x32x16_bf16(__builtin_bit_cast(bf16x8, pw3), (bf16x8){l1[0], l1[1], l1[2], l1[3], h1[0], h1[1], h1[2], h1[3]}, o[d0], 0, 0, 0); }
            }
        }
    }
    AT_WAIT_BAR(0);
    SW_EPI(3);
    asm volatile("s_waitcnt lgkmcnt(0)\n\ts_barrier" ::: "memory");
#undef SW_DMA
#undef SW_QLOAD
#undef SW_EPI
#undef SW_WAIT
}
__device__ __forceinline__ void sa_loop(Frame& F, int l, unsigned xcc, int qset) {
    constexpr int NPER = 144;
    unsigned* qcnt = F.ctl + CW_ATQ + ((qset * 3 + 0) * 8) * 64;
    LAS int* qw = (LAS int*)(F.lds + CTRL_BASE + 1024);
    const int tid = opaque_tid0();
    const int xq = (int)xcc & 7; int pre = -2;
    for (;;) {
        if (tid == 0) { int id, x; at_dequeue(qcnt, NPER, xq, pre, id, x); qw[0] = id; qw[1] = x; }
        __syncthreads();
        const int id = qw[0], x = qw[1];
        __syncthreads();
        if (id < 0) break;
        pre = -2; if (tid == 0 && x == xq) pre = (int)__hip_atomic_fetch_add(qcnt + xq * 64, 1u, RLX_AGENT);
        const int P = x * 24 + id / 6, b = P / 6, h = P % 6, p = (id % 6) >> 1, half = id & 1;
        sw_unit(F.lds, b, h, p, half, qkv_ptr(F, h, b * SEQ), qkv_ptr(F, 6 + h, b * SEQ), qkv_ptr(F, 12 + h, b * SEQ), (bf16_t*)(F.ws + WS_PO), (float*)(F.ws + WS_PL));
    }
}
}

__device__ __forceinline__ void moe_weights_beside(Frame& F, int l, int qset) {
    PHASE_IDS(F);
    if ((blockIdx.x & 31) >= 8) return;
    LAS float* scr = (LAS float*)(F.lds + F.wave * 16384);
    LAS int* qw = (LAS int*)(F.lds + CTRL_BASE + 1024);
    constexpr int I_G = 16 * 16, I_D = 8 * 32, PER_E = 2 * I_G + I_D, NIT = NE * PER_E, BATCH_IT = 64;
    unsigned* head = F.ctl + CW_WQ + qset * 64;
    for (;;) {
        if (F.tid == 0) qw[2] = (int)__hip_atomic_fetch_add(head, 1u, RLX_AGENT);
        __syncthreads();
        const int bt = qw[2];
        __syncthreads();
        if (bt * BATCH_IT >= NIT) break;
        auto dec = [&](int j) { const int it = bt * BATCH_IT + j; const int e = it / PER_E; int r = it % PER_E; const size_t le = (size_t)l * NE + e;
            if (r < I_G) return TrItem{in_ptr(15) + le * D * DE, in_ptr(10) + l * D, (bf16_t*)(F.ws + WS_WGU + le * 1024 * D), D, DE, 6, r};
            r -= I_G;
            if (r < I_G) return TrItem{in_ptr(16) + le * D * DE, in_ptr(10) + l * D, (bf16_t*)(F.ws + WS_WGU + le * 1024 * D), D, DE, 7, r};
            r -= I_G;
            return TrItem{in_ptr(17) + le * DE * D, (const float*)nullptr, (bf16_t*)(F.ws + WS_WD + le * D * DE), DE, D, 5, r}; };
        float wa[32], wb[32];
        TrItem d0 = dec(F.wave); tr_load(d0, F.lane, wa);
#pragma unroll
        for (int jj = 0; jj < BATCH_IT / NWAVES; jj += 2) {
            TrItem d1 = dec(F.wave + (jj + 1) * NWAVES); tr_load(d1, F.lane, wb);
            tr_finish(d0, F.lane, wa, scr);
            if (jj + 2 < BATCH_IT / NWAVES) { d0 = dec(F.wave + (jj + 2) * NWAVES); tr_load(d0, F.lane, wa); }
            tr_finish(d1, F.lane, wb, scr);
        }
    }
    __syncthreads();
}
__device__ __forceinline__ void phase_attn_fast(Frame& F, int l, int qset) {
    if (qset < 2) moe_weights_beside(F, l, qset);
    PHASE_IDS(F);
    const unsigned xcc = xb_xcc_id();
    at::sa_loop(F, l, xcc, qset);
    if (PROBE_ID == 100 && l == 0) { __syncthreads(); at::sa_loop(F, l, xcc, 2); }
    at::attn_type_loop<1>(F, l, xcc, qset);
    if (PROBE_ID == 101 && l == 0) { __syncthreads(); at::attn_type_loop<1>(F, l, xcc, 2); }
    at::attn_type_loop<2>(F, l, xcc, qset);
    if (PROBE_ID == 102 && l == 0) { __syncthreads(); at::attn_type_loop<2>(F, l, xcc, 2); }
}

__device__ __forceinline__ bool in_ph(int lo, int hi, int k) { asm volatile("" : "+s"(lo), "+s"(hi)); return lo <= k && k < hi; }
constexpr int PH_TOTAL = 2 + 8 * DEPTH - 1;
__global__ void __launch_bounds__(NWAVES * 64, 2) fwd(Args args) {
    extern __shared__ __attribute__((aligned(16))) unsigned char lds[];
    Frame F;
    F.lds = (LAS unsigned char*)lds; PHASE_IDS(F);
    F.G = gridDim.x; F.ngw = F.G * NWAVES;
    F.out = args.out; F.ws = args.ws; F.ctl = (unsigned*)(args.ws + WS_CTL);
    volatile LAS unsigned* MISC = (volatile LAS unsigned*)(F.lds + MISC_OFF);
    if (F.tid < 32) MISC[F.tid] = 0u;
    __syncthreads();
    const int lo = args.ph_lo, hi = args.ph_hi;
    XcdBarrier bar; bar.bar = F.ctl + CW_BAR; bar.x = 0; bar.st = nullptr;
    if (hi - lo > 1) bar = xcd_barrier_post(F.ctl + CW_BAR, MISC + 8);
#define IN(k) in_ph(lo, hi, (k))
#define SEAM(k) do { if (IN(k) && IN((k) + 1)) xcd_barrier(bar); else __syncthreads(); } while (0)
#define RUN(k, code) do { if (IN(k)) { code; if (PROBE_ID == (k)) { xcd_barrier(bar); code; } } SEAM(k); } while (0)
    RUN(0, { phase_weights(F); phase_x0(F); });
    RUN(1, { phase_memkv_fast(F); phase_inproj_fast(F, 0); });
    { const int l = 0, pb = 2;
      if (IN(pb + 0)) { phase_attn_fast(F, l, 0); if (PROBE_ID == pb + 0) { xcd_barrier(bar); phase_attn_fast(F, l, 2); } } SEAM(pb + 0);
      RUN(pb + 1, { phase_groupnorm(F); });
      RUN(pb + 2, { phase_outproj_fast(F, l); });
      RUN(pb + 3, { phase_router_fast(F, l); });
      RUN(pb + 4, { phase_moe1_fast(F, l); });
      RUN(pb + 5, { phase_moe2_fast(F, l); });
      RUN(pb + 6, { phase_combine(F, l); });
      RUN(pb + 7, { phase_inproj_fast(F, 1); });
    }
    { const int l = 1, pb = 10;
      if (IN(pb + 0)) { phase_attn_fast(F, l, 1); if (PROBE_ID == pb + 0) { xcd_barrier(bar); phase_attn_fast(F, l, 3); } } SEAM(pb + 0);
      RUN(pb + 1, { phase_groupnorm(F); });
      RUN(pb + 2, { phase_outproj_fast(F, l); });
      RUN(pb + 3, { phase_router_fast(F, l); });
      RUN(pb + 4, { phase_moe1_fast(F, l); });
      RUN(pb + 5, { phase_moe2_fast(F, l); });
      RUN(pb + 6, { phase_combine(F, l); });
    }
#undef IN
#undef SEAM
#undef RUN
}

extern "C" void kernel_launch(void* const* d_in, const int* in_sizes, int n_in, void* d_out, int out_size, void* d_ws, size_t ws_size, hipStream_t stream) {
    static int grid = 0;
    if (grid == 0) {
        if (n_in != 18 || in_sizes[0] != T * D || out_size != T * D || ws_size < WS_END) { fprintf(stderr, "kernel_launch: unexpected shapes (n_in %d, in0 %d, out %d, ws %zu < %zu); nothing launched\n", n_in, n_in > 0 ? in_sizes[0] : -1, out_size, ws_size, (size_t)WS_END); grid = -1; return; }
        int dev = 0, cus = 0, per_cu = 0;
        if (hipGetDevice(&dev) != hipSuccess || hipDeviceGetAttribute(&cus, hipDeviceAttributeMultiprocessorCount, dev) != hipSuccess) { grid = -1; return; }
        if (hipFuncSetAttribute((const void*)fwd, hipFuncAttributeMaxDynamicSharedMemorySize, LDS_BYTES) != hipSuccess) { fprintf(stderr, "kernel_launch: hipFuncSetAttribute failed\n"); grid = -1; return; }
        if (hipOccupancyMaxActiveBlocksPerMultiprocessor(&per_cu, (const void*)fwd, NWAVES * 64, LDS_BYTES) != hipSuccess || per_cu < 1) fprintf(stderr, "kernel_launch: occupancy query reports %d\n", per_cu);
        (void)hipGetLastError();
        grid = cus;
    }
    if (grid < 0) return;
    if (hipMemsetAsync((char*)d_ws + WS_CTL, 0, CTL_ZERO_BYTES, stream) != hipSuccess) { fprintf(stderr, "kernel_launch: memset failed\n"); return; }
    Args a{};
    for (int i = 0; i < 18; ++i) a.in[i] = (const float*)d_in[i];
    a.out = (float*)d_out; a.ws = (unsigned char*)d_ws;
#if MK_ONE_LAUNCH
    a.ph_lo = 0; a.ph_hi = PH_TOTAL;
    hipLaunchKernelGGL(fwd, dim3(grid), dim3(NWAVES * 64), LDS_BYTES, stream, a);
#else
    for (int p = 0; p < PH_TOTAL; ++p) { a.ph_lo = p; a.ph_hi = p + 1; hipLaunchKernelGGL(fwd, dim3(grid), dim3(NWAVES * 64), LDS_BYTES, stream, a); }
#endif
    const hipError_t le = hipPeekAtLastError();
    if (le != hipSuccess) fprintf(stderr, "kernel_launch: launch failed: %s\n", hipGetErrorName(le));
}
```

```cpp
#include <hip/hip_runtime.h>
#include <cstdio>
#include <cstdint>

#ifndef PROBE_ID
#define PROBE_ID (-1)
#endif
#ifndef SPARSE_A
#define SPARSE_A 1
#endif
#ifndef MK_ONE_LAUNCH
#define MK_ONE_LAUNCH 1
#endif

constexpr int D = 1024, BATCH = 32, SEQ = 2048, T = BATCH * SEQ, DEPTH = 2;
constexpr int MEM_LEN = 256, TM = BATCH * MEM_LEN;
constexpr int HD = 64, INW = 2560, NHS = 40;
constexpr int NE = 32, EPG = 8, NGRP = 4, DE = 512;
constexpr float EPS = 1e-6f, LOG2E = 1.4426950408889634f, ATTN_SCALE = 0.125f;
constexpr int YROWS = 2 * T + NE * 256;

constexpr size_t MiB = 1u << 20;
constexpr size_t WS_CTL = 0, CTL_ZERO_BYTES = 1 * MiB;
constexpr size_t WS_WIN = 1 * MiB;
constexpr size_t WS_WMEM = WS_WIN + 10 * MiB;
constexpr size_t WS_WOUT = WS_WMEM + 2 * MiB;
constexpr size_t WS_WR = WS_WOUT + 4 * MiB;
constexpr size_t WS_WGU = WS_WR + 1 * MiB;
constexpr size_t WS_X8 = WS_WGU + 64 * MiB;
constexpr size_t WS_WD = WS_WGU + 128 * MiB;
constexpr size_t WS_FAB = WS_WD + 32 * MiB;
constexpr size_t WS_RM = WS_WD + 33 * MiB;
constexpr size_t WS_XB = WS_WD + 64 * MiB;
constexpr size_t WS_RS = WS_XB + 128 * MiB;
constexpr size_t WS_SSQ1 = WS_RS + 1 * MiB;
constexpr size_t WS_SSQH = WS_SSQ1 + 4 * MiB;
constexpr size_t WS_MB = WS_SSQH + 4 * MiB;
constexpr size_t WS_RSM = WS_MB + 16 * MiB;
constexpr size_t WS_MEMKV = WS_RSM + 1 * MiB;
constexpr size_t WS_ROUTE = WS_MEMKV + 16 * MiB;
constexpr size_t WS_LIST = WS_ROUTE + 1 * MiB;
constexpr size_t WS_WL = WS_LIST + 8 * MiB;
constexpr size_t WS_RSL = WS_WL + 8 * MiB;
constexpr size_t WS_QKV = WS_RSL + 8 * MiB;
constexpr size_t WS_MIX = WS_QKV + 320 * MiB;
constexpr size_t WS_PO = WS_MIX + 136 * MiB;
constexpr size_t WS_PL = WS_PO + 144 * MiB;
constexpr size_t WS_END = WS_PL + 6 * MiB;
static_assert(WS_END <= 1024 * MiB, "workspace map exceeds 1 GiB");
static_assert((size_t)YROWS * 1024 * 2 <= 320 * MiB && (size_t)YROWS * 512 * 4 <= 320 * MiB && (size_t)YROWS * 512 * 2 <= 136 * MiB, "aliases");
constexpr int CW_BAR = 4096;
constexpr int CW_WQ = 40960;
constexpr int CW_ATQ = 32768;
constexpr int CW_CNT = 16384;

constexpr int LDS_BYTES = 163840;
constexpr int CTRL_BASE = 159744;
constexpr int MISC_OFF = CTRL_BASE + 2048;
constexpr int NWAVES = 8;

#define GAS __attribute__((address_space(1)))
#define LAS __attribute__((address_space(3)))
typedef unsigned short bf16_t;
typedef unsigned u32x4 __attribute__((ext_vector_type(4)));
typedef unsigned u32x2 __attribute__((ext_vector_type(2)));
typedef float f32x4 __attribute__((ext_vector_type(4)));
#define RLX_AGENT __ATOMIC_RELAXED, __HIP_MEMORY_SCOPE_AGENT

__device__ __forceinline__ float bf2f(unsigned v) { return __uint_as_float(v << 16); }
__device__ __forceinline__ unsigned f2bf(float f) { unsigned u = __float_as_uint(f); return (u + 0x7fffu + ((u >> 16) & 1u)) >> 16; }
__device__ __forceinline__ unsigned pk2(float lo, float hi) { return f2bf(lo) | (f2bf(hi) << 16); }
__device__ __forceinline__ float wave_sum(float v) {
#pragma unroll
    for (int o = 1; o < 64; o <<= 1) v += __shfl_xor(v, o);
    return v;
}
__device__ __forceinline__ float wave_max(float v) {
#pragma unroll
    for (int o = 1; o < 64; o <<= 1) v = fmaxf(v, __shfl_xor(v, o));
    return v;
}

#define XB_TMO      128
#define XB_XCNT(j)  (256  + 64 * (j))
#define XB_XSUB(j)  (1280 + 64 * (j))
#define XB_XGEN(j)  (2304 + 64 * (j))
#define XB_TOP      3328
#define XB_TOPGEN   3392
#define XCD_BAR_WORDS 3456
#define XB_SPIN_CAP (1u << 18)
__device__ __forceinline__ unsigned xb_ld(unsigned* p)              { return __hip_atomic_load(p, __ATOMIC_RELAXED, __HIP_MEMORY_SCOPE_AGENT); }
__device__ __forceinline__ unsigned xb_add(unsigned* p, unsigned v) { return __hip_atomic_fetch_add(p, v, __ATOMIC_RELAXED, __HIP_MEMORY_SCOPE_AGENT); }
__device__ __forceinline__ unsigned xb_xcc_id() { return (unsigned)__builtin_amdgcn_s_getreg((3 << 11) | 20) & 0xFu; }
#define XB_SPIN(cond, bar) do { unsigned _sp = 0; while (cond) { __builtin_amdgcn_s_sleep(1); \
    if ((++_sp & 255u) == 0u) { if (xb_ld(&(bar)[XB_TMO])) break; if (_sp > XB_SPIN_CAP) { atomicAdd(&(bar)[XB_TMO], 1u); break; } } } } while (0)
struct XcdBarrier { unsigned* bar; unsigned x; volatile LAS unsigned* st; };
__device__ __forceinline__ XcdBarrier xcd_barrier_post(unsigned* bar, volatile LAS unsigned* st) {
    XcdBarrier b; b.bar = bar; b.x = xb_xcc_id(); b.st = st;
    if (threadIdx.x == 0) (void)xb_add(&bar[XB_XCNT(b.x)], 1u);
    return b;
}
__device__ __forceinline__ void xcd_barrier_complete(unsigned* bar, unsigned x, unsigned& nloc, unsigned& nx) {
    const unsigned G = gridDim.x * gridDim.y * gridDim.z;
    unsigned sum, cnt, mine, sp = 0u;
    for (;;) {
        sum = 0u; cnt = 0u; mine = 0u;
#pragma unroll
        for (unsigned j = 0; j < 16; ++j) { const unsigned c = xb_ld(&bar[XB_XCNT(j)]); sum += c; cnt += (c > 0u) ? 1u : 0u; mine = (j == x) ? c : mine; }
        if (sum == G) break;
        __builtin_amdgcn_s_sleep(1);
        if ((++sp & 255u) == 0u) { if (xb_ld(&bar[XB_TMO])) break; if (sp > XB_SPIN_CAP) { atomicAdd(&bar[XB_TMO], 1u); break; } }
    }
    nloc = mine > 0u ? mine : 1u; nx = cnt > 0u ? cnt : 1u;
}
__device__ __forceinline__ void xcd_barrier(const XcdBarrier& b) {
    asm volatile("s_waitcnt vmcnt(0)" ::: "memory");
    __syncthreads();
    if (threadIdx.x == 0) {
        unsigned* bar = b.bar;
        __builtin_amdgcn_s_waitcnt(0);
        unsigned nloc = b.st[0], nx = b.st[1];
        if (nloc == 0u) { xcd_barrier_complete(bar, b.x, nloc, nx); b.st[0] = nloc; b.st[1] = nx; }
        const unsigned old = xb_add(&bar[XB_XSUB(b.x)], 1u);
        const unsigned gen = old / nloc;
        if (old + 1u == (gen + 1u) * nloc) {
            __builtin_amdgcn_fence(__ATOMIC_RELEASE, "agent");
            asm volatile("s_waitcnt vmcnt(0)" ::: "memory");
            const unsigned og = xb_add(&bar[XB_TOP], 1u);
            const unsigned tg = og / nx;
            if (og + 1u == (tg + 1u) * nx) xb_add(&bar[XB_TOPGEN], 1u);
            else XB_SPIN(xb_ld(&bar[XB_TOPGEN]) == tg, bar);
            __builtin_amdgcn_fence(__ATOMIC_ACQUIRE, "agent");
            xb_add(&bar[XB_XGEN(b.x)], 1u);
            asm volatile("s_waitcnt vmcnt(0)" ::: "memory");
        } else {
            XB_SPIN(xb_ld(&bar[XB_XGEN(b.x)]) == gen, bar);
            __builtin_amdgcn_fence(__ATOMIC_ACQUIRE, "agent");
            asm volatile("s_waitcnt vmcnt(0)" ::: "memory");
        }
    }
    __syncthreads();
}

struct Args {
    const float* in[18]; float* out; unsigned char* ws; int ph_lo, ph_hi;
};
__device__ __forceinline__ const float* in_ptr(int k) {
    const __attribute__((address_space(4))) char* ka = (const __attribute__((address_space(4))) char*)__builtin_amdgcn_kernarg_segment_ptr();
    asm volatile("" : "+s"(ka));
    return *(const float* const __attribute__((address_space(4)))*)(ka + 8 * k);
}
struct Frame {
    LAS unsigned char* lds; int tid, lane, wave, G, gw, ngw;
    float* out; unsigned char* ws; unsigned* ctl;
};

#define PHASE_IDS(F) do { (F).tid = opaque_tid0(); (F).lane = (F).tid & 63; (F).wave = __builtin_amdgcn_readfirstlane((F).tid >> 6); (F).gw = blockIdx.x * NWAVES + (F).wave; } while (0)
__device__ __forceinline__ int opaque_tid0() { int t = threadIdx.x; asm volatile("" : "+v"(t)); return t; }
__host__ __device__ __forceinline__ int inproj_gemm_col(int H, int dim) {
    const int pn = H >> 2, wc = H & 3, bj = dim >> 5, fq = (dim >> 3) & 3, nn = (dim >> 2) & 1, j = dim & 3;
    return 256 * pn + 128 * bj + 32 * wc + 16 * nn + 4 * fq + j;
}
__host__ __device__ __forceinline__ void inproj_head_dim(int c, int& H, int& dim) {
    const int pn = c >> 8, r = c & 255, bj = r >> 7, wc = (r >> 5) & 3, nn = (r >> 4) & 1, fq = (r >> 2) & 3, j = r & 3;
    H = 4 * pn + wc; dim = 32 * bj + 8 * fq + 4 * nn + j;
}

struct TrItem { const float* W; const float* kgain; bf16_t* WT; int K, N, kind, item; };
__device__ __forceinline__ void tr_load(const TrItem& d, int lane, float (&wv)[32]) {
    const int nblk = d.N / 32, kb = d.item / nblk, nb = d.item % nblk, k0 = 64 * kb, n0 = 32 * nb;
#pragma unroll
    for (int i = 0; i < 32; ++i) wv[i] = d.W[(size_t)(k0 + 2 * i + (lane >> 5)) * d.N + n0 + (lane & 31)];
}
__device__ __forceinline__ int tr_rowmap(int kind, int n);
__device__ __forceinline__ void tr_finish(const TrItem& d, int lane, const float (&wv)[32], LAS float* scr) {
    const int nblk = d.N / 32, kb = d.item / nblk, nb = d.item % nblk, k0 = 64 * kb, n0 = 32 * nb;
#pragma unroll
    for (int i = 0; i < 32; ++i) { const int kk = 2 * i + (lane >> 5); const float g = d.kgain ? d.kgain[k0 + kk] : 1.f; scr[kk * 33 + (lane & 31)] = wv[i] * g; }
    asm volatile("s_waitcnt lgkmcnt(0)" ::: "memory");
    const int c = lane & 7;
#pragma unroll
    for (int j = 0; j < 4; ++j) { const int n = (lane >> 3) + 8 * j; const LAS float* s = scr + (8 * c) * 33 + n;
        u32x4 o; o.x = pk2(s[0 * 33], s[1 * 33]); o.y = pk2(s[2 * 33], s[3 * 33]); o.z = pk2(s[4 * 33], s[5 * 33]); o.w = pk2(s[6 * 33], s[7 * 33]);
        if (d.kind >= 5) {
            int w0 = 0, w1 = 0;
            w0 = __builtin_amdgcn_cvt_pk_fp8_f32(32.f * s[0 * 33], 32.f * s[1 * 33], w0, false); w0 = __builtin_amdgcn_cvt_pk_fp8_f32(32.f * s[2 * 33], 32.f * s[3 * 33], w0, true);
            w1 = __builtin_amdgcn_cvt_pk_fp8_f32(32.f * s[4 * 33], 32.f * s[5 * 33], w1, false); w1 = __builtin_amdgcn_cvt_pk_fp8_f32(32.f * s[6 * 33], 32.f * s[7 * 33], w1, true);
            u32x2 o8; o8.x = (unsigned)w0; o8.y = (unsigned)w1;
            *(u32x2*)((unsigned char*)d.WT + (size_t)tr_rowmap(d.kind, n0 + n) * d.K + k0 + 8 * c) = o8;
        } else *(u32x4*)(d.WT + (size_t)tr_rowmap(d.kind, n0 + n) * d.K + k0 + 8 * c) = o; }
    asm volatile("s_waitcnt lgkmcnt(0)" ::: "memory");
}
struct RmId { __device__ __forceinline__ int operator()(int n) const { return n; } };
struct RmHead { __device__ __forceinline__ int operator()(int n) const { return inproj_gemm_col(n >> 6, n & 63); } };
__host__ __device__ __forceinline__ int perm_row32(int c) { const int o = c & 31; return (c & ~31) | (16 * ((o >> 2) & 1) + 4 * (o >> 3) + (o & 3)); }
__host__ __device__ __forceinline__ int gate_row(int c, int up) { return 256 * (c >> 7) + 128 * up + perm_row32(c & 127); }
struct RmGate { int up; __device__ __forceinline__ int operator()(int n) const { return gate_row(n, up); } };
struct RmPerm { __device__ __forceinline__ int operator()(int n) const { return perm_row32(n); } };
__device__ __forceinline__ int tr_rowmap(int kind, int n) { return kind == 0 ? n : ((kind == 1 || kind == 8) ? inproj_gemm_col(n >> 6, n & 63) : ((kind == 2 || kind == 6) ? gate_row(n, 0) : ((kind == 3 || kind == 7) ? gate_row(n, 1) : perm_row32(n)))); }

__device__ __forceinline__ TrItem tr_decode_small(int it) {
    constexpr int I_IN = 16 * 80, I_MEM = 16 * 16, I_OUT = 16 * 32, PER_L = I_IN + I_MEM + I_OUT;
    const int l = it / PER_L; int r = it % PER_L;
    if (r < I_IN) return TrItem{in_ptr(3) + (size_t)l * D * INW, in_ptr(2) + l * D, (bf16_t*)nullptr, D, INW, 100 + l, r};
    r -= I_IN;
    if (r < I_MEM) return TrItem{in_ptr(7) + (size_t)l * D * 512, in_ptr(6) + l * D, (bf16_t*)nullptr, D, 512, 200 + l, r};
    r -= I_MEM;
    return TrItem{in_ptr(9) + (size_t)l * D * D, in_ptr(8) + l * D, (bf16_t*)nullptr, D, D, 300 + l, r};
}
__device__ __forceinline__ void phase_weights(Frame& F) {
    PHASE_IDS(F);
    LAS float* scr = (LAS float*)(F.lds + F.wave * 16384);
    constexpr int PER_L = 16 * 80 + 16 * 16 + 16 * 32, NIT = DEPTH * PER_L;
    auto fix = [&](TrItem d) { const int l = d.kind % 100, w = d.kind / 100;
        if (w == 1) { if (l == 0) { d.WT = (bf16_t*)(F.ws + WS_WIN); d.kind = 1; } else { d.WT = (bf16_t*)(F.ws + WS_WIN + (size_t)INW * D * 2); d.kind = 8; } } else if (w == 2) { d.WT = (bf16_t*)(F.ws + WS_WMEM) + (size_t)l * 512 * D; d.kind = 1; } else { d.WT = (bf16_t*)(F.ws + WS_WOUT) + (size_t)l * D * D; d.kind = 4; }
        return d; };
    float wa[32], wb[32];
    int it = F.gw;
    if (it < NIT) { TrItem d = fix(tr_decode_small(it)); tr_load(d, F.lane, wa);
        for (;;) {
            const int it2 = it + F.ngw; TrItem d2 = d; const bool more = it2 < NIT;
            if (more) { d2 = fix(tr_decode_small(it2)); tr_load(d2, F.lane, wb); }
            tr_finish(d, F.lane, wa, scr);
            if (!more) break;
            const int it3 = it2 + F.ngw; const bool more3 = it3 < NIT; TrItem d3 = d2;
            if (more3) { d3 = fix(tr_decode_small(it3)); tr_load(d3, F.lane, wa); }
            tr_finish(d2, F.lane, wb, scr);
            if (!more3) break;
            it = it3; d = d3;
        } }
    for (int i = F.gw * 64 + F.lane; i < DEPTH * 256 * D; i += F.ngw * 64) {
        const int l = i / (256 * D), j = (i / D) % 256, k = i % D; float v = 0.f;
        if (j < 4) v = in_ptr(11)[((size_t)l * D + k) * NGRP + j] * in_ptr(10)[l * D + k]; else if (j < 36) v = in_ptr(13)[((size_t)l * D + k) * NE + (j - 4)] * in_ptr(10)[l * D + k];
        ((bf16_t*)(F.ws + WS_WR))[i] = (bf16_t)f2bf(v);
    }
}

__device__ __forceinline__ void row_to_bf16_rs(int lane, const float* xrow, bf16_t* orow, float* rs) {
    const f32x4* xr = (const f32x4*)xrow + lane; f32x4 v[4]; float s = 0.f;
#pragma unroll
    for (int j = 0; j < 4; ++j) { v[j] = xr[64 * j]; s += (v[j].x * v[j].x + v[j].y * v[j].y) + (v[j].z * v[j].z + v[j].w * v[j].w); }
    s = wave_sum(s);
    if (lane == 0) *rs = 1.0f / sqrtf(s * (1.f / D) + EPS);
    u32x2* o8 = (u32x2*)orow + lane;
#pragma unroll
    for (int j = 0; j < 4; ++j) { u32x2 w; w.x = pk2(v[j].x, v[j].y); w.y = pk2(v[j].z, v[j].w); o8[64 * j] = w; }
}
__device__ __forceinline__ void phase_x0(Frame& F) {
    PHASE_IDS(F);
    const float* xp = in_ptr(0); const float* mp = in_ptr(1); const int lane = F.lane;
    for (int m0 = F.gw * 2; m0 < T + TM; m0 += F.ngw * 2) {
        const bool isx = m0 < T; const int r0 = isx ? m0 : m0 - T;
        const float* src = (isx ? xp : mp) + (size_t)r0 * D; bf16_t* dst = (bf16_t*)(F.ws + (isx ? WS_XB : WS_MB)) + (size_t)r0 * D; float* rs = (float*)(F.ws + (isx ? WS_RS : WS_RSM)) + r0;
        f32x4 v[2][4];
#pragma unroll
        for (int k = 0; k < 2; ++k)
#pragma unroll
            for (int j = 0; j < 4; ++j) v[k][j] = ((const f32x4*)(src + (size_t)k * D) + lane)[64 * j];
#pragma unroll
        for (int k = 0; k < 2; ++k) { float s = 0.f;
#pragma unroll
            for (int j = 0; j < 4; ++j) s += (v[k][j].x * v[k][j].x + v[k][j].y * v[k][j].y) + (v[k][j].z * v[k][j].z + v[k][j].w * v[k][j].w);
            s = wave_sum(s);
            if (lane == 0) rs[k] = 1.0f / sqrtf(s * (1.f / D) + EPS);
            u32x2* o8 = (u32x2*)(dst + (size_t)k * D) + lane;
#pragma unroll
            for (int j = 0; j < 4; ++j) { u32x2 w; w.x = pk2(v[k][j].x, v[k][j].y); w.y = pk2(v[k][j].z, v[k][j].w); o8[64 * j] = w; } }
    }
}

__device__ __forceinline__ bf16_t* qkv_ptr(Frame& F, int H, int t) { return (bf16_t*)(F.ws + WS_QKV) + ((size_t)H * T + t) * HD; }
__device__ __forceinline__ bf16_t* memkv_ptr(Frame& F, int l, int H, int r) { return (bf16_t*)(F.ws + WS_MEMKV) + (((size_t)l * 8 + H) * TM + r) * HD; }

__device__ __forceinline__ void slice_kind(int H, int& gi, bool& isq) {
    gi = -1; isq = false;
    if (H < 6) { gi = 0; isq = true; } else if (H < 12) gi = 1; else if (H < 18) gi = -1;
    else if (H < 24) { gi = 2; isq = true; } else if (H < 30) gi = 3; else if (H < 36) gi = -1; else { gi = 4; isq = true; }
}
__device__ __forceinline__ void phase_groupnorm(Frame& F) {
    PHASE_IDS(F);
    const int lane = F.lane, half = lane >> 5, l32 = lane & 31, h = l32 >> 2; const bool act = l32 < 24;
    const bf16_t* PO = (const bf16_t*)(F.ws + WS_PO); const float* PL = (const float*)(F.ws + WS_PL); bf16_t* MX = (bf16_t*)(F.ws + WS_MIX);
    const float* SQ = (const float*)(F.ws + WS_SSQH); float* FAB = (float*)(F.ws + WS_FAB); float* RM = (float*)(F.ws + WS_RM);
    for (int t0 = F.gw * 8; t0 < T; t0 += F.ngw * 8) {
        u32x4 raw[4][3][2]; float den[4][3]; f32x4 sq[4][3];
#pragma unroll
        for (int u = 0; u < 4; ++u) { const int t = t0 + 2 * u + half;
            if (act) {
#pragma unroll
                for (int p = 0; p < 3; ++p) { const u32x4* pp = (const u32x4*)(PO + ((size_t)p * T + t) * 384 + l32 * 16); raw[u][p][0] = pp[0]; raw[u][p][1] = pp[1]; den[u][p] = PL[((size_t)p * T + t) * 8 + h]; }
            }
#pragma unroll
            for (int q = 0; q < 3; ++q) sq[u][q] = *(const f32x4*)(SQ + (size_t)t * 16 + 4 + 4 * q);
        }
#pragma unroll
        for (int u = 0; u < 4; ++u) { const int t = t0 + 2 * u + half; float v[16]; float s = 0.f;
            if (act) {
#pragma unroll
                for (int i = 0; i < 2; ++i) { const u32x4 w = raw[u][0][i]; v[8 * i + 0] = bf2f(w.x & 0xffffu); v[8 * i + 1] = bf2f(w.x >> 16); v[8 * i + 2] = bf2f(w.y & 0xffffu); v[8 * i + 3] = bf2f(w.y >> 16);
                    v[8 * i + 4] = bf2f(w.z & 0xffffu); v[8 * i + 5] = bf2f(w.z >> 16); v[8 * i + 6] = bf2f(w.w & 0xffffu); v[8 * i + 7] = bf2f(w.w >> 16); }
#pragma unroll
                for (int p = 1; p < 3; ++p)
#pragma unroll
                    for (int i = 0; i < 2; ++i) { const u32x4 w = raw[u][p][i]; v[8 * i + 0] += bf2f(w.x & 0xffffu); v[8 * i + 1] += bf2f(w.x >> 16); v[8 * i + 2] += bf2f(w.y & 0xffffu); v[8 * i + 3] += bf2f(w.y >> 16);
                        v[8 * i + 4] += bf2f(w.z & 0xffffu); v[8 * i + 5] += bf2f(w.z >> 16); v[8 * i + 6] += bf2f(w.w & 0xffffu); v[8 * i + 7] += bf2f(w.w >> 16); }
                const float rd = 1.0f / ((den[u][0] + den[u][1]) + den[u][2]);
                u32x4 o[2];
#pragma unroll
                for (int i = 0; i < 2; ++i) { o[i].x = pk2(v[8 * i + 0] * rd, v[8 * i + 1] * rd); o[i].y = pk2(v[8 * i + 2] * rd, v[8 * i + 3] * rd); o[i].z = pk2(v[8 * i + 4] * rd, v[8 * i + 5] * rd); o[i].w = pk2(v[8 * i + 6] * rd, v[8 * i + 7] * rd);
                    float a;
                    a = bf2f(o[i].x & 0xffffu); s += a * a; a = bf2f(o[i].x >> 16); s += a * a; a = bf2f(o[i].y & 0xffffu); s += a * a; a = bf2f(o[i].y >> 16); s += a * a;
                    a = bf2f(o[i].z & 0xffffu); s += a * a; a = bf2f(o[i].z >> 16); s += a * a; a = bf2f(o[i].w & 0xffffu); s += a * a; a = bf2f(o[i].w >> 16); s += a * a; }
                u32x4* mp = (u32x4*)(MX + (size_t)t * D + l32 * 16); mp[0] = o[0]; mp[1] = o[1];
            }
            s += __shfl_xor(s, 1); s += __shfl_xor(s, 2); s += __shfl_xor(s, 4); s += __shfl_xor(s, 8); s += __shfl_xor(s, 16);
            if (l32 == 0) {
                const float sb = ((sq[u][0][2] + sq[u][0][3]) + (sq[u][1][0] + sq[u][1][1])) + (sq[u][1][2] + sq[u][1][3]), sm = (sq[u][2][0] + sq[u][2][1]) + (sq[u][2][2] + sq[u][2][3]);
                const float ra = 1.f / sqrtf(s * (1.f / 384.f) + EPS), rb = 1.f / sqrtf(sb * (1.f / 384.f) + EPS), rmv = 1.f / sqrtf(sm * (1.f / 256.f) + EPS);
                FAB[(size_t)t * 2] = ra / rb; FAB[(size_t)t * 2 + 1] = rb / rmv; RM[t] = rmv; }
        }
    }
}
__device__ __forceinline__ void load_expert_table(LAS int* tab, const unsigned* cnt) {
    const int tid = opaque_tid0(), lane = tid & 63;
    if (tid < 64) {
        const int c = lane < NE ? (int)__hip_atomic_load(cnt + lane * 64, RLX_AGENT) : 0;
        int inc = (c + 255) >> 8;
#pragma unroll
        for (int o = 1; o < 64; o <<= 1) { const int v = __shfl_up(inc, o); if (lane >= o) inc += v; }
        tab[lane] = inc - ((c + 255) >> 8); tab[64 + lane] = c;
    }
    __syncthreads();
}
__device__ __forceinline__ float cl8(float v) { return fminf(fmaxf(v, -440.f), 440.f); }
__device__ __forceinline__ void phase_combine(Frame& F, int l) {
    PHASE_IDS(F);
    LAS int* tab = (LAS int*)(F.lds + CTRL_BASE);
    load_expert_table(tab, F.ctl + CW_CNT + l * NE * 64);
    const unsigned char* Y = (const unsigned char*)(F.ws + WS_QKV); const int lane = F.lane;
    typedef float f32x2_t __attribute__((ext_vector_type(2)));
    typedef int i32x4_t __attribute__((ext_vector_type(4)));
    constexpr int TK = 2;
    for (int t0 = F.gw * TK; t0 < T; t0 += F.ngw * TK) {
        i32x4_t rt[TK];
#pragma unroll
        for (int k = 0; k < TK; ++k) rt[k] = *(const i32x4_t*)((const int*)(F.ws + WS_ROUTE) + (size_t)(t0 + k) * 4);
        u32x2 xv[TK][4]; unsigned ya[TK][4], yb[TK][4];
#pragma unroll
        for (int k = 0; k < TK; ++k) { int ea = rt[k][0], pa = rt[k][1], eb = rt[k][2], pb = rt[k][3];
            if (ea > eb) { int q = ea; ea = eb; eb = q; q = pa; pa = pb; pb = q; }
            const unsigned* pya = (const unsigned*)(Y + (size_t)(tab[ea] * 256 + pa) * D) + lane; const unsigned* pyb = (const unsigned*)(Y + (size_t)(tab[eb] * 256 + pb) * D) + lane;
            const u32x2* xr = (const u32x2*)((const bf16_t*)(F.ws + WS_XB) + (size_t)(t0 + k) * D) + lane;
#pragma unroll
            for (int j = 0; j < 4; ++j) { xv[k][j] = xr[64 * j]; ya[k][j] = pya[64 * j]; yb[k][j] = pyb[64 * j]; } }
#pragma unroll
        for (int k = 0; k < TK; ++k) { const int t = t0 + k; f32x4 v[4]; float s = 0.f;
#pragma unroll
            for (int j = 0; j < 4; ++j) { const u32x2 x = xv[k][j]; const int a = (int)ya[k][j], b2 = (int)yb[k][j];
                const f32x2_t a0 = __builtin_amdgcn_cvt_pk_f32_fp8(a, false), a1 = __builtin_amdgcn_cvt_pk_f32_fp8(a, true), b0 = __builtin_amdgcn_cvt_pk_f32_fp8(b2, false), b1 = __builtin_amdgcn_cvt_pk_f32_fp8(b2, true);
                v[j].x = (bf2f(x.x & 0xffffu) + 0.125f * a0[0]) + 0.125f * b0[0]; v[j].y = (bf2f(x.x >> 16) + 0.125f * a0[1]) + 0.125f * b0[1];
                v[j].z = (bf2f(x.y & 0xffffu) + 0.125f * a1[0]) + 0.125f * b1[0]; v[j].w = (bf2f(x.y >> 16) + 0.125f * a1[1]) + 0.125f * b1[1]; }
            if (l + 1 < DEPTH) {
                u32x2* o8 = (u32x2*)((bf16_t*)(F.ws + WS_XB) + (size_t)t * D) + lane;
#pragma unroll
                for (int j = 0; j < 4; ++j) { u32x2 w; w.x = pk2(v[j].x, v[j].y); w.y = pk2(v[j].z, v[j].w); o8[64 * j] = w;
                    const float o0 = bf2f(w.x & 0xffffu), o1 = bf2f(w.x >> 16), o2 = bf2f(w.y & 0xffffu), o3 = bf2f(w.y >> 16); s += (o0 * o0 + o1 * o1) + (o2 * o2 + o3 * o3);
                    int q8 = 0; q8 = __builtin_amdgcn_cvt_pk_fp8_f32(cl8(16.f * o0), cl8(16.f * o1), q8, false); q8 = __builtin_amdgcn_cvt_pk_fp8_f32(cl8(16.f * o2), cl8(16.f * o3), q8, true);
                    ((int*)(F.ws + WS_X8 + (size_t)t * D))[lane + 64 * j] = q8; }
                s = wave_sum(s);
                if (lane == 0) ((float*)(F.ws + WS_RS))[t] = 1.0f / sqrtf(s * (1.f / D) + EPS);
            } else {
                f32x4* xo = (f32x4*)(F.out + (size_t)t * D) + lane;
#pragma unroll
                for (int j = 0; j < 4; ++j) xo[64 * j] = v[j];
            }
        }
    }
}

namespace g8 {
typedef short bf16x8 __attribute__((ext_vector_type(8)));
constexpr int BK = 64, HALF = 128, HTB = HALF * BK * 2, NXCD = 8, WGM = 8;
__device__ __forceinline__ int lds_byte(int r, int c) { const int st = (r >> 4) * 2 + (c >> 5), rr = r & 15, cc = c & 31, ob = rr * 64 + cc * 2; return st * 1024 + (ob ^ (((ob >> 9) & 1) << 5)); }
__device__ __forceinline__ void stage_rc(int b, int& R, int& C) { const int st = b / 1024, sb = b % 1024, swz = sb ^ (((sb >> 9) & 1) << 5); R = (st >> 1) * 16 + swz / 64; C = (st & 1) * 32 + (swz % 64) / 2; }
__device__ __forceinline__ unsigned cvt_pk_bf16(float lo, float hi) { unsigned r; asm volatile("v_cvt_pk_bf16_f32 %0, %1, %2" : "=v"(r) : "v"(lo), "v"(hi)); return r; }
__device__ __forceinline__ int opaque_tid() { int t = threadIdx.x; asm volatile("" : "+v"(t)); return t; }
__device__ __forceinline__ const char* uni(const char* p) { const unsigned long long v = (unsigned long long)p;
    return (const char*)(((unsigned long long)(unsigned)__builtin_amdgcn_readfirstlane((int)(v >> 32)) << 32) | (unsigned)__builtin_amdgcn_readfirstlane((int)v)); }
typedef int i32x8 __attribute__((ext_vector_type(8)));
typedef int i32x4v __attribute__((ext_vector_type(4)));
__device__ __forceinline__ float clamp8(float v) { return fminf(fmaxf(v, -440.f), 440.f); }
__device__ __forceinline__ i32x8 cat8(i32x4v a, i32x4v b) { return __builtin_shufflevector(a, b, 0, 1, 2, 3, 4, 5, 6, 7); }
__device__ __forceinline__ bf16x8 lo8(i32x8 v) { return __builtin_bit_cast(bf16x8, (i32x4v)__builtin_shufflevector(v, v, 0, 1, 2, 3)); }
__device__ __forceinline__ bf16x8 hi8(i32x8 v) { return __builtin_bit_cast(bf16x8, (i32x4v)__builtin_shufflevector(v, v, 4, 5, 6, 7)); }
struct Unit { const char* B; unsigned a00, a01, a10, a11; int pm, pn, e, ti, ce; };
struct DenseSched {
    int nM, nN, nwg, G, c, K; const char* Bbase;
    __device__ __forceinline__ void init(int M, int N, int K_, int G_, int c_, int tid, const void* Bt) { nM = M / 256; nN = N / 256; nwg = nM * nN; G = G_; c = c_; K = K_; Bbase = (const char*)Bt; }
    __device__ __forceinline__ bool next(int i, Unit& u) const {
        const long L = (long)i * G + c; if (L >= nwg) return false;
        int wgid = (int)L; { const int q = nwg / NXCD, r = nwg % NXCD, xcd = wgid % NXCD, off = wgid / NXCD; wgid = (xcd < r ? xcd * (q + 1) : r * (q + 1) + (xcd - r) * q) + off; }
        const int nig = WGM * nN, gid = wgid / nig, fm = gid * WGM, gsz = (nM - fm) < WGM ? (nM - fm) : WGM;
        u.pm = fm + ((wgid % nig) % gsz); u.pn = (wgid % nig) / gsz; u.e = 0; u.ti = 0; u.ce = 0;
        u.B = Bbase + (size_t)u.pn * 256 * K * 2;
        int R[2], C[2]; { const int tid = opaque_tid(); stage_rc(tid * 16, R[0], C[0]); stage_rc(tid * 16 + 8192, R[1], C[1]); }
        u.a00 = (unsigned)((u.pm * 256 + R[0]) * K + C[0]) * 2u; u.a01 = (unsigned)((u.pm * 256 + R[1]) * K + C[1]) * 2u;
        u.a10 = (unsigned)((u.pm * 256 + 128 + R[0]) * K + C[0]) * 2u; u.a11 = (unsigned)((u.pm * 256 + 128 + R[1]) * K + C[1]) * 2u;
        return true;
    }
};
struct GroupSched {
    int NP, total, G, vb, K; const char* Bbase; size_t Bstride; const int* list; bool gather; LAS int* tab;
    __device__ __forceinline__ void init(LAS int* tab_, const unsigned* cnt, int NP_, int K_, int G_, int bid, const void* Bt, size_t Bstride_, const int* list_, bool gather_) {
        const int tid = opaque_tid(), lane = tid & 63; NP = NP_; K = K_; G = G_; vb = (G_ % 8 == 0) ? (bid % 8) * (G_ / 8) + bid / 8 : bid; Bbase = (const char*)Bt; Bstride = Bstride_; list = list_; gather = gather_; tab = tab_;
        const int c = lane < NE ? (int)__hip_atomic_load(cnt + lane * 64, RLX_AGENT) : 0;
        int inc = (c + 255) >> 8;
#pragma unroll
        for (int o = 1; o < 64; o <<= 1) { const int v = __shfl_up(inc, o); if (lane >= o) inc += v; }
        total = __builtin_amdgcn_readfirstlane(__shfl(inc, 63)) * NP;
        if (tid < 64) { tab[lane] = inc - ((c + 255) >> 8); tab[64 + lane] = c; }
        __syncthreads();
    }
    __device__ __forceinline__ bool next(int i, Unit& u) const {
        const int L = i * G + vb; if (L >= total) return false;
        const int tid = opaque_tid(), g = L / NP, lane = tid & 63; u.pn = L % NP; u.pm = g;
        int R[2], C[2]; stage_rc(tid * 16, R[0], C[0]); stage_rc(tid * 16 + 8192, R[1], C[1]);
        const int e = __builtin_amdgcn_readfirstlane(__popcll(__ballot(lane < NE && tab[lane] <= g)) - 1);
        u.e = e; u.ti = g - __builtin_amdgcn_readfirstlane(tab[e]); u.ce = __builtin_amdgcn_readfirstlane(tab[64 + e]);
        u.B = Bbase + (size_t)e * Bstride + (size_t)u.pn * 256 * K * 2;
        if (gather) {
            const int* le = list + (size_t)e * T; const int b = u.ti * 256, mx = u.ce - 1;
            const int t00 = le[min(b + R[0], mx)], t01 = le[min(b + R[1], mx)], t10 = le[min(b + 128 + R[0], mx)], t11 = le[min(b + 128 + R[1], mx)];
            u.a00 = (unsigned)(t00 * K + C[0]) * 2u; u.a01 = (unsigned)(t01 * K + C[1]) * 2u; u.a10 = (unsigned)(t10 * K + C[0]) * 2u; u.a11 = (unsigned)(t11 * K + C[1]) * 2u;
        } else {
            u.a00 = (unsigned)((g * 256 + R[0]) * K + C[0]) * 2u; u.a01 = (unsigned)((g * 256 + R[1]) * K + C[1]) * 2u;
            u.a10 = (unsigned)((g * 256 + 128 + R[0]) * K + C[0]) * 2u; u.a11 = (unsigned)((g * 256 + 128 + R[1]) * K + C[1]) * 2u;
        }
        return true;
    }
};

template <class Epi, class Sched>
__device__ __forceinline__ void gemm_phase(LAS unsigned char* lds, const void* Abase_, int K, const Sched& S, const Epi& E) {
    const int tid = opaque_tid(), wid = __builtin_amdgcn_readfirstlane(tid >> 6), lane = tid & 63, wr = wid >> 2, wc = wid & 3, fr = lane & 15, fq = lane >> 4;
    int nt = K / BK; asm volatile("" : "+s"(nt)); const char* Abase = (const char*)Abase_;
    unsigned voffB[2];
#pragma unroll
    for (int i = 0; i < 2; ++i) { int R, C; stage_rc(tid * 16 + i * 8192, R, C); voffB[i] = (unsigned)(R * K + C) * 2u; }
    const size_t kstep = (size_t)(BK * 2), hstep = (size_t)HALF * K * 2;
    const unsigned ldsw = (unsigned)wid * 1024u;
    const int aoff = lds_byte(wr * 64 + fr, fq * 8), boff = lds_byte(wc * 32 + fr, fq * 8);
#define G8_SA(b, h) (((b) * 2 + (h)) * HTB)
#define G8_SB(b, h) ((4 + (b) * 2 + (h)) * HTB)
#define G8_STAGE(bufoff, gbase, voff) do { const char* _g = uni((const char*)(gbase)); _Pragma("unroll") for (int _i = 0; _i < 2; ++_i) \
        __builtin_amdgcn_global_load_lds((const unsigned*)(_g + (voff)[_i]), (LAS unsigned*)(lds + (bufoff) + ldsw + _i * 8192), 16, 0, 0); } while (0)
#define G8_STAGE_A(bufoff, gbase, o0, o1) do { const char* _g = uni((const char*)(gbase)); \
        __builtin_amdgcn_global_load_lds((const unsigned*)(_g + (o0)), (LAS unsigned*)(lds + (bufoff) + ldsw), 16, 0, 0); \
        __builtin_amdgcn_global_load_lds((const unsigned*)(_g + (o1)), (LAS unsigned*)(lds + (bufoff) + ldsw + 8192), 16, 0, 0); } while (0)
#define G8_LDA(dst, b, h) do { _Pragma("unroll") for (int m = 0; m < 4; ++m) dst[m] = cat8(*(const LAS i32x4v*)(lds + G8_SA(b, h) + aoff + m * 2048), *(const LAS i32x4v*)(lds + G8_SA(b, h) + aoff + m * 2048 + 1024)); } while (0)
#define G8_LDB(dst, b, h) do { _Pragma("unroll") for (int n = 0; n < 2; ++n) dst[n] = cat8(*(const LAS i32x4v*)(lds + G8_SB(b, h) + boff + n * 2048), *(const LAS i32x4v*)(lds + G8_SB(b, h) + boff + n * 2048 + 1024)); } while (0)
#define G8_MMA(ai, bj, At, Bt) do { __builtin_amdgcn_s_setprio(1); _Pragma("unroll") for (int m = 0; m < 4; ++m) _Pragma("unroll") for (int n = 0; n < 2; ++n) { \
        if constexpr (Epi::FP8) acc[ai][bj][m][n] = __builtin_amdgcn_mfma_scale_f32_16x16x128_f8f6f4(Bt[n], At[m], acc[ai][bj][m][n], 0, 0, 0, 0x7F7F7F7F, 0, 0x7F7F7F7F); \
        else { acc[ai][bj][m][n] = __builtin_amdgcn_mfma_f32_16x16x32_bf16(lo8(Bt[n]), lo8(At[m]), acc[ai][bj][m][n], 0, 0, 0); \
               acc[ai][bj][m][n] = __builtin_amdgcn_mfma_f32_16x16x32_bf16(hi8(Bt[n]), hi8(At[m]), acc[ai][bj][m][n], 0, 0, 0); } } __builtin_amdgcn_s_setprio(0); } while (0)
#define G8_WAIT_V(n) asm volatile("s_waitcnt vmcnt(" #n ")" ::: "memory")
#define G8_WAIT_L(n) asm volatile("s_waitcnt lgkmcnt(" #n ")" ::: "memory")
#define G8_BAR __builtin_amdgcn_s_barrier()
#define G8_SCHED __builtin_amdgcn_sched_barrier(0)
    Unit cur, nxt; int ui = 0;
    if (!S.next(0, cur)) return;
    constexpr int FACL = 131072;
#define G8_FAC(u_, par_) __builtin_amdgcn_global_load_lds((const unsigned*)(E.fab + (size_t)(u_).pm * 512 + tid), (LAS unsigned*)(lds + FACL + (par_) * 2048 + wid * 256), 4, 0, 0)
    if constexpr (Epi::RESCALE) G8_FAC(cur, 0);
    f32x4 acc[2][2][4][2];
#pragma unroll
    for (int a = 0; a < 2; ++a)
#pragma unroll
        for (int b = 0; b < 2; ++b)
#pragma unroll
            for (int m = 0; m < 4; ++m)
#pragma unroll
                for (int n = 0; n < 2; ++n) acc[a][b][m][n] = (f32x4){0.f, 0.f, 0.f, 0.f};
    i32x8 At[4], B0[2], B1[2];
    unsigned a00 = cur.a00, a01 = cur.a01, a10 = cur.a10, a11 = cur.a11;
    G8_STAGE(G8_SB(0, 0), cur.B, voffB); G8_STAGE(G8_SB(0, 1), cur.B + hstep, voffB); G8_STAGE_A(G8_SA(0, 0), Abase, a00, a01); G8_STAGE_A(G8_SA(0, 1), Abase, a10, a11);
    if (wr == 1) G8_BAR;
    G8_WAIT_V(2); G8_BAR;
    G8_STAGE(G8_SB(1, 0), cur.B + kstep, voffB); G8_STAGE_A(G8_SA(1, 0), Abase + kstep, a00, a01); G8_STAGE(G8_SB(1, 1), cur.B + hstep + kstep, voffB);
    G8_WAIT_V(6); G8_BAR;
    for (;;) {
        bool has_next = false; const char* curB = cur.B; const char* nB = curB;
        for (int t = 0; t < nt; t += 2) {
            const bool last = (t == nt - 2);
            if (t == nt - 4) { has_next = S.next(ui + 1, nxt); if (has_next) nB = nxt.B;
                if constexpr (Epi::RESCALE) { if (has_next) G8_FAC(nxt, (ui + 1) & 1); } }
            if constexpr (Epi::RESCALE) {
                if (t == 6 || t == 12) { const LAS float* fl = (const LAS float*)(lds + FACL + (ui & 1) * 2048) + (t == 12 ? 1 : 0);
#pragma unroll
                    for (int ai = 0; ai < 2; ++ai)
#pragma unroll
                        for (int m = 0; m < 4; ++m) { const float f = fl[(ai * HALF + wr * 64 + m * 16 + fr) * 2];
#pragma unroll
                            for (int bj = 0; bj < 2; ++bj)
#pragma unroll
                                for (int n = 0; n < 2; ++n) acc[ai][bj][m][n] = acc[ai][bj][m][n] * f; } } }
            const char* a1 = Abase + (size_t)(t + 1) * kstep;
            const char* a2 = last ? Abase : Abase + (size_t)(t + 2) * kstep; const char* b2 = last ? nB : curB + (size_t)(t + 2) * kstep;
            const char* a3 = a2 + kstep; const char* b3 = b2 + kstep;
            G8_LDB(B0, 0, 0); G8_LDB(B1, 0, 1); G8_SCHED; G8_LDA(At, 0, 0); G8_STAGE_A(G8_SA(1, 1), a1, a10, a11);
            if (last && has_next) { a00 = nxt.a00; a01 = nxt.a01; a10 = nxt.a10; a11 = nxt.a11; }
            G8_WAIT_V(8); G8_WAIT_L(0); G8_BAR; G8_MMA(0, 0, At, B0); G8_MMA(0, 1, At, B1); G8_BAR; G8_SCHED;
            G8_LDA(At, 0, 1); G8_STAGE(G8_SB(0, 0), b2, voffB); G8_STAGE(G8_SB(0, 1), b2 + hstep, voffB); G8_STAGE_A(G8_SA(0, 0), a2, a00, a01);
            G8_WAIT_V(8); G8_WAIT_L(0); G8_BAR; G8_MMA(1, 0, At, B0); G8_MMA(1, 1, At, B1); G8_BAR; G8_SCHED;
            G8_LDB(B0, 1, 0); G8_LDB(B1, 1, 1); G8_SCHED; G8_LDA(At, 1, 0); G8_STAGE_A(G8_SA(0, 1), a2, a10, a11);
            G8_WAIT_V(8); G8_WAIT_L(0); G8_BAR; G8_MMA(0, 0, At, B0); G8_MMA(0, 1, At, B1); G8_BAR; G8_SCHED;
            G8_LDA(At, 1, 1); G8_STAGE(G8_SB(1, 0), b3, voffB); G8_STAGE(G8_SB(1, 1), b3 + hstep, voffB); G8_STAGE_A(G8_SA(1, 0), a3, a00, a01);
            G8_WAIT_V(8); G8_WAIT_L(0); G8_BAR; G8_MMA(1, 0, At, B0); G8_MMA(1, 1, At, B1); G8_BAR; G8_SCHED;
        }
        if (wr == 0) G8_BAR;
        if constexpr (!Epi::AFTER_DRAIN) E(acc, cur, wr, wc, fr, fq);
        if (!has_next) break;
#pragma unroll
        for (int a = 0; a < 2; ++a)
#pragma unroll
            for (int b = 0; b < 2; ++b)
#pragma unroll
                for (int m = 0; m < 4; ++m)
#pragma unroll
                    for (int n = 0; n < 2; ++n) acc[a][b][m][n] = (f32x4){0.f, 0.f, 0.f, 0.f};
        cur = nxt; ++ui;
        if (wr == 1) G8_BAR;
    }
    G8_WAIT_V(0);
    G8_BAR;
    if constexpr (Epi::AFTER_DRAIN) E.fused(acc, cur, wr, wc, fr, fq, lds);
#undef G8_FAC
#undef G8_SA
#undef G8_SB
#undef G8_STAGE
#undef G8_STAGE_A
#undef G8_LDA
#undef G8_LDB
#undef G8_MMA
#undef G8_WAIT_V
#undef G8_WAIT_L
#undef G8_BAR
#undef G8_SCHED
}

template <bool F8>
struct EpiQKVT {
    static constexpr bool AFTER_DRAIN = false, FP8 = F8, RESCALE = false;
    const float* rs; const float* qk_gain_l; bf16_t* base; int mode;
    __device__ __forceinline__ void operator()(const f32x4 (&acc)[2][2][4][2], const Unit& u, int wr, int wc, int fr_, int fq_) const {
        int fr = fr_, fq = fq_; asm volatile("" : "+v"(fr), "+v"(fq));
        int gi; bool isq; bf16_t* dst; const float* g;
        if (mode == 0) { const int H = 4 * u.pn + wc; slice_kind(H, gi, isq); dst = base + (size_t)H * T * HD; g = qk_gain_l + (gi < 0 ? 0 : gi) * HD; }
        else { const int lyr = u.pn >> 1, Hp = 4 * (u.pn & 1) + wc; gi = Hp < 4 ? 5 : -1; isq = false; dst = base + ((size_t)lyr * 8 + Hp) * TM * HD; g = qk_gain_l + (lyr * 6 + 5) * HD; }
        const float post = isq ? ATTN_SCALE * LOG2E : 1.0f;
        f32x4 gv[2][2];
#pragma unroll
        for (int bj = 0; bj < 2; ++bj)
#pragma unroll
            for (int n = 0; n < 2; ++n) gv[bj][n] = *(const f32x4*)(g + 32 * bj + 8 * fq + 4 * n) * post;
        float rs8[2][4];
#pragma unroll
        for (int ai = 0; ai < 2; ++ai)
#pragma unroll
            for (int m = 0; m < 4; ++m) rs8[ai][m] = rs[u.pm * 256 + ai * HALF + wr * 64 + m * 16 + fr];
#pragma unroll
        for (int ai = 0; ai < 2; ++ai)
#pragma unroll
            for (int m = 0; m < 4; ++m) {
                const int row = u.pm * 256 + ai * HALF + wr * 64 + m * 16 + fr; const float rsv = rs8[ai][m] * (F8 ? 1.0f / 512.0f : 1.0f);
                f32x4 v[2][2]; float ss = 0.f;
#pragma unroll
                for (int bj = 0; bj < 2; ++bj)
#pragma unroll
                    for (int n = 0; n < 2; ++n) { v[bj][n] = acc[ai][bj][m][n] * rsv; ss += (v[bj][n][0] * v[bj][n][0] + v[bj][n][1] * v[bj][n][1]) + (v[bj][n][2] * v[bj][n][2] + v[bj][n][3] * v[bj][n][3]); }
                if (gi >= 0) {
                    ss += __shfl_xor(ss, 16); ss += __shfl_xor(ss, 32);
                    const float r = __builtin_amdgcn_rsqf(ss * (1.f / 64.f) + EPS);
#pragma unroll
                    for (int bj = 0; bj < 2; ++bj)
#pragma unroll
                        for (int n = 0; n < 2; ++n) v[bj][n] = v[bj][n] * r * gv[bj][n];
                }
#pragma unroll
                for (int bj = 0; bj < 2; ++bj) { u32x4 w; w.x = cvt_pk_bf16(v[bj][0][0], v[bj][0][1]); w.y = cvt_pk_bf16(v[bj][0][2], v[bj][0][3]); w.z = cvt_pk_bf16(v[bj][1][0], v[bj][1][1]); w.w = cvt_pk_bf16(v[bj][1][2], v[bj][1][3]);
                    *(u32x4*)(dst + (size_t)row * HD + 32 * bj + 8 * fq) = w; }
            }
    }
};
struct EpiOut {
    static constexpr bool AFTER_DRAIN = false, FP8 = false, RESCALE = true;
    bf16_t* xb; float* ssq; unsigned char* x8; const float* fab; const float* rm;
    __device__ __forceinline__ void operator()(const f32x4 (&acc)[2][2][4][2], const Unit& u, int wr, int wc, int fr_, int fq_) const {
        int fr = fr_, fq = fq_; asm volatile("" : "+v"(fr), "+v"(fq));
        const int col0 = u.pn * 256 + wc * 32 + 8 * fq;
#pragma unroll
        for (int ai = 0; ai < 2; ++ai) {
        float fm8[2][4]; u32x4 xi8[2][4][2];
#pragma unroll
            for (int m = 0; m < 4; ++m) { const int row = u.pm * 256 + ai * HALF + wr * 64 + m * 16 + fr; fm8[ai][m] = rm[row];
#pragma unroll
                for (int bj = 0; bj < 2; ++bj) xi8[ai][m][bj] = *(const u32x4*)(xb + (size_t)row * D + col0 + bj * HALF); }
#pragma unroll
            for (int m = 0; m < 4; ++m) {
                const int row = u.pm * 256 + ai * HALF + wr * 64 + m * 16 + fr; bf16_t* p = xb + (size_t)row * D + col0; float s = 0.f; const float fm = fm8[ai][m];
                u32x4 xi[2];
#pragma unroll
                for (int bj = 0; bj < 2; ++bj) xi[bj] = xi8[ai][m][bj];
#pragma unroll
                for (int bj = 0; bj < 2; ++bj) { const f32x4 a = acc[ai][bj][m][0] * fm, b = acc[ai][bj][m][1] * fm; const u32x4 x = xi[bj];
                    u32x4 w; w.x = cvt_pk_bf16(bf2f(x.x & 0xffffu) + a[0], bf2f(x.x >> 16) + a[1]); w.y = cvt_pk_bf16(bf2f(x.y & 0xffffu) + a[2], bf2f(x.y >> 16) + a[3]);
                    w.z = cvt_pk_bf16(bf2f(x.z & 0xffffu) + b[0], bf2f(x.z >> 16) + b[1]); w.w = cvt_pk_bf16(bf2f(x.w & 0xffffu) + b[2], bf2f(x.w >> 16) + b[3]);
                    *(u32x4*)(p + bj * HALF) = w;
                    const float o0 = bf2f(w.x & 0xffffu), o1 = bf2f(w.x >> 16), o2 = bf2f(w.y & 0xffffu), o3 = bf2f(w.y >> 16), o4 = bf2f(w.z & 0xffffu), o5 = bf2f(w.z >> 16), o6 = bf2f(w.w & 0xffffu), o7 = bf2f(w.w >> 16);
                    s += ((o0 * o0 + o1 * o1) + (o2 * o2 + o3 * o3)) + ((o4 * o4 + o5 * o5) + (o6 * o6 + o7 * o7));
                    int q0 = 0, q1 = 0; q0 = __builtin_amdgcn_cvt_pk_fp8_f32(clamp8(16.f * o0), clamp8(16.f * o1), q0, false); q0 = __builtin_amdgcn_cvt_pk_fp8_f32(clamp8(16.f * o2), clamp8(16.f * o3), q0, true);
                    q1 = __builtin_amdgcn_cvt_pk_fp8_f32(clamp8(16.f * o4), clamp8(16.f * o5), q1, false); q1 = __builtin_amdgcn_cvt_pk_fp8_f32(clamp8(16.f * o6), clamp8(16.f * o7), q1, true);
                    u32x2 q; q.x = (unsigned)q0; q.y = (unsigned)q1;
                    *(u32x2*)(x8 + (size_t)row * D + col0 + bj * HALF) = q; }
                s += __shfl_xor(s, 16); s += __shfl_xor(s, 32);
                if (fq == 0) ssq[row * 16 + u.pn * 4 + wc] = s;
            }
        }
    }
};
struct EpiSwiGLU {
    static constexpr bool AFTER_DRAIN = false, FP8 = true, RESCALE = false;
    const float* rsl; unsigned char* hid;
    __device__ __forceinline__ void operator()(const f32x4 (&acc)[2][2][4][2], const Unit& u, int wr, int wc, int fr_, int fq_) const {
        int fr = fr_, fq = fq_; asm volatile("" : "+v"(fr), "+v"(fq));
        float rs8[2][4];
#pragma unroll
        for (int ai = 0; ai < 2; ++ai)
#pragma unroll
            for (int m = 0; m < 4; ++m) rs8[ai][m] = rsl[(size_t)u.e * T + min(u.ti * 256 + ai * HALF + wr * 64 + m * 16 + fr, u.ce - 1)];
#pragma unroll
        for (int ai = 0; ai < 2; ++ai)
#pragma unroll
            for (int m = 0; m < 4; ++m) {
                const int lr = ai * HALF + wr * 64 + m * 16 + fr; const float rsv = (1.0f / 512.0f) * rs8[ai][m];
                f32x4 h[2];
#pragma unroll
                for (int n = 0; n < 2; ++n) { const f32x4 gt = acc[ai][0][m][n] * rsv, up = acc[ai][1][m][n] * rsv;
#pragma unroll
                    for (int j = 0; j < 4; ++j) h[n][j] = gt[j] * up[j] * __builtin_amdgcn_rcpf(1.0f + __builtin_amdgcn_exp2f(-gt[j] * LOG2E)); }
#pragma unroll
                for (int n = 0; n < 2; ++n)
#pragma unroll
                    for (int j = 0; j < 4; ++j) h[n][j] = fminf(fmaxf(h[n][j] * 8.0f, -440.f), 440.f);
                int w0 = 0, w1 = 0;
                w0 = __builtin_amdgcn_cvt_pk_fp8_f32(h[0][0], h[0][1], w0, false); w0 = __builtin_amdgcn_cvt_pk_fp8_f32(h[0][2], h[0][3], w0, true);
                w1 = __builtin_amdgcn_cvt_pk_fp8_f32(h[1][0], h[1][1], w1, false); w1 = __builtin_amdgcn_cvt_pk_fp8_f32(h[1][2], h[1][3], w1, true);
                u32x2 w; w.x = (unsigned)w0; w.y = (unsigned)w1;
                *(u32x2*)(hid + (size_t)(u.pm * 256 + lr) * DE + u.pn * 128 + wc * 32 + 8 * fq) = w;
            }
    }
};
struct EpiDown {
    static constexpr bool AFTER_DRAIN = false, NB1 = false, FP8 = true, RESCALE = false;
    const float* wl; unsigned char* Y;
    __device__ __forceinline__ void operator()(const f32x4 (&acc)[2][2][4][2], const Unit& u, int wr, int wc, int fr_, int fq_) const {
        int fr = fr_, fq = fq_; asm volatile("" : "+v"(fr), "+v"(fq));
        float wl8[2][4];
#pragma unroll
        for (int ai = 0; ai < 2; ++ai)
#pragma unroll
            for (int m = 0; m < 4; ++m) wl8[ai][m] = wl[(size_t)u.e * T + min(u.ti * 256 + ai * HALF + wr * 64 + m * 16 + fr, u.ce - 1)];
#pragma unroll
        for (int ai = 0; ai < 2; ++ai)
#pragma unroll
            for (int m = 0; m < 4; ++m) {
                const int lr = ai * HALF + wr * 64 + m * 16 + fr; const float w8 = (8.0f / 256.0f) * wl8[ai][m];
#pragma unroll
                for (int bj = 0; bj < 2; ++bj) { f32x4 a = acc[ai][bj][m][0] * w8, b = acc[ai][bj][m][1] * w8;
#pragma unroll
                    for (int j = 0; j < 4; ++j) { a[j] = fminf(fmaxf(a[j], -400.f), 400.f); b[j] = fminf(fmaxf(b[j], -400.f), 400.f); }
                    int w0 = 0, w1 = 0;
                    w0 = __builtin_amdgcn_cvt_pk_fp8_f32(a[0], a[1], w0, false); w0 = __builtin_amdgcn_cvt_pk_fp8_f32(a[2], a[3], w0, true);
                    w1 = __builtin_amdgcn_cvt_pk_fp8_f32(b[0], b[1], w1, false); w1 = __builtin_amdgcn_cvt_pk_fp8_f32(b[2], b[3], w1, true);
                    u32x2 w; w.x = (unsigned)w0; w.y = (unsigned)w1;
                    *(u32x2*)(Y + (size_t)(u.pm * 256 + lr) * D + u.pn * 256 + bj * HALF + wc * 32 + 8 * fq) = w; }
            }
    }
};
struct EpiRouter {
    static constexpr bool AFTER_DRAIN = true, FP8 = false, RESCALE = false;
    const float* ssq1; float* rs1; const float* b_group; const float* b_router; unsigned* cnt; int* list; float* wl; float* rsl; int* route;
    __device__ __forceinline__ void fused(const f32x4 (&acc)[2][2][4][2], const Unit& u, int wr, int wc, int fr_, int fq_, LAS unsigned char* lds) const {
        int fr = fr_, fq = fq_; asm volatile("" : "+v"(fr), "+v"(fq));
        LAS float* lg = (LAS float*)lds;
        LAS int* hist = (LAS int*)(lds + 256 * 65 * 4);
        const int tid = opaque_tid();
        if (tid < 64) hist[tid] = 0;
        if (wc < 2) {
#pragma unroll
            for (int ai = 0; ai < 2; ++ai)
#pragma unroll
                for (int m = 0; m < 4; ++m) { const int row = ai * HALF + wr * 64 + m * 16 + fr;
#pragma unroll
                    for (int n = 0; n < 2; ++n)
#pragma unroll
                        for (int j = 0; j < 4; ++j) lg[row * 65 + 32 * wc + 16 * n + 4 * fq + j] = acc[ai][0][m][n][j]; }
        }
        __syncthreads();
        int ex0 = 0, ex1 = 0, lp0 = 0, lp1 = 0; float w0 = 0.f, w1 = 0.f, rsv = 0.f; const int t = u.pm * 256 + tid;
        if (tid < 256) {
            const f32x4* sq = (const f32x4*)(ssq1 + (size_t)t * 16); const f32x4 a = sq[0], b = sq[1], c = sq[2], d = sq[3];
            const float ss = ((a[0] + a[1]) + (a[2] + a[3])) + ((b[0] + b[1]) + (b[2] + b[3])) + ((c[0] + c[1]) + (c[2] + c[3])) + ((d[0] + d[1]) + (d[2] + d[3]));
            rsv = 1.0f / sqrtf(ss * (1.f / D) + EPS); rs1[t] = rsv;
            const LAS float* my = lg + tid * 65;
            float g[4];
#pragma unroll
            for (int i = 0; i < 4; ++i) g[i] = my[i] * rsv + b_group[i];
            int gi = 0; float gm = g[0];
#pragma unroll
            for (int i = 1; i < 4; ++i) if (g[i] > gm) { gm = g[i]; gi = i; }
            float den = 0.f;
#pragma unroll
            for (int i = 0; i < 4; ++i) den += expf(g[i] - gm);
            const float gtop = 1.0f / den;
            float ev[8];
#pragma unroll
            for (int i = 0; i < 8; ++i) ev[i] = my[4 + gi * 8 + i] * rsv + b_router[gi * 8 + i];
            int i0 = 0; float v0 = ev[0];
#pragma unroll
            for (int i = 1; i < 8; ++i) if (ev[i] > v0) { v0 = ev[i]; i0 = i; }
            int i1 = -1; float v1 = -INFINITY;
#pragma unroll
            for (int i = 0; i < 8; ++i) if (i != i0 && ev[i] > v1) { v1 = ev[i]; i1 = i; }
            const float e1 = expf(v1 - v0); w0 = gtop / (1.f + e1); w1 = gtop * e1 / (1.f + e1);
            ex0 = gi * 8 + i0; ex1 = gi * 8 + i1;
            lp0 = __hip_atomic_fetch_add(hist + ex0, 1, __ATOMIC_RELAXED, __HIP_MEMORY_SCOPE_WORKGROUP);
            lp1 = __hip_atomic_fetch_add(hist + ex1, 1, __ATOMIC_RELAXED, __HIP_MEMORY_SCOPE_WORKGROUP);
        }
        __syncthreads();
        if (tid < NE) { const int c = hist[tid]; hist[32 + tid] = c ? (int)__hip_atomic_fetch_add(cnt + tid * 64, (unsigned)c, RLX_AGENT) : 0; }
        __syncthreads();
        if (tid < 256) {
            const int p0 = hist[32 + ex0] + lp0, p1 = hist[32 + ex1] + lp1;
            list[(size_t)ex0 * T + p0] = t; wl[(size_t)ex0 * T + p0] = w0; rsl[(size_t)ex0 * T + p0] = rsv;
            list[(size_t)ex1 * T + p1] = t; wl[(size_t)ex1 * T + p1] = w1; rsl[(size_t)ex1 * T + p1] = rsv;
            *(int4*)(route + (size_t)t * 4) = make_int4(ex0, p0, ex1, p1);
        }
    }
};
}

__device__ __forceinline__ void phase_memkv_fast(Frame& F) {
    PHASE_IDS(F);
    g8::DenseSched S; S.init(TM, 1024, D, F.G, (int)blockIdx.x, F.tid, F.ws + WS_WMEM);
    g8::EpiQKVT<false> E{(const float*)(F.ws + WS_RSM), in_ptr(4), (bf16_t*)(F.ws + WS_MEMKV), 1};
    g8::gemm_phase(F.lds, F.ws + WS_MB, D, S, E);
}
__device__ __forceinline__ void phase_inproj_fast(Frame& F, int l) {
    PHASE_IDS(F);
    if (l == 0) {
        g8::DenseSched S; S.init(T, INW, D, F.G, (int)blockIdx.x, F.tid, F.ws + WS_WIN);
        g8::EpiQKVT<false> E{(const float*)(F.ws + WS_RS), in_ptr(4), (bf16_t*)(F.ws + WS_QKV), 0};
        g8::gemm_phase(F.lds, F.ws + WS_XB, D, S, E);
    } else {
        g8::DenseSched S; S.init(T, INW, D / 2, F.G, (int)blockIdx.x, F.tid, F.ws + WS_WIN + (size_t)INW * D * 2);
        g8::EpiQKVT<true> E{(const float*)(F.ws + WS_RS), in_ptr(4) + l * 6 * HD, (bf16_t*)(F.ws + WS_QKV), 0};
        g8::gemm_phase(F.lds, F.ws + WS_X8, D / 2, S, E);
    }
}
__device__ __forceinline__ void phase_outproj_fast(Frame& F, int l) {
    PHASE_IDS(F);
    g8::DenseSched S; S.init(T, D, D, F.G, (int)blockIdx.x, F.tid, F.ws + WS_WOUT + (size_t)l * D * D * 2);
    g8::EpiOut E{(bf16_t*)(F.ws + WS_XB), (float*)(F.ws + WS_SSQ1), (unsigned char*)(F.ws + WS_X8), (const float*)(F.ws + WS_FAB), (const float*)(F.ws + WS_RM)};
    g8::gemm_phase(F.lds, F.ws + WS_MIX, D, S, E);
}
__device__ __forceinline__ void phase_router_fast(Frame& F, int l) {
    PHASE_IDS(F);
    g8::DenseSched S; S.init(T, 256, D, F.G, (int)blockIdx.x, F.tid, F.ws + WS_WR + (size_t)l * 256 * D * 2);
    g8::EpiRouter E{(const float*)(F.ws + WS_SSQ1), (float*)(F.ws + WS_RS) + T, in_ptr(12) + l * NGRP, in_ptr(14) + l * NE, F.ctl + CW_CNT + l * NE * 64,
                    (int*)(F.ws + WS_LIST), (float*)(F.ws + WS_WL), (float*)(F.ws + WS_RSL), (int*)(F.ws + WS_ROUTE)};
    g8::gemm_phase(F.lds, F.ws + WS_XB, D, S, E);
}
__device__ __forceinline__ void phase_moe1_fast(Frame& F, int l) {
    PHASE_IDS(F);
    g8::GroupSched S; S.init((LAS int*)(F.lds + CTRL_BASE), F.ctl + CW_CNT + l * NE * 64, 4, D / 2, F.G, (int)blockIdx.x, F.ws + WS_WGU + (size_t)l * NE * 1024 * D, (size_t)1024 * D, (const int*)(F.ws + WS_LIST), true);
    g8::EpiSwiGLU E{(const float*)(F.ws + WS_RSL), (unsigned char*)(F.ws + WS_MIX)};
    g8::gemm_phase(F.lds, F.ws + WS_X8, D / 2, S, E);
}
__device__ __forceinline__ void phase_moe2_fast(Frame& F, int l) {
    PHASE_IDS(F);
    g8::GroupSched S; S.init((LAS int*)(F.lds + CTRL_BASE), F.ctl + CW_CNT + l * NE * 64, 4, DE / 2, F.G, (int)blockIdx.x, F.ws + WS_WD + (size_t)l * NE * D * DE, (size_t)D * DE, (const int*)(F.ws + WS_LIST), false);
    g8::EpiDown E{(const float*)(F.ws + WS_WL), (unsigned char*)(F.ws + WS_QKV)};
    g8::gemm_phase(F.lds, F.ws + WS_MIX, DE / 2, S, E);
}

namespace at {
typedef short bf16x8 __attribute__((ext_vector_type(8)));
typedef short s16x4 __attribute__((ext_vector_type(4)));
typedef short v4i16_t __attribute__((ext_vector_type(4)));
typedef float f32x16 __attribute__((ext_vector_type(16)));
typedef const LAS char* lds_cptr;
constexpr int NSLOT = 3, NPRE = NSLOT - 1, SLOTB = 8192, LDS_K = 0, LDS_V = NSLOT * SLOTB, TB_CS = 576, TB_ROW = 4 * TB_CS, LDS_TBB = 2 * NSLOT * SLOTB, LDS_TBM = LDS_TBB + 16 * TB_ROW, LDS_WS = LDS_TBM + TB_ROW, LDS_QW = LDS_WS + 2048;
static_assert(LDS_QW + 64 <= 131072, "attention LDS map");
constexpr float NEGBIG = -1.0e30f;
__device__ __forceinline__ int crow(int r, int hi) { return (r & 3) + 8 * (r >> 2) + 4 * hi; }
__device__ __forceinline__ void glds16(const void* gsrc, unsigned lds_dst) { unsigned keep;
    asm volatile("s_mov_b32 %0, m0\n\ts_mov_b32 m0, %2\n\ts_nop 0\n\tglobal_load_lds_dwordx4 %1, off\n\ts_mov_b32 m0, %0" : "=&s"(keep) : "v"(gsrc), "s"(lds_dst) : "memory"); }
typedef float f32x2_t __attribute__((ext_vector_type(2))); typedef __bf16 bf16x2_t __attribute__((ext_vector_type(2)));
__device__ __forceinline__ unsigned cvtpk(float lo, float hi) { f32x2_t v = {lo, hi}; bf16x2_t b = __builtin_convertvector(v, bf16x2_t); return __builtin_bit_cast(unsigned, b); }
__device__ __forceinline__ s16x4 vtr(lds_cptr p) { return __builtin_bit_cast(s16x4, __builtin_amdgcn_ds_read_tr16_b64_v4i16((LAS v4i16_t*)p)); }
#define AT_WAIT_BAR(N) asm volatile("s_waitcnt vmcnt(" #N ") lgkmcnt(0)\n\ts_barrier" ::: "memory")

__device__ __forceinline__ void at_dequeue(unsigned* qcnt, int nper, int xq, int pre, int& id_out, int& x_out) {
    int id = pre, x = xq;
    if (id == -2) id = (int)__hip_atomic_fetch_add(qcnt + xq * 64, 1u, RLX_AGENT);
    if (id >= nper) {
        id = -1;
        for (int tries = 0; tries < 8 && id < 0; ++tries) {
            unsigned hv[8];
#pragma unroll
            for (int k = 0; k < 8; ++k) hv[k] = __hip_atomic_load(qcnt + ((xq + k) & 7) * 64, RLX_AGENT);
            int pick = -1;
#pragma unroll
            for (int k = 7; k >= 0; --k) if ((int)hv[k] < nper) pick = k;
            if (pick < 0) break;
            x = (xq + pick) & 7; id = (int)__hip_atomic_fetch_add(qcnt + x * 64, 1u, RLX_AGENT); if (id >= nper) id = -1;
        }
    }
    id_out = id; x_out = x;
}
struct UnitDesc { const bf16_t* Q; const bf16_t* K; const bf16_t* V; int t0, hh16, qb, h, kt0, nt; };

template <int TYPE>
__device__ __forceinline__ void attn_unit(LAS unsigned char* lds, const UnitDesc& u, bf16_t* mixed, float* ssq) {
    const int tid = opaque_tid0(), lane = tid & 63, r32 = lane & 31, hi = lane >> 5; const int wid = __builtin_amdgcn_readfirstlane(tid >> 6);
    const unsigned lds0 = (unsigned)(size_t)lds;
    lds_cptr shm3 = (lds_cptr)lds;
    const int prow = 8 * wid + (lane >> 3);
    const bf16_t* ksrc = u.K + (size_t)(u.kt0 * 64 + prow) * HD + (((lane & 7) ^ ((4 * wid + (lane >> 4)) & 7)) * 8);
    const bf16_t* vsrc = u.V + (size_t)(u.kt0 * 64 + prow) * HD + ((((lane & 7) >> 1) ^ (prow & 2)) * 16) + (lane & 1) * 8;
    const unsigned kdst = lds0 + LDS_K + wid * 1024, vdst = lds0 + LDS_V + wid * 1024;
#define AT_DMA_K(t, slot) glds16(ksrc + (size_t)(t) * 64 * HD, (unsigned)__builtin_amdgcn_readfirstlane(kdst + (slot)))
#define AT_DMA_V(t, slot) glds16(vsrc + (size_t)(t) * 64 * HD, (unsigned)__builtin_amdgcn_readfirstlane(vdst + (slot)))
    lds_cptr ka[4], va[2];
    { const int sw = (r32 >> 1) & 7;
#pragma unroll
      for (int d0 = 0; d0 < 4; ++d0) ka[d0] = shm3 + LDS_K + r32 * 128 + (((2 * d0 + hi) ^ sw) * 16);
      const int q = (lane & 15) >> 2, gb = (lane >> 4) & 1;
#pragma unroll
      for (int d0 = 0; d0 < 2; ++d0) va[d0] = shm3 + LDS_V + (4 * hi + q) * 128 + ((2 * (d0 ^ (q >> 1)) + gb) * 32) + (lane & 3) * 8; }
    const int nt = u.nt;
    const bf16_t* Qw = u.Q + (size_t)(u.qb * 256 + wid * 32 + r32) * HD;
    bf16x8 qr[4];
#pragma unroll
    for (int d0 = 0; d0 < 4; ++d0) qr[d0] = *(const bf16x8*)(Qw + d0 * 16 + hi * 8);
#pragma unroll
    for (int j = 0; j < NPRE; ++j) if (j < nt) { AT_DMA_K(j, j * SLOTB); AT_DMA_V(j, j * SLOTB); }
    lds_cptr tb = shm3; int r0w = 0, qrw = 0;
    lds_cptr tbm = shm3;
    if (TYPE == 1) { const int qc = 32 * (wid & 1) + r32, c0 = min(max(qc - 8, 0), 48); qrw = 4 * u.qb + (wid >> 1); r0w = min(max(qrw - 4, 0), 24);
        const int ib = 4 * hi - qc + 63, cb = (-ib) & 3, im = 4 * hi - c0 + 63, cm = (-im) & 3;
        tb = shm3 + LDS_TBB + cb * TB_CS + (ib + cb) * 4; tbm = shm3 + LDS_TBM + cm * TB_CS + (im + cm) * 4; }
    float lsum = 0.f; f32x16 o[2]; o[0] = f32x16{}; o[1] = f32x16{};
    int sl_cur = 0, sl_n2 = NPRE * SLOTB;
    for (int i = 0; i < nt; ++i) {
        { const int rem = nt - 1 - i, yo = rem < NPRE - 1 ? rem : NPRE - 1; if (yo >= 3) AT_WAIT_BAR(6); else if (yo == 2) AT_WAIT_BAR(4); else if (yo == 1) AT_WAIT_BAR(2); else AT_WAIT_BAR(0); }
        static_assert(NPRE <= 4, "wait ladder");
        if (i + NPRE < nt) { AT_DMA_K(i + NPRE, sl_n2); AT_DMA_V(i + NPRE, sl_n2); }
        bool need = true;
        if (TYPE == 1) { const int kr = u.kt0 + i; need = (kr >= r0w) && (kr < r0w + 8); }
        if (need) {
#pragma unroll
            for (int hf = 0; hf < 2; ++hf) {
                f32x16 p;
                if (TYPE == 1) {
                    const lds_cptr tp = tb + (u.kt0 + i - qrw + 7) * TB_ROW;
#pragma unroll
                    for (int g = 0; g < 4; ++g) { const f32x4 a = *(const LAS f32x4*)(tp + 32 * (g + 4 * hf)) + *(const LAS f32x4*)(tbm + 32 * (g + 4 * hf)); p[4 * g] = a[0]; p[4 * g + 1] = a[1]; p[4 * g + 2] = a[2]; p[4 * g + 3] = a[3]; }
                } else p = f32x16{};
#pragma unroll
                for (int d0 = 0; d0 < 4; ++d0) p = __builtin_amdgcn_mfma_f32_32x32x16_bf16(*(const LAS bf16x8*)(ka[d0] + sl_cur + 4096 * hf), qr[d0], p, 0, 0, 0);
                float s0 = 0.f;
#pragma unroll
                for (int r = 0; r < 16; ++r) { p[r] = __builtin_amdgcn_exp2f(p[r]); s0 += p[r]; }
                lsum += s0;
                const u32x4 pwa = (u32x4){cvtpk(p[0], p[1]), cvtpk(p[2], p[3]), cvtpk(p[4], p[5]), cvtpk(p[6], p[7])}, pwb = (u32x4){cvtpk(p[8], p[9]), cvtpk(p[10], p[11]), cvtpk(p[12], p[13]), cvtpk(p[14], p[15])};
#pragma unroll
                for (int d0 = 0; d0 < 2; ++d0) { const lds_cptr vp = va[d0] + sl_cur + 4096 * hf; const s16x4 l0 = vtr(vp), h0 = vtr(vp + 1024), l1 = vtr(vp + 2048), h1 = vtr(vp + 2048 + 1024);
                    o[d0] = __builtin_amdgcn_mfma_f32_32x32x16_bf16(__builtin_bit_cast(bf16x8, pwa), (bf16x8){l0[0], l0[1], l0[2], l0[3], h0[0], h0[1], h0[2], h0[3]}, o[d0], 0, 0, 0);
                    o[d0] = __builtin_amdgcn_mfma_f32_32x32x16_bf16(__builtin_bit_cast(bf16x8, pwb), (bf16x8){l1[0], l1[1], l1[2], l1[3], h1[0], h1[1], h1[2], h1[3]}, o[d0], 0, 0, 0); }
            }
        }
        sl_n2 = sl_cur;
        sl_cur = (sl_cur == (NSLOT - 1) * SLOTB) ? 0 : sl_cur + SLOTB;
    }
    AT_WAIT_BAR(0);
    int lane2 = lane; asm volatile("" : "+v"(lane2)); const int r32e = lane2 & 31, hie = lane2 >> 5;
    lsum += __shfl_xor(lsum, 32);
    LAS float* wsf = (LAS float*)(lds + LDS_WS) + wid * 64;
    if (hie == 0) wsf[r32e] = lsum;
    asm volatile("s_waitcnt lgkmcnt(0)" ::: "memory");
    LAS bf16_t* stg = (LAS bf16_t*)(lds) + wid * 2048;
#pragma unroll
    for (int r = 0; r < 16; ++r) { const int orow = crow(r, hie); const float rl = __builtin_amdgcn_rcpf(wsf[orow]);
        stg[orow * 64 + r32e] = (bf16_t)f2bf(o[0][r] * rl); stg[orow * 64 + 32 + r32e] = (bf16_t)f2bf(o[1][r] * rl); }
    asm volatile("s_waitcnt lgkmcnt(0)" ::: "memory");
    const int trow0 = u.t0 + wid * 32;
#pragma unroll
    for (int i = 0; i < 4; ++i) { const int row = i * 8 + (lane2 >> 3), ch = lane2 & 7; const u32x4 v = *(const LAS u32x4*)(stg + row * 64 + ch * 8);
        *(u32x4*)(mixed + (size_t)(trow0 + row) * D + u.hh16 * 64 + ch * 8) = v;
        float s = 0.f; { float a;
            a = bf2f(v.x & 0xffffu); s += a * a; a = bf2f(v.x >> 16); s += a * a; a = bf2f(v.y & 0xffffu); s += a * a; a = bf2f(v.y >> 16); s += a * a;
            a = bf2f(v.z & 0xffffu); s += a * a; a = bf2f(v.z >> 16); s += a * a; a = bf2f(v.w & 0xffffu); s += a * a; a = bf2f(v.w >> 16); s += a * a; }
        s += __shfl_xor(s, 1); s += __shfl_xor(s, 2); s += __shfl_xor(s, 4);
        if (ch == 0) ssq[(size_t)(trow0 + row) * 16 + u.hh16] = s; }
    asm volatile("s_waitcnt lgkmcnt(0)\n\ts_barrier" ::: "memory");
#undef AT_DMA_K
#undef AT_DMA_V
}

template <int NQB>
__device__ __forceinline__ void mem_unit(LAS unsigned char* lds, const bf16_t* Qh, const bf16_t* Kh, const bf16_t* Vh, int t0, int hh16, bf16_t* mixed, float* ssq) {
    constexpr int MK = 0, MV = 32768, MSTG = 65536, MWS = 98304;
    const int tid = opaque_tid0(), lane = tid & 63, r32 = lane & 31, hi = lane >> 5; const int wid = __builtin_amdgcn_readfirstlane(tid >> 6);
    const unsigned lds0 = (unsigned)(size_t)lds; lds_cptr shm3 = (lds_cptr)lds;
    const int prow = 8 * wid + (lane >> 3);
    const bf16_t* ksrc = Kh + (size_t)prow * HD + (((lane & 7) ^ ((4 * wid + (lane >> 4)) & 7)) * 8);
    const bf16_t* vsrc = Vh + (size_t)prow * HD + ((((lane & 7) >> 1) ^ (prow & 2)) * 16) + (lane & 1) * 8;
    const bf16_t* Qw = Qh + (size_t)(wid * 32 + r32) * HD + hi * 8;
    bf16x8 qr[4], qn[4];
#pragma unroll
    for (int d0 = 0; d0 < 4; ++d0) { qr[d0] = *(const bf16x8*)(Qw + d0 * 16); qn[d0] = qr[d0]; }
#pragma unroll
    for (int j = 0; j < 4; ++j) { glds16(ksrc + (size_t)j * 64 * HD, (unsigned)__builtin_amdgcn_readfirstlane(lds0 + MK + j * 8192 + wid * 1024));
                                  glds16(vsrc + (size_t)j * 64 * HD, (unsigned)__builtin_amdgcn_readfirstlane(lds0 + MV + j * 8192 + wid * 1024)); }
    lds_cptr ka[4], va[2];
    { const int sw = (r32 >> 1) & 7;
#pragma unroll
      for (int d0 = 0; d0 < 4; ++d0) ka[d0] = shm3 + MK + r32 * 128 + (((2 * d0 + hi) ^ sw) * 16);
      const int q = (lane & 15) >> 2, gb = (lane >> 4) & 1;
#pragma unroll
      for (int d0 = 0; d0 < 2; ++d0) va[d0] = shm3 + MV + (4 * hi + q) * 128 + ((2 * (d0 ^ (q >> 1)) + gb) * 32) + (lane & 3) * 8; }
    LAS float* wsf = (LAS float*)(lds + MWS) + wid * 64;
    LAS bf16_t* stg = (LAS bf16_t*)(lds + MSTG) + wid * 2048;
#pragma unroll
    for (int qb = 0; qb < NQB; ++qb) {
        const bool has_next = qb + 1 < NQB;
        float lsum = 0.f; f32x16 o[2]; o[0] = f32x16{}; o[1] = f32x16{};
#pragma unroll
        for (int i = 0; i < 4; ++i) {
            if (qb == 0) {
                if (i == 0) AT_WAIT_BAR(6); else if (i == 1) AT_WAIT_BAR(4); else if (i == 2) { if (has_next) AT_WAIT_BAR(6); else AT_WAIT_BAR(2); } else { if (has_next) AT_WAIT_BAR(4); else AT_WAIT_BAR(0); }
            }
            if (i == 1 && has_next) {
#pragma unroll
                for (int d0 = 0; d0 < 4; ++d0) qn[d0] = *(const bf16x8*)(Qw + (size_t)(qb + 1) * 256 * HD + d0 * 16); }
#pragma unroll
            for (int hf = 0; hf < 2; ++hf) {
                f32x16 p = f32x16{};
#pragma unroll
                for (int d0 = 0; d0 < 4; ++d0) p = __builtin_amdgcn_mfma_f32_32x32x16_bf16(*(const LAS bf16x8*)(ka[d0] + i * 8192 + 4096 * hf), qr[d0], p, 0, 0, 0);
                float s0 = 0.f;
#pragma unroll
                for (int r = 0; r < 16; ++r) { p[r] = __builtin_amdgcn_exp2f(p[r]); s0 += p[r]; }
                lsum += s0;
                const u32x4 pwa = (u32x4){cvtpk(p[0], p[1]), cvtpk(p[2], p[3]), cvtpk(p[4], p[5]), cvtpk(p[6], p[7])}, pwb = (u32x4){cvtpk(p[8], p[9]), cvtpk(p[10], p[11]), cvtpk(p[12], p[13]), cvtpk(p[14], p[15])};
#pragma unroll
                for (int d0 = 0; d0 < 2; ++d0) { const lds_cptr vp = va[d0] + i * 8192 + 4096 * hf; const s16x4 l0 = vtr(vp), h0 = vtr(vp + 1024), l1 = vtr(vp + 2048), h1 = vtr(vp + 2048 + 1024);
                    o[d0] = __builtin_amdgcn_mfma_f32_32x32x16_bf16(__builtin_bit_cast(bf16x8, pwa), (bf16x8){l0[0], l0[1], l0[2], l0[3], h0[0], h0[1], h0[2], h0[3]}, o[d0], 0, 0, 0);
                    o[d0] = __builtin_amdgcn_mfma_f32_32x32x16_bf16(__builtin_bit_cast(bf16x8, pwb), (bf16x8){l1[0], l1[1], l1[2], l1[3], h1[0], h1[1], h1[2], h1[3]}, o[d0], 0, 0, 0); }
            }
        }
        lsum += __shfl_xor(lsum, 32);
        if (hi == 0) wsf[r32] = lsum;
        asm volatile("s_waitcnt lgkmcnt(0)" ::: "memory");
#pragma unroll
        for (int r = 0; r < 16; ++r) { const int orow = crow(r, hi); const float rl = __builtin_amdgcn_rcpf(wsf[orow]);
            stg[orow * 64 + r32] = (bf16_t)f2bf(o[0][r] * rl); stg[orow * 64 + 32 + r32] = (bf16_t)f2bf(o[1][r] * rl); }
        asm volatile("s_waitcnt lgkmcnt(0)" ::: "memory");
        const int trow0 = t0 + qb * 256 + wid * 32;
#pragma unroll
        for (int i = 0; i < 4; ++i) { const int row = i * 8 + (lane >> 3), ch = lane & 7; const u32x4 v = *(const LAS u32x4*)(stg + row * 64 + ch * 8);
            *(u32x4*)(mixed + (size_t)(trow0 + row) * D + hh16 * 64 + ch * 8) = v;
            { float s = 0.f, a;
              a = bf2f(v.x & 0xffffu); s += a * a; a = bf2f(v.x >> 16); s += a * a; a = bf2f(v.y & 0xffffu); s += a * a; a = bf2f(v.y >> 16); s += a * a;
              a = bf2f(v.z & 0xffffu); s += a * a; a = bf2f(v.z >> 16); s += a * a; a = bf2f(v.w & 0xffffu); s += a * a; a = bf2f(v.w >> 16); s += a * a;
              s += __shfl_xor(s, 1); s += __shfl_xor(s, 2); s += __shfl_xor(s, 4);
              if (ch == 0) ssq[(size_t)(trow0 + row) * 16 + hh16] = s; } }
        asm volatile("s_waitcnt lgkmcnt(0)" ::: "memory");
        if (has_next) {
#pragma unroll
            for (int d0 = 0; d0 < 4; ++d0) qr[d0] = qn[d0]; }
    }
    asm volatile("s_waitcnt lgkmcnt(0)\n\ts_barrier" ::: "memory");
}

__device__ __forceinline__ void nb_unit(LAS unsigned char* lds, const UnitDesc& u, bf16_t* mixed, float* ssq) {
    const int tid = opaque_tid0(), lane = tid & 63, r32 = lane & 31, hi = lane >> 5; const int wid = __builtin_amdgcn_readfirstlane(tid >> 6);
    const unsigned lds0 = (unsigned)(size_t)lds; lds_cptr shm3 = (lds_cptr)lds;
    const int prow = 8 * wid + (lane >> 3);
    const bf16_t* ksrc = u.K + (size_t)(u.kt0 * 64 + prow) * HD + (((lane & 7) ^ ((4 * wid + (lane >> 4)) & 7)) * 8);
    const bf16_t* vsrc = u.V + (size_t)(u.kt0 * 64 + prow) * HD + ((((lane & 7) >> 1) ^ (prow & 2)) * 16) + (lane & 1) * 8;
    const unsigned kdst = lds0 + LDS_K + wid * 1024, vdst = lds0 + LDS_V + wid * 1024;
#define AT_DMA_K(t, slot) glds16(ksrc + (size_t)(t) * 64 * HD, (unsigned)__builtin_amdgcn_readfirstlane(kdst + (slot)))
#define AT_DMA_V(t, slot) glds16(vsrc + (size_t)(t) * 64 * HD, (unsigned)__builtin_amdgcn_readfirstlane(vdst + (slot)))
    const int rp = wid >> 2, jb = wid & 3, cs = min(max(16 * jb - 8, 0), 32);
    const int qrl = 4 * u.qb + 2 * rp + (r32 >> 4), qc = 16 * jb + (r32 & 15), c0 = min(max(qc - 8, 0), 48), r0l = min(max(qrl - 4, 0), 24);
    const int rwa = min(max(4 * u.qb + 2 * rp - 4, 0), 24), rwb = min(max(4 * u.qb + 2 * rp + 1 - 4, 0), 24) + 8;
    lds_cptr ka[4], va[2];
    { const int key = cs + r32, sw = (key >> 1) & 7;
#pragma unroll
      for (int d0 = 0; d0 < 4; ++d0) ka[d0] = shm3 + LDS_K + key * 128 + (((2 * d0 + hi) ^ sw) * 16);
      const int q = (lane & 15) >> 2, gb = (lane >> 4) & 1;
#pragma unroll
      for (int d0 = 0; d0 < 2; ++d0) va[d0] = shm3 + LDS_V + (cs + 4 * hi + q) * 128 + ((2 * (d0 ^ (q >> 1)) + gb) * 32) + (lane & 3) * 8; }
    const int nt = u.nt;
    const bf16_t* Qw = u.Q + (size_t)(qrl * 64 + qc) * HD;
    bf16x8 qr[4];
#pragma unroll
    for (int d0 = 0; d0 < 4; ++d0) qr[d0] = *(const bf16x8*)(Qw + d0 * 16 + hi * 8);
#pragma unroll
    for (int j = 0; j < NPRE; ++j) if (j < nt) { AT_DMA_K(j, j * SLOTB); AT_DMA_V(j, j * SLOTB); }
    lds_cptr tb, tbm;
    { const int ib = cs + 4 * hi - qc + 63, cb = (-ib) & 3, im = cs + 4 * hi - c0 + 63, cm = (-im) & 3;
      tb = shm3 + LDS_TBB + cb * TB_CS + (ib + cb) * 4; tbm = shm3 + LDS_TBM + cm * TB_CS + (im + cm) * 4; }
    float lsum = 0.f; f32x16 o[2]; o[0] = f32x16{}; o[1] = f32x16{};
    int sl_cur = 0, sl_n2 = NPRE * SLOTB;
    for (int i = 0; i < nt; ++i) {
        { const int rem = nt - 1 - i, yo = rem < NPRE - 1 ? rem : NPRE - 1; if (yo >= 3) AT_WAIT_BAR(6); else if (yo == 2) AT_WAIT_BAR(4); else if (yo == 1) AT_WAIT_BAR(2); else AT_WAIT_BAR(0); }
        if (i + NPRE < nt) { AT_DMA_K(i + NPRE, sl_n2); AT_DMA_V(i + NPRE, sl_n2); }
        const int kr = u.kt0 + i;
        if (kr >= rwa && kr < rwb) {
            const int drow = (kr >= r0l && kr < r0l + 8) ? (kr - qrl + 7) : 15;
            const lds_cptr tp = tb + drow * TB_ROW;
            f32x16 p0;
#pragma unroll
            for (int g = 0; g < 4; ++g) { const f32x4 a = *(const LAS f32x4*)(tp + 32 * g) + *(const LAS f32x4*)(tbm + 32 * g); p0[4 * g] = a[0]; p0[4 * g + 1] = a[1]; p0[4 * g + 2] = a[2]; p0[4 * g + 3] = a[3]; }
            bf16x8 kf[4];
#pragma unroll
            for (int j = 0; j < 4; ++j) kf[j] = *(const LAS bf16x8*)(ka[j] + sl_cur);
#pragma unroll
            for (int d0 = 0; d0 < 4; ++d0) p0 = __builtin_amdgcn_mfma_f32_32x32x16_bf16(kf[d0], qr[d0], p0, 0, 0, 0);
            float s0 = 0.f;
#pragma unroll
            for (int r = 0; r < 16; ++r) { p0[r] = __builtin_amdgcn_exp2f(p0[r]); s0 += p0[r]; }
            lsum += s0;
            const u32x4 pw0 = (u32x4){cvtpk(p0[0], p0[1]), cvtpk(p0[2], p0[3]), cvtpk(p0[4], p0[5]), cvtpk(p0[6], p0[7])};
            const u32x4 pw1 = (u32x4){cvtpk(p0[8], p0[9]), cvtpk(p0[10], p0[11]), cvtpk(p0[12], p0[13]), cvtpk(p0[14], p0[15])};
#pragma unroll
            for (int d0 = 0; d0 < 2; ++d0) {
                s16x4 lo[2], hh[2]; const lds_cptr vp = va[d0] + sl_cur;
#pragma unroll
                for (int ks = 0; ks < 2; ++ks) { lo[ks] = vtr(vp + ks * 2048); hh[ks] = vtr(vp + ks * 2048 + 1024); }
                o[d0] = __builtin_amdgcn_mfma_f32_32x32x16_bf16(__builtin_bit_cast(bf16x8, pw0), (bf16x8){lo[0][0], lo[0][1], lo[0][2], lo[0][3], hh[0][0], hh[0][1], hh[0][2], hh[0][3]}, o[d0], 0, 0, 0);
                o[d0] = __builtin_amdgcn_mfma_f32_32x32x16_bf16(__builtin_bit_cast(bf16x8, pw1), (bf16x8){lo[1][0], lo[1][1], lo[1][2], lo[1][3], hh[1][0], hh[1][1], hh[1][2], hh[1][3]}, o[d0], 0, 0, 0);
            }
        }
        sl_n2 = sl_cur;
        sl_cur = (sl_cur == (NSLOT - 1) * SLOTB) ? 0 : sl_cur + SLOTB;
    }
    AT_WAIT_BAR(0);
    int lane2 = lane; asm volatile("" : "+v"(lane2)); const int r32e = lane2 & 31, hie = lane2 >> 5;
    lsum += __shfl_xor(lsum, 32);
    LAS float* wsf = (LAS float*)(lds + LDS_WS) + wid * 64;
    if (hie == 0) wsf[r32e] = lsum;
    asm volatile("s_waitcnt lgkmcnt(0)" ::: "memory");
    LAS bf16_t* stg = (LAS bf16_t*)(lds) + wid * 2048;
#pragma unroll
    for (int r = 0; r < 16; ++r) { const int orow = crow(r, hie); const float rl = __builtin_amdgcn_rcpf(wsf[orow]);
        stg[orow * 64 + r32e] = (bf16_t)f2bf(o[0][r] * rl); stg[orow * 64 + 32 + r32e] = (bf16_t)f2bf(o[1][r] * rl); }
    asm volatile("s_waitcnt lgkmcnt(0)" ::: "memory");
    const int tbase = u.t0 + 2 * rp * 64 + 16 * jb;
#pragma unroll
    for (int i = 0; i < 4; ++i) { const int row = i * 8 + (lane2 >> 3), ch = lane2 & 7; const u32x4 v = *(const LAS u32x4*)(stg + row * 64 + ch * 8);
        *(u32x4*)(mixed + (size_t)(tbase + (row >> 4) * 64 + (row & 15)) * D + u.hh16 * 64 + ch * 8) = v; const int hh16 = u.hh16;
            { float s = 0.f, a;
              a = bf2f(v.x & 0xffffu); s += a * a; a = bf2f(v.x >> 16); s += a * a; a = bf2f(v.y & 0xffffu); s += a * a; a = bf2f(v.y >> 16); s += a * a;
              a = bf2f(v.z & 0xffffu); s += a * a; a = bf2f(v.z >> 16); s += a * a; a = bf2f(v.w & 0xffffu); s += a * a; a = bf2f(v.w >> 16); s += a * a;
              s += __shfl_xor(s, 1); s += __shfl_xor(s, 2); s += __shfl_xor(s, 4);
              if (ch == 0) ssq[(size_t)(tbase + (row >> 4) * 64 + (row & 15)) * 16 + hh16] = s; } }
    asm volatile("s_waitcnt lgkmcnt(0)\n\ts_barrier" ::: "memory");
#undef AT_DMA_K
#undef AT_DMA_V
}
__device__ __forceinline__ void build_table_b(LAS unsigned char* lds, const float* rpb_lh) {
    const int tid = opaque_tid0();
    for (int e = tid; e < 15 * 127; e += 512) { const int dr = e / 127, idx = e - dr * 127, rel = idx - 63; const float v = (rel >= -15 && rel <= 15) ? rpb_lh[dr * 31 + rel + 15] * LOG2E : 0.f;
#pragma unroll
        for (int c = 0; c < 4; ++c) *(LAS float*)(lds + LDS_TBB + dr * TB_ROW + c * TB_CS + (idx + c) * 4) = v; }
    if (tid >= 256 && tid < 256 + 127) { const int idx = tid - 256;
#pragma unroll
        for (int c = 0; c < 4; ++c) *(LAS float*)(lds + LDS_TBB + 15 * TB_ROW + c * TB_CS + (idx + c) * 4) = NEGBIG; }
    if (tid < 127) { const int j = tid - 63; const float v = (j >= 0 && j < 16) ? 0.f : NEGBIG;
#pragma unroll
        for (int c = 0; c < 4; ++c) *(LAS float*)(lds + LDS_TBM + c * TB_CS + (tid + c) * 4) = v; }
}

template <int TYPE>
__device__ __forceinline__ void attn_type_loop(Frame& F, int l, unsigned xcc, int qset) {
    constexpr int MQB = 2, MUP = 8 / MQB;
    constexpr int NPER = (TYPE == 2) ? 16 * MUP : 192;
    unsigned* qcnt = F.ctl + CW_ATQ + ((qset * 3 + TYPE) * 8) * 64;
    LAS int* qw = (LAS int*)(F.lds + CTRL_BASE + 1024);
    const int tid = opaque_tid0();
    const int xq = (int)xcc & 7; int pre = -2;
    for (;;) {
        if (tid == 0) { int id, x; at_dequeue(qcnt, NPER, xq, pre, id, x); qw[0] = id; qw[1] = x; }
        __syncthreads();
        const int id = qw[0], x = qw[1];
        __syncthreads();
        if (id < 0) break;
        pre = -2; if (tid == 0 && x == xq) pre = (int)__hip_atomic_fetch_add(qcnt + xq * 64, 1u, RLX_AGENT);
        UnitDesc u; int h;
        if (TYPE == 2) { const int P = x * 16 + id / MUP, b = P >> 2, q0 = (id % MUP) * MQB; h = P & 3;
            mem_unit<MQB>(F.lds, qkv_ptr(F, 36 + h, b * SEQ + q0 * 256), memkv_ptr(F, l, h, b * MEM_LEN), memkv_ptr(F, l, 4 + h, b * MEM_LEN), b * SEQ + q0 * 256, 12 + h, (bf16_t*)(F.ws + WS_MIX), (float*)(F.ws + WS_SSQH));
            continue; }
        else { const int ord = (0x70615243 >> (4 * (id & 7))) & 7;
            const int P = x * 24 + (id >> 3), b = P / 6; h = P % 6; u.qb = ord; u.h = h; u.t0 = b * SEQ + ord * 256;
            if (TYPE == 0) { u.hh16 = h; u.Q = qkv_ptr(F, h, b * SEQ); u.K = qkv_ptr(F, 6 + h, b * SEQ); u.V = qkv_ptr(F, 12 + h, b * SEQ);
                const int lo = max(4 * ord - 16, 0), hi2 = min(4 * ord + 20, 32); u.kt0 = lo; u.nt = hi2 - lo; }
            else { u.hh16 = 6 + h; u.Q = qkv_ptr(F, 18 + h, b * SEQ); u.K = qkv_ptr(F, 24 + h, b * SEQ); u.V = qkv_ptr(F, 30 + h, b * SEQ);
                const int lo = min(max(4 * ord - 4, 0), 24), hi2 = min(max(4 * ord + 3 - 4, 0), 24) + 8; u.kt0 = lo; u.nt = hi2 - lo; } }
        if (TYPE == 1) build_table_b(F.lds, in_ptr(5) + (size_t)(l * 6 + h) * 15 * 31);
        if (TYPE == 1) nb_unit(F.lds, u, (bf16_t*)(F.ws + WS_MIX), (float*)(F.ws + WS_SSQH)); else attn_unit<TYPE>(F.lds, u, (bf16_t*)(F.ws + WS_MIX), (float*)(F.ws + WS_SSQH));
    }
}
constexpr int SW_TAB = 131072, SW_CS = 1088, SW_STG = SW_TAB + 4 * SW_CS;
static_assert(SW_STG + 8 * 2048 <= CTRL_BASE, "sliding-window LDS map");
__device__ __forceinline__ void sw_unit(LAS unsigned char* lds, int b, int h, int p, int half, const bf16_t* Qh, const bf16_t* Kh, const bf16_t* Vh, bf16_t* PO, float* PL) {
    const int tid = opaque_tid0(), lane = tid & 63, r32 = lane & 31, hi = lane >> 5; const int wid = __builtin_amdgcn_readfirstlane(tid >> 6), pair = wid >> 1, w2 = wid & 1;
    const int dsh = 2 * p, nbsh = 5 - dsh, nblk = 1 << nbsh;
    const unsigned lds0 = (unsigned)(size_t)lds; lds_cptr shm3 = (lds_cptr)lds;
    { const float sd = exp2f(-8.0f * (float)(h + 1) / 6.0f) * LOG2E * (float)(1 << dsh);
      if (tid < 255) { const int rel = tid - 127, a = rel < 0 ? -rel : rel; const float v = a <= 64 ? -sd * (float)a : NEGBIG;
#pragma unroll
          for (int c = 0; c < 4; ++c) *(LAS float*)(lds + SW_TAB + c * SW_CS + (tid + c) * 4) = v; } }
    lds_cptr ka[4], va[2];
    { const int sw = (r32 >> 1) & 7;
#pragma unroll
      for (int d0 = 0; d0 < 4; ++d0) ka[d0] = shm3 + r32 * 128 + (((2 * d0 + hi) ^ sw) * 16);
      const int q = (lane & 15) >> 2, gb = (lane >> 4) & 1;
#pragma unroll
      for (int d0 = 0; d0 < 2; ++d0) va[d0] = shm3 + 8192 + (4 * hi + q) * 128 + ((2 * (d0 ^ (q >> 1)) + gb) * 32) + (lane & 3) * 8; }
    lds_cptr tb0; { const int idx0 = 63 - 32 * w2 - r32 + 4 * hi, c = (-idx0) & 3; tb0 = shm3 + SW_TAB + c * SW_CS + (idx0 + c) * 4; }
    const int G0 = 16 * half;
    const int prow = 8 * wid + (lane >> 3);
    const int kcol = ((lane & 7) ^ ((4 * wid + (lane >> 4)) & 7)) * 8, vcol = ((((lane & 7) >> 1) ^ (prow & 2)) * 16) + (lane & 1) * 8;
#define SW_DMA(lam) do { int tau_ = G0 - 1 + (lam); tau_ = tau_ < 0 ? 0 : (tau_ > 31 ? 31 : tau_); const int r_ = tau_ >> nbsh, n_ = tau_ & (nblk - 1); \
        const size_t ro_ = (size_t)((((n_ * 64 + prow) << dsh) + r_)) * HD; const unsigned d_ = lds0 + ((lam) & 7) * 16384 + wid * 1024; \
        glds16(Kh + ro_ + kcol, (unsigned)__builtin_amdgcn_readfirstlane(d_)); glds16(Vh + ro_ + vcol, (unsigned)__builtin_amdgcn_readfirstlane(d_ + 8192)); } while (0)
#define SW_QLOAD(dst, s) do { const int G_ = G0 + 4 * (s) + pair, r_ = G_ >> nbsh, n_ = G_ & (nblk - 1); const bf16_t* qw_ = Qh + (size_t)((((n_ * 64 + 32 * w2 + r32) << dsh) + r_)) * HD; \
        _Pragma("unroll") for (int d0 = 0; d0 < 4; ++d0) dst[d0] = *(const bf16x8*)(qw_ + d0 * 16 + hi * 8); } while (0)
    bf16x8 qr[4], qn[4];
    SW_QLOAD(qr, 0);
#pragma unroll
    for (int d0 = 0; d0 < 4; ++d0) qn[d0] = qr[d0];
#pragma unroll
    for (int lam = 0; lam < 8; ++lam) SW_DMA(lam);
    float lsum = 0.f; f32x16 o[2]; o[0] = f32x16{}; o[1] = f32x16{};
#define SW_EPI(s) do { const int G_ = G0 + 4 * (s) + pair, r_ = G_ >> nbsh, n_ = G_ & (nblk - 1); \
        lsum += __shfl_xor(lsum, 32); \
        if (hi == 0) PL[((size_t)p * T + (size_t)b * SEQ + (((n_ * 64 + 32 * w2 + r32) << dsh) + r_)) * 8 + h] = lsum; \
        LAS bf16_t* stg_ = (LAS bf16_t*)(lds + SW_STG + wid * 2048); \
        _Pragma("unroll") for (int d0 = 0; d0 < 2; ++d0) { \
            _Pragma("unroll") for (int r = 0; r < 16; ++r) stg_[crow(r, hi) * 32 + r32] = (bf16_t)f2bf(o[d0][r]); \
            asm volatile("s_waitcnt lgkmcnt(0)" ::: "memory"); \
            _Pragma("unroll") for (int i2 = 0; i2 < 2; ++i2) { const int row = i2 * 16 + (lane >> 2), ch = lane & 3; const u32x4 v = *(const LAS u32x4*)(stg_ + row * 32 + ch * 8); \
                *(u32x4*)(PO + ((size_t)p * T + (size_t)b * SEQ + (((n_ * 64 + 32 * w2 + row) << dsh) + r_)) * 384 + h * 64 + d0 * 32 + ch * 8) = v; } \
            asm volatile("s_waitcnt lgkmcnt(0)" ::: "memory"); } \
        lsum = 0.f; o[0] = f32x16{}; o[1] = f32x16{}; } while (0)
#define SW_WAIT(sig) do { if ((sig) == 0) AT_WAIT_BAR(8); else if ((sig) == 3 || (sig) == 6 || (sig) == 9) AT_WAIT_BAR(4); else if ((sig) == 10) AT_WAIT_BAR(2); else if ((sig) == 11) AT_WAIT_BAR(0); else AT_WAIT_BAR(6); } while (0)
#pragma unroll
    for (int sig = 0; sig < 12; ++sig) {
        const int s = sig / 3, t = sig - 3 * s;
        SW_WAIT(sig);
        if (t == 0 && s > 0) { SW_EPI(s - 1);
#pragma unroll
            for (int d0 = 0; d0 < 4; ++d0) qr[d0] = qn[d0]; }
        if (t == 2 && s < 3) SW_QLOAD(qn, s + 1);
        if (t == 1) { if (4 * s + 8 <= 17) SW_DMA(4 * s + 8); }
        if (t == 2) { if (4 * s + 9 <= 17) SW_DMA(4 * s + 9); }
        if (t == 0 && s > 0) { if (4 * s + 6 <= 17) SW_DMA(4 * s + 6); if (4 * s + 7 <= 17) SW_DMA(4 * s + 7); }
        const int G = G0 + 4 * s + pair, n = G & (nblk - 1);
        if (!(t == 0 && n == 0) && !(t == 2 && n == nblk - 1)) {
            const int slo = ((4 * s + t + pair) & 7) * 16384;
            const bool do0 = !(t == 0 && w2 == 1), do1 = !(t == 2 && w2 == 0);
            const lds_cptr tp = tb0 + t * 256;
            if (do0) {
                f32x16 p0;
#pragma unroll
                for (int gq = 0; gq < 4; ++gq) { const f32x4 a = *(const LAS f32x4*)(tp + 32 * gq); p0[4 * gq] = a[0]; p0[4 * gq + 1] = a[1]; p0[4 * gq + 2] = a[2]; p0[4 * gq + 3] = a[3]; }
#pragma unroll
                for (int d0 = 0; d0 < 4; ++d0) p0 = __builtin_amdgcn_mfma_f32_32x32x16_bf16(*(const LAS bf16x8*)(ka[d0] + slo), qr[d0], p0, 0, 0, 0);
                float s0 = 0.f;
#pragma unroll
                for (int r = 0; r < 16; ++r) { p0[r] = __builtin_amdgcn_exp2f(p0[r]); s0 += p0[r]; }
                lsum += s0;
                const u32x4 pw0 = (u32x4){cvtpk(p0[0], p0[1]), cvtpk(p0[2], p0[3]), cvtpk(p0[4], p0[5]), cvtpk(p0[6], p0[7])}, pw1 = (u32x4){cvtpk(p0[8], p0[9]), cvtpk(p0[10], p0[11]), cvtpk(p0[12], p0[13]), cvtpk(p0[14], p0[15])};
#pragma unroll
                for (int d0 = 0; d0 < 2; ++d0) { const lds_cptr vp = va[d0] + slo; const s16x4 l0 = vtr(vp), h0 = vtr(vp + 1024), l1 = vtr(vp + 2048), h1 = vtr(vp + 2048 + 1024);
                    o[d0] = __builtin_amdgcn_mfma_f32_32x32x16_bf16(__builtin_bit_cast(bf16x8, pw0), (bf16x8){l0[0], l0[1], l0[2], l0[3], h0[0], h0[1], h0[2], h0[3]}, o[d0], 0, 0, 0);
                    o[d0] = __builtin_amdgcn_mfma_f32_32x32x16_bf16(__builtin_bit_cast(bf16x8, pw1), (bf16x8){l1[0], l1[1], l1[2], l1[3], h1[0], h1[1], h1[2], h1[3]}, o[d0], 0, 0, 0); }
            }
            if (do1) {
                f32x16 p1;
#pragma unroll
                for (int gq = 0; gq < 4; ++gq) { const f32x4 a = *(const LAS f32x4*)(tp + 32 * (gq + 4)); p1[4 * gq] = a[0]; p1[4 * gq + 1] = a[1]; p1[4 * gq + 2] = a[2]; p1[4 * gq + 3] = a[3]; }
#pragma unroll
                for (int d0 = 0; d0 < 4; ++d0) p1 = __builtin_amdgcn_mfma_f32_32x32x16_bf16(*(const LAS bf16x8*)(ka[d0] + slo + 4096), qr[d0], p1, 0, 0, 0);
                float s1 = 0.f;
#pragma unroll
                for (int r = 0; r < 16; ++r) { p1[r] = __builtin_amdgcn_exp2f(p1[r]); s1 += p1[r]; }
                lsum += s1;
                const u32x4 pw2 = (u32x4){cvtpk(p1[0], p1[1]), cvtpk(p1[2], p1[3]), cvtpk(p1[4], p1[5]), cvtpk(p1[6], p1[7])}, pw3 = (u32x4){cvtpk(p1[8], p1[9]), cvtpk(p1[10], p1[11]), cvtpk(p1[12], p1[13]), cvtpk(p1[14], p1[15])};
#pragma unroll
                for (int d0 = 0; d0 < 2; ++d0) { const lds_cptr vp = va[d0] + slo + 4096; const s16x4 l0 = vtr(vp), h0 = vtr(vp + 1024), l1 = vtr(vp + 2048), h1 = vtr(vp + 2048 + 1024);
                    o[d0] = __builtin_amdgcn_mfma_f32_32x32x16_bf16(__builtin_bit_cast(bf16x8, pw2), (bf16x8){l0[0], l0[1], l0[2], l0[3], h0[0], h0[1], h0[2], h0[3]}, o[d0], 0, 0, 0);
                    o[d0] = __builtin_amdgcn_mfma_f32_32x32x16_bf16(__builtin_bit_cast(bf16x8, pw3), (bf16x8){l1[0], l1[1], l1[2], l1[3], h1[0], h1[1], h1[2], h1[3]}, o[d0], 0, 0, 0); }
            }
        }
    }
    AT_WAIT_BAR(0);
    SW_EPI(3);
    asm volatile("s_waitcnt lgkmcnt(0)\n\ts_barrier" ::: "memory");
#undef SW_DMA
#undef SW_QLOAD
#undef SW_EPI
#undef SW_WAIT
}
__device__ __forceinline__ void sa_loop(Frame& F, int l, unsigned xcc, int qset) {
    constexpr int NPER = 144;
    unsigned* qcnt = F.ctl + CW_ATQ + ((qset * 3 + 0) * 8) * 64;
    LAS int* qw = (LAS int*)(F.lds + CTRL_BASE + 1024);
    const int tid = opaque_tid0();
    const int xq = (int)xcc & 7; int pre = -2;
    for (;;) {
        if (tid == 0) { int id, x; at_dequeue(qcnt, NPER, xq, pre, id, x); qw[0] = id; qw[1] = x; }
        __syncthreads();
        const int id = qw[0], x = qw[1];
        __syncthreads();
        if (id < 0) break;
        pre = -2; if (tid == 0 && x == xq) pre = (int)__hip_atomic_fetch_add(qcnt + xq * 64, 1u, RLX_AGENT);
        const int P = x * 24 + id / 6, b = P / 6, h = P % 6, p = (id % 6) >> 1, half = id & 1;
        sw_unit(F.lds, b, h, p, half, qkv_ptr(F, h, b * SEQ), qkv_ptr(F, 6 + h, b * SEQ), qkv_ptr(F, 12 + h, b * SEQ), (bf16_t*)(F.ws + WS_PO), (float*)(F.ws + WS_PL));
    }
}
}

__device__ __forceinline__ void moe_weights_beside(Frame& F, int l, int qset) {
    PHASE_IDS(F);
    if ((blockIdx.x & 31) >= 8) return;
    LAS float* scr = (LAS float*)(F.lds + F.wave * 16384);
    LAS int* qw = (LAS int*)(F.lds + CTRL_BASE + 1024);
    constexpr int I_G = 16 * 16, I_D = 8 * 32, PER_E = 2 * I_G + I_D, NIT = NE * PER_E, BATCH_IT = 64;
    unsigned* head = F.ctl + CW_WQ + qset * 64;
    for (;;) {
        if (F.tid == 0) qw[2] = (int)__hip_atomic_fetch_add(head, 1u, RLX_AGENT);
        __syncthreads();
        const int bt = qw[2];
        __syncthreads();
        if (bt * BATCH_IT >= NIT) break;
        auto dec = [&](int j) { const int it = bt * BATCH_IT + j; const int e = it / PER_E; int r = it % PER_E; const size_t le = (size_t)l * NE + e;
            if (r < I_G) return TrItem{in_ptr(15) + le * D * DE, in_ptr(10) + l * D, (bf16_t*)(F.ws + WS_WGU + le * 1024 * D), D, DE, 6, r};
            r -= I_G;
            if (r < I_G) return TrItem{in_ptr(16) + le * D * DE, in_ptr(10) + l * D, (bf16_t*)(F.ws + WS_WGU + le * 1024 * D), D, DE, 7, r};
            r -= I_G;
            return TrItem{in_ptr(17) + le * DE * D, (const float*)nullptr, (bf16_t*)(F.ws + WS_WD + le * D * DE), DE, D, 5, r}; };
        float wa[32], wb[32];
        TrItem d0 = dec(F.wave); tr_load(d0, F.lane, wa);
#pragma unroll
        for (int jj = 0; jj < BATCH_IT / NWAVES; jj += 2) {
            TrItem d1 = dec(F.wave + (jj + 1) * NWAVES); tr_load(d1, F.lane, wb);
            tr_finish(d0, F.lane, wa, scr);
            if (jj + 2 < BATCH_IT / NWAVES) { d0 = dec(F.wave + (jj + 2) * NWAVES); tr_load(d0, F.lane, wa); }
            tr_finish(d1, F.lane, wb, scr);
        }
    }
    __syncthreads();
}
__device__ __forceinline__ void phase_attn_fast(Frame& F, int l, int qset) {
    if (qset < 2) moe_weights_beside(F, l, qset);
    PHASE_IDS(F);
    const unsigned xcc = xb_xcc_id();
    at::sa_loop(F, l, xcc, qset);
    if (PROBE_ID == 100 && l == 0) { __syncthreads(); at::sa_loop(F, l, xcc, 2); }
    at::attn_type_loop<1>(F, l, xcc, qset);
    if (PROBE_ID == 101 && l == 0) { __syncthreads(); at::attn_type_loop<1>(F, l, xcc, 2); }
    at::attn_type_loop<2>(F, l, xcc, qset);
    if (PROBE_ID == 102 && l == 0) { __syncthreads(); at::attn_type_loop<2>(F, l, xcc, 2); }
}

__device__ __forceinline__ bool in_ph(int lo, int hi, int k) { asm volatile("" : "+s"(lo), "+s"(hi)); return lo <= k && k < hi; }
constexpr int PH_TOTAL = 2 + 8 * DEPTH - 1;
__global__ void __launch_bounds__(NWAVES * 64, 2) fwd(Args args) {
    extern __shared__ __attribute__((aligned(16))) unsigned char lds[];
    Frame F;
    F.lds = (LAS unsigned char*)lds; PHASE_IDS(F);
    F.G = gridDim.x; F.ngw = F.G * NWAVES;
    F.out = args.out; F.ws = args.ws; F.ctl = (unsigned*)(args.ws + WS_CTL);
    volatile LAS unsigned* MISC = (volatile LAS unsigned*)(F.lds + MISC_OFF);
    if (F.tid < 32) MISC[F.tid] = 0u;
    __syncthreads();
    const int lo = args.ph_lo, hi = args.ph_hi;
    XcdBarrier bar; bar.bar = F.ctl + CW_BAR; bar.x = 0; bar.st = nullptr;
    if (hi - lo > 1) bar = xcd_barrier_post(F.ctl + CW_BAR, MISC + 8);
#define IN(k) in_ph(lo, hi, (k))
#define SEAM(k) do { if (IN(k) && IN((k) + 1)) xcd_barrier(bar); else __syncthreads(); } while (0)
#define RUN(k, code) do { if (IN(k)) { code; if (PROBE_ID == (k)) { xcd_barrier(bar); code; } } SEAM(k); } while (0)
    RUN(0, { phase_weights(F); phase_x0(F); });
    RUN(1, { phase_memkv_fast(F); phase_inproj_fast(F, 0); });
    { const int l = 0, pb = 2;
      if (IN(pb + 0)) { phase_attn_fast(F, l, 0); if (PROBE_ID == pb + 0) { xcd_barrier(bar); phase_attn_fast(F, l, 2); } } SEAM(pb + 0);
      RUN(pb + 1, { phase_groupnorm(F); });
      RUN(pb + 2, { phase_outproj_fast(F, l); });
      RUN(pb + 3, { phase_router_fast(F, l); });
      RUN(pb + 4, { phase_moe1_fast(F, l); });
      RUN(pb + 5, { phase_moe2_fast(F, l); });
      RUN(pb + 6, { phase_combine(F, l); });
      RUN(pb + 7, { phase_inproj_fast(F, 1); });
    }
    { const int l = 1, pb = 10;
      if (IN(pb + 0)) { phase_attn_fast(F, l, 1); if (PROBE_ID == pb + 0) { xcd_barrier(bar); phase_attn_fast(F, l, 3); } } SEAM(pb + 0);
      RUN(pb + 1, { phase_groupnorm(F); });
      RUN(pb + 2, { phase_outproj_fast(F, l); });
      RUN(pb + 3, { phase_router_fast(F, l); });
      RUN(pb + 4, { phase_moe1_fast(F, l); });
      RUN(pb + 5, { phase_moe2_fast(F, l); });
      RUN(pb + 6, { phase_combine(F, l); });
    }
#undef IN
#undef SEAM
#undef RUN
}

extern "C" void kernel_launch(void* const* d_in, const int* in_sizes, int n_in, void* d_out, int out_size, void* d_ws, size_t ws_size, hipStream_t stream) {
    static int grid = 0;
    if (grid == 0) {
        if (n_in != 18 || in_sizes[0] != T * D || out_size != T * D || ws_size < WS_END) { fprintf(stderr, "kernel_launch: unexpected shapes (n_in %d, in0 %d, out %d, ws %zu < %zu); nothing launched\n", n_in, n_in > 0 ? in_sizes[0] : -1, out_size, ws_size, (size_t)WS_END); grid = -1; return; }
        int dev = 0, cus = 0, per_cu = 0;
        if (hipGetDevice(&dev) != hipSuccess || hipDeviceGetAttribute(&cus, hipDeviceAttributeMultiprocessorCount, dev) != hipSuccess) { grid = -1; return; }
        if (hipFuncSetAttribute((const void*)fwd, hipFuncAttributeMaxDynamicSharedMemorySize, LDS_BYTES) != hipSuccess) { fprintf(stderr, "kernel_launch: hipFuncSetAttribute failed\n"); grid = -1; return; }
        if (hipOccupancyMaxActiveBlocksPerMultiprocessor(&per_cu, (const void*)fwd, NWAVES * 64, LDS_BYTES) != hipSuccess || per_cu < 1) fprintf(stderr, "kernel_launch: occupancy query reports %d\n", per_cu);
        (void)hipGetLastError();
        grid = cus;
    }
    if (grid < 0) return;
    if (hipMemsetAsync((char*)d_ws + WS_CTL, 0, CTL_ZERO_BYTES, stream) != hipSuccess) { fprintf(stderr, "kernel_launch: memset failed\n"); return; }
    Args a{};
    for (int i = 0; i < 18; ++i) a.in[i] = (const float*)d_in[i];
    a.out = (float*)d_out; a.ws = (unsigned char*)d_ws;
#if MK_ONE_LAUNCH
    a.ph_lo = 0; a.ph_hi = PH_TOTAL;
    hipLaunchKernelGGL(fwd, dim3(grid), dim3(NWAVES * 64), LDS_BYTES, stream, a);
#else
    for (int p = 0; p < PH_TOTAL; ++p) { a.ph_lo = p; a.ph_hi = p + 1; hipLaunchKernelGGL(fwd, dim3(grid), dim3(NWAVES * 64), LDS_BYTES, stream, a); }
#endif
    const hipError_t le = hipPeekAtLastError();
    if (le != hipSuccess) fprintf(stderr, "kernel_launch: launch failed: %s\n", hipGetErrorName(le));
}
```

```cpp
#include <hip/hip_runtime.h>
#include <cstdio>
#include <cstdint>

#ifndef PROBE_ID
#define PROBE_ID (-1)
#endif
#ifndef SPARSE_A
#define SPARSE_A 1
#endif
#ifndef MK_ONE_LAUNCH
#define MK_ONE_LAUNCH 1
#endif

constexpr int D = 1024, BATCH = 32, SEQ = 2048, T = BATCH * SEQ, DEPTH = 2;
constexpr int MEM_LEN = 256, TM = BATCH * MEM_LEN;
constexpr int HD = 64, INW = 2560, NHS = 40;
constexpr int NE = 32, EPG = 8, NGRP = 4, DE = 512;
constexpr float EPS = 1e-6f, LOG2E = 1.4426950408889634f, ATTN_SCALE = 0.125f;
constexpr int YROWS = 2 * T + NE * 256;

constexpr size_t MiB = 1u << 20;
constexpr size_t WS_CTL = 0, CTL_ZERO_BYTES = 1 * MiB;
constexpr size_t WS_WIN = 1 * MiB;
constexpr size_t WS_WMEM = WS_WIN + 10 * MiB;
constexpr size_t WS_WOUT = WS_WMEM + 2 * MiB;
constexpr size_t WS_WR = WS_WOUT + 4 * MiB;
constexpr size_t WS_WGU = WS_WR + 1 * MiB;
constexpr size_t WS_X8 = WS_WGU + 64 * MiB;
constexpr size_t WS_WD = WS_WGU + 128 * MiB;
constexpr size_t WS_FAB = WS_WD + 32 * MiB;
constexpr size_t WS_RM = WS_WD + 33 * MiB;
constexpr size_t WS_XB = WS_WD + 64 * MiB;
constexpr size_t WS_RS = WS_XB + 128 * MiB;
constexpr size_t WS_SSQ1 = WS_RS + 1 * MiB;
constexpr size_t WS_SSQH = WS_SSQ1 + 4 * MiB;
constexpr size_t WS_MB = WS_SSQH + 4 * MiB;
constexpr size_t WS_RSM = WS_MB + 16 * MiB;
constexpr size_t WS_MEMKV = WS_RSM + 1 * MiB;
constexpr size_t WS_ROUTE = WS_MEMKV + 16 * MiB;
constexpr size_t WS_LIST = WS_ROUTE + 1 * MiB;
constexpr size_t WS_WL = WS_LIST + 8 * MiB;
constexpr size_t WS_RSL = WS_WL + 8 * MiB;
constexpr size_t WS_QKV = WS_RSL + 8 * MiB;
constexpr size_t WS_MIX = WS_QKV + 320 * MiB;
constexpr size_t WS_PO = WS_MIX + 136 * MiB;
constexpr size_t WS_PL = WS_PO + 144 * MiB;
constexpr size_t WS_END = WS_PL + 6 * MiB;
static_assert(WS_END <= 1024 * MiB, "workspace map exceeds 1 GiB");
static_assert((size_t)YROWS * 1024 * 2 <= 320 * MiB && (size_t)YROWS * 512 * 4 <= 320 * MiB && (size_t)YROWS * 512 * 2 <= 136 * MiB, "aliases");
constexpr int CW_BAR = 4096;
constexpr int CW_WQ = 40960;
constexpr int CW_ATQ = 32768;
constexpr int CW_CNT = 16384;

constexpr int LDS_BYTES = 163840;
constexpr int CTRL_BASE = 159744;
constexpr int MISC_OFF = CTRL_BASE + 2048;
constexpr int NWAVES = 8;

#define GAS __attribute__((address_space(1)))
#define LAS __attribute__((address_space(3)))
typedef unsigned short bf16_t;
typedef unsigned u32x4 __attribute__((ext_vector_type(4)));
typedef unsigned u32x2 __attribute__((ext_vector_type(2)));
typedef float f32x4 __attribute__((ext_vector_type(4)));
#define RLX_AGENT __ATOMIC_RELAXED, __HIP_MEMORY_SCOPE_AGENT

__device__ __forceinline__ float bf2f(unsigned v) { return __uint_as_float(v << 16); }
__device__ __forceinline__ unsigned f2bf(float f) { unsigned u = __float_as_uint(f); return (u + 0x7fffu + ((u >> 16) & 1u)) >> 16; }
__device__ __forceinline__ unsigned pk2(float lo, float hi) { return f2bf(lo) | (f2bf(hi) << 16); }
__device__ __forceinline__ float wave_sum(float v) {
#pragma unroll
    for (int o = 1; o < 64; o <<= 1) v += __shfl_xor(v, o);
    return v;
}
__device__ __forceinline__ float wave_max(float v) {
#pragma unroll
    for (int o = 1; o < 64; o <<= 1) v = fmaxf(v, __shfl_xor(v, o));
    return v;
}

#define XB_TMO      128
#define XB_XCNT(j)  (256  + 64 * (j))
#define XB_XSUB(j)  (1280 + 64 * (j))
#define XB_XGEN(j)  (2304 + 64 * (j))
#define XB_TOP      3328
#define XB_TOPGEN   3392
#define XCD_BAR_WORDS 3456
#define XB_SPIN_CAP (1u << 18)
__device__ __forceinline__ unsigned xb_ld(unsigned* p)              { return __hip_atomic_load(p, __ATOMIC_RELAXED, __HIP_MEMORY_SCOPE_AGENT); }
__device__ __forceinline__ unsigned xb_add(unsigned* p, unsigned v) { return __hip_atomic_fetch_add(p, v, __ATOMIC_RELAXED, __HIP_MEMORY_SCOPE_AGENT); }
__device__ __forceinline__ unsigned xb_xcc_id() { return (unsigned)__builtin_amdgcn_s_getreg((3 << 11) | 20) & 0xFu; }
#define XB_SPIN(cond, bar) do { unsigned _sp = 0; while (cond) { __builtin_amdgcn_s_sleep(1); \
    if ((++_sp & 255u) == 0u) { if (xb_ld(&(bar)[XB_TMO])) break; if (_sp > XB_SPIN_CAP) { atomicAdd(&(bar)[XB_TMO], 1u); break; } } } } while (0)
struct XcdBarrier { unsigned* bar; unsigned x; volatile LAS unsigned* st; };
__device__ __forceinline__ XcdBarrier xcd_barrier_post(unsigned* bar, volatile LAS unsigned* st) {
    XcdBarrier b; b.bar = bar; b.x = xb_xcc_id(); b.st = st;
    if (threadIdx.x == 0) (void)xb_add(&bar[XB_XCNT(b.x)], 1u);
    return b;
}
__device__ __forceinline__ void xcd_barrier_complete(unsigned* bar, unsigned x, unsigned& nloc, unsigned& nx) {
    const unsigned G = gridDim.x * gridDim.y * gridDim.z;
    unsigned sum, cnt, mine, sp = 0u;
    for (;;) {
        sum = 0u; cnt = 0u; mine = 0u;
#pragma unroll
        for (unsigned j = 0; j < 16; ++j) { const unsigned c = xb_ld(&bar[XB_XCNT(j)]); sum += c; cnt += (c > 0u) ? 1u : 0u; mine = (j == x) ? c : mine; }
        if (sum == G) break;
        __builtin_amdgcn_s_sleep(1);
        if ((++sp & 255u) == 0u) { if (xb_ld(&bar[XB_TMO])) break; if (sp > XB_SPIN_CAP) { atomicAdd(&bar[XB_TMO], 1u); break; } }
    }
    nloc = mine > 0u ? mine : 1u; nx = cnt > 0u ? cnt : 1u;
}
__device__ __forceinline__ void xcd_barrier(const XcdBarrier& b) {
    asm volatile("s_waitcnt vmcnt(0)" ::: "memory");
    __syncthreads();
    if (threadIdx.x == 0) {
        unsigned* bar = b.bar;
        __builtin_amdgcn_s_waitcnt(0);
        unsigned nloc = b.st[0], nx = b.st[1];
        if (nloc == 0u) { xcd_barrier_complete(bar, b.x, nloc, nx); b.st[0] = nloc; b.st[1] = nx; }
        const unsigned old = xb_add(&bar[XB_XSUB(b.x)], 1u);
        const unsigned gen = old / nloc;
        if (old + 1u == (gen + 1u) * nloc) {
            __builtin_amdgcn_fence(__ATOMIC_RELEASE, "agent");
            asm volatile("s_waitcnt vmcnt(0)" ::: "memory");
            const unsigned og = xb_add(&bar[XB_TOP], 1u);
            const unsigned tg = og / nx;
            if (og + 1u == (tg + 1u) * nx) xb_add(&bar[XB_TOPGEN], 1u);
            else XB_SPIN(xb_ld(&bar[XB_TOPGEN]) == tg, bar);
            __builtin_amdgcn_fence(__ATOMIC_ACQUIRE, "agent");
            xb_add(&bar[XB_XGEN(b.x)], 1u);
            asm volatile("s_waitcnt vmcnt(0)" ::: "memory");
        } else {
            XB_SPIN(xb_ld(&bar[XB_XGEN(b.x)]) == gen, bar);
            __builtin_amdgcn_fence(__ATOMIC_ACQUIRE, "agent");
            asm volatile("s_waitcnt vmcnt(0)" ::: "memory");
        }
    }
    __syncthreads();
}

struct Args {
    const float* in[18]; float* out; unsigned char* ws; int ph_lo, ph_hi;
};
__device__ __forceinline__ const float* in_ptr(int k) {
    const __attribute__((address_space(4))) char* ka = (const __attribute__((address_space(4))) char*)__builtin_amdgcn_kernarg_segment_ptr();
    asm volatile("" : "+s"(ka));
    return *(const float* const __attribute__((address_space(4)))*)(ka + 8 * k);
}
struct Frame {
    LAS unsigned char* lds; int tid, lane, wave, G, gw, ngw;
    float* out; unsigned char* ws; unsigned* ctl;
};

#define PHASE_IDS(F) do { (F).tid = opaque_tid0(); (F).lane = (F).tid & 63; (F).wave = __builtin_amdgcn_readfirstlane((F).tid >> 6); (F).gw = blockIdx.x * NWAVES + (F).wave; } while (0)
__device__ __forceinline__ int opaque_tid0() { int t = threadIdx.x; asm volatile("" : "+v"(t)); return t; }
__host__ __device__ __forceinline__ int inproj_gemm_col(int H, int dim) {
    const int pn = H >> 2, wc = H & 3, bj = dim >> 5, fq = (dim >> 3) & 3, nn = (dim >> 2) & 1, j = dim & 3;
    return 256 * pn + 128 * bj + 32 * wc + 16 * nn + 4 * fq + j;
}
__host__ __device__ __forceinline__ void inproj_head_dim(int c, int& H, int& dim) {
    const int pn = c >> 8, r = c & 255, bj = r >> 7, wc = (r >> 5) & 3, nn = (r >> 4) & 1, fq = (r >> 2) & 3, j = r & 3;
    H = 4 * pn + wc; dim = 32 * bj + 8 * fq + 4 * nn + j;
}

struct TrItem { const float* W; const float* kgain; bf16_t* WT; int K, N, kind, item; };
__device__ __forceinline__ void tr_load(const TrItem& d, int lane, float (&wv)[32]) {
    const int nblk = d.N / 32, kb = d.item / nblk, nb = d.item % nblk, k0 = 64 * kb, n0 = 32 * nb;
#pragma unroll
    for (int i = 0; i < 32; ++i) wv[i] = d.W[(size_t)(k0 + 2 * i + (lane >> 5)) * d.N + n0 + (lane & 31)];
}
__device__ __forceinline__ int tr_rowmap(int kind, int n);
__device__ __forceinline__ void tr_finish(const TrItem& d, int lane, const float (&wv)[32], LAS float* scr) {
    const int nblk = d.N / 32, kb = d.item / nblk, nb = d.item % nblk, k0 = 64 * kb, n0 = 32 * nb;
#pragma unroll
    for (int i = 0; i < 32; ++i) { const int kk = 2 * i + (lane >> 5); const float g = d.kgain ? d.kgain[k0 + kk] : 1.f; scr[kk * 33 + (lane & 31)] = wv[i] * g; }
    asm volatile("s_waitcnt lgkmcnt(0)" ::: "memory");
    const int c = lane & 7;
#pragma unroll
    for (int j = 0; j < 4; ++j) { const int n = (lane >> 3) + 8 * j; const LAS float* s = scr + (8 * c) * 33 + n;
        u32x4 o; o.x = pk2(s[0 * 33], s[1 * 33]); o.y = pk2(s[2 * 33], s[3 * 33]); o.z = pk2(s[4 * 33], s[5 * 33]); o.w = pk2(s[6 * 33], s[7 * 33]);
        if (d.kind >= 5) {
            int w0 = 0, w1 = 0;
            w0 = __builtin_amdgcn_cvt_pk_fp8_f32(32.f * s[0 * 33], 32.f * s[1 * 33], w0, false); w0 = __builtin_amdgcn_cvt_pk_fp8_f32(32.f * s[2 * 33], 32.f * s[3 * 33], w0, true);
            w1 = __builtin_amdgcn_cvt_pk_fp8_f32(32.f * s[4 * 33], 32.f * s[5 * 33], w1, false); w1 = __builtin_amdgcn_cvt_pk_fp8_f32(32.f * s[6 * 33], 32.f * s[7 * 33], w1, true);
            u32x2 o8; o8.x = (unsigned)w0; o8.y = (unsigned)w1;
            *(u32x2*)((unsigned char*)d.WT + (size_t)tr_rowmap(d.kind, n0 + n) * d.K + k0 + 8 * c) = o8;
        } else *(u32x4*)(d.WT + (size_t)tr_rowmap(d.kind, n0 + n) * d.K + k0 + 8 * c) = o; }
    asm volatile("s_waitcnt lgkmcnt(0)" ::: "memory");
}
struct RmId { __device__ __forceinline__ int operator()(int n) const { return n; } };
struct RmHead { __device__ __forceinline__ int operator()(int n) const { return inproj_gemm_col(n >> 6, n & 63); } };
__host__ __device__ __forceinline__ int perm_row32(int c) { const int o = c & 31; return (c & ~31) | (16 * ((o >> 2) & 1) + 4 * (o >> 3) + (o & 3)); }
__host__ __device__ __forceinline__ int gate_row(int c, int up) { return 256 * (c >> 7) + 128 * up + perm_row32(c & 127); }
struct RmGate { int up; __device__ __forceinline__ int operator()(int n) const { return gate_row(n, up); } };
struct RmPerm { __device__ __forceinline__ int operator()(int n) const { return perm_row32(n); } };
__device__ __forceinline__ int tr_rowmap(int kind, int n) { return kind == 0 ? n : ((kind == 1 || kind == 8) ? inproj_gemm_col(n >> 6, n & 63) : ((kind == 2 || kind == 6) ? gate_row(n, 0) : ((kind == 3 || kind == 7) ? gate_row(n, 1) : perm_row32(n)))); }

__device__ __forceinline__ TrItem tr_decode_small(int it) {
    constexpr int I_IN = 16 * 80, I_MEM = 16 * 16, I_OUT = 16 * 32, PER_L = I_IN + I_MEM + I_OUT;
    const int l = it / PER_L; int r = it % PER_L;
    if (r < I_IN) return TrItem{in_ptr(3) + (size_t)l * D * INW, in_ptr(2) + l * D, (bf16_t*)nullptr, D, INW, 100 + l, r};
    r -= I_IN;
    if (r < I_MEM) return TrItem{in_ptr(7) + (size_t)l * D * 512, in_ptr(6) + l * D, (bf16_t*)nullptr, D, 512, 200 + l, r};
    r -= I_MEM;
    return TrItem{in_ptr(9) + (size_t)l * D * D, in_ptr(8) + l * D, (bf16_t*)nullptr, D, D, 300 + l, r};
}
__device__ __forceinline__ void phase_weights(Frame& F) {
    PHASE_IDS(F);
    LAS float* scr = (LAS float*)(F.lds + F.wave * 16384);
    constexpr int PER_L = 16 * 80 + 16 * 16 + 16 * 32, NIT = DEPTH * PER_L;
    auto fix = [&](TrItem d) { const int l = d.kind % 100, w = d.kind / 100;
        if (w == 1) { if (l == 0) { d.WT = (bf16_t*)(F.ws + WS_WIN); d.kind = 1; } else { d.WT = (bf16_t*)(F.ws + WS_WIN + (size_t)INW * D * 2); d.kind = 8; } } else if (w == 2) { d.WT = (bf16_t*)(F.ws + WS_WMEM) + (size_t)l * 512 * D; d.kind = 1; } else { d.WT = (bf16_t*)(F.ws + WS_WOUT) + (size_t)l * D * D; d.kind = 4; }
        return d; };
    float wa[32], wb[32];
    int it = F.gw;
    if (it < NIT) { TrItem d = fix(tr_decode_small(it)); tr_load(d, F.lane, wa);
        for (;;) {
            const int it2 = it + F.ngw; TrItem d2 = d; const bool more = it2 < NIT;
            if (more) { d2 = fix(tr_decode_small(it2)); tr_load(d2, F.lane, wb); }
            tr_finish(d, F.lane, wa, scr);
            if (!more) break;
            const int it3 = it2 + F.ngw; const bool more3 = it3 < NIT; TrItem d3 = d2;
            if (more3) { d3 = fix(tr_decode_small(it3)); tr_load(d3, F.lane, wa); }
            tr_finish(d2, F.lane, wb, scr);
            if (!more3) break;
            it = it3; d = d3;
        } }
    for (int i = F.gw * 64 + F.lane; i < DEPTH * 256 * D; i += F.ngw * 64) {
        const int l = i / (256 * D), j = (i / D) % 256, k = i % D; float v = 0.f;
        if (j < 4) v = in_ptr(11)[((size_t)l * D + k) * NGRP + j] * in_ptr(10)[l * D + k]; else if (j < 36) v = in_ptr(13)[((size_t)l * D + k) * NE + (j - 4)] * in_ptr(10)[l * D + k];
        ((bf16_t*)(F.ws + WS_WR))[i] = (bf16_t)f2bf(v);
    }
}

__device__ __forceinline__ void row_to_bf16_rs(int lane, const float* xrow, bf16_t* orow, float* rs) {
    const f32x4* xr = (const f32x4*)xrow + lane; f32x4 v[4]; float s = 0.f;
#pragma unroll
    for (int j = 0; j < 4; ++j) { v[j] = xr[64 * j]; s += (v[j].x * v[j].x + v[j].y * v[j].y) + (v[j].z * v[j].z + v[j].w * v[j].w); }
    s = wave_sum(s);
    if (lane == 0) *rs = 1.0f / sqrtf(s * (1.f / D) + EPS);
    u32x2* o8 = (u32x2*)orow + lane;
#pragma unroll
    for (int j = 0; j < 4; ++j) { u32x2 w; w.x = pk2(v[j].x, v[j].y); w.y = pk2(v[j].z, v[j].w); o8[64 * j] = w; }
}
__device__ __forceinline__ void phase_x0(Frame& F) {
    PHASE_IDS(F);
    const float* xp = in_ptr(0); const float* mp = in_ptr(1); const int lane = F.lane;
    for (int m0 = F.gw * 2; m0 < T + TM; m0 += F.ngw * 2) {
        const bool isx = m0 < T; const int r0 = isx ? m0 : m0 - T;
        const float* src = (isx ? xp : mp) + (size_t)r0 * D; bf16_t* dst = (bf16_t*)(F.ws + (isx ? WS_XB : WS_MB)) + (size_t)r0 * D; float* rs = (float*)(F.ws + (isx ? WS_RS : WS_RSM)) + r0;
        f32x4 v[2][4];
#pragma unroll
        for (int k = 0; k < 2; ++k)
#pragma unroll
            for (int j = 0; j < 4; ++j) v[k][j] = ((const f32x4*)(src + (size_t)k * D) + lane)[64 * j];
#pragma unroll
        for (int k = 0; k < 2; ++k) { float s = 0.f;
#pragma unroll
            for (int j = 0; j < 4; ++j) s += (v[k][j].x * v[k][j].x + v[k][j].y * v[k][j].y) + (v[k][j].z * v[k][j].z + v[k][j].w * v[k][j].w);
            s = wave_sum(s);
            if (lane == 0) rs[k] = 1.0f / sqrtf(s * (1.f / D) + EPS);
            u32x2* o8 = (u32x2*)(dst + (size_t)k * D) + lane;
#pragma unroll
            for (int j = 0; j < 4; ++j) { u32x2 w; w.x = pk2(v[k][j].x, v[k][j].y); w.y = pk2(v[k][j].z, v[k][j].w); o8[64 * j] = w; } }
    }
}

__device__ __forceinline__ bf16_t* qkv_ptr(Frame& F, int H, int t) { return (bf16_t*)(F.ws + WS_QKV) + ((size_t)H * T + t) * HD; }
__device__ __forceinline__ bf16_t* memkv_ptr(Frame& F, int l, int H, int r) { return (bf16_t*)(F.ws + WS_MEMKV) + (((size_t)l * 8 + H) * TM + r) * HD; }

__device__ __forceinline__ void slice_kind(int H, int& gi, bool& isq) {
    gi = -1; isq = false;
    if (H < 6) { gi = 0; isq = true; } else if (H < 12) gi = 1; else if (H < 18) gi = -1;
    else if (H < 24) { gi = 2; isq = true; } else if (H < 30) gi = 3; else if (H < 36) gi = -1; else { gi = 4; isq = true; }
}
__device__ __forceinline__ void phase_groupnorm(Frame& F) {
    PHASE_IDS(F);
    const int lane = F.lane, half = lane >> 5, l32 = lane & 31, h = l32 >> 2; const bool act = l32 < 24;
    const bf16_t* PO = (const bf16_t*)(F.ws + WS_PO); const float* PL = (const float*)(F.ws + WS_PL); bf16_t* MX = (bf16_t*)(F.ws + WS_MIX);
    const float* SQ = (const float*)(F.ws + WS_SSQH); float* FAB = (float*)(F.ws + WS_FAB); float* RM = (float*)(F.ws + WS_RM);
    for (int t0 = F.gw * 8; t0 < T; t0 += F.ngw * 8) {
        u32x4 raw[4][3][2]; float den[4][3]; f32x4 sq[4][3];
#pragma unroll
        for (int u = 0; u < 4; ++u) { const int t = t0 + 2 * u + half;
            if (act) {
#pragma unroll
                for (int p = 0; p < 3; ++p) { const u32x4* pp = (const u32x4*)(PO + ((size_t)p * T + t) * 384 + l32 * 16); raw[u][p][0] = pp[0]; raw[u][p][1] = pp[1]; den[u][p] = PL[((size_t)p * T + t) * 8 + h]; }
            }
#pragma unroll
            for (int q = 0; q < 3; ++q) sq[u][q] = *(const f32x4*)(SQ + (size_t)t * 16 + 4 + 4 * q);
        }
#pragma unroll
        for (int u = 0; u < 4; ++u) { const int t = t0 + 2 * u + half; float v[16]; float s = 0.f;
            if (act) {
#pragma unroll
                for (int i = 0; i < 2; ++i) { const u32x4 w = raw[u][0][i]; v[8 * i + 0] = bf2f(w.x & 0xffffu); v[8 * i + 1] = bf2f(w.x >> 16); v[8 * i + 2] = bf2f(w.y & 0xffffu); v[8 * i + 3] = bf2f(w.y >> 16);
                    v[8 * i + 4] = bf2f(w.z & 0xffffu); v[8 * i + 5] = bf2f(w.z >> 16); v[8 * i + 6] = bf2f(w.w & 0xffffu); v[8 * i + 7] = bf2f(w.w >> 16); }
#pragma unroll
                for (int p = 1; p < 3; ++p)
#pragma unroll
                    for (int i = 0; i < 2; ++i) { const u32x4 w = raw[u][p][i]; v[8 * i + 0] += bf2f(w.x & 0xffffu); v[8 * i + 1] += bf2f(w.x >> 16); v[8 * i + 2] += bf2f(w.y & 0xffffu); v[8 * i + 3] += bf2f(w.y >> 16);
                        v[8 * i + 4] += bf2f(w.z & 0xffffu); v[8 * i + 5] += bf2f(w.z >> 16); v[8 * i + 6] += bf2f(w.w & 0xffffu); v[8 * i + 7] += bf2f(w.w >> 16); }
                const float rd = 1.0f / ((den[u][0] + den[u][1]) + den[u][2]);
                u32x4 o[2];
#pragma unroll
                for (int i = 0; i < 2; ++i) { o[i].x = pk2(v[8 * i + 0] * rd, v[8 * i + 1] * rd); o[i].y = pk2(v[8 * i + 2] * rd, v[8 * i + 3] * rd); o[i].z = pk2(v[8 * i + 4] * rd, v[8 * i + 5] * rd); o[i].w = pk2(v[8 * i + 6] * rd, v[8 * i + 7] * rd);
                    float a;
                    a = bf2f(o[i].x & 0xffffu); s += a * a; a = bf2f(o[i].x >> 16); s += a * a; a = bf2f(o[i].y & 0xffffu); s += a * a; a = bf2f(o[i].y >> 16); s += a * a;
                    a = bf2f(o[i].z & 0xffffu); s += a * a; a = bf2f(o[i].z >> 16); s += a * a; a = bf2f(o[i].w & 0xffffu); s += a * a; a = bf2f(o[i].w >> 16); s += a * a; }
                u32x4* mp = (u32x4*)(MX + (size_t)t * D + l32 * 16); mp[0] = o[0]; mp[1] = o[1];
            }
            s += __shfl_xor(s, 1); s += __shfl_xor(s, 2); s += __shfl_xor(s, 4); s += __shfl_xor(s, 8); s += __shfl_xor(s, 16);
            if (l32 == 0) {
                const float sb = ((sq[u][0][2] + sq[u][0][3]) + (sq[u][1][0] + sq[u][1][1])) + (sq[u][1][2] + sq[u][1][3]), sm = (sq[u][2][0] + sq[u][2][1]) + (sq[u][2][2] + sq[u][2][3]);
                const float ra = 1.f / sqrtf(s * (1.f / 384.f) + EPS), rb = 1.f / sqrtf(sb * (1.f / 384.f) + EPS), rmv = 1.f / sqrtf(sm * (1.f / 256.f) + EPS);
                FAB[(size_t)t * 2] = ra / rb; FAB[(size_t)t * 2 + 1] = rb / rmv; RM[t] = rmv; }
        }
    }
}
__device__ __forceinline__ void load_expert_table(LAS int* tab, const unsigned* cnt) {
    const int tid = opaque_tid0(), lane = tid & 63;
    if (tid < 64) {
        const int c = lane < NE ? (int)__hip_atomic_load(cnt + lane * 64, RLX_AGENT) : 0;
        int inc = (c + 255) >> 8;
#pragma unroll
        for (int o = 1; o < 64; o <<= 1) { const int v = __shfl_up(inc, o); if (lane >= o) inc += v; }
        tab[lane] = inc - ((c + 255) >> 8); tab[64 + lane] = c;
    }
    __syncthreads();
}
__device__ __forceinline__ float cl8(float v) { return fminf(fmaxf(v, -440.f), 440.f); }
__device__ __forceinline__ void phase_combine(Frame& F, int l) {
    PHASE_IDS(F);
    LAS int* tab = (LAS int*)(F.lds + CTRL_BASE);
    load_expert_table(tab, F.ctl + CW_CNT + l * NE * 64);
    const unsigned char* Y = (const unsigned char*)(F.ws + WS_QKV); const int lane = F.lane;
    typedef float f32x2_t __attribute__((ext_vector_type(2)));
    typedef int i32x4_t __attribute__((ext_vector_type(4)));
    constexpr int TK = 2;
    for (int t0 = F.gw * TK; t0 < T; t0 += F.ngw * TK) {
        i32x4_t rt[TK];
#pragma unroll
        for (int k = 0; k < TK; ++k) rt[k] = *(const i32x4_t*)((const int*)(F.ws + WS_ROUTE) + (size_t)(t0 + k) * 4);
        u32x2 xv[TK][4]; unsigned ya[TK][4], yb[TK][4];
#pragma unroll
        for (int k = 0; k < TK; ++k) { int ea = rt[k][0], pa = rt[k][1], eb = rt[k][2], pb = rt[k][3];
            if (ea > eb) { int q = ea; ea = eb; eb = q; q = pa; pa = pb; pb = q; }
            const unsigned* pya = (const unsigned*)(Y + (size_t)(tab[ea] * 256 + pa) * D) + lane; const unsigned* pyb = (const unsigned*)(Y + (size_t)(tab[eb] * 256 + pb) * D) + lane;
            const u32x2* xr = (const u32x2*)((const bf16_t*)(F.ws + WS_XB) + (size_t)(t0 + k) * D) + lane;
#pragma unroll
            for (int j = 0; j < 4; ++j) { xv[k][j] = xr[64 * j]; ya[k][j] = pya[64 * j]; yb[k][j] = pyb[64 * j]; } }
#pragma unroll
        for (int k = 0; k < TK; ++k) { const int t = t0 + k; f32x4 v[4]; float s = 0.f;
#pragma unroll
            for (int j = 0; j < 4; ++j) { const u32x2 x = xv[k][j]; const int a = (int)ya[k][j], b2 = (int)yb[k][j];
                const f32x2_t a0 = __builtin_amdgcn_cvt_pk_f32_fp8(a, false), a1 = __builtin_amdgcn_cvt_pk_f32_fp8(a, true), b0 = __builtin_amdgcn_cvt_pk_f32_fp8(b2, false), b1 = __builtin_amdgcn_cvt_pk_f32_fp8(b2, true);
                v[j].x = (bf2f(x.x & 0xffffu) + 0.125f * a0[0]) + 0.125f * b0[0]; v[j].y = (bf2f(x.x >> 16) + 0.125f * a0[1]) + 0.125f * b0[1];
                v[j].z = (bf2f(x.y & 0xffffu) + 0.125f * a1[0]) + 0.125f * b1[0]; v[j].w = (bf2f(x.y >> 16) + 0.125f * a1[1]) + 0.125f * b1[1]; }
            if (l + 1 < DEPTH) {
                u32x2* o8 = (u32x2*)((bf16_t*)(F.ws + WS_XB) + (size_t)t * D) + lane;
#pragma unroll
                for (int j = 0; j < 4; ++j) { u32x2 w; w.x = pk2(v[j].x, v[j].y); w.y = pk2(v[j].z, v[j].w); o8[64 * j] = w;
                    const float o0 = bf2f(w.x & 0xffffu), o1 = bf2f(w.x >> 16), o2 = bf2f(w.y & 0xffffu), o3 = bf2f(w.y >> 16); s += (o0 * o0 + o1 * o1) + (o2 * o2 + o3 * o3);
                    int q8 = 0; q8 = __builtin_amdgcn_cvt_pk_fp8_f32(cl8(16.f * o0), cl8(16.f * o1), q8, false); q8 = __builtin_amdgcn_cvt_pk_fp8_f32(cl8(16.f * o2), cl8(16.f * o3), q8, true);
                    ((int*)(F.ws + WS_X8 + (size_t)t * D))[lane + 64 * j] = q8; }
                s = wave_sum(s);
                if (lane == 0) ((float*)(F.ws + WS_RS))[t] = 1.0f / sqrtf(s * (1.f / D) + EPS);
            } else {
                f32x4* xo = (f32x4*)(F.out + (size_t)t * D) + lane;
#pragma unroll
                for (int j = 0; j < 4; ++j) xo[64 * j] = v[j];
            }
        }
    }
}

namespace g8 {
typedef short bf16x8 __attribute__((ext_vector_type(8)));
constexpr int BK = 64, HALF = 128, HTB = HALF * BK * 2, NXCD = 8, WGM = 8;
__device__ __forceinline__ int lds_byte(int r, int c) { const int st = (r >> 4) * 2 + (c >> 5), rr = r & 15, cc = c & 31, ob = rr * 64 + cc * 2; return st * 1024 + (ob ^ (((ob >> 9) & 1) << 5)); }
__device__ __forceinline__ void stage_rc(int b, int& R, int& C) { const int st = b / 1024, sb = b % 1024, swz = sb ^ (((sb >> 9) & 1) << 5); R = (st >> 1) * 16 + swz / 64; C = (st & 1) * 32 + (swz % 64) / 2; }
__device__ __forceinline__ unsigned cvt_pk_bf16(float lo, float hi) { unsigned r; asm volatile("v_cvt_pk_bf16_f32 %0, %1, %2" : "=v"(r) : "v"(lo), "v"(hi)); return r; }
__device__ __forceinline__ int opaque_tid() { int t = threadIdx.x; asm volatile("" : "+v"(t)); return t; }
__device__ __forceinline__ const char* uni(const char* p) { const unsigned long long v = (unsigned long long)p;
    return (const char*)(((unsigned long long)(unsigned)__builtin_amdgcn_readfirstlane((int)(v >> 32)) << 32) | (unsigned)__builtin_amdgcn_readfirstlane((int)v)); }
typedef int i32x8 __attribute__((ext_vector_type(8)));
typedef int i32x4v __attribute__((ext_vector_type(4)));
__device__ __forceinline__ float clamp8(float v) { return fminf(fmaxf(v, -440.f), 440.f); }
__device__ __forceinline__ i32x8 cat8(i32x4v a, i32x4v b) { return __builtin_shufflevector(a, b, 0, 1, 2, 3, 4, 5, 6, 7); }
__device__ __forceinline__ bf16x8 lo8(i32x8 v) { return __builtin_bit_cast(bf16x8, (i32x4v)__builtin_shufflevector(v, v, 0, 1, 2, 3)); }
__device__ __forceinline__ bf16x8 hi8(i32x8 v) { return __builtin_bit_cast(bf16x8, (i32x4v)__builtin_shufflevector(v, v, 4, 5, 6, 7)); }
struct Unit { const char* B; unsigned a00, a01, a10, a11; int pm, pn, e, ti, ce; };
struct DenseSched {
    int nM, nN, nwg, G, c, K; const char* Bbase;
    __device__ __forceinline__ void init(int M, int N, int K_, int G_, int c_, int tid, const void* Bt) { nM = M / 256; nN = N / 256; nwg = nM * nN; G = G_; c = c_; K = K_; Bbase = (const char*)Bt; }
    __device__ __forceinline__ bool next(int i, Unit& u) const {
        const long L = (long)i * G + c; if (L >= nwg) return false;
        int wgid = (int)L; { const int q = nwg / NXCD, r = nwg % NXCD, xcd = wgid % NXCD, off = wgid / NXCD; wgid = (xcd < r ? xcd * (q + 1) : r * (q + 1) + (xcd - r) * q) + off; }
        const int nig = WGM * nN, gid = wgid / nig, fm = gid * WGM, gsz = (nM - fm) < WGM ? (nM - fm) : WGM;
        u.pm = fm + ((wgid % nig) % gsz); u.pn = (wgid % nig) / gsz; u.e = 0; u.ti = 0; u.ce = 0;
        u.B = Bbase + (size_t)u.pn * 256 * K * 2;
        int R[2], C[2]; { const int tid = opaque_tid(); stage_rc(tid * 16, R[0], C[0]); stage_rc(tid * 16 + 8192, R[1], C[1]); }
        u.a00 = (unsigned)((u.pm * 256 + R[0]) * K + C[0]) * 2u; u.a01 = (unsigned)((u.pm * 256 + R[1]) * K + C[1]) * 2u;
        u.a10 = (unsigned)((u.pm * 256 + 128 + R[0]) * K + C[0]) * 2u; u.a11 = (unsigned)((u.pm * 256 + 128 + R[1]) * K + C[1]) * 2u;
        return true;
    }
};
struct GroupSched {
    int NP, total, G, vb, K; const char* Bbase; size_t Bstride; const int* list; bool gather; LAS int* tab;
    __device__ __forceinline__ void init(LAS int* tab_, const unsigned* cnt, int NP_, int K_, int G_, int bid, const void* Bt, size_t Bstride_, const int* list_, bool gather_) {
        const int tid = opaque_tid(), lane = tid & 63; NP = NP_; K = K_; G = G_; vb = (G_ % 8 == 0) ? (bid % 8) * (G_ / 8) + bid / 8 : bid; Bbase = (const char*)Bt; Bstride = Bstride_; list = list_; gather = gather_; tab = tab_;
        const int c = lane < NE ? (int)__hip_atomic_load(cnt + lane * 64, RLX_AGENT) : 0;
        int inc = (c + 255) >> 8;
#pragma unroll
        for (int o = 1; o < 64; o <<= 1) { const int v = __shfl_up(inc, o); if (lane >= o) inc += v; }
        total = __builtin_amdgcn_readfirstlane(__shfl(inc, 63)) * NP;
        if (tid < 64) { tab[lane] = inc - ((c + 255) >> 8); tab[64 + lane] = c; }
        __syncthreads();
    }
    __device__ __forceinline__ bool next(int i, Unit& u) const {
        const int L = i * G + vb; if (L >= total) return false;
        const int tid = opaque_tid(), g = L / NP, lane = tid & 63; u.pn = L % NP; u.pm = g;
        int R[2], C[2]; stage_rc(tid * 16, R[0], C[0]); stage_rc(tid * 16 + 8192, R[1], C[1]);
        const int e = __builtin_amdgcn_readfirstlane(__popcll(__ballot(lane < NE && tab[lane] <= g)) - 1);
        u.e = e; u.ti = g - __builtin_amdgcn_readfirstlane(tab[e]); u.ce = __builtin_amdgcn_readfirstlane(tab[64 + e]);
        u.B = Bbase + (size_t)e * Bstride + (size_t)u.pn * 256 * K * 2;
        if (gather) {
            const int* le = list + (size_t)e * T; const int b = u.ti * 256, mx = u.ce - 1;
            const int t00 = le[min(b + R[0], mx)], t01 = le[min(b + R[1], mx)], t10 = le[min(b + 128 + R[0], mx)], t11 = le[min(b + 128 + R[1], mx)];
            u.a00 = (unsigned)(t00 * K + C[0]) * 2u; u.a01 = (unsigned)(t01 * K + C[1]) * 2u; u.a10 = (unsigned)(t10 * K + C[0]) * 2u; u.a11 = (unsigned)(t11 * K + C[1]) * 2u;
        } else {
            u.a00 = (unsigned)((g * 256 + R[0]) * K + C[0]) * 2u; u.a01 = (unsigned)((g * 256 + R[1]) * K + C[1]) * 2u;
            u.a10 = (unsigned)((g * 256 + 128 + R[0]) * K + C[0]) * 2u; u.a11 = (unsigned)((g * 256 + 128 + R[1]) * K + C[1]) * 2u;
        }
        return true;
    }
};

template <class Epi, class Sched>
__device__ __forceinline__ void gemm_phase(LAS unsigned char* lds, const void* Abase_, int K, const Sched& S, const Epi& E) {
    const int tid = opaque_tid(), wid = __builtin_amdgcn_readfirstlane(tid >> 6), lane = tid & 63, wr = wid >> 2, wc = wid & 3, fr = lane & 15, fq = lane >> 4;
    int nt = K / BK; asm volatile("" : "+s"(nt)); const char* Abase = (const char*)Abase_;
    unsigned voffB[2];
#pragma unroll
    for (int i = 0; i < 2; ++i) { int R, C; stage_rc(tid * 16 + i * 8192, R, C); voffB[i] = (unsigned)(R * K + C) * 2u; }
    const size_t kstep = (size_t)(BK * 2), hstep = (size_t)HALF * K * 2;
    const unsigned ldsw = (unsigned)wid * 1024u;
    const int aoff = lds_byte(wr * 64 + fr, fq * 8), boff = lds_byte(wc * 32 + fr, fq * 8);
#define G8_SA(b, h) (((b) * 2 + (h)) * HTB)
#define G8_SB(b, h) ((4 + (b) * 2 + (h)) * HTB)
#define G8_STAGE(bufoff, gbase, voff) do { const char* _g = uni((const char*)(gbase)); _Pragma("unroll") for (int _i = 0; _i < 2; ++_i) \
        __builtin_amdgcn_global_load_lds((const unsigned*)(_g + (voff)[_i]), (LAS unsigned*)(lds + (bufoff) + ldsw + _i * 8192), 16, 0, 0); } while (0)
#define G8_STAGE_A(bufoff, gbase, o0, o1) do { const char* _g = uni((const char*)(gbase)); \
        __builtin_amdgcn_global_load_lds((const unsigned*)(_g + (o0)), (LAS unsigned*)(lds + (bufoff) + ldsw), 16, 0, 0); \
        __builtin_amdgcn_global_load_lds((const unsigned*)(_g + (o1)), (LAS unsigned*)(lds + (bufoff) + ldsw + 8192), 16, 0, 0); } while (0)
#define G8_LDA(dst, b, h) do { _Pragma("unroll") for (int m = 0; m < 4; ++m) dst[m] = cat8(*(const LAS i32x4v*)(lds + G8_SA(b, h) + aoff + m * 2048), *(const LAS i32x4v*)(lds + G8_SA(b, h) + aoff + m * 2048 + 1024)); } while (0)
#define G8_LDB(dst, b, h) do { _Pragma("unroll") for (int n = 0; n < 2; ++n) dst[n] = cat8(*(const LAS i32x4v*)(lds + G8_SB(b, h) + boff + n * 2048), *(const LAS i32x4v*)(lds + G8_SB(b, h) + boff + n * 2048 + 1024)); } while (0)
#define G8_MMA(ai, bj, At, Bt) do { __builtin_amdgcn_s_setprio(1); _Pragma("unroll") for (int m = 0; m < 4; ++m) _Pragma("unroll") for (int n = 0; n < 2; ++n) { \
        if constexpr (Epi::FP8) acc[ai][bj][m][n] = __builtin_amdgcn_mfma_scale_f32_16x16x128_f8f6f4(Bt[n], At[m], acc[ai][bj][m][n], 0, 0, 0, 0x7F7F7F7F, 0, 0x7F7F7F7F); \
        else { acc[ai][bj][m][n] = __builtin_amdgcn_mfma_f32_16x16x32_bf16(lo8(Bt[n]), lo8(At[m]), acc[ai][bj][m][n], 0, 0, 0); \
               acc[ai][bj][m][n] = __builtin_amdgcn_mfma_f32_16x16x32_bf16(hi8(Bt[n]), hi8(At[m]), acc[ai][bj][m][n], 0, 0, 0); } } __builtin_amdgcn_s_setprio(0); } while (0)
#define G8_WAIT_V(n) asm volatile("s_waitcnt vmcnt(" #n ")" ::: "memory")
#define G8_WAIT_L(n) asm volatile("s_waitcnt lgkmcnt(" #n ")" ::: "memory")
#define G8_BAR __builtin_amdgcn_s_barrier()
#define G8_SCHED __builtin_amdgcn_sched_barrier(0)
    Unit cur, nxt; int ui = 0;
    if (!S.next(0, cur)) return;
    constexpr int FACL = 131072;
#define G8_FAC(u_, par_) __builtin_amdgcn_global_load_lds((const unsigned*)(E.fab + (size_t)(u_).pm * 512 + tid), (LAS unsigned*)(lds + FACL + (par_) * 2048 + wid * 256), 4, 0, 0)
    if constexpr (Epi::RESCALE) G8_FAC(cur, 0);
    f32x4 acc[2][2][4][2];
#pragma unroll
    for (int a = 0; a < 2; ++a)
#pragma unroll
        for (int b = 0; b < 2; ++b)
#pragma unroll
            for (int m = 0; m < 4; ++m)
#pragma unroll
                for (int n = 0; n < 2; ++n) acc[a][b][m][n] = (f32x4){0.f, 0.f, 0.f, 0.f};
    i32x8 At[4], B0[2], B1[2];
    unsigned a00 = cur.a00, a01 = cur.a01, a10 = cur.a10, a11 = cur.a11;
    G8_STAGE(G8_SB(0, 0), cur.B, voffB); G8_STAGE(G8_SB(0, 1), cur.B + hstep, voffB); G8_STAGE_A(G8_SA(0, 0), Abase, a00, a01); G8_STAGE_A(G8_SA(0, 1), Abase, a10, a11);
    if (wr == 1) G8_BAR;
    G8_WAIT_V(2); G8_BAR;
    G8_STAGE(G8_SB(1, 0), cur.B + kstep, voffB); G8_STAGE_A(G8_SA(1, 0), Abase + kstep, a00, a01); G8_STAGE(G8_SB(1, 1), cur.B + hstep + kstep, voffB);
    G8_WAIT_V(6); G8_BAR;
    for (;;) {
        bool has_next = false; const char* curB = cur.B; const char* nB = curB;
        for (int t = 0; t < nt; t += 2) {
            const bool last = (t == nt - 2);
            if (t == nt - 4) { has_next = S.next(ui + 1, nxt); if (has_next) nB = nxt.B;
                if constexpr (Epi::RESCALE) { if (has_next) G8_FAC(nxt, (ui + 1) & 1); } }
            if constexpr (Epi::RESCALE) {
                if (t == 6 || t == 12) { const LAS float* fl = (const LAS float*)(lds + FACL + (ui & 1) * 2048) + (t == 12 ? 1 : 0);
#pragma unroll
                    for (int ai = 0; ai < 2; ++ai)
#pragma unroll
                        for (int m = 0; m < 4; ++m) { const float f = fl[(ai * HALF + wr * 64 + m * 16 + fr) * 2];
#pragma unroll
                            for (int bj = 0; bj < 2; ++bj)
#pragma unroll
                                for (int n = 0; n < 2; ++n) acc[ai][bj][m][n] = acc[ai][bj][m][n] * f; } } }
            const char* a1 = Abase + (size_t)(t + 1) * kstep;
            const char* a2 = last ? Abase : Abase + (size_t)(t + 2) * kstep; const char* b2 = last ? nB : curB + (size_t)(t + 2) * kstep;
            const char* a3 = a2 + kstep; const char* b3 = b2 + kstep;
            G8_LDB(B0, 0, 0); G8_LDB(B1, 0, 1); G8_SCHED; G8_LDA(At, 0, 0); G8_STAGE_A(G8_SA(1, 1), a1, a10, a11);
            if (last && has_next) { a00 = nxt.a00; a01 = nxt.a01; a10 = nxt.a10; a11 = nxt.a11; }
            G8_WAIT_V(8); G8_WAIT_L(0); G8_BAR; G8_MMA(0, 0, At, B0); G8_MMA(0, 1, At, B1); G8_BAR; G8_SCHED;
            G8_LDA(At, 0, 1); G8_STAGE(G8_SB(0, 0), b2, voffB); G8_STAGE(G8_SB(0, 1), b2 + hstep, voffB); G8_STAGE_A(G8_SA(0, 0), a2, a00, a01);
            G8_WAIT_V(8); G8_WAIT_L(0); G8_BAR; G8_MMA(1, 0, At, B0); G8_MMA(1, 1, At, B1); G8_BAR; G8_SCHED;
            G8_LDB(B0, 1, 0); G8_LDB(B1, 1, 1); G8_SCHED; G8_LDA(At, 1, 0); G8_STAGE_A(G8_SA(0, 1), a2, a10, a11);
            G8_WAIT_V(8); G8_WAIT_L(0); G8_BAR; G8_MMA(0, 0, At, B0); G8_MMA(0, 1, At, B1); G8_BAR; G8_SCHED;
            G8_LDA(At, 1, 1); G8_STAGE(G8_SB(1, 0), b3, voffB); G8_STAGE(G8_SB(1, 1), b3 + hstep, voffB); G8_STAGE_A(G8_SA(1, 0), a3, a00, a01);
            G8_WAIT_V(8); G8_WAIT_L(0); G8_BAR; G8_MMA(1, 0, At, B0); G8_MMA(1, 1, At, B1); G8_BAR; G8_SCHED;
        }
        if (wr == 0) G8_BAR;
        if constexpr (!Epi::AFTER_DRAIN) E(acc, cur, wr, wc, fr, fq);
        if (!has_next) break;
#pragma unroll
        for (int a = 0; a < 2; ++a)
#pragma unroll
            for (int b = 0; b < 2; ++b)
#pragma unroll
                for (int m = 0; m < 4; ++m)
#pragma unroll
                    for (int n = 0; n < 2; ++n) acc[a][b][m][n] = (f32x4){0.f, 0.f, 0.f, 0.f};
        cur = nxt; ++ui;
        if (wr == 1) G8_BAR;
    }
    G8_WAIT_V(0);
    G8_BAR;
    if constexpr (Epi::AFTER_DRAIN) E.fused(acc, cur, wr, wc, fr, fq, lds);
#undef G8_FAC
#undef G8_SA
#undef G8_SB
#undef G8_STAGE
#undef G8_STAGE_A
#undef G8_LDA
#undef G8_LDB
#undef G8_MMA
#undef G8_WAIT_V
#undef G8_WAIT_L
#undef G8_BAR
#undef G8_SCHED
}

template <bool F8>
struct EpiQKVT {
    static constexpr bool AFTER_DRAIN = false, FP8 = F8, RESCALE = false;
    const float* rs; const float* qk_gain_l; bf16_t* base; int mode;
    __device__ __forceinline__ void operator()(const f32x4 (&acc)[2][2][4][2], const Unit& u, int wr, int wc, int fr_, int fq_) const {
        int fr = fr_, fq = fq_; asm volatile("" : "+v"(fr), "+v"(fq));
        int gi; bool isq; bf16_t* dst; const float* g;
        if (mode == 0) { const int H = 4 * u.pn + wc; slice_kind(H, gi, isq); dst = base + (size_t)H * T * HD; g = qk_gain_l + (gi < 0 ? 0 : gi) * HD; }
        else { const int lyr = u.pn >> 1, Hp = 4 * (u.pn & 1) + wc; gi = Hp < 4 ? 5 : -1; isq = false; dst = base + ((size_t)lyr * 8 + Hp) * TM * HD; g = qk_gain_l + (lyr * 6 + 5) * HD; }
        const float post = isq ? ATTN_SCALE * LOG2E : 1.0f;
        f32x4 gv[2][2];
#pragma unroll
        for (int bj = 0; bj < 2; ++bj)
#pragma unroll
            for (int n = 0; n < 2; ++n) gv[bj][n] = *(const f32x4*)(g + 32 * bj + 8 * fq + 4 * n) * post;
        float rs8[2][4];
#pragma unroll
        for (int ai = 0; ai < 2; ++ai)
#pragma unroll
            for (int m = 0; m < 4; ++m) rs8[ai][m] = rs[u.pm * 256 + ai * HALF + wr * 64 + m * 16 + fr];
#pragma unroll
        for (int ai = 0; ai < 2; ++ai)
#pragma unroll
            for (int m = 0; m < 4; ++m) {
                const int row = u.pm * 256 + ai * HALF + wr * 64 + m * 16 + fr; const float rsv = rs8[ai][m] * (F8 ? 1.0f / 512.0f : 1.0f);
                f32x4 v[2][2]; float ss = 0.f;
#pragma unroll
                for (int bj = 0; bj < 2; ++bj)
#pragma unroll
                    for (int n = 0; n < 2; ++n) { v[bj][n] = acc[ai][bj][m][n] * rsv; ss += (v[bj][n][0] * v[bj][n][0] + v[bj][n][1] * v[bj][n][1]) + (v[bj][n][2] * v[bj][n][2] + v[bj][n][3] * v[bj][n][3]); }
                if (gi >= 0) {
                    ss += __shfl_xor(ss, 16); ss += __shfl_xor(ss, 32);
                    const float r = __builtin_amdgcn_rsqf(ss * (1.f / 64.f) + EPS);
#pragma unroll
                    for (int bj = 0; bj < 2; ++bj)
#pragma unroll
                        for (int n = 0; n < 2; ++n) v[bj][n] = v[bj][n] * r * gv[bj][n];
                }
#pragma unroll
                for (int bj = 0; bj < 2; ++bj) { u32x4 w; w.x = cvt_pk_bf16(v[bj][0][0], v[bj][0][1]); w.y = cvt_pk_bf16(v[bj][0][2], v[bj][0][3]); w.z = cvt_pk_bf16(v[bj][1][0], v[bj][1][1]); w.w = cvt_pk_bf16(v[bj][1][2], v[bj][1][3]);
                    *(u32x4*)(dst + (size_t)row * HD + 32 * bj + 8 * fq) = w; }
            }
    }
};
struct EpiOut {
    static constexpr bool AFTER_DRAIN = false, FP8 = false, RESCALE = true;
    bf16_t* xb; float* ssq; unsigned char* x8; const float* fab; const float* rm;
    __device__ __forceinline__ void operator()(const f32x4 (&acc)[2][2][4][2], const Unit& u, int wr, int wc, int fr_, int fq_) const {
        int fr = fr_, fq = fq_; asm volatile("" : "+v"(fr), "+v"(fq));
        const int col0 = u.pn * 256 + wc * 32 + 8 * fq;
#pragma unroll
        for (int ai = 0; ai < 2; ++ai) {
        float fm8[2][4]; u32x4 xi8[2][4][2];
#pragma unroll
            for (int m = 0; m < 4; ++m) { const int row = u.pm * 256 + ai * HALF + wr * 64 + m * 16 + fr; fm8[ai][m] = rm[row];
#pragma unroll
                for (int bj = 0; bj < 2; ++bj) xi8[ai][m][bj] = *(const u32x4*)(xb + (size_t)row * D + col0 + bj * HALF); }
#pragma unroll
            for (int m = 0; m < 4; ++m) {
                const int row = u.pm * 256 + ai * HALF + wr * 64 + m * 16 + fr; bf16_t* p = xb + (size_t)row * D + col0; float s = 0.f; const float fm = fm8[ai][m];
                u32x4 xi[2];
#pragma unroll
                for (int bj = 0; bj < 2; ++bj) xi[bj] = xi8[ai][m][bj];
#pragma unroll
                for (int bj = 0; bj < 2; ++bj) { const f32x4 a = acc[ai][bj][m][0] * fm, b = acc[ai][bj][m][1] * fm; const u32x4 x = xi[bj];
                    u32x4 w; w.x = cvt_pk_bf16(bf2f(x.x & 0xffffu) + a[0], bf2f(x.x >> 16) + a[1]); w.y = cvt_pk_bf16(bf2f(x.y & 0xffffu) + a[2], bf2f(x.y >> 16) + a[3]);
                    w.z = cvt_pk_bf16(bf2f(x.z & 0xffffu) + b[0], bf2f(x.z >> 16) + b[1]); w.w = cvt_pk_bf16(bf2f(x.w & 0xffffu) + b[2], bf2f(x.w >> 16) + b[3]);
                    *(u32x4*)(p + bj * HALF) = w;
                    const float o0 = bf2f(w.x & 0xffffu), o1 = bf2f(w.x >> 16), o2 = bf2f(w.y & 0xffffu), o3 = bf2f(w.y >> 16), o4 = bf2f(w.z & 0xffffu), o5 = bf2f(w.z >> 16), o6 = bf2f(w.w & 0xffffu), o7 = bf2f(w.w >> 16);
                    s += ((o0 * o0 + o1 * o1) + (o2 * o2 + o3 * o3)) + ((o4 * o4 + o5 * o5) + (o6 * o6 + o7 * o7));
                    int q0 = 0, q1 = 0; q0 = __builtin_amdgcn_cvt_pk_fp8_f32(clamp8(16.f * o0), clamp8(16.f * o1), q0, false); q0 = __builtin_amdgcn_cvt_pk_fp8_f32(clamp8(16.f * o2), clamp8(16.f * o3), q0, true);
                    q1 = __builtin_amdgcn_cvt_pk_fp8_f32(clamp8(16.f * o4), clamp8(16.f * o5), q1, false); q1 = __builtin_amdgcn_cvt_pk_fp8_f32(clamp8(16.f * o6), clamp8(16.f * o7), q1, true);
                    u32x2 q; q.x = (unsigned)q0; q.y = (unsigned)q1;
                    *(u32x2*)(x8 + (size_t)row * D + col0 + bj * HALF) = q; }
                s += __shfl_xor(s, 16); s += __shfl_xor(s, 32);
                if (fq == 0) ssq[row * 16 + u.pn * 4 + wc] = s;
            }
        }
    }
};
struct EpiSwiGLU {
    static constexpr bool AFTER_DRAIN = false, FP8 = true, RESCALE = false;
    const float* rsl; unsigned char* hid;
    __device__ __forceinline__ void operator()(const f32x4 (&acc)[2][2][4][2], const Unit& u, int wr, int wc, int fr_, int fq_) const {
        int fr = fr_, fq = fq_; asm volatile("" : "+v"(fr), "+v"(fq));
        float rs8[2][4];
#pragma unroll
        for (int ai = 0; ai < 2; ++ai)
#pragma unroll
            for (int m = 0; m < 4; ++m) rs8[ai][m] = rsl[(size_t)u.e * T + min(u.ti * 256 + ai * HALF + wr * 64 + m * 16 + fr, u.ce - 1)];
#pragma unroll
        for (int ai = 0; ai < 2; ++ai)
#pragma unroll
            for (int m = 0; m < 4; ++m) {
                const int lr = ai * HALF + wr * 64 + m * 16 + fr; const float rsv = (1.0f / 512.0f) * rs8[ai][m];
                f32x4 h[2];
#pragma unroll
                for (int n = 0; n < 2; ++n) { const f32x4 gt = acc[ai][0][m][n] * rsv, up = acc[ai][1][m][n] * rsv;
#pragma unroll
                    for (int j = 0; j < 4; ++j) h[n][j] = gt[j] * up[j] * __builtin_amdgcn_rcpf(1.0f + __builtin_amdgcn_exp2f(-gt[j] * LOG2E)); }
#pragma unroll
                for (int n = 0; n < 2; ++n)
#pragma unroll
                    for (int j = 0; j < 4; ++j) h[n][j] = fminf(fmaxf(h[n][j] * 8.0f, -440.f), 440.f);
                int w0 = 0, w1 = 0;
                w0 = __builtin_amdgcn_cvt_pk_fp8_f32(h[0][0], h[0][1], w0, false); w0 = __builtin_amdgcn_cvt_pk_fp8_f32(h[0][2], h[0][3], w0, true);
                w1 = __builtin_amdgcn_cvt_pk_fp8_f32(h[1][0], h[1][1], w1, false); w1 = __builtin_amdgcn_cvt_pk_fp8_f32(h[1][2], h[1][3], w1, true);
                u32x2 w; w.x = (unsigned)w0; w.y = (unsigned)w1;
                *(u32x2*)(hid + (size_t)(u.pm * 256 + lr) * DE + u.pn * 128 + wc * 32 + 8 * fq) = w;
            }
    }
};
struct EpiDown {
    static constexpr bool AFTER_DRAIN = false, NB1 = false, FP8 = true, RESCALE = false;
    const float* wl; unsigned char* Y;
    __device__ __forceinline__ void operator()(const f32x4 (&acc)[2][2][4][2], const Unit& u, int wr, int wc, int fr_, int fq_) const {
        int fr = fr_, fq = fq_; asm volatile("" : "+v"(fr), "+v"(fq));
        float wl8[2][4];
#pragma unroll
        for (int ai = 0; ai < 2; ++ai)
#pragma unroll
            for (int m = 0; m < 4; ++m) wl8[ai][m] = wl[(size_t)u.e * T + min(u.ti * 256 + ai * HALF + wr * 64 + m * 16 + fr, u.ce - 1)];
#pragma unroll
        for (int ai = 0; ai < 2; ++ai)
#pragma unroll
            for (int m = 0; m < 4; ++m) {
                const int lr = ai * HALF + wr * 64 + m * 16 + fr; const float w8 = (8.0f / 256.0f) * wl8[ai][m];
#pragma unroll
                for (int bj = 0; bj < 2; ++bj) { f32x4 a = acc[ai][bj][m][0] * w8, b = acc[ai][bj][m][1] * w8;
#pragma unroll
                    for (int j = 0; j < 4; ++j) { a[j] = fminf(fmaxf(a[j], -400.f), 400.f); b[j] = fminf(fmaxf(b[j], -400.f), 400.f); }
                    int w0 = 0, w1 = 0;
                    w0 = __builtin_amdgcn_cvt_pk_fp8_f32(a[0], a[1], w0, false); w0 = __builtin_amdgcn_cvt_pk_fp8_f32(a[2], a[3], w0, true);
                    w1 = __builtin_amdgcn_cvt_pk_fp8_f32(b[0], b[1], w1, false); w1 = __builtin_amdgcn_cvt_pk_fp8_f32(b[2], b[3], w1, true);
                    u32x2 w; w.x = (unsigned)w0; w.y = (unsigned)w1;
                    *(u32x2*)(Y + (size_t)(u.pm * 256 + lr) * D + u.pn * 256 + bj * HALF + wc * 32 + 8 * fq) = w; }
            }
    }
};
struct EpiRouter {
    static constexpr bool AFTER_DRAIN = true, FP8 = false, RESCALE = false;
    const float* ssq1; float* rs1; const float* b_group; const float* b_router; unsigned* cnt; int* list; float* wl; float* rsl; int* route;
    __device__ __forceinline__ void fused(const f32x4 (&acc)[2][2][4][2], const Unit& u, int wr, int wc, int fr_, int fq_, LAS unsigned char* lds) const {
        int fr = fr_, fq = fq_; asm volatile("" : "+v"(fr), "+v"(fq));
        LAS float* lg = (LAS float*)lds;
        LAS int* hist = (LAS int*)(lds + 256 * 65 * 4);
        const int tid = opaque_tid();
        if (tid < 64) hist[tid] = 0;
        if (wc < 2) {
#pragma unroll
            for (int ai = 0; ai < 2; ++ai)
#pragma unroll
                for (int m = 0; m < 4; ++m) { const int row = ai * HALF + wr * 64 + m * 16 + fr;
#pragma unroll
                    for (int n = 0; n < 2; ++n)
#pragma unroll
                        for (int j = 0; j < 4; ++j) lg[row * 65 + 32 * wc + 16 * n + 4 * fq + j] = acc[ai][0][m][n][j]; }
        }
        __syncthreads();
        int ex0 = 0, ex1 = 0, lp0 = 0, lp1 = 0; float w0 = 0.f, w1 = 0.f, rsv = 0.f; const int t = u.pm * 256 + tid;
        if (tid < 256) {
            const f32x4* sq = (const f32x4*)(ssq1 + (size_t)t * 16); const f32x4 a = sq[0], b = sq[1], c = sq[2], d = sq[3];
            const float ss = ((a[0] + a[1]) + (a[2] + a[3])) + ((b[0] + b[1]) + (b[2] + b[3])) + ((c[0] + c[1]) + (c[2] + c[3])) + ((d[0] + d[1]) + (d[2] + d[3]));
            rsv = 1.0f / sqrtf(ss * (1.f / D) + EPS); rs1[t] = rsv;
            const LAS float* my = lg + tid * 65;
            float g[4];
#pragma unroll
            for (int i = 0; i < 4; ++i) g[i] = my[i] * rsv + b_group[i];
            int gi = 0; float gm = g[0];
#pragma unroll
            for (int i = 1; i < 4; ++i) if (g[i] > gm) { gm = g[i]; gi = i; }
            float den = 0.f;
#pragma unroll
            for (int i = 0; i < 4; ++i) den += expf(g[i] - gm);
            const float gtop = 1.0f / den;
            float ev[8];
#pragma unroll
            for (int i = 0; i < 8; ++i) ev[i] = my[4 + gi * 8 + i] * rsv + b_router[gi * 8 + i];
            int i0 = 0; float v0 = ev[0];
#pragma unroll
            for (int i = 1; i < 8; ++i) if (ev[i] > v0) { v0 = ev[i]; i0 = i; }
            int i1 = -1; float v1 = -INFINITY;
#pragma unroll
            for (int i = 0; i < 8; ++i) if (i != i0 && ev[i] > v1) { v1 = ev[i]; i1 = i; }
            const float e1 = expf(v1 - v0); w0 = gtop / (1.f + e1); w1 = gtop * e1 / (1.f + e1);
            ex0 = gi * 8 + i0; ex1 = gi * 8 + i1;
            lp0 = __hip_atomic_fetch_add(hist + ex0, 1, __ATOMIC_RELAXED, __HIP_MEMORY_SCOPE_WORKGROUP);
            lp1 = __hip_atomic_fetch_add(hist + ex1, 1, __ATOMIC_RELAXED, __HIP_MEMORY_SCOPE_WORKGROUP);
        }
        __syncthreads();
        if (tid < NE) { const int c = hist[tid]; hist[32 + tid] = c ? (int)__hip_atomic_fetch_add(cnt + tid * 64, (unsigned)c, RLX_AGENT) : 0; }
        __syncthreads();
        if (tid < 256) {
            const int p0 = hist[32 + ex0] + lp0, p1 = hist[32 + ex1] + lp1;
            list[(size_t)ex0 * T + p0] = t; wl[(size_t)ex0 * T + p0] = w0; rsl[(size_t)ex0 * T + p0] = rsv;
            list[(size_t)ex1 * T + p1] = t; wl[(size_t)ex1 * T + p1] = w1; rsl[(size_t)ex1 * T + p1] = rsv;
            *(int4*)(route + (size_t)t * 4) = make_int4(ex0, p0, ex1, p1);
        }
    }
};
}

__device__ __forceinline__ void phase_memkv_fast(Frame& F) {
    PHASE_IDS(F);
    g8::DenseSched S; S.init(TM, 1024, D, F.G, (int)blockIdx.x, F.tid, F.ws + WS_WMEM);
    g8::EpiQKVT<false> E{(const float*)(F.ws + WS_RSM), in_ptr(4), (bf16_t*)(F.ws + WS_MEMKV), 1};
    g8::gemm_phase(F.lds, F.ws + WS_MB, D, S, E);
}
__device__ __forceinline__ void phase_inproj_fast(Frame& F, int l) {
    PHASE_IDS(F);
    if (l == 0) {
        g8::DenseSched S; S.init(T, INW, D, F.G, (int)blockIdx.x, F.tid, F.ws + WS_WIN);
        g8::EpiQKVT<false> E{(const float*)(F.ws + WS_RS), in_ptr(4), (bf16_t*)(F.ws + WS_QKV), 0};
        g8::gemm_phase(F.lds, F.ws + WS_XB, D, S, E);
    } else {
        g8::DenseSched S; S.init(T, INW, D / 2, F.G, (int)blockIdx.x, F.tid, F.ws + WS_WIN + (size_t)INW * D * 2);
        g8::EpiQKVT<true> E{(const float*)(F.ws + WS_RS), in_ptr(4) + l * 6 * HD, (bf16_t*)(F.ws + WS_QKV), 0};
        g8::gemm_phase(F.lds, F.ws + WS_X8, D / 2, S, E);
    }
}
__device__ __forceinline__ void phase_outproj_fast(Frame& F, int l) {
    PHASE_IDS(F);
    g8::DenseSched S; S.init(T, D, D, F.G, (int)blockIdx.x, F.tid, F.ws + WS_WOUT + (size_t)l * D * D * 2);
    g8::EpiOut E{(bf16_t*)(F.ws + WS_XB), (float*)(F.ws + WS_SSQ1), (unsigned char*)(F.ws + WS_X8), (const float*)(F.ws + WS_FAB), (const float*)(F.ws + WS_RM)};
    g8::gemm_phase(F.lds, F.ws + WS_MIX, D, S, E);
}
__device__ __forceinline__ void phase_router_fast(Frame& F, int l) {
    PHASE_IDS(F);
    g8::DenseSched S; S.init(T, 256, D, F.G, (int)blockIdx.x, F.tid, F.ws + WS_WR + (size_t)l * 256 * D * 2);
    g8::EpiRouter E{(const float*)(F.ws + WS_SSQ1), (float*)(F.ws + WS_RS) + T, in_ptr(12) + l * NGRP, in_ptr(14) + l * NE, F.ctl + CW_CNT + l * NE * 64,
                    (int*)(F.ws + WS_LIST), (float*)(F.ws + WS_WL), (float*)(F.ws + WS_RSL), (int*)(F.ws + WS_ROUTE)};
    g8::gemm_phase(F.lds, F.ws + WS_XB, D, S, E);
}
__device__ __forceinline__ void phase_moe1_fast(Frame& F, int l) {
    PHASE_IDS(F);
    g8::GroupSched S; S.init((LAS int*)(F.lds + CTRL_BASE), F.ctl + CW_CNT + l * NE * 64, 4, D / 2, F.G, (int)blockIdx.x, F.ws + WS_WGU + (size_t)l * NE * 1024 * D, (size_t)1024 * D, (const int*)(F.ws + WS_LIST), true);
    g8::EpiSwiGLU E{(const float*)(F.ws + WS_RSL), (unsigned char*)(F.ws + WS_MIX)};
    g8::gemm_phase(F.lds, F.ws + WS_X8, D / 2, S, E);
}
__device__ __forceinline__ void phase_moe2_fast(Frame& F, int l) {
    PHASE_IDS(F);
    g8::GroupSched S; S.init((LAS int*)(F.lds + CTRL_BASE), F.ctl + CW_CNT + l * NE * 64, 4, DE / 2, F.G, (int)blockIdx.x, F.ws + WS_WD + (size_t)l * NE * D * DE, (size_t)D * DE, (const int*)(F.ws + WS_LIST), false);
    g8::EpiDown E{(const float*)(F.ws + WS_WL), (unsigned char*)(F.ws + WS_QKV)};
    g8::gemm_phase(F.lds, F.ws + WS_MIX, DE / 2, S, E);
}

namespace at {
typedef short bf16x8 __attribute__((ext_vector_type(8)));
typedef short s16x4 __attribute__((ext_vector_type(4)));
typedef short v4i16_t __attribute__((ext_vector_type(4)));
typedef float f32x16 __attribute__((ext_vector_type(16)));
typedef const LAS char* lds_cptr;
constexpr int NSLOT = 3, NPRE = NSLOT - 1, SLOTB = 8192, LDS_K = 0, LDS_V = NSLOT * SLOTB, TB_CS = 576, TB_ROW = 4 * TB_CS, LDS_TBB = 2 * NSLOT * SLOTB, LDS_TBM = LDS_TBB + 16 * TB_ROW, LDS_WS = LDS_TBM + TB_ROW, LDS_QW = LDS_WS + 2048;
static_assert(LDS_QW + 64 <= 131072, "attention LDS map");
constexpr float NEGBIG = -1.0e30f;
__device__ __forceinline__ int crow(int r, int hi) { return (r & 3) + 8 * (r >> 2) + 4 * hi; }
__device__ __forceinline__ void glds16(const void* gsrc, unsigned lds_dst) { unsigned keep;
    asm volatile("s_mov_b32 %0, m0\n\ts_mov_b32 m0, %2\n\ts_nop 0\n\tglobal_load_lds_dwordx4 %1, off\n\ts_mov_b32 m0, %0" : "=&s"(keep) : "v"(gsrc), "s"(lds_dst) : "memory"); }
typedef float f32x2_t __attribute__((ext_vector_type(2))); typedef __bf16 bf16x2_t __attribute__((ext_vector_type(2)));
__device__ __forceinline__ unsigned cvtpk(float lo, float hi) { f32x2_t v = {lo, hi}; bf16x2_t b = __builtin_convertvector(v, bf16x2_t); return __builtin_bit_cast(unsigned, b); }
__device__ __forceinline__ s16x4 vtr(lds_cptr p) { return __builtin_bit_cast(s16x4, __builtin_amdgcn_ds_read_tr16_b64_v4i16((LAS v4i16_t*)p)); }
#define AT_WAIT_BAR(N) asm volatile("s_waitcnt vmcnt(" #N ") lgkmcnt(0)\n\ts_barrier" ::: "memory")

__device__ __forceinline__ void at_dequeue(unsigned* qcnt, int nper, int xq, int pre, int& id_out, int& x_out) {
    int id = pre, x = xq;
    if (id == -2) id = (int)__hip_atomic_fetch_add(qcnt + xq * 64, 1u, RLX_AGENT);
    if (id >= nper) {
        id = -1;
        for (int tries = 0; tries < 8 && id < 0; ++tries) {
            unsigned hv[8];
#pragma unroll
            for (int k = 0; k < 8; ++k) hv[k] = __hip_atomic_load(qcnt + ((xq + k) & 7) * 64, RLX_AGENT);
            int pick = -1;
#pragma unroll
            for (int k = 7; k >= 0; --k) if ((int)hv[k] < nper) pick = k;
            if (pick < 0) break;
            x = (xq + pick) & 7; id = (int)__hip_atomic_fetch_add(qcnt + x * 64, 1u, RLX_AGENT); if (id >= nper) id = -1;
        }
    }
    id_out = id; x_out = x;
}
struct UnitDesc { const bf16_t* Q; const bf16_t* K; const bf16_t* V; int t0, hh16, qb, h, kt0, nt; };

template <int TYPE>
__device__ __forceinline__ void attn_unit(LAS unsigned char* lds, const UnitDesc& u, bf16_t* mixed, float* ssq) {
    const int tid = opaque_tid0(), lane = tid & 63, r32 = lane & 31, hi = lane >> 5; const int wid = __builtin_amdgcn_readfirstlane(tid >> 6);
    const unsigned lds0 = (unsigned)(size_t)lds;
    lds_cptr shm3 = (lds_cptr)lds;
    const int prow = 8 * wid + (lane >> 3);
    const bf16_t* ksrc = u.K + (size_t)(u.kt0 * 64 + prow) * HD + (((lane & 7) ^ ((4 * wid + (lane >> 4)) & 7)) * 8);
    const bf16_t* vsrc = u.V + (size_t)(u.kt0 * 64 + prow) * HD + ((((lane & 7) >> 1) ^ (prow & 2)) * 16) + (lane & 1) * 8;
    const unsigned kdst = lds0 + LDS_K + wid * 1024, vdst = lds0 + LDS_V + wid * 1024;
#define AT_DMA_K(t, slot) glds16(ksrc + (size_t)(t) * 64 * HD, (unsigned)__builtin_amdgcn_readfirstlane(kdst + (slot)))
#define AT_DMA_V(t, slot) glds16(vsrc + (size_t)(t) * 64 * HD, (unsigned)__builtin_amdgcn_readfirstlane(vdst + (slot)))
    lds_cptr ka[4], va[2];
    { const int sw = (r32 >> 1) & 7;
#pragma unroll
      for (int d0 = 0; d0 < 4; ++d0) ka[d0] = shm3 + LDS_K + r32 * 128 + (((2 * d0 + hi) ^ sw) * 16);
      const int q = (lane & 15) >> 2, gb = (lane >> 4) & 1;
#pragma unroll
      for (int d0 = 0; d0 < 2; ++d0) va[d0] = shm3 + LDS_V + (4 * hi + q) * 128 + ((2 * (d0 ^ (q >> 1)) + gb) * 32) + (lane & 3) * 8; }
    const int nt = u.nt;
    const bf16_t* Qw = u.Q + (size_t)(u.qb * 256 + wid * 32 + r32) * HD;
    bf16x8 qr[4];
#pragma unroll
    for (int d0 = 0; d0 < 4; ++d0) qr[d0] = *(const bf16x8*)(Qw + d0 * 16 + hi * 8);
#pragma unroll
    for (int j = 0; j < NPRE; ++j) if (j < nt) { AT_DMA_K(j, j * SLOTB); AT_DMA_V(j, j * SLOTB); }
    lds_cptr tb = shm3; int r0w = 0, qrw = 0;
    lds_cptr tbm = shm3;
    if (TYPE == 1) { const int qc = 32 * (wid & 1) + r32, c0 = min(max(qc - 8, 0), 48); qrw = 4 * u.qb + (wid >> 1); r0w = min(max(qrw - 4, 0), 24);
        const int ib = 4 * hi - qc + 63, cb = (-ib) & 3, im = 4 * hi - c0 + 63, cm = (-im) & 3;
        tb = shm3 + LDS_TBB + cb * TB_CS + (ib + cb) * 4; tbm = shm3 + LDS_TBM + cm * TB_CS + (im + cm) * 4; }
    float lsum = 0.f; f32x16 o[2]; o[0] = f32x16{}; o[1] = f32x16{};
    int sl_cur = 0, sl_n2 = NPRE * SLOTB;
    for (int i = 0; i < nt; ++i) {
        { const int rem = nt - 1 - i, yo = rem < NPRE - 1 ? rem : NPRE - 1; if (yo >= 3) AT_WAIT_BAR(6); else if (yo == 2) AT_WAIT_BAR(4); else if (yo == 1) AT_WAIT_BAR(2); else AT_WAIT_BAR(0); }
        static_assert(NPRE <= 4, "wait ladder");
        if (i + NPRE < nt) { AT_DMA_K(i + NPRE, sl_n2); AT_DMA_V(i + NPRE, sl_n2); }
        bool need = true;
        if (TYPE == 1) { const int kr = u.kt0 + i; need = (kr >= r0w) && (kr < r0w + 8); }
        if (need) {
#pragma unroll
            for (int hf = 0; hf < 2; ++hf) {
                f32x16 p;
                if (TYPE == 1) {
                    const lds_cptr tp = tb + (u.kt0 + i - qrw + 7) * TB_ROW;
#pragma unroll
                    for (int g = 0; g < 4; ++g) { const f32x4 a = *(const LAS f32x4*)(tp + 32 * (g + 4 * hf)) + *(const LAS f32x4*)(tbm + 32 * (g + 4 * hf)); p[4 * g] = a[0]; p[4 * g + 1] = a[1]; p[4 * g + 2] = a[2]; p[4 * g + 3] = a[3]; }
                } else p = f32x16{};
#pragma unroll
                for (int d0 = 0; d0 < 4; ++d0) p = __builtin_amdgcn_mfma_f32_32x32x16_bf16(*(const LAS bf16x8*)(ka[d0] + sl_cur + 4096 * hf), qr[d0], p, 0, 0, 0);
                float s0 = 0.f;
#pragma unroll
                for (int r = 0; r < 16; ++r) { p[r] = __builtin_amdgcn_exp2f(p[r]); s0 += p[r]; }
                lsum += s0;
                const u32x4 pwa = (u32x4){cvtpk(p[0], p[1]), cvtpk(p[2], p[3]), cvtpk(p[4], p[5]), cvtpk(p[6], p[7])}, pwb = (u32x4){cvtpk(p[8], p[9]), cvtpk(p[10], p[11]), cvtpk(p[12], p[13]), cvtpk(p[14], p[15])};
#pragma unroll
                for (int d0 = 0; d0 < 2; ++d0) { const lds_cptr vp = va[d0] + sl_cur + 4096 * hf; const s16x4 l0 = vtr(vp), h0 = vtr(vp + 1024), l1 = vtr(vp + 2048), h1 = vtr(vp + 2048 + 1024);
                    o[d0] = __builtin_amdgcn_mfma_f32_32x32x16_bf16(__builtin_bit_cast(bf16x8, pwa), (bf16x8){l0[0], l0[1], l0[2], l0[3], h0[0], h0[1], h0[2], h0[3]}, o[d0], 0, 0, 0);
                    o[d0] = __builtin_amdgcn_mfma_f32_32x32x16_bf16(__builtin_bit_cast(bf16x8, pwb), (bf16x8){l1[0], l1[1], l1[2], l1[3], h1[0], h1[1], h1[2], h1[3]}, o[d0], 0, 0, 0); }
            }
        }
        sl_n2 = sl_cur;
        sl_cur = (sl_cur == (NSLOT - 1) * SLOTB) ? 0 : sl_cur + SLOTB;
    }
    AT_WAIT_BAR(0);
    int lane2 = lane; asm volatile("" : "+v"(lane2)); const int r32e = lane2 & 31, hie = lane2 >> 5;
    lsum += __shfl_xor(lsum, 32);
    LAS float* wsf = (LAS float*)(lds + LDS_WS) + wid * 64;
    if (hie == 0) wsf[r32e] = lsum;
    asm volatile("s_waitcnt lgkmcnt(0)" ::: "memory");
    LAS bf16_t* stg = (LAS bf16_t*)(lds) + wid * 2048;
#pragma unroll
    for (int r = 0; r < 16; ++r) { const int orow = crow(r, hie); const float rl = __builtin_amdgcn_rcpf(wsf[orow]);
        stg[orow * 64 + r32e] = (bf16_t)f2bf(o[0][r] * rl); stg[orow * 64 + 32 + r32e] = (bf16_t)f2bf(o[1][r] * rl); }
    asm volatile("s_waitcnt lgkmcnt(0)" ::: "memory");
    const int trow0 = u.t0 + wid * 32;
#pragma unroll
    for (int i = 0; i < 4; ++i) { const int row = i * 8 + (lane2 >> 3), ch = lane2 & 7; const u32x4 v = *(const LAS u32x4*)(stg + row * 64 + ch * 8);
        *(u32x4*)(mixed + (size_t)(trow0 + row) * D + u.hh16 * 64 + ch * 8) = v;
        float s = 0.f; { float a;
            a = bf2f(v.x & 0xffffu); s += a * a; a = bf2f(v.x >> 16); s += a * a; a = bf2f(v.y & 0xffffu); s += a * a; a = bf2f(v.y >> 16); s += a * a;
            a = bf2f(v.z & 0xffffu); s += a * a; a = bf2f(v.z >> 16); s += a * a; a = bf2f(v.w & 0xffffu); s += a * a; a = bf2f(v.w >> 16); s += a * a; }
        s += __shfl_xor(s, 1); s += __shfl_xor(s, 2); s += __shfl_xor(s, 4);
        if (ch == 0) ssq[(size_t)(trow0 + row) * 16 + u.hh16] = s; }
    asm volatile("s_waitcnt lgkmcnt(0)\n\ts_barrier" ::: "memory");
#undef AT_DMA_K
#undef AT_DMA_V
}

template <int NQB>
__device__ __forceinline__ void mem_unit(LAS unsigned char* lds, const bf16_t* Qh, const bf16_t* Kh, const bf16_t* Vh, int t0, int hh16, bf16_t* mixed, float* ssq) {
    constexpr int MK = 0, MV = 32768, MSTG = 65536, MWS = 98304;
    const int tid = opaque_tid0(), lane = tid & 63, r32 = lane & 31, hi = lane >> 5; const int wid = __builtin_amdgcn_readfirstlane(tid >> 6);
    const unsigned lds0 = (unsigned)(size_t)lds; lds_cptr shm3 = (lds_cptr)lds;
    const int prow = 8 * wid + (lane >> 3);
    const bf16_t* ksrc = Kh + (size_t)prow * HD + (((lane & 7) ^ ((4 * wid + (lane >> 4)) & 7)) * 8);
    const bf16_t* vsrc = Vh + (size_t)prow * HD + ((((lane & 7) >> 1) ^ (prow & 2)) * 16) + (lane & 1) * 8;
    const bf16_t* Qw = Qh + (size_t)(wid * 32 + r32) * HD + hi * 8;
    bf16x8 qr[4], qn[4];
#pragma unroll
    for (int d0 = 0; d0 < 4; ++d0) { qr[d0] = *(const bf16x8*)(Qw + d0 * 16); qn[d0] = qr[d0]; }
#pragma unroll
    for (int j = 0; j < 4; ++j) { glds16(ksrc + (size_t)j * 64 * HD, (unsigned)__builtin_amdgcn_readfirstlane(lds0 + MK + j * 8192 + wid * 1024));
                                  glds16(vsrc + (size_t)j * 64 * HD, (unsigned)__builtin_amdgcn_readfirstlane(lds0 + MV + j * 8192 + wid * 1024)); }
    lds_cptr ka[4], va[2];
    { const int sw = (r32 >> 1) & 7;
#pragma unroll
      for (int d0 = 0; d0 < 4; ++d0) ka[d0] = shm3 + MK + r32 * 128 + (((2 * d0 + hi) ^ sw) * 16);
      const int q = (lane & 15) >> 2, gb = (lane >> 4) & 1;
#pragma unroll
      for (int d0 = 0; d0 < 2; ++d0) va[d0] = shm3 + MV + (4 * hi + q) * 128 + ((2 * (d0 ^ (q >> 1)) + gb) * 32) + (lane & 3) * 8; }
    LAS float* wsf = (LAS float*)(lds + MWS) + wid * 64;
    LAS bf16_t* stg = (LAS bf16_t*)(lds + MSTG) + wid * 2048;
#pragma unroll
    for (int qb = 0; qb < NQB; ++qb) {
        const bool has_next = qb + 1 < NQB;
        float lsum = 0.f; f32x16 o[2]; o[0] = f32x16{}; o[1] = f32x16{};
#pragma unroll
        for (int i = 0; i < 4; ++i) {
            if (qb == 0) {
                if (i == 0) AT_WAIT_BAR(6); else if (i == 1) AT_WAIT_BAR(4); else if (i == 2) { if (has_next) AT_WAIT_BAR(6); else AT_WAIT_BAR(2); } else { if (has_next) AT_WAIT_BAR(4); else AT_WAIT_BAR(0); }
            }
            if (i == 1 && has_next) {
#pragma unroll
                for (int d0 = 0; d0 < 4; ++d0) qn[d0] = *(const bf16x8*)(Qw + (size_t)(qb + 1) * 256 * HD + d0 * 16); }
#pragma unroll
            for (int hf = 0; hf < 2; ++hf) {
                f32x16 p = f32x16{};
#pragma unroll
                for (int d0 = 0; d0 < 4; ++d0) p = __builtin_amdgcn_mfma_f32_32x32x16_bf16(*(const LAS bf16x8*)(ka[d0] + i * 8192 + 4096 * hf), qr[d0], p, 0, 0, 0);
                float s0 = 0.f;
#pragma unroll
                for (int r = 0; r < 16; ++r) { p[r] = __builtin_amdgcn_exp2f(p[r]); s0 += p[r]; }
                lsum += s0;
                const u32x4 pwa = (u32x4){cvtpk(p[0], p[1]), cvtpk(p[2], p[3]), cvtpk(p[4], p[5]), cvtpk(p[6], p[7])}, pwb = (u32x4){cvtpk(p[8], p[9]), cvtpk(p[10], p[11]), cvtpk(p[12], p[13]), cvtpk(p[14], p[15])};
#pragma unroll
                for (int d0 = 0; d0 < 2; ++d0) { const lds_cptr vp = va[d0] + i * 8192 + 4096 * hf; const s16x4 l0 = vtr(vp), h0 = vtr(vp + 1024), l1 = vtr(vp + 2048), h1 = vtr(vp + 2048 + 1024);
                    o[d0] = __builtin_amdgcn_mfma_f32_32x32x16_bf16(__builtin_bit_cast(bf16x8, pwa), (bf16x8){l0[0], l0[1], l0[2], l0[3], h0[0], h0[1], h0[2], h0[3]}, o[d0], 0, 0, 0);
                    o[d0] = __builtin_amdgcn_mfma_f32_32x32x16_bf16(__builtin_bit_cast(bf16x8, pwb), (bf16x8){l1[0], l1[1], l1[2], l1[3], h1[0], h1[1], h1[2], h1[3]}, o[d0], 0, 0, 0); }
            }
        }
        lsum += __shfl_xor(lsum, 32);
        if (hi == 0) wsf[r32] = lsum;
        asm volatile("s_waitcnt lgkmcnt(0)" ::: "memory");
#pragma unroll
        for (int r = 0; r < 16; ++r) { const int orow = crow(r, hi); const float rl = __builtin_amdgcn_rcpf(wsf[orow]);
            stg[orow * 64 + r32] = (bf16_t)f2bf(o[0][r] * rl); stg[orow * 64 + 32 + r32] = (bf16_t)f2bf(o[1][r] * rl); }
        asm volatile("s_waitcnt lgkmcnt(0)" ::: "memory");
        const int trow0 = t0 + qb * 256 + wid * 32;
#pragma unroll
        for (int i = 0; i < 4; ++i) { const int row = i * 8 + (lane >> 3), ch = lane & 7; const u32x4 v = *(const LAS u32x4*)(stg + row * 64 + ch * 8);
            *(u32x4*)(mixed + (size_t)(trow0 + row) * D + hh16 * 64 + ch * 8) = v;
            { float s = 0.f, a;
              a = bf2f(v.x & 0xffffu); s += a * a; a = bf2f(v.x >> 16); s += a * a; a = bf2f(v.y & 0xffffu); s += a * a; a = bf2f(v.y >> 16); s += a * a;
              a = bf2f(v.z & 0xffffu); s += a * a; a = bf2f(v.z >> 16); s += a * a; a = bf2f(v.w & 0xffffu); s += a * a; a = bf2f(v.w >> 16); s += a * a;
              s += __shfl_xor(s, 1); s += __shfl_xor(s, 2); s += __shfl_xor(s, 4);
              if (ch == 0) ssq[(size_t)(trow0 + row) * 16 + hh16] = s; } }
        asm volatile("s_waitcnt lgkmcnt(0)" ::: "memory");
        if (has_next) {
#pragma unroll
            for (int d0 = 0; d0 < 4; ++d0) qr[d0] = qn[d0]; }
    }
    asm volatile("s_waitcnt lgkmcnt(0)\n\ts_barrier" ::: "memory");
}

__device__ __forceinline__ void nb_unit(LAS unsigned char* lds, const UnitDesc& u, bf16_t* mixed, float* ssq) {
    const int tid = opaque_tid0(), lane = tid & 63, r32 = lane & 31, hi = lane >> 5; const int wid = __builtin_amdgcn_readfirstlane(tid >> 6);
    const unsigned lds0 = (unsigned)(size_t)lds; lds_cptr shm3 = (lds_cptr)lds;
    const int prow = 8 * wid + (lane >> 3);
    const bf16_t* ksrc = u.K + (size_t)(u.kt0 * 64 + prow) * HD + (((lane & 7) ^ ((4 * wid + (lane >> 4)) & 7)) * 8);
    const bf16_t* vsrc = u.V + (size_t)(u.kt0 * 64 + prow) * HD + ((((lane & 7) >> 1) ^ (prow & 2)) * 16) + (lane & 1) * 8;
    const unsigned kdst = lds0 + LDS_K + wid * 1024, vdst = lds0 + LDS_V + wid * 1024;
#define AT_DMA_K(t, slot) glds16(ksrc + (size_t)(t) * 64 * HD, (unsigned)__builtin_amdgcn_readfirstlane(kdst + (slot)))
#define AT_DMA_V(t, slot) glds16(vsrc + (size_t)(t) * 64 * HD, (unsigned)__builtin_amdgcn_readfirstlane(vdst + (slot)))
    const int rp = wid >> 2, jb = wid & 3, cs = min(max(16 * jb - 8, 0), 32);
    const int qrl = 4 * u.qb + 2 * rp + (r32 >> 4), qc = 16 * jb + (r32 & 15), c0 = min(max(qc - 8, 0), 48), r0l = min(max(qrl - 4, 0), 24);
    const int rwa = min(max(4 * u.qb + 2 * rp - 4, 0), 24), rwb = min(max(4 * u.qb + 2 * rp + 1 - 4, 0), 24) + 8;
    lds_cptr ka[4], va[2];
    { const int key = cs + r32, sw = (key >> 1) & 7;
#pragma unroll
      for (int d0 = 0; d0 < 4; ++d0) ka[d0] = shm3 + LDS_K + key * 128 + (((2 * d0 + hi) ^ sw) * 16);
      const int q = (lane & 15) >> 2, gb = (lane >> 4) & 1;
#pragma unroll
      for (int d0 = 0; d0 < 2; ++d0) va[d0] = shm3 + LDS_V + (cs + 4 * hi + q) * 128 + ((2 * (d0 ^ (q >> 1)) + gb) * 32) + (lane & 3) * 8; }
    const int nt = u.nt;
    const bf16_t* Qw = u.Q + (size_t)(qrl * 64 + qc) * HD;
    bf16x8 qr[4];
#pragma unroll
    for (int d0 = 0; d0 < 4; ++d0) qr[d0] = *(const bf16x8*)(Qw + d0 * 16 + hi * 8);
#pragma unroll
    for (int j = 0; j < NPRE; ++j) if (j < nt) { AT_DMA_K(j, j * SLOTB); AT_DMA_V(j, j * SLOTB); }
    lds_cptr tb, tbm;
    { const int ib = cs + 4 * hi - qc + 63, cb = (-ib) & 3, im = cs + 4 * hi - c0 + 63, cm = (-im) & 3;
      tb = shm3 + LDS_TBB + cb * TB_CS + (ib + cb) * 4; tbm = shm3 + LDS_TBM + cm * TB_CS + (im + cm) * 4; }
    float lsum = 0.f; f32x16 o[2]; o[0] = f32x16{}; o[1] = f32x16{};
    int sl_cur = 0, sl_n2 = NPRE * SLOTB;
    for (int i = 0; i < nt; ++i) {
        { const int rem = nt - 1 - i, yo = rem < NPRE - 1 ? rem : NPRE - 1; if (yo >= 3) AT_WAIT_BAR(6); else if (yo == 2) AT_WAIT_BAR(4); else if (yo == 1) AT_WAIT_BAR(2); else AT_WAIT_BAR(0); }
        if (i + NPRE < nt) { AT_DMA_K(i + NPRE, sl_n2); AT_DMA_V(i + NPRE, sl_n2); }
        const int kr = u.kt0 + i;
        if (kr >= rwa && kr < rwb) {
            const int drow = (kr >= r0l && kr < r0l + 8) ? (kr - qrl + 7) : 15;
            const lds_cptr tp = tb + drow * TB_ROW;
            f32x16 p0;
#pragma unroll
            for (int g = 0; g < 4; ++g) { const f32x4 a = *(const LAS f32x4*)(tp + 32 * g) + *(const LAS f32x4*)(tbm + 32 * g); p0[4 * g] = a[0]; p0[4 * g + 1] = a[1]; p0[4 * g + 2] = a[2]; p0[4 * g + 3] = a[3]; }
            bf16x8 kf[4];
#pragma unroll
            for (int j = 0; j < 4; ++j) kf[j] = *(const LAS bf16x8*)(ka[j] + sl_cur);
#pragma unroll
            for (int d0 = 0; d0 < 4; ++d0) p0 = __builtin_amdgcn_mfma_f32_32x32x16_bf16(kf[d0], qr[d0], p0, 0, 0, 0);
            float s0 = 0.f;
#pragma unroll
            for (int r = 0; r < 16; ++r) { p0[r] = __builtin_amdgcn_exp2f(p0[r]); s0 += p0[r]; }
            lsum += s0;
            const u32x4 pw0 = (u32x4){cvtpk(p0[0], p0[1]), cvtpk(p0[2], p0[3]), cvtpk(p0[4], p0[5]), cvtpk(p0[6], p0[7])};
            const u32x4 pw1 = (u32x4){cvtpk(p0[8], p0[9]), cvtpk(p0[10], p0[11]), cvtpk(p0[12], p0[13]), cvtpk(p0[14], p0[15])};
#pragma unroll
            for (int d0 = 0; d0 < 2; ++d0) {
                s16x4 lo[2], hh[2]; const lds_cptr vp = va[d0] + sl_cur;
#pragma unroll
                for (int ks = 0; ks < 2; ++ks) { lo[ks] = vtr(vp + ks * 2048); hh[ks] = vtr(vp + ks * 2048 + 1024); }
                o[d0] = __builtin_amdgcn_mfma_f32_32x32x16_bf16(__builtin_bit_cast(bf16x8, pw0), (bf16x8){lo[0][0], lo[0][1], lo[0][2], lo[0][3], hh[0][0], hh[0][1], hh[0][2], hh[0][3]}, o[d0], 0, 0, 0);
                o[d0] = __builtin_amdgcn_mfma_f32_32x32x16_bf16(__builtin_bit_cast(bf16x8, pw1), (bf16x8){lo[1][0], lo[1][1], lo[1][2], lo[1][3], hh[1][0], hh[1][1], hh[1][2], hh[1][3]}, o[d0], 0, 0, 0);
            }
        }
        sl_n2 = sl_cur;
        sl_cur = (sl_cur == (NSLOT - 1) * SLOTB) ? 0 : sl_cur + SLOTB;
    }
    AT_WAIT_BAR(0);
    int lane2 = lane; asm volatile("" : "+v"(lane2)); const int r32e = lane2 & 31, hie = lane2 >> 5;
    lsum += __shfl_xor(lsum, 32);
    LAS float* wsf = (LAS float*)(lds + LDS_WS) + wid * 64;
    if (hie == 0) wsf[r32e] = lsum;
    asm volatile("s_waitcnt lgkmcnt(0)" ::: "memory");
    LAS bf16_t* stg = (LAS bf16_t*)(lds) + wid * 2048;
#pragma unroll
    for (int r = 0; r < 16; ++r) { const int orow = crow(r, hie); const float rl = __builtin_amdgcn_rcpf(wsf[orow]);
        stg[orow * 64 + r32e] = (bf16_t)f2bf(o[0][r] * rl); stg[orow * 64 + 32 + r32e] = (bf16_t)f2bf(o[1][r] * rl); }
    asm volatile("s_waitcnt lgkmcnt(0)" ::: "memory");
    const int tbase = u.t0 + 2 * rp * 64 + 16 * jb;
#pragma unroll
    for (int i = 0; i < 4; ++i) { const int row = i * 8 + (lane2 >> 3), ch = lane2 & 7; const u32x4 v = *(const LAS u32x4*)(stg + row * 64 + ch * 8);
        *(u32x4*)(mixed + (size_t)(tbase + (row >> 4) * 64 + (row & 15)) * D + u.hh16 * 64 + ch * 8) = v; const int hh16 = u.hh16;
            { float s = 0.f, a;
              a = bf2f(v.x & 0xffffu); s += a * a; a = bf2f(v.x >> 16); s += a * a; a = bf2f(v.y & 0xffffu); s += a * a; a = bf2f(v.y >> 16); s += a * a;
              a = bf2f(v.z & 0xffffu); s += a * a; a = bf2f(v.z >> 16); s += a * a; a = bf2f(v.w & 0xffffu); s += a * a; a = bf2f(v.w >> 16); s += a * a;
              s += __shfl_xor(s, 1); s += __shfl_xor(s, 2); s += __shfl_xor(s, 4);
              if (ch == 0) ssq[(size_t)(tbase + (row >> 4) * 64 + (row & 15)) * 16 + hh16] = s; } }
    asm volatile("s_waitcnt lgkmcnt(0)\n\ts_barrier" ::: "memory");
#undef AT_DMA_K
#undef AT_DMA_V
}
__device__ __forceinline__ void nb_unit2(LAS unsigned char* lds, const UnitDesc& u, bf16_t* mixed, float* ssq) {
    const int tid = opaque_tid0(), lane = tid & 63, r32 = lane & 31, hi = lane >> 5; const int wid = __builtin_amdgcn_readfirstlane(tid >> 6);
    const unsigned lds0 = (unsigned)(size_t)lds; lds_cptr shm3 = (lds_cptr)lds;
    const int prow = 8 * wid + (lane >> 3);
    const bf16_t* ksrc = u.K + (size_t)(u.kt0 * 64 + prow) * HD + (((lane & 7) ^ ((4 * wid + (lane >> 4)) & 7)) * 8);
    const bf16_t* vsrc = u.V + (size_t)(u.kt0 * 64 + prow) * HD + ((((lane & 7) >> 1) ^ (prow & 2)) * 16) + (lane & 1) * 8;
    const unsigned kdst = lds0 + LDS_K + wid * 1024, vdst = lds0 + LDS_V + wid * 1024;
#define AT_DMA_K(t, slot) glds16(ksrc + (size_t)(t) * 64 * HD, (unsigned)__builtin_amdgcn_readfirstlane(kdst + (slot)))
#define AT_DMA_V(t, slot) glds16(vsrc + (size_t)(t) * 64 * HD, (unsigned)__builtin_amdgcn_readfirstlane(vdst + (slot)))
    const int rp = wid >> 2, jb = wid & 3, cs = min(max(16 * jb - 8, 0), 32);
    const int qc = 16 * jb + (r32 & 15), c0 = min(max(qc - 8, 0), 48);
    int qrl[2], r0l[2], rwa[2], rwb[2];
#pragma unroll
    for (int sb = 0; sb < 2; ++sb) { const int base = 8 * u.qb + 4 * sb + 2 * rp; qrl[sb] = base + (r32 >> 4); r0l[sb] = min(max(qrl[sb] - 4, 0), 24);
        rwa[sb] = min(max(base - 4, 0), 24); rwb[sb] = min(max(base + 1 - 4, 0), 24) + 8; }
    lds_cptr ka[4], va[2];
    { const int key = cs + r32, sw = (key >> 1) & 7;
#pragma unroll
      for (int d0 = 0; d0 < 4; ++d0) ka[d0] = shm3 + LDS_K + key * 128 + (((2 * d0 + hi) ^ sw) * 16);
      const int q = (lane & 15) >> 2, gb = (lane >> 4) & 1;
#pragma unroll
      for (int d0 = 0; d0 < 2; ++d0) va[d0] = shm3 + LDS_V + (cs + 4 * hi + q) * 128 + ((2 * (d0 ^ (q >> 1)) + gb) * 32) + (lane & 3) * 8; }
    const int nt = u.nt;
    bf16x8 qr[2][4];
#pragma unroll
    for (int sb = 0; sb < 2; ++sb) { const bf16_t* Qw = u.Q + (size_t)(qrl[sb] * 64 + qc) * HD;
#pragma unroll
        for (int d0 = 0; d0 < 4; ++d0) qr[sb][d0] = *(const bf16x8*)(Qw + d0 * 16 + hi * 8); }
#pragma unroll
    for (int j = 0; j < NPRE; ++j) if (j < nt) { AT_DMA_K(j, j * SLOTB); AT_DMA_V(j, j * SLOTB); }
    lds_cptr tb, tbm;
    { const int ib = cs + 4 * hi - qc + 63, cb = (-ib) & 3, im = cs + 4 * hi - c0 + 63, cm = (-im) & 3;
      tb = shm3 + LDS_TBB + cb * TB_CS + (ib + cb) * 4; tbm = shm3 + LDS_TBM + cm * TB_CS + (im + cm) * 4; }
    float lsum[2] = {0.f, 0.f}; f32x16 o[2][2]; o[0][0] = f32x16{}; o[0][1] = f32x16{}; o[1][0] = f32x16{}; o[1][1] = f32x16{};
    int sl_cur = 0, sl_n2 = NPRE * SLOTB;
    for (int i = 0; i < nt; ++i) {
        { const int rem = nt - 1 - i, yo = rem < NPRE - 1 ? rem : NPRE - 1; if (yo >= 3) AT_WAIT_BAR(6); else if (yo == 2) AT_WAIT_BAR(4); else if (yo == 1) AT_WAIT_BAR(2); else AT_WAIT_BAR(0); }
        if (i + NPRE < nt) { AT_DMA_K(i + NPRE, sl_n2); AT_DMA_V(i + NPRE, sl_n2); }
        const int kr = u.kt0 + i;
        const bool act0 = kr >= rwa[0] && kr < rwb[0], act1 = kr >= rwa[1] && kr < rwb[1];
        if (act0 || act1) {
            bf16x8 kf[4];
#pragma unroll
            for (int j = 0; j < 4; ++j) kf[j] = *(const LAS bf16x8*)(ka[j] + sl_cur);
            s16x4 lo[2][2], hh[2][2];
#pragma unroll
            for (int d0 = 0; d0 < 2; ++d0) { const lds_cptr vp = va[d0] + sl_cur;
#pragma unroll
                for (int ks = 0; ks < 2; ++ks) { lo[d0][ks] = vtr(vp + ks * 2048); hh[d0][ks] = vtr(vp + ks * 2048 + 1024); } }
#pragma unroll
            for (int sb = 0; sb < 2; ++sb) {
                if (sb == 0 ? act0 : act1) {
                    const int drow = (kr >= r0l[sb] && kr < r0l[sb] + 8) ? (kr - qrl[sb] + 7) : 15;
                    const lds_cptr tp = tb + drow * TB_ROW;
                    f32x16 p0;
#pragma unroll
                    for (int g = 0; g < 4; ++g) { const f32x4 a = *(const LAS f32x4*)(tp + 32 * g) + *(const LAS f32x4*)(tbm + 32 * g); p0[4 * g] = a[0]; p0[4 * g + 1] = a[1]; p0[4 * g + 2] = a[2]; p0[4 * g + 3] = a[3]; }
#pragma unroll
                    for (int d0 = 0; d0 < 4; ++d0) p0 = __builtin_amdgcn_mfma_f32_32x32x16_bf16(kf[d0], qr[sb][d0], p0, 0, 0, 0);
                    float s0 = 0.f;
#pragma unroll
                    for (int r = 0; r < 16; ++r) { p0[r] = __builtin_amdgcn_exp2f(p0[r]); s0 += p0[r]; }
                    lsum[sb] += s0;
                    const u32x4 pw0 = (u32x4){cvtpk(p0[0], p0[1]), cvtpk(p0[2], p0[3]), cvtpk(p0[4], p0[5]), cvtpk(p0[6], p0[7])};
                    const u32x4 pw1 = (u32x4){cvtpk(p0[8], p0[9]), cvtpk(p0[10], p0[11]), cvtpk(p0[12], p0[13]), cvtpk(p0[14], p0[15])};
#pragma unroll
                    for (int d0 = 0; d0 < 2; ++d0) {
                        o[sb][d0] = __builtin_amdgcn_mfma_f32_32x32x16_bf16(__builtin_bit_cast(bf16x8, pw0), (bf16x8){lo[d0][0][0], lo[d0][0][1], lo[d0][0][2], lo[d0][0][3], hh[d0][0][0], hh[d0][0][1], hh[d0][0][2], hh[d0][0][3]}, o[sb][d0], 0, 0, 0);
                        o[sb][d0] = __builtin_amdgcn_mfma_f32_32x32x16_bf16(__builtin_bit_cast(bf16x8, pw1), (bf16x8){lo[d0][1][0], lo[d0][1][1], lo[d0][1][2], lo[d0][1][3], hh[d0][1][0], hh[d0][1][1], hh[d0][1][2], hh[d0][1][3]}, o[sb][d0], 0, 0, 0);
                    }
                }
            }
        }
        sl_n2 = sl_cur;
        sl_cur = (sl_cur == (NSLOT - 1) * SLOTB) ? 0 : sl_cur + SLOTB;
    }
    AT_WAIT_BAR(0);
    int lane2 = lane; asm volatile("" : "+v"(lane2)); const int r32e = lane2 & 31, hie = lane2 >> 5;
    LAS float* wsf = (LAS float*)(lds + LDS_WS) + wid * 64;
    LAS bf16_t* stg = (LAS bf16_t*)(lds) + wid * 2048;
#pragma unroll
    for (int sb = 0; sb < 2; ++sb) {
        float ls = lsum[sb]; ls += __shfl_xor(ls, 32);
        if (hie == 0) wsf[r32e] = ls;
        asm volatile("s_waitcnt lgkmcnt(0)" ::: "memory");
#pragma unroll
        for (int r = 0; r < 16; ++r) { const int orow = crow(r, hie); const float rl = __builtin_amdgcn_rcpf(wsf[orow]);
            stg[orow * 64 + r32e] = (bf16_t)f2bf(o[sb][0][r] * rl); stg[orow * 64 + 32 + r32e] = (bf16_t)f2bf(o[sb][1][r] * rl); }
        asm volatile("s_waitcnt lgkmcnt(0)" ::: "memory");
        const int tbase = u.t0 + (4 * sb + 2 * rp) * 64 + 16 * jb;
#pragma unroll
        for (int i = 0; i < 4; ++i) { const int row = i * 8 + (lane2 >> 3), ch = lane2 & 7; const u32x4 v = *(const LAS u32x4*)(stg + row * 64 + ch * 8); const int tok = tbase + (row >> 4) * 64 + (row & 15);
            *(u32x4*)(mixed + (size_t)tok * D + u.hh16 * 64 + ch * 8) = v;
            { float s = 0.f, a;
              a = bf2f(v.x & 0xffffu); s += a * a; a = bf2f(v.x >> 16); s += a * a; a = bf2f(v.y & 0xffffu); s += a * a; a = bf2f(v.y >> 16); s += a * a;
              a = bf2f(v.z & 0xffffu); s += a * a; a = bf2f(v.z >> 16); s += a * a; a = bf2f(v.w & 0xffffu); s += a * a; a = bf2f(v.w >> 16); s += a * a;
              s += __shfl_xor(s, 1); s += __shfl_xor(s, 2); s += __shfl_xor(s, 4);
              if (ch == 0) ssq[(size_t)tok * 16 + u.hh16] = s; } }
        asm volatile("s_waitcnt lgkmcnt(0)" ::: "memory");
    }
    asm volatile("s_waitcnt lgkmcnt(0)\n\ts_barrier" ::: "memory");
#undef AT_DMA_K
#undef AT_DMA_V
}
__device__ __forceinline__ void build_table_b(LAS unsigned char* lds, const float* rpb_lh) {
    const int tid = opaque_tid0();
    for (int e = tid; e < 15 * 127; e += 512) { const int dr = e / 127, idx = e - dr * 127, rel = idx - 63; const float v = (rel >= -15 && rel <= 15) ? rpb_lh[dr * 31 + rel + 15] * LOG2E : 0.f;
#pragma unroll
        for (int c = 0; c < 4; ++c) *(LAS float*)(lds + LDS_TBB + dr * TB_ROW + c * TB_CS + (idx + c) * 4) = v; }
    if (tid >= 256 && tid < 256 + 127) { const int idx = tid - 256;
#pragma unroll
        for (int c = 0; c < 4; ++c) *(LAS float*)(lds + LDS_TBB + 15 * TB_ROW + c * TB_CS + (idx + c) * 4) = NEGBIG; }
    if (tid < 127) { const int j = tid - 63; const float v = (j >= 0 && j < 16) ? 0.f : NEGBIG;
#pragma unroll
        for (int c = 0; c < 4; ++c) *(LAS float*)(lds + LDS_TBM + c * TB_CS + (tid + c) * 4) = v; }
}

template <int TYPE>
__device__ __forceinline__ void attn_type_loop(Frame& F, int l, unsigned xcc, int qset) {
    constexpr int MQB = 2, MUP = 8 / MQB;
    constexpr int NPER = (TYPE == 2) ? 16 * MUP : (TYPE == 1 ? 96 : 192);
    unsigned* qcnt = F.ctl + CW_ATQ + ((qset * 3 + TYPE) * 8) * 64;
    LAS int* qw = (LAS int*)(F.lds + CTRL_BASE + 1024);
    const int tid = opaque_tid0();
    const int xq = (int)xcc & 7; int pre = -2;
    for (;;) {
        if (tid == 0) { int id, x; at_dequeue(qcnt, NPER, xq, pre, id, x); qw[0] = id; qw[1] = x; }
        __syncthreads();
        const int id = qw[0], x = qw[1];
        __syncthreads();
        if (id < 0) break;
        pre = -2; if (tid == 0 && x == xq) pre = (int)__hip_atomic_fetch_add(qcnt + xq * 64, 1u, RLX_AGENT);
        UnitDesc u; int h;
        if (TYPE == 2) { const int P = x * 16 + id / MUP, b = P >> 2, q0 = (id % MUP) * MQB; h = P & 3;
            mem_unit<MQB>(F.lds, qkv_ptr(F, 36 + h, b * SEQ + q0 * 256), memkv_ptr(F, l, h, b * MEM_LEN), memkv_ptr(F, l, 4 + h, b * MEM_LEN), b * SEQ + q0 * 256, 12 + h, (bf16_t*)(F.ws + WS_MIX), (float*)(F.ws + WS_SSQH));
            continue; }
        else if (TYPE == 1) { const int up = (0x0321 >> (4 * (id & 3))) & 3;
            const int P = x * 24 + (id >> 2), b = P / 6; h = P % 6; u.qb = up; u.h = h; u.t0 = b * SEQ + up * 512; u.hh16 = 6 + h;
            u.Q = qkv_ptr(F, 18 + h, b * SEQ); u.K = qkv_ptr(F, 24 + h, b * SEQ); u.V = qkv_ptr(F, 30 + h, b * SEQ);
            const int lo = min(max(8 * up - 4, 0), 24), hi2 = min(max(8 * up + 7 - 4, 0), 24) + 8; u.kt0 = lo; u.nt = hi2 - lo; }
        else { const int ord = (0x70615243 >> (4 * (id & 7))) & 7;
            const int P = x * 24 + (id >> 3), b = P / 6; h = P % 6; u.qb = ord; u.h = h; u.t0 = b * SEQ + ord * 256;
            if (TYPE == 0) { u.hh16 = h; u.Q = qkv_ptr(F, h, b * SEQ); u.K = qkv_ptr(F, 6 + h, b * SEQ); u.V = qkv_ptr(F, 12 + h, b * SEQ);
                const int lo = max(4 * ord - 16, 0), hi2 = min(4 * ord + 20, 32); u.kt0 = lo; u.nt = hi2 - lo; }
            else { u.hh16 = 6 + h; u.Q = qkv_ptr(F, 18 + h, b * SEQ); u.K = qkv_ptr(F, 24 + h, b * SEQ); u.V = qkv_ptr(F, 30 + h, b * SEQ);
                const int lo = min(max(4 * ord - 4, 0), 24), hi2 = min(max(4 * ord + 3 - 4, 0), 24) + 8; u.kt0 = lo; u.nt = hi2 - lo; } }
        if (TYPE == 1) build_table_b(F.lds, in_ptr(5) + (size_t)(l * 6 + h) * 15 * 31);
        if (TYPE == 1) nb_unit2(F.lds, u, (bf16_t*)(F.ws + WS_MIX), (float*)(F.ws + WS_SSQH)); else attn_unit<TYPE>(F.lds, u, (bf16_t*)(F.ws + WS_MIX), (float*)(F.ws + WS_SSQH));
    }
}
constexpr int SW_TAB = 131072, SW_CS = 1088, SW_STG = SW_TAB + 4 * SW_CS;
static_assert(SW_STG + 8 * 2048 <= CTRL_BASE, "sliding-window LDS map");
__device__ __forceinline__ void sw_unit(LAS unsigned char* lds, int b, int h, int p, int half, const bf16_t* Qh, const bf16_t* Kh, const bf16_t* Vh, bf16_t* PO, float* PL) {
    const int tid = opaque_tid0(), lane = tid & 63, r32 = lane & 31, hi = lane >> 5; const int wid = __builtin_amdgcn_readfirstlane(tid >> 6), pair = wid >> 1, w2 = wid & 1;
    const int dsh = 2 * p, nbsh = 5 - dsh, nblk = 1 << nbsh;
    const unsigned lds0 = (unsigned)(size_t)lds; lds_cptr shm3 = (lds_cptr)lds;
    { const float sd = exp2f(-8.0f * (float)(h + 1) / 6.0f) * LOG2E * (float)(1 << dsh);
      if (tid < 255) { const int rel = tid - 127, a = rel < 0 ? -rel : rel; const float v = a <= 64 ? -sd * (float)a : NEGBIG;
#pragma unroll
          for (int c = 0; c < 4; ++c) *(LAS float*)(lds + SW_TAB + c * SW_CS + (tid + c) * 4) = v; } }
    lds_cptr ka[4], va[2];
    { const int sw = (r32 >> 1) & 7;
#pragma unroll
      for (int d0 = 0; d0 < 4; ++d0) ka[d0] = shm3 + r32 * 128 + (((2 * d0 + hi) ^ sw) * 16);
      const int q = (lane & 15) >> 2, gb = (lane >> 4) & 1;
#pragma unroll
      for (int d0 = 0; d0 < 2; ++d0) va[d0] = shm3 + 8192 + (4 * hi + q) * 128 + ((2 * (d0 ^ (q >> 1)) + gb) * 32) + (lane & 3) * 8; }
    lds_cptr tb0; { const int idx0 = 63 - 32 * w2 - r32 + 4 * hi, c = (-idx0) & 3; tb0 = shm3 + SW_TAB + c * SW_CS + (idx0 + c) * 4; }
    const int G0 = 16 * half;
    const int prow = 8 * wid + (lane >> 3);
    const int kcol = ((lane & 7) ^ ((4 * wid + (lane >> 4)) & 7)) * 8, vcol = ((((lane & 7) >> 1) ^ (prow & 2)) * 16) + (lane & 1) * 8;
#define SW_DMA(lam) do { int tau_ = G0 - 1 + (lam); tau_ = tau_ < 0 ? 0 : (tau_ > 31 ? 31 : tau_); const int r_ = tau_ >> nbsh, n_ = tau_ & (nblk - 1); \
        const size_t ro_ = (size_t)((((n_ * 64 + prow) << dsh) + r_)) * HD; const unsigned d_ = lds0 + ((lam) & 7) * 16384 + wid * 1024; \
        glds16(Kh + ro_ + kcol, (unsigned)__builtin_amdgcn_readfirstlane(d_)); glds16(Vh + ro_ + vcol, (unsigned)__builtin_amdgcn_readfirstlane(d_ + 8192)); } while (0)
#define SW_QLOAD(dst, s) do { const int G_ = G0 + 4 * (s) + pair, r_ = G_ >> nbsh, n_ = G_ & (nblk - 1); const bf16_t* qw_ = Qh + (size_t)((((n_ * 64 + 32 * w2 + r32) << dsh) + r_)) * HD; \
        _Pragma("unroll") for (int d0 = 0; d0 < 4; ++d0) dst[d0] = *(const bf16x8*)(qw_ + d0 * 16 + hi * 8); } while (0)
    bf16x8 qr[4], qn[4];
    SW_QLOAD(qr, 0);
#pragma unroll
    for (int d0 = 0; d0 < 4; ++d0) qn[d0] = qr[d0];
#pragma unroll
    for (int lam = 0; lam < 8; ++lam) SW_DMA(lam);
    float lsum = 0.f; f32x16 o[2]; o[0] = f32x16{}; o[1] = f32x16{};
#define SW_EPI(s) do { const int G_ = G0 + 4 * (s) + pair, r_ = G_ >> nbsh, n_ = G_ & (nblk - 1); \
        lsum += __shfl_xor(lsum, 32); \
        if (hi == 0) PL[((size_t)p * T + (size_t)b * SEQ + (((n_ * 64 + 32 * w2 + r32) << dsh) + r_)) * 8 + h] = lsum; \
        LAS bf16_t* stg_ = (LAS bf16_t*)(lds + SW_STG + wid * 2048); \
        _Pragma("unroll") for (int d0 = 0; d0 < 2; ++d0) { \
            _Pragma("unroll") for (int r = 0; r < 16; ++r) stg_[crow(r, hi) * 32 + r32] = (bf16_t)f2bf(o[d0][r]); \
            asm volatile("s_waitcnt lgkmcnt(0)" ::: "memory"); \
            _Pragma("unroll") for (int i2 = 0; i2 < 2; ++i2) { const int row = i2 * 16 + (lane >> 2), ch = lane & 3; const u32x4 v = *(const LAS u32x4*)(stg_ + row * 32 + ch * 8); \
                *(u32x4*)(PO + ((size_t)p * T + (size_t)b * SEQ + (((n_ * 64 + 32 * w2 + row) << dsh) + r_)) * 384 + h * 64 + d0 * 32 + ch * 8) = v; } \
            asm volatile("s_waitcnt lgkmcnt(0)" ::: "memory"); } \
        lsum = 0.f; o[0] = f32x16{}; o[1] = f32x16{}; } while (0)
#define SW_WAIT(sig) do { if ((sig) == 0) AT_WAIT_BAR(8); else if ((sig) == 3 || (sig) == 6 || (sig) == 9) AT_WAIT_BAR(4); else if ((sig) == 10) AT_WAIT_BAR(2); else if ((sig) == 11) AT_WAIT_BAR(0); else AT_WAIT_BAR(6); } while (0)
#pragma unroll
    for (int sig = 0; sig < 12; ++sig) {
        const int s = sig / 3, t = sig - 3 * s;
        SW_WAIT(sig);
        if (t == 0 && s > 0) { SW_EPI(s - 1);
#pragma unroll
            for (int d0 = 0; d0 < 4; ++d0) qr[d0] = qn[d0]; }
        if (t == 2 && s < 3) SW_QLOAD(qn, s + 1);
        if (t == 1) { if (4 * s + 8 <= 17) SW_DMA(4 * s + 8); }
        if (t == 2) { if (4 * s + 9 <= 17) SW_DMA(4 * s + 9); }
        if (t == 0 && s > 0) { if (4 * s + 6 <= 17) SW_DMA(4 * s + 6); if (4 * s + 7 <= 17) SW_DMA(4 * s + 7); }
        const int G = G0 + 4 * s + pair, n = G & (nblk - 1);
        if (!(t == 0 && n == 0) && !(t == 2 && n == nblk - 1)) {
            const int slo = ((4 * s + t + pair) & 7) * 16384;
            const bool do0 = !(t == 0 && w2 == 1), do1 = !(t == 2 && w2 == 0);
            const lds_cptr tp = tb0 + t * 256;
            if (do0) {
                f32x16 p0;
#pragma unroll
                for (int gq = 0; gq < 4; ++gq) { const f32x4 a = *(const LAS f32x4*)(tp + 32 * gq); p0[4 * gq] = a[0]; p0[4 * gq + 1] = a[1]; p0[4 * gq + 2] = a[2]; p0[4 * gq + 3] = a[3]; }
#pragma unroll
                for (int d0 = 0; d0 < 4; ++d0) p0 = __builtin_amdgcn_mfma_f32_32x32x16_bf16(*(const LAS bf16x8*)(ka[d0] + slo), qr[d0], p0, 0, 0, 0);
                float s0 = 0.f;
#pragma unroll
                for (int r = 0; r < 16; ++r) { p0[r] = __builtin_amdgcn_exp2f(p0[r]); s0 += p0[r]; }
                lsum += s0;
                const u32x4 pw0 = (u32x4){cvtpk(p0[0], p0[1]), cvtpk(p0[2], p0[3]), cvtpk(p0[4], p0[5]), cvtpk(p0[6], p0[7])}, pw1 = (u32x4){cvtpk(p0[8], p0[9]), cvtpk(p0[10], p0[11]), cvtpk(p0[12], p0[13]), cvtpk(p0[14], p0[15])};
#pragma unroll
                for (int d0 = 0; d0 < 2; ++d0) { const lds_cptr vp = va[d0] + slo; const s16x4 l0 = vtr(vp), h0 = vtr(vp + 1024), l1 = vtr(vp + 2048), h1 = vtr(vp + 2048 + 1024);
                    o[d0] = __builtin_amdgcn_mfma_f32_32x32x16_bf16(__builtin_bit_cast(bf16x8, pw0), (bf16x8){l0[0], l0[1], l0[2], l0[3], h0[0], h0[1], h0[2], h0[3]}, o[d0], 0, 0, 0);
                    o[d0] = __builtin_amdgcn_mfma_f32_32x32x16_bf16(__builtin_bit_cast(bf16x8, pw1), (bf16x8){l1[0], l1[1], l1[2], l1[3], h1[0], h1[1], h1[2], h1[3]}, o[d0], 0, 0, 0); }
            }
            if (do1) {
                f32x16 p1;
#pragma unroll
                for (int gq = 0; gq < 4; ++gq) { const f32x4 a = *(const LAS f32x4*)(tp + 32 * (gq + 4)); p1[4 * gq] = a[0]; p1[4 * gq + 1] = a[1]; p1[4 * gq + 2] = a[2]; p1[4 * gq + 3] = a[3]; }
#pragma unroll
                for (int d0 = 0; d0 < 4; ++d0) p1 = __builtin_amdgcn_mfma_f32_32x32x16_bf16(*(const LAS bf16x8*)(ka[d0] + slo + 4096), qr[d0], p1, 0, 0, 0);
                float s1 = 0.f;
#pragma unroll
                for (int r = 0; r < 16; ++r) { p1[r] = __builtin_amdgcn_exp2f(p1[r]); s1 += p1[r]; }
                lsum += s1;
                const u32x4 pw2 = (u32x4){cvtpk(p1[0], p1[1]), cvtpk(p1[2], p1[3]), cvtpk(p1[4], p1[5]), cvtpk(p1[6], p1[7])}, pw3 = (u32x4){cvtpk(p1[8], p1[9]), cvtpk(p1[10], p1[11]), cvtpk(p1[12], p1[13]), cvtpk(p1[14], p1[15])};
#pragma unroll
                for (int d0 = 0; d0 < 2; ++d0) { const lds_cptr vp = va[d0] + slo + 4096; const s16x4 l0 = vtr(vp), h0 = vtr(vp + 1024), l1 = vtr(vp + 2048), h1 = vtr(vp + 2048 + 1024);
                    o[d0] = __builtin_amdgcn_mfma_f32_32x32x16_bf16(__builtin_bit_cast(bf16x8, pw2), (bf16x8){l0[0], l0[1], l0[2], l0[3], h0[0], h0[1], h0[2], h0[3]}, o[d0], 0, 0, 0);
                    o[d0] = __builtin_amdgcn_mfma_f32_32x32x16_bf16(__builtin_bit_cast(bf16x8, pw3), (bf16x8){l1[0], l1[1], l1[2], l1[3], h1[0], h1[1], h1[2], h1[3]}, o[d0], 0, 0, 0); }
            }
        }
    }
    AT_WAIT_BAR(0);
    SW_EPI(3);
    asm volatile("s_waitcnt lgkmcnt(0)\n\ts_barrier" ::: "memory");
#undef SW_DMA
#undef SW_QLOAD
#undef SW_EPI
#undef SW_WAIT
}
__device__ __forceinline__ void sa_loop(Frame& F, int l, unsigned xcc, int qset) {
    constexpr int NPER = 144;
    unsigned* qcnt = F.ctl + CW_ATQ + ((qset * 3 + 0) * 8) * 64;
    LAS int* qw = (LAS int*)(F.lds + CTRL_BASE + 1024);
    const int tid = opaque_tid0();
    const int xq = (int)xcc & 7; int pre = -2;
    for (;;) {
        if (tid == 0) { int id, x; at_dequeue(qcnt, NPER, xq, pre, id, x); qw[0] = id; qw[1] = x; }
        __syncthreads();
        const int id = qw[0], x = qw[1];
        __syncthreads();
        if (id < 0) break;
        pre = -2; if (tid == 0 && x == xq) pre = (int)__hip_atomic_fetch_add(qcnt + xq * 64, 1u, RLX_AGENT);
        const int P = x * 24 + id / 6, b = P / 6, h = P % 6, p = (id % 6) >> 1, half = id & 1;
        sw_unit(F.lds, b, h, p, half, qkv_ptr(F, h, b * SEQ), qkv_ptr(F, 6 + h, b * SEQ), qkv_ptr(F, 12 + h, b * SEQ), (bf16_t*)(F.ws + WS_PO), (float*)(F.ws + WS_PL));
    }
}
}

__device__ __forceinline__ void moe_weights_beside(Frame& F, int l, int qset) {
    PHASE_IDS(F);
    if ((blockIdx.x & 31) >= 8) return;
    LAS float* scr = (LAS float*)(F.lds + F.wave * 16384);
    LAS int* qw = (LAS int*)(F.lds + CTRL_BASE + 1024);
    constexpr int I_G = 16 * 16, I_D = 8 * 32, PER_E = 2 * I_G + I_D, NIT = NE * PER_E, BATCH_IT = 64;
    unsigned* head = F.ctl + CW_WQ + qset * 64;
    for (;;) {
        if (F.tid == 0) qw[2] = (int)__hip_atomic_fetch_add(head, 1u, RLX_AGENT);
        __syncthreads();
        const int bt = qw[2];
        __syncthreads();
        if (bt * BATCH_IT >= NIT) break;
        auto dec = [&](int j) { const int it = bt * BATCH_IT + j; const int e = it / PER_E; int r = it % PER_E; const size_t le = (size_t)l * NE + e;
            if (r < I_G) return TrItem{in_ptr(15) + le * D * DE, in_ptr(10) + l * D, (bf16_t*)(F.ws + WS_WGU + le * 1024 * D), D, DE, 6, r};
            r -= I_G;
            if (r < I_G) return TrItem{in_ptr(16) + le * D * DE, in_ptr(10) + l * D, (bf16_t*)(F.ws + WS_WGU + le * 1024 * D), D, DE, 7, r};
            r -= I_G;
            return TrItem{in_ptr(17) + le * DE * D, (const float*)nullptr, (bf16_t*)(F.ws + WS_WD + le * D * DE), DE, D, 5, r}; };
        float wa[32], wb[32];
        TrItem d0 = dec(F.wave); tr_load(d0, F.lane, wa);
#pragma unroll
        for (int jj = 0; jj < BATCH_IT / NWAVES; jj += 2) {
            TrItem d1 = dec(F.wave + (jj + 1) * NWAVES); tr_load(d1, F.lane, wb);
            tr_finish(d0, F.lane, wa, scr);
            if (jj + 2 < BATCH_IT / NWAVES) { d0 = dec(F.wave + (jj + 2) * NWAVES); tr_load(d0, F.lane, wa); }
            tr_finish(d1, F.lane, wb, scr);
        }
    }
    __syncthreads();
}
__device__ __forceinline__ void phase_attn_fast(Frame& F, int l, int qset) {
    if (qset < 2) moe_weights_beside(F, l, qset);
    PHASE_IDS(F);
    const unsigned xcc = xb_xcc_id();
    at::sa_loop(F, l, xcc, qset);
    if (PROBE_ID == 100 && l == 0) { __syncthreads(); at::sa_loop(F, l, xcc, 2); }
    at::attn_type_loop<1>(F, l, xcc, qset);
    if (PROBE_ID == 101 && l == 0) { __syncthreads(); at::attn_type_loop<1>(F, l, xcc, 2); }
    at::attn_type_loop<2>(F, l, xcc, qset);
    if (PROBE_ID == 102 && l == 0) { __syncthreads(); at::attn_type_loop<2>(F, l, xcc, 2); }
}

__device__ __forceinline__ bool in_ph(int lo, int hi, int k) { asm volatile("" : "+s"(lo), "+s"(hi)); return lo <= k && k < hi; }
constexpr int PH_TOTAL = 2 + 8 * DEPTH - 1;
__global__ void __launch_bounds__(NWAVES * 64, 2) fwd(Args args) {
    extern __shared__ __attribute__((aligned(16))) unsigned char lds[];
    Frame F;
    F.lds = (LAS unsigned char*)lds; PHASE_IDS(F);
    F.G = gridDim.x; F.ngw = F.G * NWAVES;
    F.out = args.out; F.ws = args.ws; F.ctl = (unsigned*)(args.ws + WS_CTL);
    volatile LAS unsigned* MISC = (volatile LAS unsigned*)(F.lds + MISC_OFF);
    if (F.tid < 32) MISC[F.tid] = 0u;
    __syncthreads();
    const int lo = args.ph_lo, hi = args.ph_hi;
    XcdBarrier bar; bar.bar = F.ctl + CW_BAR; bar.x = 0; bar.st = nullptr;
    if (hi - lo > 1) bar = xcd_barrier_post(F.ctl + CW_BAR, MISC + 8);
#define IN(k) in_ph(lo, hi, (k))
#define SEAM(k) do { if (IN(k) && IN((k) + 1)) xcd_barrier(bar); else __syncthreads(); } while (0)
#define RUN(k, code) do { if (IN(k)) { code; if (PROBE_ID == (k)) { xcd_barrier(bar); code; } } SEAM(k); } while (0)
    RUN(0, { phase_weights(F); phase_x0(F); });
    RUN(1, { phase_memkv_fast(F); phase_inproj_fast(F, 0); });
    { const int l = 0, pb = 2;
      if (IN(pb + 0)) { phase_attn_fast(F, l, 0); if (PROBE_ID == pb + 0) { xcd_barrier(bar); phase_attn_fast(F, l, 2); } } SEAM(pb + 0);
      RUN(pb + 1, { phase_groupnorm(F); });
      RUN(pb + 2, { phase_outproj_fast(F, l); });
      RUN(pb + 3, { phase_router_fast(F, l); });
      RUN(pb + 4, { phase_moe1_fast(F, l); });
      RUN(pb + 5, { phase_moe2_fast(F, l); });
      RUN(pb + 6, { phase_combine(F, l); });
      RUN(pb + 7, { phase_inproj_fast(F, 1); });
    }
    { const int l = 1, pb = 10;
      if (IN(pb + 0)) { phase_attn_fast(F, l, 1); if (PROBE_ID == pb + 0) { xcd_barrier(bar); phase_attn_fast(F, l, 3); } } SEAM(pb + 0);
      RUN(pb + 1, { phase_groupnorm(F); });
      RUN(pb + 2, { phase_outproj_fast(F, l); });
      RUN(pb + 3, { phase_router_fast(F, l); });
      RUN(pb + 4, { phase_moe1_fast(F, l); });
      RUN(pb + 5, { phase_moe2_fast(F, l); });
      RUN(pb + 6, { phase_combine(F, l); });
    }
#undef IN
#undef SEAM
#undef RUN
}

extern "C" void kernel_launch(void* const* d_in, const int* in_sizes, int n_in, void* d_out, int out_size, void* d_ws, size_t ws_size, hipStream_t stream) {
    static int grid = 0;
    if (grid == 0) {
        if (n_in != 18 || in_sizes[0] != T * D || out_size != T * D || ws_size < WS_END) { fprintf(stderr, "kernel_launch: unexpected shapes (n_in %d, in0 %d, out %d, ws %zu < %zu); nothing launched\n", n_in, n_in > 0 ? in_sizes[0] : -1, out_size, ws_size, (size_t)WS_END); grid = -1; return; }
        int dev = 0, cus = 0, per_cu = 0;
        if (hipGetDevice(&dev) != hipSuccess || hipDeviceGetAttribute(&cus, hipDeviceAttributeMultiprocessorCount, dev) != hipSuccess) { grid = -1; return; }
        if (hipFuncSetAttribute((const void*)fwd, hipFuncAttributeMaxDynamicSharedMemorySize, LDS_BYTES) != hipSuccess) { fprintf(stderr, "kernel_launch: hipFuncSetAttribute failed\n"); grid = -1; return; }
        if (hipOccupancyMaxActiveBlocksPerMultiprocessor(&per_cu, (const void*)fwd, NWAVES * 64, LDS_BYTES) != hipSuccess || per_cu < 1) fprintf(stderr, "kernel_launch: occupancy query reports %d\n", per_cu);
        (void)hipGetLastError();
        grid = cus;
    }
    if (grid < 0) return;
    if (hipMemsetAsync((char*)d_ws + WS_CTL, 0, CTL_ZERO_BYTES, stream) != hipSuccess) { fprintf(stderr, "kernel_launch: memset failed\n"); return; }
    Args a{};
    for (int i = 0; i < 18; ++i) a.in[i] = (const float*)d_in[i];
    a.out = (float*)d_out; a.ws = (unsigned char*)d_ws;
#if MK_ONE_LAUNCH
    a.ph_lo = 0; a.ph_hi = PH_TOTAL;
    hipLaunchKernelGGL(fwd, dim3(grid), dim3(NWAVES * 64), LDS_BYTES, stream, a);
#else
    for (int p = 0; p < PH_TOTAL; ++p) { a.ph_lo = p; a.ph_hi = p + 1; hipLaunchKernelGGL(fwd, dim3(grid), dim3(NWAVES * 64), LDS_BYTES, stream, a); }
#endif
    const hipError_t le = hipPeekAtLastError();
    if (le != hipSuccess) fprintf(stderr, "kernel_launch: launch failed: %s\n", hipGetErrorName(le));
}
```

```cpp
#include <hip/hip_runtime.h>
#include <cstdio>
#include <cstdint>

#ifndef PROBE_ID
#define PROBE_ID (-1)
#endif
#ifndef SPARSE_A
#define SPARSE_A 1
#endif
#ifndef MK_ONE_LAUNCH
#define MK_ONE_LAUNCH 1
#endif

constexpr int D = 1024, BATCH = 32, SEQ = 2048, T = BATCH * SEQ, DEPTH = 2;
constexpr int MEM_LEN = 256, TM = BATCH * MEM_LEN;
constexpr int HD = 64, INW = 2560, NHS = 40;
constexpr int NE = 32, EPG = 8, NGRP = 4, DE = 512;
constexpr float EPS = 1e-6f, LOG2E = 1.4426950408889634f, ATTN_SCALE = 0.125f;
constexpr int YROWS = 2 * T + NE * 256;

constexpr size_t MiB = 1u << 20;
constexpr size_t WS_CTL = 0, CTL_ZERO_BYTES = 1 * MiB;
constexpr size_t WS_WIN = 1 * MiB;
constexpr size_t WS_WMEM = WS_WIN + 10 * MiB;
constexpr size_t WS_WOUT = WS_WMEM + 2 * MiB;
constexpr size_t WS_WR = WS_WOUT + 4 * MiB;
constexpr size_t WS_WGU = WS_WR + 1 * MiB;
constexpr size_t WS_X8 = WS_WGU + 64 * MiB;
constexpr size_t WS_WD = WS_WGU + 128 * MiB;
constexpr size_t WS_FAB = WS_WD + 32 * MiB;
constexpr size_t WS_RM = WS_WD + 33 * MiB;
constexpr size_t WS_XB = WS_WD + 64 * MiB;
constexpr size_t WS_RS = WS_XB + 128 * MiB;
constexpr size_t WS_SSQ1 = WS_RS + 1 * MiB;
constexpr size_t WS_SSQH = WS_SSQ1 + 4 * MiB;
constexpr size_t WS_MB = WS_SSQH + 4 * MiB;
constexpr size_t WS_RSM = WS_MB + 16 * MiB;
constexpr size_t WS_MEMKV = WS_RSM + 1 * MiB;
constexpr size_t WS_ROUTE = WS_MEMKV + 16 * MiB;
constexpr size_t WS_LIST = WS_ROUTE + 1 * MiB;
constexpr size_t WS_WL = WS_LIST + 8 * MiB;
constexpr size_t WS_RSL = WS_WL + 8 * MiB;
constexpr size_t WS_QKV = WS_RSL + 8 * MiB;
constexpr size_t WS_MIX = WS_QKV + 320 * MiB;
constexpr size_t WS_PO = WS_MIX + 136 * MiB;
constexpr size_t WS_PL = WS_PO + 144 * MiB;
constexpr size_t WS_END = WS_PL + 6 * MiB;
static_assert(WS_END <= 1024 * MiB, "workspace map exceeds 1 GiB");
static_assert((size_t)YROWS * 1024 * 2 <= 320 * MiB && (size_t)YROWS * 512 * 4 <= 320 * MiB && (size_t)YROWS * 512 * 2 <= 136 * MiB, "aliases");
constexpr int CW_BAR = 4096;
constexpr int CW_RND = 45056;
constexpr int CW_WQ = 40960;
constexpr int CW_ATQ = 32768;
constexpr int CW_CNT = 16384;

constexpr int LDS_BYTES = 163840;
constexpr int CTRL_BASE = 159744;
constexpr int MISC_OFF = CTRL_BASE + 2048;
constexpr int NWAVES = 8;

#define GAS __attribute__((address_space(1)))
#define LAS __attribute__((address_space(3)))
typedef unsigned short bf16_t;
typedef unsigned u32x4 __attribute__((ext_vector_type(4)));
typedef unsigned u32x2 __attribute__((ext_vector_type(2)));
typedef float f32x4 __attribute__((ext_vector_type(4)));
#define RLX_AGENT __ATOMIC_RELAXED, __HIP_MEMORY_SCOPE_AGENT

__device__ __forceinline__ float bf2f(unsigned v) { return __uint_as_float(v << 16); }
__device__ __forceinline__ unsigned f2bf(float f) { unsigned u = __float_as_uint(f); return (u + 0x7fffu + ((u >> 16) & 1u)) >> 16; }
__device__ __forceinline__ unsigned pk2(float lo, float hi) { return f2bf(lo) | (f2bf(hi) << 16); }
__device__ __forceinline__ float wave_sum(float v) {
#pragma unroll
    for (int o = 1; o < 64; o <<= 1) v += __shfl_xor(v, o);
    return v;
}
__device__ __forceinline__ float wave_max(float v) {
#pragma unroll
    for (int o = 1; o < 64; o <<= 1) v = fmaxf(v, __shfl_xor(v, o));
    return v;
}

#define XB_TMO      128
#define XB_XCNT(j)  (256  + 64 * (j))
#define XB_XSUB(j)  (1280 + 64 * (j))
#define XB_XGEN(j)  (2304 + 64 * (j))
#define XB_TOP      3328
#define XB_TOPGEN   3392
#define XCD_BAR_WORDS 3456
#define XB_SPIN_CAP (1u << 18)
__device__ __forceinline__ unsigned xb_ld(unsigned* p)              { return __hip_atomic_load(p, __ATOMIC_RELAXED, __HIP_MEMORY_SCOPE_AGENT); }
__device__ __forceinline__ unsigned xb_add(unsigned* p, unsigned v) { return __hip_atomic_fetch_add(p, v, __ATOMIC_RELAXED, __HIP_MEMORY_SCOPE_AGENT); }
__device__ __forceinline__ unsigned xb_xcc_id() { return (unsigned)__builtin_amdgcn_s_getreg((3 << 11) | 20) & 0xFu; }
#define XB_SPIN(cond, bar) do { unsigned _sp = 0; while (cond) { __builtin_amdgcn_s_sleep(1); \
    if ((++_sp & 255u) == 0u) { if (xb_ld(&(bar)[XB_TMO])) break; if (_sp > XB_SPIN_CAP) { atomicAdd(&(bar)[XB_TMO], 1u); break; } } } } while (0)
struct XcdBarrier { unsigned* bar; unsigned x; volatile LAS unsigned* st; };
__device__ __forceinline__ XcdBarrier xcd_barrier_post(unsigned* bar, volatile LAS unsigned* st) {
    XcdBarrier b; b.bar = bar; b.x = xb_xcc_id(); b.st = st;
    if (threadIdx.x == 0) (void)xb_add(&bar[XB_XCNT(b.x)], 1u);
    return b;
}
__device__ __forceinline__ void xcd_barrier_complete(unsigned* bar, unsigned x, unsigned& nloc, unsigned& nx) {
    const unsigned G = gridDim.x * gridDim.y * gridDim.z;
    unsigned sum, cnt, mine, sp = 0u;
    for (;;) {
        sum = 0u; cnt = 0u; mine = 0u;
#pragma unroll
        for (unsigned j = 0; j < 16; ++j) { const unsigned c = xb_ld(&bar[XB_XCNT(j)]); sum += c; cnt += (c > 0u) ? 1u : 0u; mine = (j == x) ? c : mine; }
        if (sum == G) break;
        __builtin_amdgcn_s_sleep(1);
        if ((++sp & 255u) == 0u) { if (xb_ld(&bar[XB_TMO])) break; if (sp > XB_SPIN_CAP) { atomicAdd(&bar[XB_TMO], 1u); break; } }
    }
    nloc = mine > 0u ? mine : 1u; nx = cnt > 0u ? cnt : 1u;
}
__device__ __forceinline__ void xcd_barrier(const XcdBarrier& b) {
    asm volatile("s_waitcnt vmcnt(0)" ::: "memory");
    __syncthreads();
    if (threadIdx.x == 0) {
        unsigned* bar = b.bar;
        __builtin_amdgcn_s_waitcnt(0);
        unsigned nloc = b.st[0], nx = b.st[1];
        if (nloc == 0u) { xcd_barrier_complete(bar, b.x, nloc, nx); b.st[0] = nloc; b.st[1] = nx; }
        const unsigned old = xb_add(&bar[XB_XSUB(b.x)], 1u);
        const unsigned gen = old / nloc;
        if (old + 1u == (gen + 1u) * nloc) {
            __builtin_amdgcn_fence(__ATOMIC_RELEASE, "agent");
            asm volatile("s_waitcnt vmcnt(0)" ::: "memory");
            const unsigned og = xb_add(&bar[XB_TOP], 1u);
            const unsigned tg = og / nx;
            if (og + 1u == (tg + 1u) * nx) xb_add(&bar[XB_TOPGEN], 1u);
            else XB_SPIN(xb_ld(&bar[XB_TOPGEN]) == tg, bar);
            __builtin_amdgcn_fence(__ATOMIC_ACQUIRE, "agent");
            xb_add(&bar[XB_XGEN(b.x)], 1u);
            asm volatile("s_waitcnt vmcnt(0)" ::: "memory");
        } else {
            XB_SPIN(xb_ld(&bar[XB_XGEN(b.x)]) == gen, bar);
            __builtin_amdgcn_fence(__ATOMIC_ACQUIRE, "agent");
            asm volatile("s_waitcnt vmcnt(0)" ::: "memory");
        }
    }
    __syncthreads();
}

struct Args {
    const float* in[18]; float* out; unsigned char* ws; int ph_lo, ph_hi;
};
__device__ __forceinline__ const float* in_ptr(int k) {
    const __attribute__((address_space(4))) char* ka = (const __attribute__((address_space(4))) char*)__builtin_amdgcn_kernarg_segment_ptr();
    asm volatile("" : "+s"(ka));
    return *(const float* const __attribute__((address_space(4)))*)(ka + 8 * k);
}
struct Frame {
    LAS unsigned char* lds; int tid, lane, wave, G, gw, ngw;
    float* out; unsigned char* ws; unsigned* ctl;
};

#define PHASE_IDS(F) do { (F).tid = opaque_tid0(); (F).lane = (F).tid & 63; (F).wave = __builtin_amdgcn_readfirstlane((F).tid >> 6); (F).gw = blockIdx.x * NWAVES + (F).wave; } while (0)
__device__ __forceinline__ int opaque_tid0() { int t = threadIdx.x; asm volatile("" : "+v"(t)); return t; }
__host__ __device__ __forceinline__ int inproj_gemm_col(int H, int dim) {
    const int pn = H >> 2, wc = H & 3, bj = dim >> 5, fq = (dim >> 3) & 3, nn = (dim >> 2) & 1, j = dim & 3;
    return 256 * pn + 128 * bj + 32 * wc + 16 * nn + 4 * fq + j;
}
__host__ __device__ __forceinline__ void inproj_head_dim(int c, int& H, int& dim) {
    const int pn = c >> 8, r = c & 255, bj = r >> 7, wc = (r >> 5) & 3, nn = (r >> 4) & 1, fq = (r >> 2) & 3, j = r & 3;
    H = 4 * pn + wc; dim = 32 * bj + 8 * fq + 4 * nn + j;
}

struct TrItem { const float* W; const float* kgain; bf16_t* WT; int K, N, kind, item; };
__device__ __forceinline__ void tr_load(const TrItem& d, int lane, float (&wv)[32]) {
    const int nblk = d.N / 32, kb = d.item / nblk, nb = d.item % nblk, k0 = 64 * kb, n0 = 32 * nb;
#pragma unroll
    for (int i = 0; i < 32; ++i) wv[i] = d.W[(size_t)(k0 + 2 * i + (lane >> 5)) * d.N + n0 + (lane & 31)];
}
__device__ __forceinline__ int tr_rowmap(int kind, int n);
__device__ __forceinline__ void tr_finish(const TrItem& d, int lane, const float (&wv)[32], LAS float* scr) {
    const int nblk = d.N / 32, kb = d.item / nblk, nb = d.item % nblk, k0 = 64 * kb, n0 = 32 * nb;
#pragma unroll
    for (int i = 0; i < 32; ++i) { const int kk = 2 * i + (lane >> 5); const float g = d.kgain ? d.kgain[k0 + kk] : 1.f; scr[kk * 33 + (lane & 31)] = wv[i] * g; }
    asm volatile("s_waitcnt lgkmcnt(0)" ::: "memory");
    const int c = lane & 7;
#pragma unroll
    for (int j = 0; j < 4; ++j) { const int n = (lane >> 3) + 8 * j; const LAS float* s = scr + (8 * c) * 33 + n;
        u32x4 o; o.x = pk2(s[0 * 33], s[1 * 33]); o.y = pk2(s[2 * 33], s[3 * 33]); o.z = pk2(s[4 * 33], s[5 * 33]); o.w = pk2(s[6 * 33], s[7 * 33]);
        if (d.kind >= 5) {
            int w0 = 0, w1 = 0;
            w0 = __builtin_amdgcn_cvt_pk_fp8_f32(32.f * s[0 * 33], 32.f * s[1 * 33], w0, false); w0 = __builtin_amdgcn_cvt_pk_fp8_f32(32.f * s[2 * 33], 32.f * s[3 * 33], w0, true);
            w1 = __builtin_amdgcn_cvt_pk_fp8_f32(32.f * s[4 * 33], 32.f * s[5 * 33], w1, false); w1 = __builtin_amdgcn_cvt_pk_fp8_f32(32.f * s[6 * 33], 32.f * s[7 * 33], w1, true);
            u32x2 o8; o8.x = (unsigned)w0; o8.y = (unsigned)w1;
            *(u32x2*)((unsigned char*)d.WT + (size_t)tr_rowmap(d.kind, n0 + n) * d.K + k0 + 8 * c) = o8;
        } else *(u32x4*)(d.WT + (size_t)tr_rowmap(d.kind, n0 + n) * d.K + k0 + 8 * c) = o; }
    asm volatile("s_waitcnt lgkmcnt(0)" ::: "memory");
}
struct RmId { __device__ __forceinline__ int operator()(int n) const { return n; } };
struct RmHead { __device__ __forceinline__ int operator()(int n) const { return inproj_gemm_col(n >> 6, n & 63); } };
__host__ __device__ __forceinline__ int perm_row32(int c) { const int o = c & 31; return (c & ~31) | (16 * ((o >> 2) & 1) + 4 * (o >> 3) + (o & 3)); }
__host__ __device__ __forceinline__ int gate_row(int c, int up) { return 256 * (c >> 7) + 128 * up + perm_row32(c & 127); }
struct RmGate { int up; __device__ __forceinline__ int operator()(int n) const { return gate_row(n, up); } };
struct RmPerm { __device__ __forceinline__ int operator()(int n) const { return perm_row32(n); } };
__device__ __forceinline__ int tr_rowmap(int kind, int n) { return kind == 0 ? n : ((kind == 1 || kind == 8) ? inproj_gemm_col(n >> 6, n & 63) : ((kind == 2 || kind == 6) ? gate_row(n, 0) : ((kind == 3 || kind == 7) ? gate_row(n, 1) : perm_row32(n)))); }

__device__ __forceinline__ TrItem tr_decode_small(int it) {
    constexpr int I_IN = 16 * 80, I_MEM = 16 * 16, I_OUT = 16 * 32, PER_L = I_IN + I_MEM + I_OUT;
    const int l = it / PER_L; int r = it % PER_L;
    if (r < I_IN) return TrItem{in_ptr(3) + (size_t)l * D * INW, in_ptr(2) + l * D, (bf16_t*)nullptr, D, INW, 100 + l, r};
    r -= I_IN;
    if (r < I_MEM) return TrItem{in_ptr(7) + (size_t)l * D * 512, in_ptr(6) + l * D, (bf16_t*)nullptr, D, 512, 200 + l, r};
    r -= I_MEM;
    return TrItem{in_ptr(9) + (size_t)l * D * D, in_ptr(8) + l * D, (bf16_t*)nullptr, D, D, 300 + l, r};
}
__device__ __forceinline__ void phase_weights(Frame& F) {
    PHASE_IDS(F);
    LAS float* scr = (LAS float*)(F.lds + F.wave * 16384);
    constexpr int PER_L = 16 * 80 + 16 * 16 + 16 * 32, NIT = DEPTH * PER_L;
    auto fix = [&](TrItem d) { const int l = d.kind % 100, w = d.kind / 100;
        if (w == 1) { if (l == 0) { d.WT = (bf16_t*)(F.ws + WS_WIN); d.kind = 1; } else { d.WT = (bf16_t*)(F.ws + WS_WIN + (size_t)INW * D * 2); d.kind = 8; } } else if (w == 2) { d.WT = (bf16_t*)(F.ws + WS_WMEM) + (size_t)l * 512 * D; d.kind = 1; } else { d.WT = (bf16_t*)(F.ws + WS_WOUT) + (size_t)l * D * D; d.kind = 4; }
        return d; };
    float wa[32], wb[32];
    int it = F.gw;
    if (it < NIT) { TrItem d = fix(tr_decode_small(it)); tr_load(d, F.lane, wa);
        for (;;) {
            const int it2 = it + F.ngw; TrItem d2 = d; const bool more = it2 < NIT;
            if (more) { d2 = fix(tr_decode_small(it2)); tr_load(d2, F.lane, wb); }
            tr_finish(d, F.lane, wa, scr);
            if (!more) break;
            const int it3 = it2 + F.ngw; const bool more3 = it3 < NIT; TrItem d3 = d2;
            if (more3) { d3 = fix(tr_decode_small(it3)); tr_load(d3, F.lane, wa); }
            tr_finish(d2, F.lane, wb, scr);
            if (!more3) break;
            it = it3; d = d3;
        } }
    for (int i = F.gw * 64 + F.lane; i < DEPTH * 256 * D; i += F.ngw * 64) {
        const int l = i / (256 * D), j = (i / D) % 256, k = i % D; float v = 0.f;
        if (j < 4) v = in_ptr(11)[((size_t)l * D + k) * NGRP + j] * in_ptr(10)[l * D + k]; else if (j < 36) v = in_ptr(13)[((size_t)l * D + k) * NE + (j - 4)] * in_ptr(10)[l * D + k];
        ((bf16_t*)(F.ws + WS_WR))[i] = (bf16_t)f2bf(v);
    }
}

__device__ __forceinline__ void row_to_bf16_rs(int lane, const float* xrow, bf16_t* orow, float* rs) {
    const f32x4* xr = (const f32x4*)xrow + lane; f32x4 v[4]; float s = 0.f;
#pragma unroll
    for (int j = 0; j < 4; ++j) { v[j] = xr[64 * j]; s += (v[j].x * v[j].x + v[j].y * v[j].y) + (v[j].z * v[j].z + v[j].w * v[j].w); }
    s = wave_sum(s);
    if (lane == 0) *rs = 1.0f / sqrtf(s * (1.f / D) + EPS);
    u32x2* o8 = (u32x2*)orow + lane;
#pragma unroll
    for (int j = 0; j < 4; ++j) { u32x2 w; w.x = pk2(v[j].x, v[j].y); w.y = pk2(v[j].z, v[j].w); o8[64 * j] = w; }
}
__device__ __forceinline__ void phase_x0(Frame& F) {
    PHASE_IDS(F);
    const float* xp = in_ptr(0); const float* mp = in_ptr(1); const int lane = F.lane;
    for (int m0 = F.gw * 2; m0 < T + TM; m0 += F.ngw * 2) {
        const bool isx = m0 < T; const int r0 = isx ? m0 : m0 - T;
        const float* src = (isx ? xp : mp) + (size_t)r0 * D; bf16_t* dst = (bf16_t*)(F.ws + (isx ? WS_XB : WS_MB)) + (size_t)r0 * D; float* rs = (float*)(F.ws + (isx ? WS_RS : WS_RSM)) + r0;
        f32x4 v[2][4];
#pragma unroll
        for (int k = 0; k < 2; ++k)
#pragma unroll
            for (int j = 0; j < 4; ++j) v[k][j] = ((const f32x4*)(src + (size_t)k * D) + lane)[64 * j];
#pragma unroll
        for (int k = 0; k < 2; ++k) { float s = 0.f;
#pragma unroll
            for (int j = 0; j < 4; ++j) s += (v[k][j].x * v[k][j].x + v[k][j].y * v[k][j].y) + (v[k][j].z * v[k][j].z + v[k][j].w * v[k][j].w);
            s = wave_sum(s);
            if (lane == 0) rs[k] = 1.0f / sqrtf(s * (1.f / D) + EPS);
            u32x2* o8 = (u32x2*)(dst + (size_t)k * D) + lane;
#pragma unroll
            for (int j = 0; j < 4; ++j) { u32x2 w; w.x = pk2(v[k][j].x, v[k][j].y); w.y = pk2(v[k][j].z, v[k][j].w); o8[64 * j] = w; } }
    }
}

__device__ __forceinline__ bf16_t* qkv_ptr(Frame& F, int H, int t) { return (bf16_t*)(F.ws + WS_QKV) + ((size_t)H * T + t) * HD; }
__device__ __forceinline__ bf16_t* memkv_ptr(Frame& F, int l, int H, int r) { return (bf16_t*)(F.ws + WS_MEMKV) + (((size_t)l * 8 + H) * TM + r) * HD; }

__device__ __forceinline__ void slice_kind(int H, int& gi, bool& isq) {
    gi = -1; isq = false;
    if (H < 6) { gi = 0; isq = true; } else if (H < 12) gi = 1; else if (H < 18) gi = -1;
    else if (H < 24) { gi = 2; isq = true; } else if (H < 30) gi = 3; else if (H < 36) gi = -1; else { gi = 4; isq = true; }
}
__device__ __forceinline__ void phase_groupnorm(Frame& F) {
    PHASE_IDS(F);
    const int lane = F.lane, half = lane >> 5, l32 = lane & 31, h = l32 >> 2; const bool act = l32 < 24;
    const bf16_t* PO = (const bf16_t*)(F.ws + WS_PO); const float* PL = (const float*)(F.ws + WS_PL); bf16_t* MX = (bf16_t*)(F.ws + WS_MIX);
    const float* SQ = (const float*)(F.ws + WS_SSQH); float* FAB = (float*)(F.ws + WS_FAB); float* RM = (float*)(F.ws + WS_RM);
    for (int t0 = F.gw * 8; t0 < T; t0 += F.ngw * 8) {
        u32x4 raw[4][3][2]; float den[4][3]; f32x4 sq[4][3];
#pragma unroll
        for (int u = 0; u < 4; ++u) { const int t = t0 + 2 * u + half;
            if (act) {
#pragma unroll
                for (int p = 0; p < 3; ++p) { const u32x4* pp = (const u32x4*)(PO + ((size_t)p * T + t) * 384 + l32 * 16); raw[u][p][0] = pp[0]; raw[u][p][1] = pp[1]; den[u][p] = PL[((size_t)p * T + t) * 8 + h]; }
            }
#pragma unroll
            for (int q = 0; q < 3; ++q) sq[u][q] = *(const f32x4*)(SQ + (size_t)t * 16 + 4 + 4 * q);
        }
#pragma unroll
        for (int u = 0; u < 4; ++u) { const int t = t0 + 2 * u + half; float v[16]; float s = 0.f;
            if (act) {
#pragma unroll
                for (int i = 0; i < 2; ++i) { const u32x4 w = raw[u][0][i]; v[8 * i + 0] = bf2f(w.x & 0xffffu); v[8 * i + 1] = bf2f(w.x >> 16); v[8 * i + 2] = bf2f(w.y & 0xffffu); v[8 * i + 3] = bf2f(w.y >> 16);
                    v[8 * i + 4] = bf2f(w.z & 0xffffu); v[8 * i + 5] = bf2f(w.z >> 16); v[8 * i + 6] = bf2f(w.w & 0xffffu); v[8 * i + 7] = bf2f(w.w >> 16); }
#pragma unroll
                for (int p = 1; p < 3; ++p)
#pragma unroll
                    for (int i = 0; i < 2; ++i) { const u32x4 w = raw[u][p][i]; v[8 * i + 0] += bf2f(w.x & 0xffffu); v[8 * i + 1] += bf2f(w.x >> 16); v[8 * i + 2] += bf2f(w.y & 0xffffu); v[8 * i + 3] += bf2f(w.y >> 16);
                        v[8 * i + 4] += bf2f(w.z & 0xffffu); v[8 * i + 5] += bf2f(w.z >> 16); v[8 * i + 6] += bf2f(w.w & 0xffffu); v[8 * i + 7] += bf2f(w.w >> 16); }
                const float rd = 1.0f / ((den[u][0] + den[u][1]) + den[u][2]);
                u32x4 o[2];
#pragma unroll
                for (int i = 0; i < 2; ++i) { o[i].x = pk2(v[8 * i + 0] * rd, v[8 * i + 1] * rd); o[i].y = pk2(v[8 * i + 2] * rd, v[8 * i + 3] * rd); o[i].z = pk2(v[8 * i + 4] * rd, v[8 * i + 5] * rd); o[i].w = pk2(v[8 * i + 6] * rd, v[8 * i + 7] * rd);
                    float a;
                    a = bf2f(o[i].x & 0xffffu); s += a * a; a = bf2f(o[i].x >> 16); s += a * a; a = bf2f(o[i].y & 0xffffu); s += a * a; a = bf2f(o[i].y >> 16); s += a * a;
                    a = bf2f(o[i].z & 0xffffu); s += a * a; a = bf2f(o[i].z >> 16); s += a * a; a = bf2f(o[i].w & 0xffffu); s += a * a; a = bf2f(o[i].w >> 16); s += a * a; }
                u32x4* mp = (u32x4*)(MX + (size_t)t * D + l32 * 16); mp[0] = o[0]; mp[1] = o[1];
            }
            s += __shfl_xor(s, 1); s += __shfl_xor(s, 2); s += __shfl_xor(s, 4); s += __shfl_xor(s, 8); s += __shfl_xor(s, 16);
            if (l32 == 0) {
                const float sb = ((sq[u][0][2] + sq[u][0][3]) + (sq[u][1][0] + sq[u][1][1])) + (sq[u][1][2] + sq[u][1][3]), sm = (sq[u][2][0] + sq[u][2][1]) + (sq[u][2][2] + sq[u][2][3]);
                const float ra = 1.f / sqrtf(s * (1.f / 384.f) + EPS), rb = 1.f / sqrtf(sb * (1.f / 384.f) + EPS), rmv = 1.f / sqrtf(sm * (1.f / 256.f) + EPS);
                FAB[(size_t)t * 2] = ra / rb; FAB[(size_t)t * 2 + 1] = rb / rmv; RM[t] = rmv; }
        }
    }
}
__device__ __forceinline__ void load_expert_table(LAS int* tab, const unsigned* cnt) {
    const int tid = opaque_tid0(), lane = tid & 63;
    if (tid < 64) {
        const int c = lane < NE ? (int)__hip_atomic_load(cnt + lane * 64, RLX_AGENT) : 0;
        int inc = (c + 255) >> 8;
#pragma unroll
        for (int o = 1; o < 64; o <<= 1) { const int v = __shfl_up(inc, o); if (lane >= o) inc += v; }
        tab[lane] = inc - ((c + 255) >> 8); tab[64 + lane] = c;
    }
    __syncthreads();
}
__device__ __forceinline__ float cl8(float v) { return fminf(fmaxf(v, -440.f), 440.f); }
__device__ __forceinline__ void phase_combine(Frame& F, int l) {
    PHASE_IDS(F);
    LAS int* tab = (LAS int*)(F.lds + CTRL_BASE);
    load_expert_table(tab, F.ctl + CW_CNT + l * NE * 64);
    const unsigned char* Y = (const unsigned char*)(F.ws + WS_QKV); const int lane = F.lane;
    typedef float f32x2_t __attribute__((ext_vector_type(2)));
    typedef int i32x4_t __attribute__((ext_vector_type(4)));
    constexpr int TK = 2;
    for (int t0 = F.gw * TK; t0 < T; t0 += F.ngw * TK) {
        i32x4_t rt[TK];
#pragma unroll
        for (int k = 0; k < TK; ++k) rt[k] = *(const i32x4_t*)((const int*)(F.ws + WS_ROUTE) + (size_t)(t0 + k) * 4);
        u32x2 xv[TK][4]; unsigned ya[TK][4], yb[TK][4];
#pragma unroll
        for (int k = 0; k < TK; ++k) { int ea = rt[k][0], pa = rt[k][1], eb = rt[k][2], pb = rt[k][3];
            if (ea > eb) { int q = ea; ea = eb; eb = q; q = pa; pa = pb; pb = q; }
            const unsigned* pya = (const unsigned*)(Y + (size_t)(tab[ea] * 256 + pa) * D) + lane; const unsigned* pyb = (const unsigned*)(Y + (size_t)(tab[eb] * 256 + pb) * D) + lane;
            const u32x2* xr = (const u32x2*)((const bf16_t*)(F.ws + WS_XB) + (size_t)(t0 + k) * D) + lane;
#pragma unroll
            for (int j = 0; j < 4; ++j) { xv[k][j] = xr[64 * j]; ya[k][j] = pya[64 * j]; yb[k][j] = pyb[64 * j]; } }
#pragma unroll
        for (int k = 0; k < TK; ++k) { const int t = t0 + k; f32x4 v[4]; float s = 0.f;
#pragma unroll
            for (int j = 0; j < 4; ++j) { const u32x2 x = xv[k][j]; const int a = (int)ya[k][j], b2 = (int)yb[k][j];
                const f32x2_t a0 = __builtin_amdgcn_cvt_pk_f32_fp8(a, false), a1 = __builtin_amdgcn_cvt_pk_f32_fp8(a, true), b0 = __builtin_amdgcn_cvt_pk_f32_fp8(b2, false), b1 = __builtin_amdgcn_cvt_pk_f32_fp8(b2, true);
                v[j].x = (bf2f(x.x & 0xffffu) + 0.125f * a0[0]) + 0.125f * b0[0]; v[j].y = (bf2f(x.x >> 16) + 0.125f * a0[1]) + 0.125f * b0[1];
                v[j].z = (bf2f(x.y & 0xffffu) + 0.125f * a1[0]) + 0.125f * b1[0]; v[j].w = (bf2f(x.y >> 16) + 0.125f * a1[1]) + 0.125f * b1[1]; }
            if (l + 1 < DEPTH) {
                u32x2* o8 = (u32x2*)((bf16_t*)(F.ws + WS_XB) + (size_t)t * D) + lane;
#pragma unroll
                for (int j = 0; j < 4; ++j) { u32x2 w; w.x = pk2(v[j].x, v[j].y); w.y = pk2(v[j].z, v[j].w); o8[64 * j] = w;
                    const float o0 = bf2f(w.x & 0xffffu), o1 = bf2f(w.x >> 16), o2 = bf2f(w.y & 0xffffu), o3 = bf2f(w.y >> 16); s += (o0 * o0 + o1 * o1) + (o2 * o2 + o3 * o3);
                    int q8 = 0; q8 = __builtin_amdgcn_cvt_pk_fp8_f32(cl8(16.f * o0), cl8(16.f * o1), q8, false); q8 = __builtin_amdgcn_cvt_pk_fp8_f32(cl8(16.f * o2), cl8(16.f * o3), q8, true);
                    ((int*)(F.ws + WS_X8 + (size_t)t * D))[lane + 64 * j] = q8; }
                s = wave_sum(s);
                if (lane == 0) ((float*)(F.ws + WS_RS))[t] = 1.0f / sqrtf(s * (1.f / D) + EPS);
            } else {
                f32x4* xo = (f32x4*)(F.out + (size_t)t * D) + lane;
#pragma unroll
                for (int j = 0; j < 4; ++j) xo[64 * j] = v[j];
            }
        }
    }
}

namespace g8 {
typedef short bf16x8 __attribute__((ext_vector_type(8)));
constexpr int BK = 64, HALF = 128, HTB = HALF * BK * 2, NXCD = 8, WGM = 8;
__device__ __forceinline__ int lds_byte(int r, int c) { const int st = (r >> 4) * 2 + (c >> 5), rr = r & 15, cc = c & 31, ob = rr * 64 + cc * 2; return st * 1024 + (ob ^ (((ob >> 9) & 1) << 5)); }
__device__ __forceinline__ void stage_rc(int b, int& R, int& C) { const int st = b / 1024, sb = b % 1024, swz = sb ^ (((sb >> 9) & 1) << 5); R = (st >> 1) * 16 + swz / 64; C = (st & 1) * 32 + (swz % 64) / 2; }
__device__ __forceinline__ unsigned cvt_pk_bf16(float lo, float hi) { unsigned r; asm volatile("v_cvt_pk_bf16_f32 %0, %1, %2" : "=v"(r) : "v"(lo), "v"(hi)); return r; }
__device__ __forceinline__ int opaque_tid() { int t = threadIdx.x; asm volatile("" : "+v"(t)); return t; }
__device__ __forceinline__ const char* uni(const char* p) { const unsigned long long v = (unsigned long long)p;
    return (const char*)(((unsigned long long)(unsigned)__builtin_amdgcn_readfirstlane((int)(v >> 32)) << 32) | (unsigned)__builtin_amdgcn_readfirstlane((int)v)); }
typedef int i32x8 __attribute__((ext_vector_type(8)));
typedef int i32x4v __attribute__((ext_vector_type(4)));
__device__ __forceinline__ float clamp8(float v) { return fminf(fmaxf(v, -440.f), 440.f); }
__device__ __forceinline__ i32x8 cat8(i32x4v a, i32x4v b) { return __builtin_shufflevector(a, b, 0, 1, 2, 3, 4, 5, 6, 7); }
__device__ __forceinline__ bf16x8 lo8(i32x8 v) { return __builtin_bit_cast(bf16x8, (i32x4v)__builtin_shufflevector(v, v, 0, 1, 2, 3)); }
__device__ __forceinline__ bf16x8 hi8(i32x8 v) { return __builtin_bit_cast(bf16x8, (i32x4v)__builtin_shufflevector(v, v, 4, 5, 6, 7)); }
struct Unit { const char* B; unsigned a00, a01, a10, a11; int pm, pn, e, ti, ce; };
struct DenseSched {
    int nM, nN, nwg, G, c, K; const char* Bbase;
    __device__ __forceinline__ void init(int M, int N, int K_, int G_, int c_, int tid, const void* Bt) { nM = M / 256; nN = N / 256; nwg = nM * nN; G = G_; c = c_; K = K_; Bbase = (const char*)Bt; }
    __device__ __forceinline__ bool next(int i, Unit& u) const {
        const long L = (long)i * G + c; if (L >= nwg) return false;
        int wgid = (int)L; { const int q = nwg / NXCD, r = nwg % NXCD, xcd = wgid % NXCD, off = wgid / NXCD; wgid = (xcd < r ? xcd * (q + 1) : r * (q + 1) + (xcd - r) * q) + off; }
        const int nig = WGM * nN, gid = wgid / nig, fm = gid * WGM, gsz = (nM - fm) < WGM ? (nM - fm) : WGM;
        u.pm = fm + ((wgid % nig) % gsz); u.pn = (wgid % nig) / gsz; u.e = 0; u.ti = 0; u.ce = 0;
        u.B = Bbase + (size_t)u.pn * 256 * K * 2;
        int R[2], C[2]; { const int tid = opaque_tid(); stage_rc(tid * 16, R[0], C[0]); stage_rc(tid * 16 + 8192, R[1], C[1]); }
        u.a00 = (unsigned)((u.pm * 256 + R[0]) * K + C[0]) * 2u; u.a01 = (unsigned)((u.pm * 256 + R[1]) * K + C[1]) * 2u;
        u.a10 = (unsigned)((u.pm * 256 + 128 + R[0]) * K + C[0]) * 2u; u.a11 = (unsigned)((u.pm * 256 + 128 + R[1]) * K + C[1]) * 2u;
        return true;
    }
};
template <bool WAITR>
struct GroupSchedT {
    const unsigned* rnd; mutable int rk;
    int NP, total, G, vb, K; const char* Bbase; size_t Bstride; const int* list; bool gather; LAS int* tab;
    __device__ __forceinline__ void init(LAS int* tab_, const unsigned* cnt, int NP_, int K_, int G_, int bid, const void* Bt, size_t Bstride_, const int* list_, bool gather_) {
        const int tid = opaque_tid(), lane = tid & 63; NP = NP_; K = K_; G = G_; vb = (G_ % 8 == 0) ? (bid % 8) * (G_ / 8) + bid / 8 : bid; rk = 0;
        if (WAITR && G_ % 16 == 0) vb = (vb + G_ / 2) % G_;
        Bbase = (const char*)Bt; Bstride = Bstride_; list = list_; gather = gather_; tab = tab_;
        const int c = lane < NE ? (int)__hip_atomic_load(cnt + lane * 64, RLX_AGENT) : 0;
        int inc = (c + 255) >> 8;
#pragma unroll
        for (int o = 1; o < 64; o <<= 1) { const int v = __shfl_up(inc, o); if (lane >= o) inc += v; }
        total = __builtin_amdgcn_readfirstlane(__shfl(inc, 63)) * NP;
        if (tid < 64) { tab[lane] = inc - ((c + 255) >> 8); tab[64 + lane] = c; }
        __syncthreads();
    }
    __device__ __forceinline__ bool next(int i, Unit& u) const {
        const int L = i * G + vb; if (L >= total) return false;
        const int tid = opaque_tid(), g = L / NP, lane = tid & 63; u.pn = L % NP; u.pm = g;
        if constexpr (WAITR) {
            if (tid < 64) {
                if (i >= rk) {
                    const int expv = min(max(total - lane * G, 0), G); unsigned polls = 0; int cnt;
                    for (;;) {
                        const unsigned c = lane < 16 ? __hip_atomic_load(rnd + lane, RLX_AGENT) : 0xffffffffu;
                        const unsigned long long okm = __ballot(lane >= 16 || (int)c >= expv);
                        cnt = (~okm == 0ull) ? 64 : (int)__builtin_ctzll(~okm);
                        if (cnt > i || ++polls > (1u << 22)) break;
                        __builtin_amdgcn_s_sleep(2);
                    }
                    rk = cnt;
                    __builtin_amdgcn_fence(__ATOMIC_ACQUIRE, "agent");
                    asm volatile("s_waitcnt vmcnt(0)" ::: "memory");
                }
            }
            asm volatile("" ::: "memory"); __builtin_amdgcn_s_barrier(); asm volatile("" ::: "memory");
        }
        int R[2], C[2]; stage_rc(tid * 16, R[0], C[0]); stage_rc(tid * 16 + 8192, R[1], C[1]);
        const int e = __builtin_amdgcn_readfirstlane(__popcll(__ballot(lane < NE && tab[lane] <= g)) - 1);
        u.e = e; u.ti = g - __builtin_amdgcn_readfirstlane(tab[e]); u.ce = __builtin_amdgcn_readfirstlane(tab[64 + e]);
        u.B = Bbase + (size_t)e * Bstride + (size_t)u.pn * 256 * K * 2;
        if (gather) {
            const int* le = list + (size_t)e * T; const int b = u.ti * 256, mx = u.ce - 1;
            const int t00 = le[min(b + R[0], mx)], t01 = le[min(b + R[1], mx)], t10 = le[min(b + 128 + R[0], mx)], t11 = le[min(b + 128 + R[1], mx)];
            u.a00 = (unsigned)(t00 * K + C[0]) * 2u; u.a01 = (unsigned)(t01 * K + C[1]) * 2u; u.a10 = (unsigned)(t10 * K + C[0]) * 2u; u.a11 = (unsigned)(t11 * K + C[1]) * 2u;
        } else {
            u.a00 = (unsigned)((g * 256 + R[0]) * K + C[0]) * 2u; u.a01 = (unsigned)((g * 256 + R[1]) * K + C[1]) * 2u;
            u.a10 = (unsigned)((g * 256 + 128 + R[0]) * K + C[0]) * 2u; u.a11 = (unsigned)((g * 256 + 128 + R[1]) * K + C[1]) * 2u;
        }
        return true;
    }
};

template <class E_, class = void> struct epi_signal_t { static constexpr bool v = false; };
template <class E_> struct epi_signal_t<E_, decltype(void(E_::SIGNAL))> { static constexpr bool v = E_::SIGNAL; };
template <class E_> constexpr bool epi_signal() { return epi_signal_t<E_>::v; }
template <class Epi, class Sched>
__device__ __forceinline__ void gemm_phase(LAS unsigned char* lds, const void* Abase_, int K, const Sched& S, const Epi& E) {
    const int tid = opaque_tid(), wid = __builtin_amdgcn_readfirstlane(tid >> 6), lane = tid & 63, wr = wid >> 2, wc = wid & 3, fr = lane & 15, fq = lane >> 4;
    int nt = K / BK; asm volatile("" : "+s"(nt)); const char* Abase = (const char*)Abase_;
    unsigned voffB[2];
#pragma unroll
    for (int i = 0; i < 2; ++i) { int R, C; stage_rc(tid * 16 + i * 8192, R, C); voffB[i] = (unsigned)(R * K + C) * 2u; }
    const size_t kstep = (size_t)(BK * 2), hstep = (size_t)HALF * K * 2;
    const unsigned ldsw = (unsigned)wid * 1024u;
    const int aoff = lds_byte(wr * 64 + fr, fq * 8), boff = lds_byte(wc * 32 + fr, fq * 8);
#define G8_SA(b, h) (((b) * 2 + (h)) * HTB)
#define G8_SB(b, h) ((4 + (b) * 2 + (h)) * HTB)
#define G8_STAGE(bufoff, gbase, voff) do { const char* _g = uni((const char*)(gbase)); _Pragma("unroll") for (int _i = 0; _i < 2; ++_i) \
        __builtin_amdgcn_global_load_lds((const unsigned*)(_g + (voff)[_i]), (LAS unsigned*)(lds + (bufoff) + ldsw + _i * 8192), 16, 0, 0); } while (0)
#define G8_STAGE_A(bufoff, gbase, o0, o1) do { const char* _g = uni((const char*)(gbase)); \
        __builtin_amdgcn_global_load_lds((const unsigned*)(_g + (o0)), (LAS unsigned*)(lds + (bufoff) + ldsw), 16, 0, 0); \
        __builtin_amdgcn_global_load_lds((const unsigned*)(_g + (o1)), (LAS unsigned*)(lds + (bufoff) + ldsw + 8192), 16, 0, 0); } while (0)
#define G8_LDA(dst, b, h) do { _Pragma("unroll") for (int m = 0; m < 4; ++m) dst[m] = cat8(*(const LAS i32x4v*)(lds + G8_SA(b, h) + aoff + m * 2048), *(const LAS i32x4v*)(lds + G8_SA(b, h) + aoff + m * 2048 + 1024)); } while (0)
#define G8_LDB(dst, b, h) do { _Pragma("unroll") for (int n = 0; n < 2; ++n) dst[n] = cat8(*(const LAS i32x4v*)(lds + G8_SB(b, h) + boff + n * 2048), *(const LAS i32x4v*)(lds + G8_SB(b, h) + boff + n * 2048 + 1024)); } while (0)
#define G8_MMA(ai, bj, At, Bt) do { __builtin_amdgcn_s_setprio(1); _Pragma("unroll") for (int m = 0; m < 4; ++m) _Pragma("unroll") for (int n = 0; n < 2; ++n) { \
        if constexpr (Epi::FP8) acc[ai][bj][m][n] = __builtin_amdgcn_mfma_scale_f32_16x16x128_f8f6f4(Bt[n], At[m], acc[ai][bj][m][n], 0, 0, 0, 0x7F7F7F7F, 0, 0x7F7F7F7F); \
        else { acc[ai][bj][m][n] = __builtin_amdgcn_mfma_f32_16x16x32_bf16(lo8(Bt[n]), lo8(At[m]), acc[ai][bj][m][n], 0, 0, 0); \
               acc[ai][bj][m][n] = __builtin_amdgcn_mfma_f32_16x16x32_bf16(hi8(Bt[n]), hi8(At[m]), acc[ai][bj][m][n], 0, 0, 0); } } __builtin_amdgcn_s_setprio(0); } while (0)
#define G8_WAIT_V(n) asm volatile("s_waitcnt vmcnt(" #n ")" ::: "memory")
#define G8_WAIT_L(n) asm volatile("s_waitcnt lgkmcnt(" #n ")" ::: "memory")
#define G8_BAR __builtin_amdgcn_s_barrier()
#define G8_SCHED __builtin_amdgcn_sched_barrier(0)
    Unit cur, nxt; int ui = 0;
    if (!S.next(0, cur)) return;
    constexpr int FACL = 131072;
#define G8_FAC(u_, par_) __builtin_amdgcn_global_load_lds((const unsigned*)(E.fab + (size_t)(u_).pm * 512 + tid), (LAS unsigned*)(lds + FACL + (par_) * 2048 + wid * 256), 4, 0, 0)
    if constexpr (Epi::RESCALE) G8_FAC(cur, 0);
    f32x4 acc[2][2][4][2];
#pragma unroll
    for (int a = 0; a < 2; ++a)
#pragma unroll
        for (int b = 0; b < 2; ++b)
#pragma unroll
            for (int m = 0; m < 4; ++m)
#pragma unroll
                for (int n = 0; n < 2; ++n) acc[a][b][m][n] = (f32x4){0.f, 0.f, 0.f, 0.f};
    i32x8 At[4], B0[2], B1[2];
    unsigned a00 = cur.a00, a01 = cur.a01, a10 = cur.a10, a11 = cur.a11;
    G8_STAGE(G8_SB(0, 0), cur.B, voffB); G8_STAGE(G8_SB(0, 1), cur.B + hstep, voffB); G8_STAGE_A(G8_SA(0, 0), Abase, a00, a01); G8_STAGE_A(G8_SA(0, 1), Abase, a10, a11);
    if (wr == 1) G8_BAR;
    G8_WAIT_V(2); G8_BAR;
    G8_STAGE(G8_SB(1, 0), cur.B + kstep, voffB); G8_STAGE_A(G8_SA(1, 0), Abase + kstep, a00, a01); G8_STAGE(G8_SB(1, 1), cur.B + hstep + kstep, voffB);
    G8_WAIT_V(6); G8_BAR;
    for (;;) {
        bool has_next = false; const char* curB = cur.B; const char* nB = curB;
        for (int t = 0; t < nt; t += 2) {
            const bool last = (t == nt - 2);
            if (t == nt - 4) { has_next = S.next(ui + 1, nxt); if (has_next) nB = nxt.B;
                if constexpr (Epi::RESCALE) { if (has_next) G8_FAC(nxt, (ui + 1) & 1); } }
            if constexpr (Epi::RESCALE) {
                if (t == 6 || t == 12) { const LAS float* fl = (const LAS float*)(lds + FACL + (ui & 1) * 2048) + (t == 12 ? 1 : 0);
#pragma unroll
                    for (int ai = 0; ai < 2; ++ai)
#pragma unroll
                        for (int m = 0; m < 4; ++m) { const float f = fl[(ai * HALF + wr * 64 + m * 16 + fr) * 2];
#pragma unroll
                            for (int bj = 0; bj < 2; ++bj)
#pragma unroll
                                for (int n = 0; n < 2; ++n) acc[ai][bj][m][n] = acc[ai][bj][m][n] * f; } } }
            const char* a1 = Abase + (size_t)(t + 1) * kstep;
            const char* a2 = last ? Abase : Abase + (size_t)(t + 2) * kstep; const char* b2 = last ? nB : curB + (size_t)(t + 2) * kstep;
            const char* a3 = a2 + kstep; const char* b3 = b2 + kstep;
            G8_LDB(B0, 0, 0); G8_LDB(B1, 0, 1); G8_SCHED; G8_LDA(At, 0, 0); G8_STAGE_A(G8_SA(1, 1), a1, a10, a11);
            if (last && has_next) { a00 = nxt.a00; a01 = nxt.a01; a10 = nxt.a10; a11 = nxt.a11; }
            G8_WAIT_V(8); G8_WAIT_L(0); G8_BAR; G8_MMA(0, 0, At, B0); G8_MMA(0, 1, At, B1); G8_BAR; G8_SCHED;
            G8_LDA(At, 0, 1); G8_STAGE(G8_SB(0, 0), b2, voffB); G8_STAGE(G8_SB(0, 1), b2 + hstep, voffB); G8_STAGE_A(G8_SA(0, 0), a2, a00, a01);
            G8_WAIT_V(8); G8_WAIT_L(0); G8_BAR; G8_MMA(1, 0, At, B0); G8_MMA(1, 1, At, B1); G8_BAR; G8_SCHED;
            G8_LDB(B0, 1, 0); G8_LDB(B1, 1, 1); G8_SCHED; G8_LDA(At, 1, 0); G8_STAGE_A(G8_SA(0, 1), a2, a10, a11);
            G8_WAIT_V(8); G8_WAIT_L(0); G8_BAR; G8_MMA(0, 0, At, B0); G8_MMA(0, 1, At, B1); G8_BAR; G8_SCHED;
            G8_LDA(At, 1, 1); G8_STAGE(G8_SB(1, 0), b3, voffB); G8_STAGE(G8_SB(1, 1), b3 + hstep, voffB); G8_STAGE_A(G8_SA(1, 0), a3, a00, a01);
            G8_WAIT_V(8); G8_WAIT_L(0); G8_BAR; G8_MMA(1, 0, At, B0); G8_MMA(1, 1, At, B1); G8_BAR; G8_SCHED;
        }
        if (wr == 0) G8_BAR;
        if constexpr (!Epi::AFTER_DRAIN) E(acc, cur, wr, wc, fr, fq);
        if constexpr (epi_signal<Epi>()) {
            asm volatile("s_waitcnt vmcnt(0)" ::: "memory"); G8_BAR;
            if (tid == 0) __hip_atomic_fetch_add(E.rnd + ui, 1u, RLX_AGENT);
        }
        if (!has_next) break;
#pragma unroll
        for (int a = 0; a < 2; ++a)
#pragma unroll
            for (int b = 0; b < 2; ++b)
#pragma unroll
                for (int m = 0; m < 4; ++m)
#pragma unroll
                    for (int n = 0; n < 2; ++n) acc[a][b][m][n] = (f32x4){0.f, 0.f, 0.f, 0.f};
        cur = nxt; ++ui;
        if (wr == 1) G8_BAR;
    }
    G8_WAIT_V(0);
    G8_BAR;
    if constexpr (Epi::AFTER_DRAIN) E.fused(acc, cur, wr, wc, fr, fq, lds);
#undef G8_FAC
#undef G8_SA
#undef G8_SB
#undef G8_STAGE
#undef G8_STAGE_A
#undef G8_LDA
#undef G8_LDB
#undef G8_MMA
#undef G8_WAIT_V
#undef G8_WAIT_L
#undef G8_BAR
#undef G8_SCHED
}

template <bool F8>
struct EpiQKVT {
    static constexpr bool AFTER_DRAIN = false, FP8 = F8, RESCALE = false;
    const float* rs; const float* qk_gain_l; bf16_t* base; int mode;
    __device__ __forceinline__ void operator()(const f32x4 (&acc)[2][2][4][2], const Unit& u, int wr, int wc, int fr_, int fq_) const {
        int fr = fr_, fq = fq_; asm volatile("" : "+v"(fr), "+v"(fq));
        int gi; bool isq; bf16_t* dst; const float* g;
        if (mode == 0) { const int H = 4 * u.pn + wc; slice_kind(H, gi, isq); dst = base + (size_t)H * T * HD; g = qk_gain_l + (gi < 0 ? 0 : gi) * HD; }
        else { const int lyr = u.pn >> 1, Hp = 4 * (u.pn & 1) + wc; gi = Hp < 4 ? 5 : -1; isq = false; dst = base + ((size_t)lyr * 8 + Hp) * TM * HD; g = qk_gain_l + (lyr * 6 + 5) * HD; }
        const float post = isq ? ATTN_SCALE * LOG2E : 1.0f;
        f32x4 gv[2][2];
#pragma unroll
        for (int bj = 0; bj < 2; ++bj)
#pragma unroll
            for (int n = 0; n < 2; ++n) gv[bj][n] = *(const f32x4*)(g + 32 * bj + 8 * fq + 4 * n) * post;
        float rs8[2][4];
#pragma unroll
        for (int ai = 0; ai < 2; ++ai)
#pragma unroll
            for (int m = 0; m < 4; ++m) rs8[ai][m] = rs[u.pm * 256 + ai * HALF + wr * 64 + m * 16 + fr];
#pragma unroll
        for (int ai = 0; ai < 2; ++ai)
#pragma unroll
            for (int m = 0; m < 4; ++m) {
                const int row = u.pm * 256 + ai * HALF + wr * 64 + m * 16 + fr; const float rsv = rs8[ai][m] * (F8 ? 1.0f / 512.0f : 1.0f);
                f32x4 v[2][2]; float ss = 0.f;
#pragma unroll
                for (int bj = 0; bj < 2; ++bj)
#pragma unroll
                    for (int n = 0; n < 2; ++n) { v[bj][n] = acc[ai][bj][m][n] * rsv; ss += (v[bj][n][0] * v[bj][n][0] + v[bj][n][1] * v[bj][n][1]) + (v[bj][n][2] * v[bj][n][2] + v[bj][n][3] * v[bj][n][3]); }
                if (gi >= 0) {
                    ss += __shfl_xor(ss, 16); ss += __shfl_xor(ss, 32);
                    const float r = __builtin_amdgcn_rsqf(ss * (1.f / 64.f) + EPS);
#pragma unroll
                    for (int bj = 0; bj < 2; ++bj)
#pragma unroll
                        for (int n = 0; n < 2; ++n) v[bj][n] = v[bj][n] * r * gv[bj][n];
                }
#pragma unroll
                for (int bj = 0; bj < 2; ++bj) { u32x4 w; w.x = cvt_pk_bf16(v[bj][0][0], v[bj][0][1]); w.y = cvt_pk_bf16(v[bj][0][2], v[bj][0][3]); w.z = cvt_pk_bf16(v[bj][1][0], v[bj][1][1]); w.w = cvt_pk_bf16(v[bj][1][2], v[bj][1][3]);
                    *(u32x4*)(dst + (size_t)row * HD + 32 * bj + 8 * fq) = w; }
            }
    }
};
struct EpiOut {
    static constexpr bool AFTER_DRAIN = false, FP8 = false, RESCALE = true;
    bf16_t* xb; float* ssq; unsigned char* x8; const float* fab; const float* rm;
    __device__ __forceinline__ void operator()(const f32x4 (&acc)[2][2][4][2], const Unit& u, int wr, int wc, int fr_, int fq_) const {
        int fr = fr_, fq = fq_; asm volatile("" : "+v"(fr), "+v"(fq));
        const int col0 = u.pn * 256 + wc * 32 + 8 * fq;
#pragma unroll
        for (int ai = 0; ai < 2; ++ai) {
        float fm8[2][4]; u32x4 xi8[2][4][2];
#pragma unroll
            for (int m = 0; m < 4; ++m) { const int row = u.pm * 256 + ai * HALF + wr * 64 + m * 16 + fr; fm8[ai][m] = rm[row];
#pragma unroll
                for (int bj = 0; bj < 2; ++bj) xi8[ai][m][bj] = *(const u32x4*)(xb + (size_t)row * D + col0 + bj * HALF); }
#pragma unroll
            for (int m = 0; m < 4; ++m) {
                const int row = u.pm * 256 + ai * HALF + wr * 64 + m * 16 + fr; bf16_t* p = xb + (size_t)row * D + col0; float s = 0.f; const float fm = fm8[ai][m];
                u32x4 xi[2];
#pragma unroll
                for (int bj = 0; bj < 2; ++bj) xi[bj] = xi8[ai][m][bj];
#pragma unroll
                for (int bj = 0; bj < 2; ++bj) { const f32x4 a = acc[ai][bj][m][0] * fm, b = acc[ai][bj][m][1] * fm; const u32x4 x = xi[bj];
                    u32x4 w; w.x = cvt_pk_bf16(bf2f(x.x & 0xffffu) + a[0], bf2f(x.x >> 16) + a[1]); w.y = cvt_pk_bf16(bf2f(x.y & 0xffffu) + a[2], bf2f(x.y >> 16) + a[3]);
                    w.z = cvt_pk_bf16(bf2f(x.z & 0xffffu) + b[0], bf2f(x.z >> 16) + b[1]); w.w = cvt_pk_bf16(bf2f(x.w & 0xffffu) + b[2], bf2f(x.w >> 16) + b[3]);
                    *(u32x4*)(p + bj * HALF) = w;
                    const float o0 = bf2f(w.x & 0xffffu), o1 = bf2f(w.x >> 16), o2 = bf2f(w.y & 0xffffu), o3 = bf2f(w.y >> 16), o4 = bf2f(w.z & 0xffffu), o5 = bf2f(w.z >> 16), o6 = bf2f(w.w & 0xffffu), o7 = bf2f(w.w >> 16);
                    s += ((o0 * o0 + o1 * o1) + (o2 * o2 + o3 * o3)) + ((o4 * o4 + o5 * o5) + (o6 * o6 + o7 * o7));
                    int q0 = 0, q1 = 0; q0 = __builtin_amdgcn_cvt_pk_fp8_f32(clamp8(16.f * o0), clamp8(16.f * o1), q0, false); q0 = __builtin_amdgcn_cvt_pk_fp8_f32(clamp8(16.f * o2), clamp8(16.f * o3), q0, true);
                    q1 = __builtin_amdgcn_cvt_pk_fp8_f32(clamp8(16.f * o4), clamp8(16.f * o5), q1, false); q1 = __builtin_amdgcn_cvt_pk_fp8_f32(clamp8(16.f * o6), clamp8(16.f * o7), q1, true);
                    u32x2 q; q.x = (unsigned)q0; q.y = (unsigned)q1;
                    *(u32x2*)(x8 + (size_t)row * D + col0 + bj * HALF) = q; }
                s += __shfl_xor(s, 16); s += __shfl_xor(s, 32);
                if (fq == 0) ssq[row * 16 + u.pn * 4 + wc] = s;
            }
        }
    }
};
struct EpiSwiGLU {
    static constexpr bool AFTER_DRAIN = false, FP8 = true, RESCALE = false;
    static constexpr bool SIGNAL = true;
    const float* rsl; unsigned char* hid; unsigned* rnd;
    __device__ __forceinline__ void operator()(const f32x4 (&acc)[2][2][4][2], const Unit& u, int wr, int wc, int fr_, int fq_) const {
        int fr = fr_, fq = fq_; asm volatile("" : "+v"(fr), "+v"(fq));
        float rs8[2][4];
#pragma unroll
        for (int ai = 0; ai < 2; ++ai)
#pragma unroll
            for (int m = 0; m < 4; ++m) rs8[ai][m] = rsl[(size_t)u.e * T + min(u.ti * 256 + ai * HALF + wr * 64 + m * 16 + fr, u.ce - 1)];
#pragma unroll
        for (int ai = 0; ai < 2; ++ai)
#pragma unroll
            for (int m = 0; m < 4; ++m) {
                const int lr = ai * HALF + wr * 64 + m * 16 + fr; const float rsv = (1.0f / 512.0f) * rs8[ai][m];
                f32x4 h[2];
#pragma unroll
                for (int n = 0; n < 2; ++n) { const f32x4 gt = acc[ai][0][m][n] * rsv, up = acc[ai][1][m][n] * rsv;
#pragma unroll
                    for (int j = 0; j < 4; ++j) h[n][j] = gt[j] * up[j] * __builtin_amdgcn_rcpf(1.0f + __builtin_amdgcn_exp2f(-gt[j] * LOG2E)); }
#pragma unroll
                for (int n = 0; n < 2; ++n)
#pragma unroll
                    for (int j = 0; j < 4; ++j) h[n][j] = fminf(fmaxf(h[n][j] * 8.0f, -440.f), 440.f);
                int w0 = 0, w1 = 0;
                w0 = __builtin_amdgcn_cvt_pk_fp8_f32(h[0][0], h[0][1], w0, false); w0 = __builtin_amdgcn_cvt_pk_fp8_f32(h[0][2], h[0][3], w0, true);
                w1 = __builtin_amdgcn_cvt_pk_fp8_f32(h[1][0], h[1][1], w1, false); w1 = __builtin_amdgcn_cvt_pk_fp8_f32(h[1][2], h[1][3], w1, true);
                { unsigned char* hp = hid + (size_t)(u.pm * 256 + lr) * DE + u.pn * 128 + wc * 32 + 8 * fq; const unsigned long long hv = ((unsigned long long)(unsigned)w1 << 32) | (unsigned long long)(unsigned)w0;
                  asm volatile("global_store_dwordx2 %0, %1, off sc1" :: "v"(hp), "v"(hv) : "memory"); }
            }
    }
};
struct EpiDown {
    static constexpr bool AFTER_DRAIN = false, NB1 = false, FP8 = true, RESCALE = false;
    const float* wl; unsigned char* Y;
    __device__ __forceinline__ void operator()(const f32x4 (&acc)[2][2][4][2], const Unit& u, int wr, int wc, int fr_, int fq_) const {
        int fr = fr_, fq = fq_; asm volatile("" : "+v"(fr), "+v"(fq));
        float wl8[2][4];
#pragma unroll
        for (int ai = 0; ai < 2; ++ai)
#pragma unroll
            for (int m = 0; m < 4; ++m) wl8[ai][m] = wl[(size_t)u.e * T + min(u.ti * 256 + ai * HALF + wr * 64 + m * 16 + fr, u.ce - 1)];
#pragma unroll
        for (int ai = 0; ai < 2; ++ai)
#pragma unroll
            for (int m = 0; m < 4; ++m) {
                const int lr = ai * HALF + wr * 64 + m * 16 + fr; const float w8 = (8.0f / 256.0f) * wl8[ai][m];
#pragma unroll
                for (int bj = 0; bj < 2; ++bj) { f32x4 a = acc[ai][bj][m][0] * w8, b = acc[ai][bj][m][1] * w8;
#pragma unroll
                    for (int j = 0; j < 4; ++j) { a[j] = fminf(fmaxf(a[j], -400.f), 400.f); b[j] = fminf(fmaxf(b[j], -400.f), 400.f); }
                    int w0 = 0, w1 = 0;
                    w0 = __builtin_amdgcn_cvt_pk_fp8_f32(a[0], a[1], w0, false); w0 = __builtin_amdgcn_cvt_pk_fp8_f32(a[2], a[3], w0, true);
                    w1 = __builtin_amdgcn_cvt_pk_fp8_f32(b[0], b[1], w1, false); w1 = __builtin_amdgcn_cvt_pk_fp8_f32(b[2], b[3], w1, true);
                    u32x2 w; w.x = (unsigned)w0; w.y = (unsigned)w1;
                    *(u32x2*)(Y + (size_t)(u.pm * 256 + lr) * D + u.pn * 256 + bj * HALF + wc * 32 + 8 * fq) = w; }
            }
    }
};
struct EpiRouter {
    static constexpr bool AFTER_DRAIN = true, FP8 = false, RESCALE = false;
    const float* ssq1; float* rs1; const float* b_group; const float* b_router; unsigned* cnt; int* list; float* wl; float* rsl; int* route;
    __device__ __forceinline__ void fused(const f32x4 (&acc)[2][2][4][2], const Unit& u, int wr, int wc, int fr_, int fq_, LAS unsigned char* lds) const {
        int fr = fr_, fq = fq_; asm volatile("" : "+v"(fr), "+v"(fq));
        LAS float* lg = (LAS float*)lds;
        LAS int* hist = (LAS int*)(lds + 256 * 65 * 4);
        const int tid = opaque_tid();
        if (tid < 64) hist[tid] = 0;
        if (wc < 2) {
#pragma unroll
            for (int ai = 0; ai < 2; ++ai)
#pragma unroll
                for (int m = 0; m < 4; ++m) { const int row = ai * HALF + wr * 64 + m * 16 + fr;
#pragma unroll
                    for (int n = 0; n < 2; ++n)
#pragma unroll
                        for (int j = 0; j < 4; ++j) lg[row * 65 + 32 * wc + 16 * n + 4 * fq + j] = acc[ai][0][m][n][j]; }
        }
        __syncthreads();
        int ex0 = 0, ex1 = 0, lp0 = 0, lp1 = 0; float w0 = 0.f, w1 = 0.f, rsv = 0.f; const int t = u.pm * 256 + tid;
        if (tid < 256) {
            const f32x4* sq = (const f32x4*)(ssq1 + (size_t)t * 16); const f32x4 a = sq[0], b = sq[1], c = sq[2], d = sq[3];
            const float ss = ((a[0] + a[1]) + (a[2] + a[3])) + ((b[0] + b[1]) + (b[2] + b[3])) + ((c[0] + c[1]) + (c[2] + c[3])) + ((d[0] + d[1]) + (d[2] + d[3]));
            rsv = 1.0f / sqrtf(ss * (1.f / D) + EPS); rs1[t] = rsv;
            const LAS float* my = lg + tid * 65;
            float g[4];
#pragma unroll
            for (int i = 0; i < 4; ++i) g[i] = my[i] * rsv + b_group[i];
            int gi = 0; float gm = g[0];
#pragma unroll
            for (int i = 1; i < 4; ++i) if (g[i] > gm) { gm = g[i]; gi = i; }
            float den = 0.f;
#pragma unroll
            for (int i = 0; i < 4; ++i) den += expf(g[i] - gm);
            const float gtop = 1.0f / den;
            float ev[8];
#pragma unroll
            for (int i = 0; i < 8; ++i) ev[i] = my[4 + gi * 8 + i] * rsv + b_router[gi * 8 + i];
            int i0 = 0; float v0 = ev[0];
#pragma unroll
            for (int i = 1; i < 8; ++i) if (ev[i] > v0) { v0 = ev[i]; i0 = i; }
            int i1 = -1; float v1 = -INFINITY;
#pragma unroll
            for (int i = 0; i < 8; ++i) if (i != i0 && ev[i] > v1) { v1 = ev[i]; i1 = i; }
            const float e1 = expf(v1 - v0); w0 = gtop / (1.f + e1); w1 = gtop * e1 / (1.f + e1);
            ex0 = gi * 8 + i0; ex1 = gi * 8 + i1;
            lp0 = __hip_atomic_fetch_add(hist + ex0, 1, __ATOMIC_RELAXED, __HIP_MEMORY_SCOPE_WORKGROUP);
            lp1 = __hip_atomic_fetch_add(hist + ex1, 1, __ATOMIC_RELAXED, __HIP_MEMORY_SCOPE_WORKGROUP);
        }
        __syncthreads();
        if (tid < NE) { const int c = hist[tid]; hist[32 + tid] = c ? (int)__hip_atomic_fetch_add(cnt + tid * 64, (unsigned)c, RLX_AGENT) : 0; }
        __syncthreads();
        if (tid < 256) {
            const int p0 = hist[32 + ex0] + lp0, p1 = hist[32 + ex1] + lp1;
            list[(size_t)ex0 * T + p0] = t; wl[(size_t)ex0 * T + p0] = w0; rsl[(size_t)ex0 * T + p0] = rsv;
            list[(size_t)ex1 * T + p1] = t; wl[(size_t)ex1 * T + p1] = w1; rsl[(size_t)ex1 * T + p1] = rsv;
            *(int4*)(route + (size_t)t * 4) = make_int4(ex0, p0, ex1, p1);
        }
    }
};
}

__device__ __forceinline__ void phase_memkv_fast(Frame& F) {
    PHASE_IDS(F);
    g8::DenseSched S; S.init(TM, 1024, D, F.G, (int)blockIdx.x, F.tid, F.ws + WS_WMEM);
    g8::EpiQKVT<false> E{(const float*)(F.ws + WS_RSM), in_ptr(4), (bf16_t*)(F.ws + WS_MEMKV), 1};
    g8::gemm_phase(F.lds, F.ws + WS_MB, D, S, E);
}
__device__ __forceinline__ void phase_inproj_fast(Frame& F, int l) {
    PHASE_IDS(F);
    if (l == 0) {
        g8::DenseSched S; S.init(T, INW, D, F.G, (int)blockIdx.x, F.tid, F.ws + WS_WIN);
        g8::EpiQKVT<false> E{(const float*)(F.ws + WS_RS), in_ptr(4), (bf16_t*)(F.ws + WS_QKV), 0};
        g8::gemm_phase(F.lds, F.ws + WS_XB, D, S, E);
    } else {
        g8::DenseSched S; S.init(T, INW, D / 2, F.G, (int)blockIdx.x, F.tid, F.ws + WS_WIN + (size_t)INW * D * 2);
        g8::EpiQKVT<true> E{(const float*)(F.ws + WS_RS), in_ptr(4) + l * 6 * HD, (bf16_t*)(F.ws + WS_QKV), 0};
        g8::gemm_phase(F.lds, F.ws + WS_X8, D / 2, S, E);
    }
}
__device__ __forceinline__ void phase_outproj_fast(Frame& F, int l) {
    PHASE_IDS(F);
    g8::DenseSched S; S.init(T, D, D, F.G, (int)blockIdx.x, F.tid, F.ws + WS_WOUT + (size_t)l * D * D * 2);
    g8::EpiOut E{(bf16_t*)(F.ws + WS_XB), (float*)(F.ws + WS_SSQ1), (unsigned char*)(F.ws + WS_X8), (const float*)(F.ws + WS_FAB), (const float*)(F.ws + WS_RM)};
    g8::gemm_phase(F.lds, F.ws + WS_MIX, D, S, E);
}
__device__ __forceinline__ void phase_router_fast(Frame& F, int l) {
    PHASE_IDS(F);
    g8::DenseSched S; S.init(T, 256, D, F.G, (int)blockIdx.x, F.tid, F.ws + WS_WR + (size_t)l * 256 * D * 2);
    g8::EpiRouter E{(const float*)(F.ws + WS_SSQ1), (float*)(F.ws + WS_RS) + T, in_ptr(12) + l * NGRP, in_ptr(14) + l * NE, F.ctl + CW_CNT + l * NE * 64,
                    (int*)(F.ws + WS_LIST), (float*)(F.ws + WS_WL), (float*)(F.ws + WS_RSL), (int*)(F.ws + WS_ROUTE)};
    g8::gemm_phase(F.lds, F.ws + WS_XB, D, S, E);
}
__device__ __forceinline__ void phase_moe1_fast(Frame& F, int l) {
    PHASE_IDS(F);
    g8::GroupSchedT<false> S; S.rnd = nullptr; S.init((LAS int*)(F.lds + CTRL_BASE), F.ctl + CW_CNT + l * NE * 64, 4, D / 2, F.G, (int)blockIdx.x, F.ws + WS_WGU + (size_t)l * NE * 1024 * D, (size_t)1024 * D, (const int*)(F.ws + WS_LIST), true);
    g8::EpiSwiGLU E{(const float*)(F.ws + WS_RSL), (unsigned char*)(F.ws + WS_MIX), F.ctl + CW_RND + l * 64};
    g8::gemm_phase(F.lds, F.ws + WS_X8, D / 2, S, E);
}
__device__ __forceinline__ void phase_moe2_fast(Frame& F, int l) {
    PHASE_IDS(F);
    g8::GroupSchedT<true> S; S.rnd = F.ctl + CW_RND + l * 64; S.init((LAS int*)(F.lds + CTRL_BASE), F.ctl + CW_CNT + l * NE * 64, 4, DE / 2, F.G, (int)blockIdx.x, F.ws + WS_WD + (size_t)l * NE * D * DE, (size_t)D * DE, (const int*)(F.ws + WS_LIST), false);
    g8::EpiDown E{(const float*)(F.ws + WS_WL), (unsigned char*)(F.ws + WS_QKV)};
    g8::gemm_phase(F.lds, F.ws + WS_MIX, DE / 2, S, E);
}

namespace at {
typedef short bf16x8 __attribute__((ext_vector_type(8)));
typedef short s16x4 __attribute__((ext_vector_type(4)));
typedef short v4i16_t __attribute__((ext_vector_type(4)));
typedef float f32x16 __attribute__((ext_vector_type(16)));
typedef const LAS char* lds_cptr;
constexpr int NSLOT = 3, NPRE = NSLOT - 1, SLOTB = 8192, LDS_K = 0, LDS_V = NSLOT * SLOTB, TB_CS = 576, TB_ROW = 4 * TB_CS, LDS_TBB = 2 * NSLOT * SLOTB, LDS_TBM = LDS_TBB + 16 * TB_ROW, LDS_WS = LDS_TBM + TB_ROW, LDS_QW = LDS_WS + 2048;
static_assert(LDS_QW + 64 <= 131072, "attention LDS map");
constexpr float NEGBIG = -1.0e30f;
__device__ __forceinline__ int crow(int r, int hi) { return (r & 3) + 8 * (r >> 2) + 4 * hi; }
__device__ __forceinline__ void glds16(const void* gsrc, unsigned lds_dst) { unsigned keep;
    asm volatile("s_mov_b32 %0, m0\n\ts_mov_b32 m0, %2\n\ts_nop 0\n\tglobal_load_lds_dwordx4 %1, off\n\ts_mov_b32 m0, %0" : "=&s"(keep) : "v"(gsrc), "s"(lds_dst) : "memory"); }
typedef float f32x2_t __attribute__((ext_vector_type(2))); typedef __bf16 bf16x2_t __attribute__((ext_vector_type(2)));
__device__ __forceinline__ unsigned cvtpk(float lo, float hi) { f32x2_t v = {lo, hi}; bf16x2_t b = __builtin_convertvector(v, bf16x2_t); return __builtin_bit_cast(unsigned, b); }
__device__ __forceinline__ s16x4 vtr(lds_cptr p) { return __builtin_bit_cast(s16x4, __builtin_amdgcn_ds_read_tr16_b64_v4i16((LAS v4i16_t*)p)); }
#define AT_WAIT_BAR(N) asm volatile("s_waitcnt vmcnt(" #N ") lgkmcnt(0)\n\ts_barrier" ::: "memory")

__device__ __forceinline__ void at_dequeue(unsigned* qcnt, int nper, int xq, int pre, int& id_out, int& x_out) {
    int id = pre, x = xq;
    if (id == -2) id = (int)__hip_atomic_fetch_add(qcnt + xq * 64, 1u, RLX_AGENT);
    if (id >= nper) {
        id = -1;
        for (int tries = 0; tries < 8 && id < 0; ++tries) {
            unsigned hv[8];
#pragma unroll
            for (int k = 0; k < 8; ++k) hv[k] = __hip_atomic_load(qcnt + ((xq + k) & 7) * 64, RLX_AGENT);
            int pick = -1;
#pragma unroll
            for (int k = 7; k >= 0; --k) if ((int)hv[k] < nper) pick = k;
            if (pick < 0) break;
            x = (xq + pick) & 7; id = (int)__hip_atomic_fetch_add(qcnt + x * 64, 1u, RLX_AGENT); if (id >= nper) id = -1;
        }
    }
    id_out = id; x_out = x;
}
struct UnitDesc { const bf16_t* Q; const bf16_t* K; const bf16_t* V; int t0, hh16, qb, h, kt0, nt; };

template <int TYPE>
__device__ __forceinline__ void attn_unit(LAS unsigned char* lds, const UnitDesc& u, bf16_t* mixed, float* ssq) {
    const int tid = opaque_tid0(), lane = tid & 63, r32 = lane & 31, hi = lane >> 5; const int wid = __builtin_amdgcn_readfirstlane(tid >> 6);
    const unsigned lds0 = (unsigned)(size_t)lds;
    lds_cptr shm3 = (lds_cptr)lds;
    const int prow = 8 * wid + (lane >> 3);
    const bf16_t* ksrc = u.K + (size_t)(u.kt0 * 64 + prow) * HD + (((lane & 7) ^ ((4 * wid + (lane >> 4)) & 7)) * 8);
    const bf16_t* vsrc = u.V + (size_t)(u.kt0 * 64 + prow) * HD + ((((lane & 7) >> 1) ^ (prow & 2)) * 16) + (lane & 1) * 8;
    const unsigned kdst = lds0 + LDS_K + wid * 1024, vdst = lds0 + LDS_V + wid * 1024;
#define AT_DMA_K(t, slot) glds16(ksrc + (size_t)(t) * 64 * HD, (unsigned)__builtin_amdgcn_readfirstlane(kdst + (slot)))
#define AT_DMA_V(t, slot) glds16(vsrc + (size_t)(t) * 64 * HD, (unsigned)__builtin_amdgcn_readfirstlane(vdst + (slot)))
    lds_cptr ka[4], va[2];
    { const int sw = (r32 >> 1) & 7;
#pragma unroll
      for (int d0 = 0; d0 < 4; ++d0) ka[d0] = shm3 + LDS_K + r32 * 128 + (((2 * d0 + hi) ^ sw) * 16);
      const int q = (lane & 15) >> 2, gb = (lane >> 4) & 1;
#pragma unroll
      for (int d0 = 0; d0 < 2; ++d0) va[d0] = shm3 + LDS_V + (4 * hi + q) * 128 + ((2 * (d0 ^ (q >> 1)) + gb) * 32) + (lane & 3) * 8; }
    const int nt = u.nt;
    const bf16_t* Qw = u.Q + (size_t)(u.qb * 256 + wid * 32 + r32) * HD;
    bf16x8 qr[4];
#pragma unroll
    for (int d0 = 0; d0 < 4; ++d0) qr[d0] = *(const bf16x8*)(Qw + d0 * 16 + hi * 8);
#pragma unroll
    for (int j = 0; j < NPRE; ++j) if (j < nt) { AT_DMA_K(j, j * SLOTB); AT_DMA_V(j, j * SLOTB); }
    lds_cptr tb = shm3; int r0w = 0, qrw = 0;
    lds_cptr tbm = shm3;
    if (TYPE == 1) { const int qc = 32 * (wid & 1) + r32, c0 = min(max(qc - 8, 0), 48); qrw = 4 * u.qb + (wid >> 1); r0w = min(max(qrw - 4, 0), 24);
        const int ib = 4 * hi - qc + 63, cb = (-ib) & 3, im = 4 * hi - c0 + 63, cm = (-im) & 3;
        tb = shm3 + LDS_TBB + cb * TB_CS + (ib + cb) * 4; tbm = shm3 + LDS_TBM + cm * TB_CS + (im + cm) * 4; }
    float lsum = 0.f; f32x16 o[2]; o[0] = f32x16{}; o[1] = f32x16{};
    int sl_cur = 0, sl_n2 = NPRE * SLOTB;
    for (int i = 0; i < nt; ++i) {
        { const int rem = nt - 1 - i, yo = rem < NPRE - 1 ? rem : NPRE - 1; if (yo >= 3) AT_WAIT_BAR(6); else if (yo == 2) AT_WAIT_BAR(4); else if (yo == 1) AT_WAIT_BAR(2); else AT_WAIT_BAR(0); }
        static_assert(NPRE <= 4, "wait ladder");
        if (i + NPRE < nt) { AT_DMA_K(i + NPRE, sl_n2); AT_DMA_V(i + NPRE, sl_n2); }
        bool need = true;
        if (TYPE == 1) { const int kr = u.kt0 + i; need = (kr >= r0w) && (kr < r0w + 8); }
        if (need) {
#pragma unroll
            for (int hf = 0; hf < 2; ++hf) {
                f32x16 p;
                if (TYPE == 1) {
                    const lds_cptr tp = tb + (u.kt0 + i - qrw + 7) * TB_ROW;
#pragma unroll
                    for (int g = 0; g < 4; ++g) { const f32x4 a = *(const LAS f32x4*)(tp + 32 * (g + 4 * hf)) + *(const LAS f32x4*)(tbm + 32 * (g + 4 * hf)); p[4 * g] = a[0]; p[4 * g + 1] = a[1]; p[4 * g + 2] = a[2]; p[4 * g + 3] = a[3]; }
                } else p = f32x16{};
#pragma unroll
                for (int d0 = 0; d0 < 4; ++d0) p = __builtin_amdgcn_mfma_f32_32x32x16_bf16(*(const LAS bf16x8*)(ka[d0] + sl_cur + 4096 * hf), qr[d0], p, 0, 0, 0);
                float s0 = 0.f;
#pragma unroll
                for (int r = 0; r < 16; ++r) { p[r] = __builtin_amdgcn_exp2f(p[r]); s0 += p[r]; }
                lsum += s0;
                const u32x4 pwa = (u32x4){cvtpk(p[0], p[1]), cvtpk(p[2], p[3]), cvtpk(p[4], p[5]), cvtpk(p[6], p[7])}, pwb = (u32x4){cvtpk(p[8], p[9]), cvtpk(p[10], p[11]), cvtpk(p[12], p[13]), cvtpk(p[14], p[15])};
#pragma unroll
                for (int d0 = 0; d0 < 2; ++d0) { const lds_cptr vp = va[d0] + sl_cur + 4096 * hf; const s16x4 l0 = vtr(vp), h0 = vtr(vp + 1024), l1 = vtr(vp + 2048), h1 = vtr(vp + 2048 + 1024);
                    o[d0] = __builtin_amdgcn_mfma_f32_32x32x16_bf16(__builtin_bit_cast(bf16x8, pwa), (bf16x8){l0[0], l0[1], l0[2], l0[3], h0[0], h0[1], h0[2], h0[3]}, o[d0], 0, 0, 0);
                    o[d0] = __builtin_amdgcn_mfma_f32_32x32x16_bf16(__builtin_bit_cast(bf16x8, pwb), (bf16x8){l1[0], l1[1], l1[2], l1[3], h1[0], h1[1], h1[2], h1[3]}, o[d0], 0, 0, 0); }
            }
        }
        sl_n2 = sl_cur;
        sl_cur = (sl_cur == (NSLOT - 1) * SLOTB) ? 0 : sl_cur + SLOTB;
    }
    AT_WAIT_BAR(0);
    int lane2 = lane; asm volatile("" : "+v"(lane2)); const int r32e = lane2 & 31, hie = lane2 >> 5;
    lsum += __shfl_xor(lsum, 32);
    LAS float* wsf = (LAS float*)(lds + LDS_WS) + wid * 64;
    if (hie == 0) wsf[r32e] = lsum;
    asm volatile("s_waitcnt lgkmcnt(0)" ::: "memory");
    LAS bf16_t* stg = (LAS bf16_t*)(lds) + wid * 2048;
#pragma unroll
    for (int r = 0; r < 16; ++r) { const int orow = crow(r, hie); const float rl = __builtin_amdgcn_rcpf(wsf[orow]);
        stg[orow * 64 + r32e] = (bf16_t)f2bf(o[0][r] * rl); stg[orow * 64 + 32 + r32e] = (bf16_t)f2bf(o[1][r] * rl); }
    asm volatile("s_waitcnt lgkmcnt(0)" ::: "memory");
    const int trow0 = u.t0 + wid * 32;
#pragma unroll
    for (int i = 0; i < 4; ++i) { const int row = i * 8 + (lane2 >> 3), ch = lane2 & 7; const u32x4 v = *(const LAS u32x4*)(stg + row * 64 + ch * 8);
        *(u32x4*)(mixed + (size_t)(trow0 + row) * D + u.hh16 * 64 + ch * 8) = v;
        float s = 0.f; { float a;
            a = bf2f(v.x & 0xffffu); s += a * a; a = bf2f(v.x >> 16); s += a * a; a = bf2f(v.y & 0xffffu); s += a * a; a = bf2f(v.y >> 16); s += a * a;
            a = bf2f(v.z & 0xffffu); s += a * a; a = bf2f(v.z >> 16); s += a * a; a = bf2f(v.w & 0xffffu); s += a * a; a = bf2f(v.w >> 16); s += a * a; }
        s += __shfl_xor(s, 1); s += __shfl_xor(s, 2); s += __shfl_xor(s, 4);
        if (ch == 0) ssq[(size_t)(trow0 + row) * 16 + u.hh16] = s; }
    asm volatile("s_waitcnt lgkmcnt(0)\n\ts_barrier" ::: "memory");
#undef AT_DMA_K
#undef AT_DMA_V
}

template <int NQB>
__device__ __forceinline__ void mem_unit(LAS unsigned char* lds, const bf16_t* Qh, const bf16_t* Kh, const bf16_t* Vh, int t0, int hh16, bf16_t* mixed, float* ssq) {
    constexpr int MK = 0, MV = 32768, MSTG = 65536, MWS = 98304;
    const int tid = opaque_tid0(), lane = tid & 63, r32 = lane & 31, hi = lane >> 5; const int wid = __builtin_amdgcn_readfirstlane(tid >> 6);
    const unsigned lds0 = (unsigned)(size_t)lds; lds_cptr shm3 = (lds_cptr)lds;
    const int prow = 8 * wid + (lane >> 3);
    const bf16_t* ksrc = Kh + (size_t)prow * HD + (((lane & 7) ^ ((4 * wid + (lane >> 4)) & 7)) * 8);
    const bf16_t* vsrc = Vh + (size_t)prow * HD + ((((lane & 7) >> 1) ^ (prow & 2)) * 16) + (lane & 1) * 8;
    const bf16_t* Qw = Qh + (size_t)(wid * 32 + r32) * HD + hi * 8;
    bf16x8 qr[4], qn[4];
#pragma unroll
    for (int d0 = 0; d0 < 4; ++d0) { qr[d0] = *(const bf16x8*)(Qw + d0 * 16); qn[d0] = qr[d0]; }
#pragma unroll
    for (int j = 0; j < 4; ++j) { glds16(ksrc + (size_t)j * 64 * HD, (unsigned)__builtin_amdgcn_readfirstlane(lds0 + MK + j * 8192 + wid * 1024));
                                  glds16(vsrc + (size_t)j * 64 * HD, (unsigned)__builtin_amdgcn_readfirstlane(lds0 + MV + j * 8192 + wid * 1024)); }
    lds_cptr ka[4], va[2];
    { const int sw = (r32 >> 1) & 7;
#pragma unroll
      for (int d0 = 0; d0 < 4; ++d0) ka[d0] = shm3 + MK + r32 * 128 + (((2 * d0 + hi) ^ sw) * 16);
      const int q = (lane & 15) >> 2, gb = (lane >> 4) & 1;
#pragma unroll
      for (int d0 = 0; d0 < 2; ++d0) va[d0] = shm3 + MV + (4 * hi + q) * 128 + ((2 * (d0 ^ (q >> 1)) + gb) * 32) + (lane & 3) * 8; }
    LAS float* wsf = (LAS float*)(lds + MWS) + wid * 64;
    LAS bf16_t* stg = (LAS bf16_t*)(lds + MSTG) + wid * 2048;
#pragma unroll
    for (int qb = 0; qb < NQB; ++qb) {
        const bool has_next = qb + 1 < NQB;
        float lsum = 0.f; f32x16 o[2]; o[0] = f32x16{}; o[1] = f32x16{};
#pragma unroll
        for (int i = 0; i < 4; ++i) {
            if (qb == 0) {
                if (i == 0) AT_WAIT_BAR(6); else if (i == 1) AT_WAIT_BAR(4); else if (i == 2) { if (has_next) AT_WAIT_BAR(6); else AT_WAIT_BAR(2); } else { if (has_next) AT_WAIT_BAR(4); else AT_WAIT_BAR(0); }
            }
            if (i == 1 && has_next) {
#pragma unroll
                for (int d0 = 0; d0 < 4; ++d0) qn[d0] = *(const bf16x8*)(Qw + (size_t)(qb + 1) * 256 * HD + d0 * 16); }
#pragma unroll
            for (int hf = 0; hf < 2; ++hf) {
                f32x16 p = f32x16{};
#pragma unroll
                for (int d0 = 0; d0 < 4; ++d0) p = __builtin_amdgcn_mfma_f32_32x32x16_bf16(*(const LAS bf16x8*)(ka[d0] + i * 8192 + 4096 * hf), qr[d0], p, 0, 0, 0);
                float s0 = 0.f;
#pragma unroll
                for (int r = 0; r < 16; ++r) { p[r] = __builtin_amdgcn_exp2f(p[r]); s0 += p[r]; }
                lsum += s0;
                const u32x4 pwa = (u32x4){cvtpk(p[0], p[1]), cvtpk(p[2], p[3]), cvtpk(p[4], p[5]), cvtpk(p[6], p[7])}, pwb = (u32x4){cvtpk(p[8], p[9]), cvtpk(p[10], p[11]), cvtpk(p[12], p[13]), cvtpk(p[14], p[15])};
#pragma unroll
                for (int d0 = 0; d0 < 2; ++d0) { const lds_cptr vp = va[d0] + i * 8192 + 4096 * hf; const s16x4 l0 = vtr(vp), h0 = vtr(vp + 1024), l1 = vtr(vp + 2048), h1 = vtr(vp + 2048 + 1024);
                    o[d0] = __builtin_amdgcn_mfma_f32_32x32x16_bf16(__builtin_bit_cast(bf16x8, pwa), (bf16x8){l0[0], l0[1], l0[2], l0[3], h0[0], h0[1], h0[2], h0[3]}, o[d0], 0, 0, 0);
                    o[d0] = __builtin_amdgcn_mfma_f32_32x32x16_bf16(__builtin_bit_cast(bf16x8, pwb), (bf16x8){l1[0], l1[1], l1[2], l1[3], h1[0], h1[1], h1[2], h1[3]}, o[d0], 0, 0, 0); }
            }
        }
        lsum += __shfl_xor(lsum, 32);
        if (hi == 0) wsf[r32] = lsum;
        asm volatile("s_waitcnt lgkmcnt(0)" ::: "memory");
#pragma unroll
        for (int r = 0; r < 16; ++r) { const int orow = crow(r, hi); const float rl = __builtin_amdgcn_rcpf(wsf[orow]);
            stg[orow * 64 + r32] = (bf16_t)f2bf(o[0][r] * rl); stg[orow * 64 + 32 + r32] = (bf16_t)f2bf(o[1][r] * rl); }
        asm volatile("s_waitcnt lgkmcnt(0)" ::: "memory");
        const int trow0 = t0 + qb * 256 + wid * 32;
#pragma unroll
        for (int i = 0; i < 4; ++i) { const int row = i * 8 + (lane >> 3), ch = lane & 7; const u32x4 v = *(const LAS u32x4*)(stg + row * 64 + ch * 8);
            *(u32x4*)(mixed + (size_t)(trow0 + row) * D + hh16 * 64 + ch * 8) = v;
            { float s = 0.f, a;
              a = bf2f(v.x & 0xffffu); s += a * a; a = bf2f(v.x >> 16); s += a * a; a = bf2f(v.y & 0xffffu); s += a * a; a = bf2f(v.y >> 16); s += a * a;
              a = bf2f(v.z & 0xffffu); s += a * a; a = bf2f(v.z >> 16); s += a * a; a = bf2f(v.w & 0xffffu); s += a * a; a = bf2f(v.w >> 16); s += a * a;
              s += __shfl_xor(s, 1); s += __shfl_xor(s, 2); s += __shfl_xor(s, 4);
              if (ch == 0) ssq[(size_t)(trow0 + row) * 16 + hh16] = s; } }
        asm volatile("s_waitcnt lgkmcnt(0)" ::: "memory");
        if (has_next) {
#pragma unroll
            for (int d0 = 0; d0 < 4; ++d0) qr[d0] = qn[d0]; }
    }
    asm volatile("s_waitcnt lgkmcnt(0)\n\ts_barrier" ::: "memory");
}

__device__ __forceinline__ void nb_unit(LAS unsigned char* lds, const UnitDesc& u, bf16_t* mixed, float* ssq) {
    const int tid = opaque_tid0(), lane = tid & 63, r32 = lane & 31, hi = lane >> 5; const int wid = __builtin_amdgcn_readfirstlane(tid >> 6);
    const unsigned lds0 = (unsigned)(size_t)lds; lds_cptr shm3 = (lds_cptr)lds;
    const int prow = 8 * wid + (lane >> 3);
    const bf16_t* ksrc = u.K + (size_t)(u.kt0 * 64 + prow) * HD + (((lane & 7) ^ ((4 * wid + (lane >> 4)) & 7)) * 8);
    const bf16_t* vsrc = u.V + (size_t)(u.kt0 * 64 + prow) * HD + ((((lane & 7) >> 1) ^ (prow & 2)) * 16) + (lane & 1) * 8;
    const unsigned kdst = lds0 + LDS_K + wid * 1024, vdst = lds0 + LDS_V + wid * 1024;
#define AT_DMA_K(t, slot) glds16(ksrc + (size_t)(t) * 64 * HD, (unsigned)__builtin_amdgcn_readfirstlane(kdst + (slot)))
#define AT_DMA_V(t, slot) glds16(vsrc + (size_t)(t) * 64 * HD, (unsigned)__builtin_amdgcn_readfirstlane(vdst + (slot)))
    const int rp = wid >> 2, jb = wid & 3, cs = min(max(16 * jb - 8, 0), 32);
    const int qrl = 4 * u.qb + 2 * rp + (r32 >> 4), qc = 16 * jb + (r32 & 15), c0 = min(max(qc - 8, 0), 48), r0l = min(max(qrl - 4, 0), 24);
    const int rwa = min(max(4 * u.qb + 2 * rp - 4, 0), 24), rwb = min(max(4 * u.qb + 2 * rp + 1 - 4, 0), 24) + 8;
    lds_cptr ka[4], va[2];
    { const int key = cs + r32, sw = (key >> 1) & 7;
#pragma unroll
      for (int d0 = 0; d0 < 4; ++d0) ka[d0] = shm3 + LDS_K + key * 128 + (((2 * d0 + hi) ^ sw) * 16);
      const int q = (lane & 15) >> 2, gb = (lane >> 4) & 1;
#pragma unroll
      for (int d0 = 0; d0 < 2; ++d0) va[d0] = shm3 + LDS_V + (cs + 4 * hi + q) * 128 + ((2 * (d0 ^ (q >> 1)) + gb) * 32) + (lane & 3) * 8; }
    const int nt = u.nt;
    const bf16_t* Qw = u.Q + (size_t)(qrl * 64 + qc) * HD;
    bf16x8 qr[4];
#pragma unroll
    for (int d0 = 0; d0 < 4; ++d0) qr[d0] = *(const bf16x8*)(Qw + d0 * 16 + hi * 8);
#pragma unroll
    for (int j = 0; j < NPRE; ++j) if (j < nt) { AT_DMA_K(j, j * SLOTB); AT_DMA_V(j, j * SLOTB); }
    lds_cptr tb, tbm;
    { const int ib = cs + 4 * hi - qc + 63, cb = (-ib) & 3, im = cs + 4 * hi - c0 + 63, cm = (-im) & 3;
      tb = shm3 + LDS_TBB + cb * TB_CS + (ib + cb) * 4; tbm = shm3 + LDS_TBM + cm * TB_CS + (im + cm) * 4; }
    float lsum = 0.f; f32x16 o[2]; o[0] = f32x16{}; o[1] = f32x16{};
    int sl_cur = 0, sl_n2 = NPRE * SLOTB;
    for (int i = 0; i < nt; ++i) {
        { const int rem = nt - 1 - i, yo = rem < NPRE - 1 ? rem : NPRE - 1; if (yo >= 3) AT_WAIT_BAR(6); else if (yo == 2) AT_WAIT_BAR(4); else if (yo == 1) AT_WAIT_BAR(2); else AT_WAIT_BAR(0); }
        if (i + NPRE < nt) { AT_DMA_K(i + NPRE, sl_n2); AT_DMA_V(i + NPRE, sl_n2); }
        const int kr = u.kt0 + i;
        if (kr >= rwa && kr < rwb) {
            const int drow = (kr >= r0l && kr < r0l + 8) ? (kr - qrl + 7) : 15;
            const lds_cptr tp = tb + drow * TB_ROW;
            f32x16 p0;
#pragma unroll
            for (int g = 0; g < 4; ++g) { const f32x4 a = *(const LAS f32x4*)(tp + 32 * g) + *(const LAS f32x4*)(tbm + 32 * g); p0[4 * g] = a[0]; p0[4 * g + 1] = a[1]; p0[4 * g + 2] = a[2]; p0[4 * g + 3] = a[3]; }
            bf16x8 kf[4];
#pragma unroll
            for (int j = 0; j < 4; ++j) kf[j] = *(const LAS bf16x8*)(ka[j] + sl_cur);
#pragma unroll
            for (int d0 = 0; d0 < 4; ++d0) p0 = __builtin_amdgcn_mfma_f32_32x32x16_bf16(kf[d0], qr[d0], p0, 0, 0, 0);
            float s0 = 0.f;
#pragma unroll
            for (int r = 0; r < 16; ++r) { p0[r] = __builtin_amdgcn_exp2f(p0[r]); s0 += p0[r]; }
            lsum += s0;
            const u32x4 pw0 = (u32x4){cvtpk(p0[0], p0[1]), cvtpk(p0[2], p0[3]), cvtpk(p0[4], p0[5]), cvtpk(p0[6], p0[7])};
            const u32x4 pw1 = (u32x4){cvtpk(p0[8], p0[9]), cvtpk(p0[10], p0[11]), cvtpk(p0[12], p0[13]), cvtpk(p0[14], p0[15])};
#pragma unroll
            for (int d0 = 0; d0 < 2; ++d0) {
                s16x4 lo[2], hh[2]; const lds_cptr vp = va[d0] + sl_cur;
#pragma unroll
                for (int ks = 0; ks < 2; ++ks) { lo[ks] = vtr(vp + ks * 2048); hh[ks] = vtr(vp + ks * 2048 + 1024); }
                o[d0] = __builtin_amdgcn_mfma_f32_32x32x16_bf16(__builtin_bit_cast(bf16x8, pw0), (bf16x8){lo[0][0], lo[0][1], lo[0][2], lo[0][3], hh[0][0], hh[0][1], hh[0][2], hh[0][3]}, o[d0], 0, 0, 0);
                o[d0] = __builtin_amdgcn_mfma_f32_32x32x16_bf16(__builtin_bit_cast(bf16x8, pw1), (bf16x8){lo[1][0], lo[1][1], lo[1][2], lo[1][3], hh[1][0], hh[1][1], hh[1][2], hh[1][3]}, o[d0], 0, 0, 0);
            }
        }
        sl_n2 = sl_cur;
        sl_cur = (sl_cur == (NSLOT - 1) * SLOTB) ? 0 : sl_cur + SLOTB;
    }
    AT_WAIT_BAR(0);
    int lane2 = lane; asm volatile("" : "+v"(lane2)); const int r32e = lane2 & 31, hie = lane2 >> 5;
    lsum += __shfl_xor(lsum, 32);
    LAS float* wsf = (LAS float*)(lds + LDS_WS) + wid * 64;
    if (hie == 0) wsf[r32e] = lsum;
    asm volatile("s_waitcnt lgkmcnt(0)" ::: "memory");
    LAS bf16_t* stg = (LAS bf16_t*)(lds) + wid * 2048;
#pragma unroll
    for (int r = 0; r < 16; ++r) { const int orow = crow(r, hie); const float rl = __builtin_amdgcn_rcpf(wsf[orow]);
        stg[orow * 64 + r32e] = (bf16_t)f2bf(o[0][r] * rl); stg[orow * 64 + 32 + r32e] = (bf16_t)f2bf(o[1][r] * rl); }
    asm volatile("s_waitcnt lgkmcnt(0)" ::: "memory");
    const int tbase = u.t0 + 2 * rp * 64 + 16 * jb;
#pragma unroll
    for (int i = 0; i < 4; ++i) { const int row = i * 8 + (lane2 >> 3), ch = lane2 & 7; const u32x4 v = *(const LAS u32x4*)(stg + row * 64 + ch * 8);
        *(u32x4*)(mixed + (size_t)(tbase + (row >> 4) * 64 + (row & 15)) * D + u.hh16 * 64 + ch * 8) = v; const int hh16 = u.hh16;
            { float s = 0.f, a;
              a = bf2f(v.x & 0xffffu); s += a * a; a = bf2f(v.x >> 16); s += a * a; a = bf2f(v.y & 0xffffu); s += a * a; a = bf2f(v.y >> 16); s += a * a;
              a = bf2f(v.z & 0xffffu); s += a * a; a = bf2f(v.z >> 16); s += a * a; a = bf2f(v.w & 0xffffu); s += a * a; a = bf2f(v.w >> 16); s += a * a;
              s += __shfl_xor(s, 1); s += __shfl_xor(s, 2); s += __shfl_xor(s, 4);
              if (ch == 0) ssq[(size_t)(tbase + (row >> 4) * 64 + (row & 15)) * 16 + hh16] = s; } }
    asm volatile("s_waitcnt lgkmcnt(0)\n\ts_barrier" ::: "memory");
#undef AT_DMA_K
#undef AT_DMA_V
}
__device__ __forceinline__ void nb_unit2(LAS unsigned char* lds, const UnitDesc& u, bf16_t* mixed, float* ssq) {
    const int tid = opaque_tid0(), lane = tid & 63, r32 = lane & 31, hi = lane >> 5; const int wid = __builtin_amdgcn_readfirstlane(tid >> 6);
    const unsigned lds0 = (unsigned)(size_t)lds; lds_cptr shm3 = (lds_cptr)lds;
    const int prow = 8 * wid + (lane >> 3);
    const bf16_t* ksrc = u.K + (size_t)(u.kt0 * 64 + prow) * HD + (((lane & 7) ^ ((4 * wid + (lane >> 4)) & 7)) * 8);
    const bf16_t* vsrc = u.V + (size_t)(u.kt0 * 64 + prow) * HD + ((((lane & 7) >> 1) ^ (prow & 2)) * 16) + (lane & 1) * 8;
    const unsigned kdst = lds0 + LDS_K + wid * 1024, vdst = lds0 + LDS_V + wid * 1024;
#define AT_DMA_K(t, slot) glds16(ksrc + (size_t)(t) * 64 * HD, (unsigned)__builtin_amdgcn_readfirstlane(kdst + (slot)))
#define AT_DMA_V(t, slot) glds16(vsrc + (size_t)(t) * 64 * HD, (unsigned)__builtin_amdgcn_readfirstlane(vdst + (slot)))
    const int rp = wid >> 2, jb = wid & 3, cs = min(max(16 * jb - 8, 0), 32);
    const int qc = 16 * jb + (r32 & 15), c0 = min(max(qc - 8, 0), 48);
    int qrl[2], r0l[2], rwa[2], rwb[2];
#pragma unroll
    for (int sb = 0; sb < 2; ++sb) { const int base = 8 * u.qb + 4 * sb + 2 * rp; qrl[sb] = base + (r32 >> 4); r0l[sb] = min(max(qrl[sb] - 4, 0), 24);
        rwa[sb] = min(max(base - 4, 0), 24); rwb[sb] = min(max(base + 1 - 4, 0), 24) + 8; }
    lds_cptr ka[4], va[2];
    { const int key = cs + r32, sw = (key >> 1) & 7;
#pragma unroll
      for (int d0 = 0; d0 < 4; ++d0) ka[d0] = shm3 + LDS_K + key * 128 + (((2 * d0 + hi) ^ sw) * 16);
      const int q = (lane & 15) >> 2, gb = (lane >> 4) & 1;
#pragma unroll
      for (int d0 = 0; d0 < 2; ++d0) va[d0] = shm3 + LDS_V + (cs + 4 * hi + q) * 128 + ((2 * (d0 ^ (q >> 1)) + gb) * 32) + (lane & 3) * 8; }
    const int nt = u.nt;
    bf16x8 qr[2][4];
#pragma unroll
    for (int sb = 0; sb < 2; ++sb) { const bf16_t* Qw = u.Q + (size_t)(qrl[sb] * 64 + qc) * HD;
#pragma unroll
        for (int d0 = 0; d0 < 4; ++d0) qr[sb][d0] = *(const bf16x8*)(Qw + d0 * 16 + hi * 8); }
#pragma unroll
    for (int j = 0; j < NPRE; ++j) if (j < nt) { AT_DMA_K(j, j * SLOTB); AT_DMA_V(j, j * SLOTB); }
    lds_cptr tb, tbm;
    { const int ib = cs + 4 * hi - qc + 63, cb = (-ib) & 3, im = cs + 4 * hi - c0 + 63, cm = (-im) & 3;
      tb = shm3 + LDS_TBB + cb * TB_CS + (ib + cb) * 4; tbm = shm3 + LDS_TBM + cm * TB_CS + (im + cm) * 4; }
    float lsum[2] = {0.f, 0.f}; f32x16 o[2][2]; o[0][0] = f32x16{}; o[0][1] = f32x16{}; o[1][0] = f32x16{}; o[1][1] = f32x16{};
    int sl_cur = 0, sl_n2 = NPRE * SLOTB;
    for (int i = 0; i < nt; ++i) {
        { const int rem = nt - 1 - i, yo = rem < NPRE - 1 ? rem : NPRE - 1; if (yo >= 3) AT_WAIT_BAR(6); else if (yo == 2) AT_WAIT_BAR(4); else if (yo == 1) AT_WAIT_BAR(2); else AT_WAIT_BAR(0); }
        if (i + NPRE < nt) { AT_DMA_K(i + NPRE, sl_n2); AT_DMA_V(i + NPRE, sl_n2); }
        const int kr = u.kt0 + i;
        const bool act0 = kr >= rwa[0] && kr < rwb[0], act1 = kr >= rwa[1] && kr < rwb[1];
        if (act0 || act1) {
            bf16x8 kf[4];
#pragma unroll
            for (int j = 0; j < 4; ++j) kf[j] = *(const LAS bf16x8*)(ka[j] + sl_cur);
            s16x4 lo[2][2], hh[2][2];
#pragma unroll
            for (int d0 = 0; d0 < 2; ++d0) { const lds_cptr vp = va[d0] + sl_cur;
#pragma unroll
                for (int ks = 0; ks < 2; ++ks) { lo[d0][ks] = vtr(vp + ks * 2048); hh[d0][ks] = vtr(vp + ks * 2048 + 1024); } }
#pragma unroll
            for (int sb = 0; sb < 2; ++sb) {
                if (sb == 0 ? act0 : act1) {
                    const int drow = (kr >= r0l[sb] && kr < r0l[sb] + 8) ? (kr - qrl[sb] + 7) : 15;
                    const lds_cptr tp = tb + drow * TB_ROW;
                    f32x16 p0;
#pragma unroll
                    for (int g = 0; g < 4; ++g) { const f32x4 a = *(const LAS f32x4*)(tp + 32 * g) + *(const LAS f32x4*)(tbm + 32 * g); p0[4 * g] = a[0]; p0[4 * g + 1] = a[1]; p0[4 * g + 2] = a[2]; p0[4 * g + 3] = a[3]; }
#pragma unroll
                    for (int d0 = 0; d0 < 4; ++d0) p0 = __builtin_amdgcn_mfma_f32_32x32x16_bf16(kf[d0], qr[sb][d0], p0, 0, 0, 0);
                    float s0 = 0.f;
#pragma unroll
                    for (int r = 0; r < 16; ++r) { p0[r] = __builtin_amdgcn_exp2f(p0[r]); s0 += p0[r]; }
                    lsum[sb] += s0;
                    const u32x4 pw0 = (u32x4){cvtpk(p0[0], p0[1]), cvtpk(p0[2], p0[3]), cvtpk(p0[4], p0[5]), cvtpk(p0[6], p0[7])};
                    const u32x4 pw1 = (u32x4){cvtpk(p0[8], p0[9]), cvtpk(p0[10], p0[11]), cvtpk(p0[12], p0[13]), cvtpk(p0[14], p0[15])};
#pragma unroll
                    for (int d0 = 0; d0 < 2; ++d0) {
                        o[sb][d0] = __builtin_amdgcn_mfma_f32_32x32x16_bf16(__builtin_bit_cast(bf16x8, pw0), (bf16x8){lo[d0][0][0], lo[d0][0][1], lo[d0][0][2], lo[d0][0][3], hh[d0][0][0], hh[d0][0][1], hh[d0][0][2], hh[d0][0][3]}, o[sb][d0], 0, 0, 0);
                        o[sb][d0] = __builtin_amdgcn_mfma_f32_32x32x16_bf16(__builtin_bit_cast(bf16x8, pw1), (bf16x8){lo[d0][1][0], lo[d0][1][1], lo[d0][1][2], lo[d0][1][3], hh[d0][1][0], hh[d0][1][1], hh[d0][1][2], hh[d0][1][3]}, o[sb][d0], 0, 0, 0);
                    }
                }
            }
        }
        sl_n2 = sl_cur;
        sl_cur = (sl_cur == (NSLOT - 1) * SLOTB) ? 0 : sl_cur + SLOTB;
    }
    AT_WAIT_BAR(0);
    int lane2 = lane; asm volatile("" : "+v"(lane2)); const int r32e = lane2 & 31, hie = lane2 >> 5;
    LAS float* wsf = (LAS float*)(lds + LDS_WS) + wid * 64;
    LAS bf16_t* stg = (LAS bf16_t*)(lds) + wid * 2048;
#pragma unroll
    for (int sb = 0; sb < 2; ++sb) {
        float ls = lsum[sb]; ls += __shfl_xor(ls, 32);
        if (hie == 0) wsf[r32e] = ls;
        asm volatile("s_waitcnt lgkmcnt(0)" ::: "memory");
#pragma unroll
        for (int r = 0; r < 16; ++r) { const int orow = crow(r, hie); const float rl = __builtin_amdgcn_rcpf(wsf[orow]);
            stg[orow * 64 + r32e] = (bf16_t)f2bf(o[sb][0][r] * rl); stg[orow * 64 + 32 + r32e] = (bf16_t)f2bf(o[sb][1][r] * rl); }
        asm volatile("s_waitcnt lgkmcnt(0)" ::: "memory");
        const int tbase = u.t0 + (4 * sb + 2 * rp) * 64 + 16 * jb;
#pragma unroll
        for (int i = 0; i < 4; ++i) { const int row = i * 8 + (lane2 >> 3), ch = lane2 & 7; const u32x4 v = *(const LAS u32x4*)(stg + row * 64 + ch * 8); const int tok = tbase + (row >> 4) * 64 + (row & 15);
            *(u32x4*)(mixed + (size_t)tok * D + u.hh16 * 64 + ch * 8) = v;
            { float s = 0.f, a;
              a = bf2f(v.x & 0xffffu); s += a * a; a = bf2f(v.x >> 16); s += a * a; a = bf2f(v.y & 0xffffu); s += a * a; a = bf2f(v.y >> 16); s += a * a;
              a = bf2f(v.z & 0xffffu); s += a * a; a = bf2f(v.z >> 16); s += a * a; a = bf2f(v.w & 0xffffu); s += a * a; a = bf2f(v.w >> 16); s += a * a;
              s += __shfl_xor(s, 1); s += __shfl_xor(s, 2); s += __shfl_xor(s, 4);
              if (ch == 0) ssq[(size_t)tok * 16 + u.hh16] = s; } }
        asm volatile("s_waitcnt lgkmcnt(0)" ::: "memory");
    }
    asm volatile("s_waitcnt lgkmcnt(0)\n\ts_barrier" ::: "memory");
#undef AT_DMA_K
#undef AT_DMA_V
}
__device__ __forceinline__ void build_table_b(LAS unsigned char* lds, const float* rpb_lh) {
    const int tid = opaque_tid0();
    for (int e = tid; e < 15 * 127; e += 512) { const int dr = e / 127, idx = e - dr * 127, rel = idx - 63; const float v = (rel >= -15 && rel <= 15) ? rpb_lh[dr * 31 + rel + 15] * LOG2E : 0.f;
#pragma unroll
        for (int c = 0; c < 4; ++c) *(LAS float*)(lds + LDS_TBB + dr * TB_ROW + c * TB_CS + (idx + c) * 4) = v; }
    if (tid >= 256 && tid < 256 + 127) { const int idx = tid - 256;
#pragma unroll
        for (int c = 0; c < 4; ++c) *(LAS float*)(lds + LDS_TBB + 15 * TB_ROW + c * TB_CS + (idx + c) * 4) = NEGBIG; }
    if (tid < 127) { const int j = tid - 63; const float v = (j >= 0 && j < 16) ? 0.f : NEGBIG;
#pragma unroll
        for (int c = 0; c < 4; ++c) *(LAS float*)(lds + LDS_TBM + c * TB_CS + (tid + c) * 4) = v; }
}

template <int TYPE>
__device__ __forceinline__ void attn_type_loop(Frame& F, int l, unsigned xcc, int qset) {
    constexpr int MQB = 2, MUP = 8 / MQB;
    constexpr int NPER = (TYPE == 2) ? 16 * MUP : (TYPE == 1 ? 96 : 192);
    unsigned* qcnt = F.ctl + CW_ATQ + ((qset * 3 + TYPE) * 8) * 64;
    LAS int* qw = (LAS int*)(F.lds + CTRL_BASE + 1024);
    const int tid = opaque_tid0();
    const int xq = (int)xcc & 7; int pre = -2;
    for (;;) {
        if (tid == 0) { int id, x; at_dequeue(qcnt, NPER, xq, pre, id, x); qw[0] = id; qw[1] = x; }
        __syncthreads();
        const int id = qw[0], x = qw[1];
        __syncthreads();
        if (id < 0) break;
        pre = -2; if (tid == 0 && x == xq) pre = (int)__hip_atomic_fetch_add(qcnt + xq * 64, 1u, RLX_AGENT);
        UnitDesc u; int h;
        if (TYPE == 2) { const int P = x * 16 + id / MUP, b = P >> 2, q0 = (id % MUP) * MQB; h = P & 3;
            mem_unit<MQB>(F.lds, qkv_ptr(F, 36 + h, b * SEQ + q0 * 256), memkv_ptr(F, l, h, b * MEM_LEN), memkv_ptr(F, l, 4 + h, b * MEM_LEN), b * SEQ + q0 * 256, 12 + h, (bf16_t*)(F.ws + WS_MIX), (float*)(F.ws + WS_SSQH));
            continue; }
        else if (TYPE == 1) { const int up = (0x0321 >> (4 * (id & 3))) & 3;
            const int P = x * 24 + (id >> 2), b = P / 6; h = P % 6; u.qb = up; u.h = h; u.t0 = b * SEQ + up * 512; u.hh16 = 6 + h;
            u.Q = qkv_ptr(F, 18 + h, b * SEQ); u.K = qkv_ptr(F, 24 + h, b * SEQ); u.V = qkv_ptr(F, 30 + h, b * SEQ);
            const int lo = min(max(8 * up - 4, 0), 24), hi2 = min(max(8 * up + 7 - 4, 0), 24) + 8; u.kt0 = lo; u.nt = hi2 - lo; }
        else { const int ord = (0x70615243 >> (4 * (id & 7))) & 7;
            const int P = x * 24 + (id >> 3), b = P / 6; h = P % 6; u.qb = ord; u.h = h; u.t0 = b * SEQ + ord * 256;
            if (TYPE == 0) { u.hh16 = h; u.Q = qkv_ptr(F, h, b * SEQ); u.K = qkv_ptr(F, 6 + h, b * SEQ); u.V = qkv_ptr(F, 12 + h, b * SEQ);
                const int lo = max(4 * ord - 16, 0), hi2 = min(4 * ord + 20, 32); u.kt0 = lo; u.nt = hi2 - lo; }
            else { u.hh16 = 6 + h; u.Q = qkv_ptr(F, 18 + h, b * SEQ); u.K = qkv_ptr(F, 24 + h, b * SEQ); u.V = qkv_ptr(F, 30 + h, b * SEQ);
                const int lo = min(max(4 * ord - 4, 0), 24), hi2 = min(max(4 * ord + 3 - 4, 0), 24) + 8; u.kt0 = lo; u.nt = hi2 - lo; } }
        if (TYPE == 1) build_table_b(F.lds, in_ptr(5) + (size_t)(l * 6 + h) * 15 * 31);
        if (TYPE == 1) nb_unit2(F.lds, u, (bf16_t*)(F.ws + WS_MIX), (float*)(F.ws + WS_SSQH)); else attn_unit<TYPE>(F.lds, u, (bf16_t*)(F.ws + WS_MIX), (float*)(F.ws + WS_SSQH));
    }
}
constexpr int SW_TAB = 131072, SW_CS = 1088, SW_STG = SW_TAB + 4 * SW_CS;
static_assert(SW_STG + 8 * 2048 <= CTRL_BASE, "sliding-window LDS map");
__device__ __forceinline__ void sw_unit(LAS unsigned char* lds, int b, int h, int p, int half, const bf16_t* Qh, const bf16_t* Kh, const bf16_t* Vh, bf16_t* PO, float* PL) {
    const int tid = opaque_tid0(), lane = tid & 63, r32 = lane & 31, hi = lane >> 5; const int wid = __builtin_amdgcn_readfirstlane(tid >> 6), pair = wid >> 1, w2 = wid & 1;
    const int dsh = 2 * p, nbsh = 5 - dsh, nblk = 1 << nbsh;
    const unsigned lds0 = (unsigned)(size_t)lds; lds_cptr shm3 = (lds_cptr)lds;
    { const float sd = exp2f(-8.0f * (float)(h + 1) / 6.0f) * LOG2E * (float)(1 << dsh);
      if (tid < 255) { const int rel = tid - 127, a = rel < 0 ? -rel : rel; const float v = a <= 64 ? -sd * (float)a : NEGBIG;
#pragma unroll
          for (int c = 0; c < 4; ++c) *(LAS float*)(lds + SW_TAB + c * SW_CS + (tid + c) * 4) = v; } }
    lds_cptr ka[4], va[2];
    { const int sw = (r32 >> 1) & 7;
#pragma unroll
      for (int d0 = 0; d0 < 4; ++d0) ka[d0] = shm3 + r32 * 128 + (((2 * d0 + hi) ^ sw) * 16);
      const int q = (lane & 15) >> 2, gb = (lane >> 4) & 1;
#pragma unroll
      for (int d0 = 0; d0 < 2; ++d0) va[d0] = shm3 + 8192 + (4 * hi + q) * 128 + ((2 * (d0 ^ (q >> 1)) + gb) * 32) + (lane & 3) * 8; }
    lds_cptr tb0; { const int idx0 = 63 - 32 * w2 - r32 + 4 * hi, c = (-idx0) & 3; tb0 = shm3 + SW_TAB + c * SW_CS + (idx0 + c) * 4; }
    const int G0 = 16 * half;
    const int prow = 8 * wid + (lane >> 3);
    const int kcol = ((lane & 7) ^ ((4 * wid + (lane >> 4)) & 7)) * 8, vcol = ((((lane & 7) >> 1) ^ (prow & 2)) * 16) + (lane & 1) * 8;
#define SW_DMA(lam) do { int tau_ = G0 - 1 + (lam); tau_ = tau_ < 0 ? 0 : (tau_ > 31 ? 31 : tau_); const int r_ = tau_ >> nbsh, n_ = tau_ & (nblk - 1); \
        const size_t ro_ = (size_t)((((n_ * 64 + prow) << dsh) + r_)) * HD; const unsigned d_ = lds0 + ((lam) & 7) * 16384 + wid * 1024; \
        glds16(Kh + ro_ + kcol, (unsigned)__builtin_amdgcn_readfirstlane(d_)); glds16(Vh + ro_ + vcol, (unsigned)__builtin_amdgcn_readfirstlane(d_ + 8192)); } while (0)
#define SW_QLOAD(dst, s) do { const int G_ = G0 + 4 * (s) + pair, r_ = G_ >> nbsh, n_ = G_ & (nblk - 1); const bf16_t* qw_ = Qh + (size_t)((((n_ * 64 + 32 * w2 + r32) << dsh) + r_)) * HD; \
        _Pragma("unroll") for (int d0 = 0; d0 < 4; ++d0) dst[d0] = *(const bf16x8*)(qw_ + d0 * 16 + hi * 8); } while (0)
    bf16x8 qr[4], qn[4];
    SW_QLOAD(qr, 0);
#pragma unroll
    for (int d0 = 0; d0 < 4; ++d0) qn[d0] = qr[d0];
#pragma unroll
    for (int lam = 0; lam < 8; ++lam) SW_DMA(lam);
    float lsum = 0.f; f32x16 o[2]; o[0] = f32x16{}; o[1] = f32x16{};
#define SW_EPI(s) do { const int G_ = G0 + 4 * (s) + pair, r_ = G_ >> nbsh, n_ = G_ & (nblk - 1); \
        lsum += __shfl_xor(lsum, 32); \
        if (hi == 0) PL[((size_t)p * T + (size_t)b * SEQ + (((n_ * 64 + 32 * w2 + r32) << dsh) + r_)) * 8 + h] = lsum; \
        LAS bf16_t* stg_ = (LAS bf16_t*)(lds + SW_STG + wid * 2048); \
        _Pragma("unroll") for (int d0 = 0; d0 < 2; ++d0) { \
            _Pragma("unroll") for (int r = 0; r < 16; ++r) stg_[crow(r, hi) * 32 + r32] = (bf16_t)f2bf(o[d0][r]); \
            asm volatile("s_waitcnt lgkmcnt(0)" ::: "memory"); \
            _Pragma("unroll") for (int i2 = 0; i2 < 2; ++i2) { const int row = i2 * 16 + (lane >> 2), ch = lane & 3; const u32x4 v = *(const LAS u32x4*)(stg_ + row * 32 + ch * 8); \
                *(u32x4*)(PO + ((size_t)p * T + (size_t)b * SEQ + (((n_ * 64 + 32 * w2 + row) << dsh) + r_)) * 384 + h * 64 + d0 * 32 + ch * 8) = v; } \
            asm volatile("s_waitcnt lgkmcnt(0)" ::: "memory"); } \
        lsum = 0.f; o[0] = f32x16{}; o[1] = f32x16{}; } while (0)
#define SW_WAIT(sig) do { if ((sig) == 0) AT_WAIT_BAR(8); else if ((sig) == 3 || (sig) == 6 || (sig) == 9) AT_WAIT_BAR(4); else if ((sig) == 10) AT_WAIT_BAR(2); else if ((sig) == 11) AT_WAIT_BAR(0); else AT_WAIT_BAR(6); } while (0)
#pragma unroll
    for (int sig = 0; sig < 12; ++sig) {
        const int s = sig / 3, t = sig - 3 * s;
        SW_WAIT(sig);
        if (t == 0 && s > 0) { SW_EPI(s - 1);
#pragma unroll
            for (int d0 = 0; d0 < 4; ++d0) qr[d0] = qn[d0]; }
        if (t == 2 && s < 3) SW_QLOAD(qn, s + 1);
        if (t == 1) { if (4 * s + 8 <= 17) SW_DMA(4 * s + 8); }
        if (t == 2) { if (4 * s + 9 <= 17) SW_DMA(4 * s + 9); }
        if (t == 0 && s > 0) { if (4 * s + 6 <= 17) SW_DMA(4 * s + 6); if (4 * s + 7 <= 17) SW_DMA(4 * s + 7); }
        const int G = G0 + 4 * s + pair, n = G & (nblk - 1);
        if (!(t == 0 && n == 0) && !(t == 2 && n == nblk - 1)) {
            const int slo = ((4 * s + t + pair) & 7) * 16384;
            const bool do0 = !(t == 0 && w2 == 1), do1 = !(t == 2 && w2 == 0);
            const lds_cptr tp = tb0 + t * 256;
            if (do0) {
                f32x16 p0;
#pragma unroll
                for (int gq = 0; gq < 4; ++gq) { const f32x4 a = *(const LAS f32x4*)(tp + 32 * gq); p0[4 * gq] = a[0]; p0[4 * gq + 1] = a[1]; p0[4 * gq + 2] = a[2]; p0[4 * gq + 3] = a[3]; }
#pragma unroll
                for (int d0 = 0; d0 < 4; ++d0) p0 = __builtin_amdgcn_mfma_f32_32x32x16_bf16(*(const LAS bf16x8*)(ka[d0] + slo), qr[d0], p0, 0, 0, 0);
                float s0 = 0.f;
#pragma unroll
                for (int r = 0; r < 16; ++r) { p0[r] = __builtin_amdgcn_exp2f(p0[r]); s0 += p0[r]; }
                lsum += s0;
                const u32x4 pw0 = (u32x4){cvtpk(p0[0], p0[1]), cvtpk(p0[2], p0[3]), cvtpk(p0[4], p0[5]), cvtpk(p0[6], p0[7])}, pw1 = (u32x4){cvtpk(p0[8], p0[9]), cvtpk(p0[10], p0[11]), cvtpk(p0[12], p0[13]), cvtpk(p0[14], p0[15])};
#pragma unroll
                for (int d0 = 0; d0 < 2; ++d0) { const lds_cptr vp = va[d0] + slo; const s16x4 l0 = vtr(vp), h0 = vtr(vp + 1024), l1 = vtr(vp + 2048), h1 = vtr(vp + 2048 + 1024);
                    o[d0] = __builtin_amdgcn_mfma_f32_32x32x16_bf16(__builtin_bit_cast(bf16x8, pw0), (bf16x8){l0[0], l0[1], l0[2], l0[3], h0[0], h0[1], h0[2], h0[3]}, o[d0], 0, 0, 0);
                    o[d0] = __builtin_amdgcn_mfma_f32_32x32x16_bf16(__builtin_bit_cast(bf16x8, pw1), (bf16x8){l1[0], l1[1], l1[2], l1[3], h1[0], h1[1], h1[2], h1[3]}, o[d0], 0, 0, 0); }
            }
            if (do1) {
                f32x16 p1;
#pragma unroll
                for (int gq = 0; gq < 4; ++gq) { const f32x4 a = *(const LAS f32x4*)(tp + 32 * (gq + 4)); p1[4 * gq] = a[0]; p1[4 * gq + 1] = a[1]; p1[4 * gq + 2] = a[2]; p1[4 * gq + 3] = a[3]; }
#pragma unroll
                for (int d0 = 0; d0 < 4; ++d0) p1 = __builtin_amdgcn_mfma_f32_32x32x16_bf16(*(const LAS bf16x8*)(ka[d0] + slo + 4096), qr[d0], p1, 0, 0, 0);
                float s1 = 0.f;
#pragma unroll
                for (int r = 0; r < 16; ++r) { p1[r] = __builtin_amdgcn_exp2f(p1[r]); s1 += p1[r]; }
                lsum += s1;
                const u32x4 pw2 = (u32x4){cvtpk(p1[0], p1[1]), cvtpk(p1[2], p1[3]), cvtpk(p1[4], p1[5]), cvtpk(p1[6], p1[7])}, pw3 = (u32x4){cvtpk(p1[8], p1[9]), cvtpk(p1[10], p1[11]), cvtpk(p1[12], p1[13]), cvtpk(p1[14], p1[15])};
#pragma unroll
                for (int d0 = 0; d0 < 2; ++d0) { const lds_cptr vp = va[d0] + slo + 4096; const s16x4 l0 = vtr(vp), h0 = vtr(vp + 1024), l1 = vtr(vp + 2048), h1 = vtr(vp + 2048 + 1024);
                    o[d0] = __builtin_amdgcn_mfma_f32_32x32x16_bf16(__builtin_bit_cast(bf16x8, pw2), (bf16x8){l0[0], l0[1], l0[2], l0[3], h0[0], h0[1], h0[2], h0[3]}, o[d0], 0, 0, 0);
                    o[d0] = __builtin_amdgcn_mfma_f32_32x32x16_bf16(__builtin_bit_cast(bf16x8, pw3), (bf16x8){l1[0], l1[1], l1[2], l1[3], h1[0], h1[1], h1[2], h1[3]}, o[d0], 0, 0, 0); }
            }
        }
    }
    AT_WAIT_BAR(0);
    SW_EPI(3);
    asm volatile("s_waitcnt lgkmcnt(0)\n\ts_barrier" ::: "memory");
#undef SW_DMA
#undef SW_QLOAD
#undef SW_EPI
#undef SW_WAIT
}
__device__ __forceinline__ void sa_loop(Frame& F, int l, unsigned xcc, int qset) {
    constexpr int NPER = 144;
    unsigned* qcnt = F.ctl + CW_ATQ + ((qset * 3 + 0) * 8) * 64;
    LAS int* qw = (LAS int*)(F.lds + CTRL_BASE + 1024);
    const int tid = opaque_tid0();
    const int xq = (int)xcc & 7; int pre = -2;
    for (;;) {
        if (tid == 0) { int id, x; at_dequeue(qcnt, NPER, xq, pre, id, x); qw[0] = id; qw[1] = x; }
        __syncthreads();
        const int id = qw[0], x = qw[1];
        __syncthreads();
        if (id < 0) break;
        pre = -2; if (tid == 0 && x == xq) pre = (int)__hip_atomic_fetch_add(qcnt + xq * 64, 1u, RLX_AGENT);
        const int P = x * 24 + id / 6, b = P / 6, h = P % 6, p = (id % 6) >> 1, half = id & 1;
        sw_unit(F.lds, b, h, p, half, qkv_ptr(F, h, b * SEQ), qkv_ptr(F, 6 + h, b * SEQ), qkv_ptr(F, 12 + h, b * SEQ), (bf16_t*)(F.ws + WS_PO), (float*)(F.ws + WS_PL));
    }
}
}

__device__ __forceinline__ void moe_weights_beside(Frame& F, int l, int qset) {
    PHASE_IDS(F);
    if ((blockIdx.x & 31) >= 8) return;
    LAS float* scr = (LAS float*)(F.lds + F.wave * 16384);
    LAS int* qw = (LAS int*)(F.lds + CTRL_BASE + 1024);
    constexpr int I_G = 16 * 16, I_D = 8 * 32, PER_E = 2 * I_G + I_D, NIT = NE * PER_E, BATCH_IT = 64;
    unsigned* head = F.ctl + CW_WQ + qset * 64;
    for (;;) {
        if (F.tid == 0) qw[2] = (int)__hip_atomic_fetch_add(head, 1u, RLX_AGENT);
        __syncthreads();
        const int bt = qw[2];
        __syncthreads();
        if (bt * BATCH_IT >= NIT) break;
        auto dec = [&](int j) { const int it = bt * BATCH_IT + j; const int e = it / PER_E; int r = it % PER_E; const size_t le = (size_t)l * NE + e;
            if (r < I_G) return TrItem{in_ptr(15) + le * D * DE, in_ptr(10) + l * D, (bf16_t*)(F.ws + WS_WGU + le * 1024 * D), D, DE, 6, r};
            r -= I_G;
            if (r < I_G) return TrItem{in_ptr(16) + le * D * DE, in_ptr(10) + l * D, (bf16_t*)(F.ws + WS_WGU + le * 1024 * D), D, DE, 7, r};
            r -= I_G;
            return TrItem{in_ptr(17) + le * DE * D, (const float*)nullptr, (bf16_t*)(F.ws + WS_WD + le * D * DE), DE, D, 5, r}; };
        float wa[32], wb[32];
        TrItem d0 = dec(F.wave); tr_load(d0, F.lane, wa);
#pragma unroll
        for (int jj = 0; jj < BATCH_IT / NWAVES; jj += 2) {
            TrItem d1 = dec(F.wave + (jj + 1) * NWAVES); tr_load(d1, F.lane, wb);
            tr_finish(d0, F.lane, wa, scr);
            if (jj + 2 < BATCH_IT / NWAVES) { d0 = dec(F.wave + (jj + 2) * NWAVES); tr_load(d0, F.lane, wa); }
            tr_finish(d1, F.lane, wb, scr);
        }
    }
    __syncthreads();
}
__device__ __forceinline__ void phase_attn_fast(Frame& F, int l, int qset) {
    if (qset < 2) moe_weights_beside(F, l, qset);
    PHASE_IDS(F);
    const unsigned xcc = xb_xcc_id();
    at::sa_loop(F, l, xcc, qset);
    if (PROBE_ID == 100 && l == 0) { __syncthreads(); at::sa_loop(F, l, xcc, 2); }
    at::attn_type_loop<1>(F, l, xcc, qset);
    if (PROBE_ID == 101 && l == 0) { __syncthreads(); at::attn_type_loop<1>(F, l, xcc, 2); }
    at::attn_type_loop<2>(F, l, xcc, qset);
    if (PROBE_ID == 102 && l == 0) { __syncthreads(); at::attn_type_loop<2>(F, l, xcc, 2); }
}

__device__ __forceinline__ bool in_ph(int lo, int hi, int k) { asm volatile("" : "+s"(lo), "+s"(hi)); return lo <= k && k < hi; }
constexpr int PH_TOTAL = 2 + 8 * DEPTH - 1;
__global__ void __launch_bounds__(NWAVES * 64, 2) fwd(Args args) {
    extern __shared__ __attribute__((aligned(16))) unsigned char lds[];
    Frame F;
    F.lds = (LAS unsigned char*)lds; PHASE_IDS(F);
    F.G = gridDim.x; F.ngw = F.G * NWAVES;
    F.out = args.out; F.ws = args.ws; F.ctl = (unsigned*)(args.ws + WS_CTL);
    volatile LAS unsigned* MISC = (volatile LAS unsigned*)(F.lds + MISC_OFF);
    if (F.tid < 32) MISC[F.tid] = 0u;
    __syncthreads();
    const int lo = args.ph_lo, hi = args.ph_hi;
    XcdBarrier bar; bar.bar = F.ctl + CW_BAR; bar.x = 0; bar.st = nullptr;
    if (hi - lo > 1) bar = xcd_barrier_post(F.ctl + CW_BAR, MISC + 8);
#define IN(k) in_ph(lo, hi, (k))
#define SEAM(k) do { if (IN(k) && IN((k) + 1)) xcd_barrier(bar); else __syncthreads(); } while (0)
#define RUN(k, code) do { if (IN(k)) { code; if (PROBE_ID == (k)) { xcd_barrier(bar); code; } } SEAM(k); } while (0)
    RUN(0, { phase_weights(F); phase_x0(F); });
    RUN(1, { phase_memkv_fast(F); phase_inproj_fast(F, 0); });
    { const int l = 0, pb = 2;
      if (IN(pb + 0)) { phase_attn_fast(F, l, 0); if (PROBE_ID == pb + 0) { xcd_barrier(bar); phase_attn_fast(F, l, 2); } } SEAM(pb + 0);
      RUN(pb + 1, { phase_groupnorm(F); });
      RUN(pb + 2, { phase_outproj_fast(F, l); });
      RUN(pb + 3, { phase_router_fast(F, l); });
      RUN(pb + 4, { phase_moe1_fast(F, l); phase_moe2_fast(F, l); });
      RUN(pb + 6, { phase_combine(F, l); });
      RUN(pb + 7, { phase_inproj_fast(F, 1); });
    }
    { const int l = 1, pb = 10;
      if (IN(pb + 0)) { phase_attn_fast(F, l, 1); if (PROBE_ID == pb + 0) { xcd_barrier(bar); phase_attn_fast(F, l, 3); } } SEAM(pb + 0);
      RUN(pb + 1, { phase_groupnorm(F); });
      RUN(pb + 2, { phase_outproj_fast(F, l); });
      RUN(pb + 3, { phase_router_fast(F, l); });
      RUN(pb + 4, { phase_moe1_fast(F, l); phase_moe2_fast(F, l); });
      RUN(pb + 6, { phase_combine(F, l); });
    }
#undef IN
#undef SEAM
#undef RUN
}

extern "C" void kernel_launch(void* const* d_in, const int* in_sizes, int n_in, void* d_out, int out_size, void* d_ws, size_t ws_size, hipStream_t stream) {
    static int grid = 0;
    if (grid == 0) {
        if (n_in != 18 || in_sizes[0] != T * D || out_size != T * D || ws_size < WS_END) { fprintf(stderr, "kernel_launch: unexpected shapes (n_in %d, in0 %d, out %d, ws %zu < %zu); nothing launched\n", n_in, n_in > 0 ? in_sizes[0] : -1, out_size, ws_size, (size_t)WS_END); grid = -1; return; }
        int dev = 0, cus = 0, per_cu = 0;
        if (hipGetDevice(&dev) != hipSuccess || hipDeviceGetAttribute(&cus, hipDeviceAttributeMultiprocessorCount, dev) != hipSuccess) { grid = -1; return; }
        if (hipFuncSetAttribute((const void*)fwd, hipFuncAttributeMaxDynamicSharedMemorySize, LDS_BYTES) != hipSuccess) { fprintf(stderr, "kernel_launch: hipFuncSetAttribute failed\n"); grid = -1; return; }
        if (hipOccupancyMaxActiveBlocksPerMultiprocessor(&per_cu, (const void*)fwd, NWAVES * 64, LDS_BYTES) != hipSuccess || per_cu < 1) fprintf(stderr, "kernel_launch: occupancy query reports %d\n", per_cu);
        (void)hipGetLastError();
        grid = cus;
    }
    if (grid < 0) return;
    if (hipMemsetAsync((char*)d_ws + WS_CTL, 0, CTL_ZERO_BYTES, stream) != hipSuccess) { fprintf(stderr, "kernel_launch: memset failed\n"); return; }
    Args a{};
    for (int i = 0; i < 18; ++i) a.in[i] = (const float*)d_in[i];
    a.out = (float*)d_out; a.ws = (unsigned char*)d_ws;
#if MK_ONE_LAUNCH
    a.ph_lo = 0; a.ph_hi = PH_TOTAL;
    hipLaunchKernelGGL(fwd, dim3(grid), dim3(NWAVES * 64), LDS_BYTES, stream, a);
#else
    for (int p = 0; p < PH_TOTAL; ++p) { a.ph_lo = p; a.ph_hi = p + 1; hipLaunchKernelGGL(fwd, dim3(grid), dim3(NWAVES * 64), LDS_BYTES, stream, a); }
#endif
    const hipError_t le = hipPeekAtLastError();
    if (le != hipSuccess) fprintf(stderr, "kernel_launch: launch failed: %s\n", hipGetErrorName(le));
}
```

```cpp
#include <hip/hip_runtime.h>
#include <cstdio>
#include <cstdint>

#ifndef PROBE_ID
#define PROBE_ID (-1)
#endif
#ifndef SPARSE_A
#define SPARSE_A 1
#endif
#ifndef MK_ONE_LAUNCH
#define MK_ONE_LAUNCH 1
#endif

constexpr int D = 1024, BATCH = 32, SEQ = 2048, T = BATCH * SEQ, DEPTH = 2;
constexpr int MEM_LEN = 256, TM = BATCH * MEM_LEN;
constexpr int HD = 64, INW = 2560, NHS = 40;
constexpr int NE = 32, EPG = 8, NGRP = 4, DE = 512;
constexpr float EPS = 1e-6f, LOG2E = 1.4426950408889634f, ATTN_SCALE = 0.125f;
constexpr int YROWS = 2 * T + NE * 256;

constexpr size_t MiB = 1u << 20;
constexpr size_t WS_CTL = 0, CTL_ZERO_BYTES = 1 * MiB;
constexpr size_t WS_WIN = 1 * MiB;
constexpr size_t WS_WMEM = WS_WIN + 10 * MiB;
constexpr size_t WS_WOUT = WS_WMEM + 2 * MiB;
constexpr size_t WS_WR = WS_WOUT + 4 * MiB;
constexpr size_t WS_WGU = WS_WR + 1 * MiB;
constexpr size_t WS_X8 = WS_WGU + 64 * MiB;
constexpr size_t WS_WD = WS_WGU + 128 * MiB;
constexpr size_t WS_FAB = WS_WD + 32 * MiB;
constexpr size_t WS_RM = WS_WD + 33 * MiB;
constexpr size_t WS_XB = WS_WD + 64 * MiB;
constexpr size_t WS_RS = WS_XB + 128 * MiB;
constexpr size_t WS_SSQ1 = WS_RS + 1 * MiB;
constexpr size_t WS_SSQH = WS_SSQ1 + 4 * MiB;
constexpr size_t WS_MB = WS_SSQH + 4 * MiB;
constexpr size_t WS_RSM = WS_MB + 16 * MiB;
constexpr size_t WS_MEMKV = WS_RSM + 1 * MiB;
constexpr size_t WS_ROUTE = WS_MEMKV + 16 * MiB;
constexpr size_t WS_LIST = WS_ROUTE + 1 * MiB;
constexpr size_t WS_WL = WS_LIST + 8 * MiB;
constexpr size_t WS_RSL = WS_WL + 8 * MiB;
constexpr size_t WS_QKV = WS_RSL + 8 * MiB;
constexpr size_t QKV_SLICE = (size_t)T * HD + 10240;
constexpr size_t WS_MIX = WS_QKV + 321 * MiB;
constexpr size_t WS_PO = WS_MIX + 136 * MiB;
constexpr size_t PO_SLICE = (size_t)T * 384 + 14336, PL_SLICE = (size_t)T * 8 + 2048 + 64;
constexpr size_t WS_PL = WS_PO + 145 * MiB;
constexpr size_t WS_END = WS_PL + 7 * MiB;
static_assert(WS_END <= 1024 * MiB, "workspace map exceeds 1 GiB");
static_assert((size_t)YROWS * 1024 * 2 <= 320 * MiB && (size_t)YROWS * 512 * 4 <= 320 * MiB && (size_t)YROWS * 512 * 2 <= 136 * MiB, "aliases");
constexpr int CW_BAR = 4096;
constexpr int CW_RND = 45056;
constexpr int CW_WQ = 40960;
constexpr int CW_ATQ = 32768;
constexpr int CW_CNT = 16384;

constexpr int LDS_BYTES = 163840;
constexpr int CTRL_BASE = 159744;
constexpr int MISC_OFF = CTRL_BASE + 2048;
constexpr int NWAVES = 8;

#define GAS __attribute__((address_space(1)))
#define LAS __attribute__((address_space(3)))
typedef unsigned short bf16_t;
typedef unsigned u32x4 __attribute__((ext_vector_type(4)));
typedef unsigned u32x2 __attribute__((ext_vector_type(2)));
typedef float f32x4 __attribute__((ext_vector_type(4)));
#define RLX_AGENT __ATOMIC_RELAXED, __HIP_MEMORY_SCOPE_AGENT

__device__ __forceinline__ float bf2f(unsigned v) { return __uint_as_float(v << 16); }
__device__ __forceinline__ unsigned f2bf(float f) { unsigned u = __float_as_uint(f); return (u + 0x7fffu + ((u >> 16) & 1u)) >> 16; }
__device__ __forceinline__ unsigned pk2(float lo, float hi) { return f2bf(lo) | (f2bf(hi) << 16); }
__device__ __forceinline__ float wave_sum(float v) {
#pragma unroll
    for (int o = 1; o < 64; o <<= 1) v += __shfl_xor(v, o);
    return v;
}
__device__ __forceinline__ float wave_max(float v) {
#pragma unroll
    for (int o = 1; o < 64; o <<= 1) v = fmaxf(v, __shfl_xor(v, o));
    return v;
}

#define XB_TMO      128
#define XB_XCNT(j)  (256  + 64 * (j))
#define XB_XSUB(j)  (1280 + 64 * (j))
#define XB_XGEN(j)  (2304 + 64 * (j))
#define XB_TOP      3328
#define XB_TOPGEN   3392
#define XCD_BAR_WORDS 3456
#define XB_SPIN_CAP (1u << 18)
__device__ __forceinline__ unsigned xb_ld(unsigned* p)              { return __hip_atomic_load(p, __ATOMIC_RELAXED, __HIP_MEMORY_SCOPE_AGENT); }
__device__ __forceinline__ unsigned xb_add(unsigned* p, unsigned v) { return __hip_atomic_fetch_add(p, v, __ATOMIC_RELAXED, __HIP_MEMORY_SCOPE_AGENT); }
__device__ __forceinline__ unsigned xb_xcc_id() { return (unsigned)__builtin_amdgcn_s_getreg((3 << 11) | 20) & 0xFu; }
#define XB_SPIN(cond, bar) do { unsigned _sp = 0; while (cond) { __builtin_amdgcn_s_sleep(1); \
    if ((++_sp & 255u) == 0u) { if (xb_ld(&(bar)[XB_TMO])) break; if (_sp > XB_SPIN_CAP) { atomicAdd(&(bar)[XB_TMO], 1u); break; } } } } while (0)
struct XcdBarrier { unsigned* bar; unsigned x; volatile LAS unsigned* st; };
__device__ __forceinline__ XcdBarrier xcd_barrier_post(unsigned* bar, volatile LAS unsigned* st) {
    XcdBarrier b; b.bar = bar; b.x = xb_xcc_id(); b.st = st;
    if (threadIdx.x == 0) (void)xb_add(&bar[XB_XCNT(b.x)], 1u);
    return b;
}
__device__ __forceinline__ void xcd_barrier_complete(unsigned* bar, unsigned x, unsigned& nloc, unsigned& nx) {
    const unsigned G = gridDim.x * gridDim.y * gridDim.z;
    unsigned sum, cnt, mine, sp = 0u;
    for (;;) {
        sum = 0u; cnt = 0u; mine = 0u;
#pragma unroll
        for (unsigned j = 0; j < 16; ++j) { const unsigned c = xb_ld(&bar[XB_XCNT(j)]); sum += c; cnt += (c > 0u) ? 1u : 0u; mine = (j == x) ? c : mine; }
        if (sum == G) break;
        __builtin_amdgcn_s_sleep(1);
        if ((++sp & 255u) == 0u) { if (xb_ld(&bar[XB_TMO])) break; if (sp > XB_SPIN_CAP) { atomicAdd(&bar[XB_TMO], 1u); break; } }
    }
    nloc = mine > 0u ? mine : 1u; nx = cnt > 0u ? cnt : 1u;
}
__device__ __forceinline__ void xcd_barrier(const XcdBarrier& b) {
    asm volatile("s_waitcnt vmcnt(0)" ::: "memory");
    __syncthreads();
    if (threadIdx.x == 0) {
        unsigned* bar = b.bar;
        __builtin_amdgcn_s_waitcnt(0);
        unsigned nloc = b.st[0], nx = b.st[1];
        if (nloc == 0u) { xcd_barrier_complete(bar, b.x, nloc, nx); b.st[0] = nloc; b.st[1] = nx; }
        const unsigned old = xb_add(&bar[XB_XSUB(b.x)], 1u);
        const unsigned gen = old / nloc;
        if (old + 1u == (gen + 1u) * nloc) {
            __builtin_amdgcn_fence(__ATOMIC_RELEASE, "agent");
            asm volatile("s_waitcnt vmcnt(0)" ::: "memory");
            const unsigned og = xb_add(&bar[XB_TOP], 1u);
            const unsigned tg = og / nx;
            if (og + 1u == (tg + 1u) * nx) xb_add(&bar[XB_TOPGEN], 1u);
            else XB_SPIN(xb_ld(&bar[XB_TOPGEN]) == tg, bar);
            __builtin_amdgcn_fence(__ATOMIC_ACQUIRE, "agent");
            xb_add(&bar[XB_XGEN(b.x)], 1u);
            asm volatile("s_waitcnt vmcnt(0)" ::: "memory");
        } else {
            XB_SPIN(xb_ld(&bar[XB_XGEN(b.x)]) == gen, bar);
            __builtin_amdgcn_fence(__ATOMIC_ACQUIRE, "agent");
            asm volatile("s_waitcnt vmcnt(0)" ::: "memory");
        }
    }
    __syncthreads();
}

struct Args {
    const float* in[18]; float* out; unsigned char* ws; int ph_lo, ph_hi;
};
__device__ __forceinline__ const float* in_ptr(int k) {
    const __attribute__((address_space(4))) char* ka = (const __attribute__((address_space(4))) char*)__builtin_amdgcn_kernarg_segment_ptr();
    asm volatile("" : "+s"(ka));
    return *(const float* const __attribute__((address_space(4)))*)(ka + 8 * k);
}
struct Frame {
    LAS unsigned char* lds; int tid, lane, wave, G, gw, ngw;
    float* out; unsigned char* ws; unsigned* ctl;
};

#define PHASE_IDS(F) do { (F).tid = opaque_tid0(); (F).lane = (F).tid & 63; (F).wave = __builtin_amdgcn_readfirstlane((F).tid >> 6); (F).gw = blockIdx.x * NWAVES + (F).wave; } while (0)
__device__ __forceinline__ int opaque_tid0() { int t = threadIdx.x; asm volatile("" : "+v"(t)); return t; }
__host__ __device__ __forceinline__ int inproj_gemm_col(int H, int dim) {
    const int pn = H >> 2, wc = H & 3, bj = dim >> 5, fq = (dim >> 3) & 3, nn = (dim >> 2) & 1, j = dim & 3;
    return 256 * pn + 128 * bj + 32 * wc + 16 * nn + 4 * fq + j;
}
__host__ __device__ __forceinline__ void inproj_head_dim(int c, int& H, int& dim) {
    const int pn = c >> 8, r = c & 255, bj = r >> 7, wc = (r >> 5) & 3, nn = (r >> 4) & 1, fq = (r >> 2) & 3, j = r & 3;
    H = 4 * pn + wc; dim = 32 * bj + 8 * fq + 4 * nn + j;
}

struct TrItem { const float* W; const float* kgain; bf16_t* WT; int K, N, kind, item; };
__device__ __forceinline__ void tr_load(const TrItem& d, int lane, float (&wv)[32]) {
    const int nblk = d.N / 32, kb = d.item / nblk, nb = d.item % nblk, k0 = 64 * kb, n0 = 32 * nb;
#pragma unroll
    for (int i = 0; i < 8; ++i) { const f32x4 v = __builtin_nontemporal_load((const f32x4*)(d.W + (size_t)(k0 + 8 * i + (lane >> 3)) * d.N + n0 + 4 * (lane & 7)));
        wv[4 * i] = v.x; wv[4 * i + 1] = v.y; wv[4 * i + 2] = v.z; wv[4 * i + 3] = v.w; }
}
__device__ __forceinline__ int tr_rowmap(int kind, int n);
__device__ __forceinline__ void tr_finish(const TrItem& d, int lane, const float (&wv)[32], LAS float* scr) {
    const int nblk = d.N / 32, kb = d.item / nblk, nb = d.item % nblk, k0 = 64 * kb, n0 = 32 * nb;
#pragma unroll
    for (int i = 0; i < 8; ++i) { const int kk = 8 * i + (lane >> 3); const float g = d.kgain ? d.kgain[k0 + kk] : 1.f; LAS float* sp = scr + kk * 33 + 4 * (lane & 7);
#pragma unroll
        for (int j = 0; j < 4; ++j) sp[j] = wv[4 * i + j] * g; }
    asm volatile("s_waitcnt lgkmcnt(0)" ::: "memory");
    const int c = lane & 7;
#pragma unroll
    for (int j = 0; j < 4; ++j) { const int n = (lane >> 3) + 8 * j; const LAS float* s = scr + (8 * c) * 33 + n;
        u32x4 o; o.x = pk2(s[0 * 33], s[1 * 33]); o.y = pk2(s[2 * 33], s[3 * 33]); o.z = pk2(s[4 * 33], s[5 * 33]); o.w = pk2(s[6 * 33], s[7 * 33]);
        if (d.kind >= 5) {
            int w0 = 0, w1 = 0;
            w0 = __builtin_amdgcn_cvt_pk_fp8_f32(32.f * s[0 * 33], 32.f * s[1 * 33], w0, false); w0 = __builtin_amdgcn_cvt_pk_fp8_f32(32.f * s[2 * 33], 32.f * s[3 * 33], w0, true);
            w1 = __builtin_amdgcn_cvt_pk_fp8_f32(32.f * s[4 * 33], 32.f * s[5 * 33], w1, false); w1 = __builtin_amdgcn_cvt_pk_fp8_f32(32.f * s[6 * 33], 32.f * s[7 * 33], w1, true);
            u32x2 o8; o8.x = (unsigned)w0; o8.y = (unsigned)w1;
            __builtin_nontemporal_store(o8, (u32x2*)((unsigned char*)d.WT + (size_t)tr_rowmap(d.kind, n0 + n) * d.K + k0 + 8 * c));
        } else *(u32x4*)(d.WT + (size_t)tr_rowmap(d.kind, n0 + n) * d.K + k0 + 8 * c) = o; }
    asm volatile("s_waitcnt lgkmcnt(0)" ::: "memory");
}
struct RmId { __device__ __forceinline__ int operator()(int n) const { return n; } };
struct RmHead { __device__ __forceinline__ int operator()(int n) const { return inproj_gemm_col(n >> 6, n & 63); } };
__host__ __device__ __forceinline__ int perm_row32(int c) { const int o = c & 31; return (c & ~31) | (16 * ((o >> 2) & 1) + 4 * (o >> 3) + (o & 3)); }
__host__ __device__ __forceinline__ int gate_row(int c, int up) { return 256 * (c >> 7) + 128 * up + perm_row32(c & 127); }
struct RmGate { int up; __device__ __forceinline__ int operator()(int n) const { return gate_row(n, up); } };
struct RmPerm { __device__ __forceinline__ int operator()(int n) const { return perm_row32(n); } };
__device__ __forceinline__ int tr_rowmap(int kind, int n) { return kind == 0 ? n : ((kind == 1 || kind == 8) ? inproj_gemm_col(n >> 6, n & 63) : ((kind == 2 || kind == 6) ? gate_row(n, 0) : ((kind == 3 || kind == 7) ? gate_row(n, 1) : perm_row32(n)))); }

__device__ __forceinline__ TrItem tr_decode_small(int it) {
    constexpr int I_IN = 16 * 80, I_MEM = 16 * 16, I_OUT = 16 * 32, PER_L = I_IN + I_MEM + I_OUT;
    const int l = it / PER_L; int r = it % PER_L;
    if (r < I_IN) return TrItem{in_ptr(3) + (size_t)l * D * INW, in_ptr(2) + l * D, (bf16_t*)nullptr, D, INW, 100 + l, r};
    r -= I_IN;
    if (r < I_MEM) return TrItem{in_ptr(7) + (size_t)l * D * 512, in_ptr(6) + l * D, (bf16_t*)nullptr, D, 512, 200 + l, r};
    r -= I_MEM;
    return TrItem{in_ptr(9) + (size_t)l * D * D, in_ptr(8) + l * D, (bf16_t*)nullptr, D, D, 300 + l, r};
}
__device__ __forceinline__ void phase_weights(Frame& F) {
    PHASE_IDS(F);
    LAS float* scr = (LAS float*)(F.lds + F.wave * 16384);
    constexpr int PER_L = 16 * 80 + 16 * 16 + 16 * 32, NIT = DEPTH * PER_L;
    auto fix = [&](TrItem d) { const int l = d.kind % 100, w = d.kind / 100;
        if (w == 1) { if (l == 0) { d.WT = (bf16_t*)(F.ws + WS_WIN); d.kind = 1; } else { d.WT = (bf16_t*)(F.ws + WS_WIN + (size_t)INW * D * 2); d.kind = 8; } } else if (w == 2) { d.WT = (bf16_t*)(F.ws + WS_WMEM) + (size_t)l * 512 * D; d.kind = 1; } else { d.WT = (bf16_t*)(F.ws + WS_WOUT) + (size_t)l * D * D; d.kind = 4; }
        return d; };
    float wa[32], wb[32];
    int it = F.gw;
    if (it < NIT) { TrItem d = fix(tr_decode_small(it)); tr_load(d, F.lane, wa);
        for (;;) {
            const int it2 = it + F.ngw; TrItem d2 = d; const bool more = it2 < NIT;
            if (more) { d2 = fix(tr_decode_small(it2)); tr_load(d2, F.lane, wb); }
            tr_finish(d, F.lane, wa, scr);
            if (!more) break;
            const int it3 = it2 + F.ngw; const bool more3 = it3 < NIT; TrItem d3 = d2;
            if (more3) { d3 = fix(tr_decode_small(it3)); tr_load(d3, F.lane, wa); }
            tr_finish(d2, F.lane, wb, scr);
            if (!more3) break;
            it = it3; d = d3;
        } }
    for (int i = F.gw * 64 + F.lane; i < DEPTH * 256 * D; i += F.ngw * 64) {
        const int l = i / (256 * D), j = (i / D) % 256, k = i % D; float v = 0.f;
        if (j < 4) v = in_ptr(11)[((size_t)l * D + k) * NGRP + j] * in_ptr(10)[l * D + k]; else if (j < 36) v = in_ptr(13)[((size_t)l * D + k) * NE + (j - 4)] * in_ptr(10)[l * D + k];
        ((bf16_t*)(F.ws + WS_WR))[i] = (bf16_t)f2bf(v);
    }
}

__device__ __forceinline__ void row_to_bf16_rs(int lane, const float* xrow, bf16_t* orow, float* rs) {
    const f32x4* xr = (const f32x4*)xrow + lane; f32x4 v[4]; float s = 0.f;
#pragma unroll
    for (int j = 0; j < 4; ++j) { v[j] = xr[64 * j]; s += (v[j].x * v[j].x + v[j].y * v[j].y) + (v[j].z * v[j].z + v[j].w * v[j].w); }
    s = wave_sum(s);
    if (lane == 0) *rs = 1.0f / sqrtf(s * (1.f / D) + EPS);
    u32x2* o8 = (u32x2*)orow + lane;
#pragma unroll
    for (int j = 0; j < 4; ++j) { u32x2 w; w.x = pk2(v[j].x, v[j].y); w.y = pk2(v[j].z, v[j].w); o8[64 * j] = w; }
}
__device__ __forceinline__ void phase_x0(Frame& F) {
    PHASE_IDS(F);
    const float* xp = in_ptr(0); const float* mp = in_ptr(1); const int lane = F.lane;
    for (int m0 = F.gw * 2; m0 < T + TM; m0 += F.ngw * 2) {
        const bool isx = m0 < T; const int r0 = isx ? m0 : m0 - T;
        const float* src = (isx ? xp : mp) + (size_t)r0 * D; bf16_t* dst = (bf16_t*)(F.ws + (isx ? WS_XB : WS_MB)) + (size_t)r0 * D; float* rs = (float*)(F.ws + (isx ? WS_RS : WS_RSM)) + r0;
        f32x4 v[2][4];
#pragma unroll
        for (int k = 0; k < 2; ++k)
#pragma unroll
            for (int j = 0; j < 4; ++j) v[k][j] = __builtin_nontemporal_load((const f32x4*)(src + (size_t)k * D) + lane + 64 * j);
#pragma unroll
        for (int k = 0; k < 2; ++k) { float s = 0.f;
#pragma unroll
            for (int j = 0; j < 4; ++j) s += (v[k][j].x * v[k][j].x + v[k][j].y * v[k][j].y) + (v[k][j].z * v[k][j].z + v[k][j].w * v[k][j].w);
            s = wave_sum(s);
            if (lane == 0) rs[k] = 1.0f / sqrtf(s * (1.f / D) + EPS);
            u32x2* o8 = (u32x2*)(dst + (size_t)k * D) + lane;
#pragma unroll
            for (int j = 0; j < 4; ++j) { u32x2 w; w.x = pk2(v[k][j].x, v[k][j].y); w.y = pk2(v[k][j].z, v[k][j].w); o8[64 * j] = w; } }
    }
}

__device__ __forceinline__ bf16_t* qkv_ptr(Frame& F, int H, int t) { return (bf16_t*)(F.ws + WS_QKV) + (size_t)H * QKV_SLICE + (size_t)t * HD; }
__device__ __forceinline__ bf16_t* memkv_ptr(Frame& F, int l, int H, int r) { return (bf16_t*)(F.ws + WS_MEMKV) + (((size_t)l * 8 + H) * TM + r) * HD; }

__device__ __forceinline__ void slice_kind(int H, int& gi, bool& isq) {
    gi = -1; isq = false;
    if (H < 6) { gi = 0; isq = true; } else if (H < 12) gi = 1; else if (H < 18) gi = -1;
    else if (H < 24) { gi = 2; isq = true; } else if (H < 30) gi = 3; else if (H < 36) gi = -1; else { gi = 4; isq = true; }
}
__device__ __forceinline__ void phase_groupnorm(Frame& F) {
    PHASE_IDS(F);
    const int lane = F.lane, half = lane >> 5, l32 = lane & 31, h = l32 >> 2; const bool act = l32 < 24;
    const bf16_t* PO = (const bf16_t*)(F.ws + WS_PO); const float* PL = (const float*)(F.ws + WS_PL); bf16_t* MX = (bf16_t*)(F.ws + WS_MIX);
    const float* SQ = (const float*)(F.ws + WS_SSQH); float* FAB = (float*)(F.ws + WS_FAB); float* RM = (float*)(F.ws + WS_RM);
    for (int t0 = F.gw * 8; t0 < T; t0 += F.ngw * 8) {
        u32x4 raw[4][3][2]; float den[4][3]; f32x4 sq[4][3];
#pragma unroll
        for (int u = 0; u < 4; ++u) { const int t = t0 + 2 * u + half;
            if (act) {
#pragma unroll
                for (int p = 0; p < 3; ++p) { const u32x4* pp = (const u32x4*)(PO + (size_t)p * PO_SLICE + (size_t)t * 384 + l32 * 16); raw[u][p][0] = __builtin_nontemporal_load(pp); raw[u][p][1] = __builtin_nontemporal_load(pp + 1); den[u][p] = PL[(size_t)p * PL_SLICE + (size_t)t * 8 + h]; }
            }
#pragma unroll
            for (int q = 0; q < 3; ++q) sq[u][q] = *(const f32x4*)(SQ + (size_t)t * 16 + 4 + 4 * q);
        }
#pragma unroll
        for (int u = 0; u < 4; ++u) { const int t = t0 + 2 * u + half; float v[16]; float s = 0.f;
            if (act) {
#pragma unroll
                for (int i = 0; i < 2; ++i) { const u32x4 w = raw[u][0][i]; v[8 * i + 0] = bf2f(w.x & 0xffffu); v[8 * i + 1] = bf2f(w.x >> 16); v[8 * i + 2] = bf2f(w.y & 0xffffu); v[8 * i + 3] = bf2f(w.y >> 16);
                    v[8 * i + 4] = bf2f(w.z & 0xffffu); v[8 * i + 5] = bf2f(w.z >> 16); v[8 * i + 6] = bf2f(w.w & 0xffffu); v[8 * i + 7] = bf2f(w.w >> 16); }
#pragma unroll
                for (int p = 1; p < 3; ++p)
#pragma unroll
                    for (int i = 0; i < 2; ++i) { const u32x4 w = raw[u][p][i]; v[8 * i + 0] += bf2f(w.x & 0xffffu); v[8 * i + 1] += bf2f(w.x >> 16); v[8 * i + 2] += bf2f(w.y & 0xffffu); v[8 * i + 3] += bf2f(w.y >> 16);
                        v[8 * i + 4] += bf2f(w.z & 0xffffu); v[8 * i + 5] += bf2f(w.z >> 16); v[8 * i + 6] += bf2f(w.w & 0xffffu); v[8 * i + 7] += bf2f(w.w >> 16); }
                const float rd = 1.0f / ((den[u][0] + den[u][1]) + den[u][2]);
                u32x4 o[2];
#pragma unroll
                for (int i = 0; i < 2; ++i) { o[i].x = pk2(v[8 * i + 0] * rd, v[8 * i + 1] * rd); o[i].y = pk2(v[8 * i + 2] * rd, v[8 * i + 3] * rd); o[i].z = pk2(v[8 * i + 4] * rd, v[8 * i + 5] * rd); o[i].w = pk2(v[8 * i + 6] * rd, v[8 * i + 7] * rd);
                    float a;
                    a = bf2f(o[i].x & 0xffffu); s += a * a; a = bf2f(o[i].x >> 16); s += a * a; a = bf2f(o[i].y & 0xffffu); s += a * a; a = bf2f(o[i].y >> 16); s += a * a;
                    a = bf2f(o[i].z & 0xffffu); s += a * a; a = bf2f(o[i].z >> 16); s += a * a; a = bf2f(o[i].w & 0xffffu); s += a * a; a = bf2f(o[i].w >> 16); s += a * a; }
                u32x4* mp = (u32x4*)(MX + (size_t)t * D + l32 * 16); mp[0] = o[0]; mp[1] = o[1];
            }
            s += __shfl_xor(s, 1); s += __shfl_xor(s, 2); s += __shfl_xor(s, 4); s += __shfl_xor(s, 8); s += __shfl_xor(s, 16);
            if (l32 == 0) {
                const float sb = ((sq[u][0][2] + sq[u][0][3]) + (sq[u][1][0] + sq[u][1][1])) + (sq[u][1][2] + sq[u][1][3]), sm = (sq[u][2][0] + sq[u][2][1]) + (sq[u][2][2] + sq[u][2][3]);
                const float ra = 1.f / sqrtf(s * (1.f / 384.f) + EPS), rb = 1.f / sqrtf(sb * (1.f / 384.f) + EPS), rmv = 1.f / sqrtf(sm * (1.f / 256.f) + EPS);
                FAB[(size_t)t * 2] = ra / rb; FAB[(size_t)t * 2 + 1] = rb / rmv; RM[t] = rmv; }
        }
    }
}
__device__ __forceinline__ void load_expert_table(LAS int* tab, const unsigned* cnt) {
    const int tid = opaque_tid0(), lane = tid & 63;
    if (tid < 64) {
        const int c = lane < NE ? (int)__hip_atomic_load(cnt + lane * 64, RLX_AGENT) : 0;
        int inc = (c + 255) >> 8;
#pragma unroll
        for (int o = 1; o < 64; o <<= 1) { const int v = __shfl_up(inc, o); if (lane >= o) inc += v; }
        tab[lane] = inc - ((c + 255) >> 8); tab[64 + lane] = c;
    }
    __syncthreads();
}
__device__ __forceinline__ float cl8(float v) { return fminf(fmaxf(v, -440.f), 440.f); }
__device__ __forceinline__ void phase_combine(Frame& F, int l) {
    PHASE_IDS(F);
    LAS int* tab = (LAS int*)(F.lds + CTRL_BASE);
    load_expert_table(tab, F.ctl + CW_CNT + l * NE * 64);
    const unsigned char* Y = (const unsigned char*)(F.ws + WS_QKV); const int lane = F.lane;
    typedef float f32x2_t __attribute__((ext_vector_type(2)));
    typedef int i32x4_t __attribute__((ext_vector_type(4)));
    constexpr int TK = 2;
    for (int t0 = F.gw * TK; t0 < T; t0 += F.ngw * TK) {
        i32x4_t rt[TK];
#pragma unroll
        for (int k = 0; k < TK; ++k) rt[k] = *(const i32x4_t*)((const int*)(F.ws + WS_ROUTE) + (size_t)(t0 + k) * 4);
        u32x2 xv[TK][4]; unsigned ya[TK][4], yb[TK][4];
#pragma unroll
        for (int k = 0; k < TK; ++k) { int ea = rt[k][0], pa = rt[k][1], eb = rt[k][2], pb = rt[k][3];
            if (ea > eb) { int q = ea; ea = eb; eb = q; q = pa; pa = pb; pb = q; }
            const unsigned* pya = (const unsigned*)(Y + (size_t)(tab[ea] * 256 + pa) * D) + lane; const unsigned* pyb = (const unsigned*)(Y + (size_t)(tab[eb] * 256 + pb) * D) + lane;
            const u32x2* xr = (const u32x2*)((const bf16_t*)(F.ws + WS_XB) + (size_t)(t0 + k) * D) + lane;
#pragma unroll
            for (int j = 0; j < 4; ++j) { xv[k][j] = (l + 1 < DEPTH) ? xr[64 * j] : __builtin_nontemporal_load(xr + 64 * j); ya[k][j] = __builtin_nontemporal_load(pya + 64 * j); yb[k][j] = __builtin_nontemporal_load(pyb + 64 * j); } }
#pragma unroll
        for (int k = 0; k < TK; ++k) { const int t = t0 + k; f32x4 v[4]; float s = 0.f;
#pragma unroll
            for (int j = 0; j < 4; ++j) { const u32x2 x = xv[k][j]; const int a = (int)ya[k][j], b2 = (int)yb[k][j];
                const f32x2_t a0 = __builtin_amdgcn_cvt_pk_f32_fp8(a, false), a1 = __builtin_amdgcn_cvt_pk_f32_fp8(a, true), b0 = __builtin_amdgcn_cvt_pk_f32_fp8(b2, false), b1 = __builtin_amdgcn_cvt_pk_f32_fp8(b2, true);
                v[j].x = (bf2f(x.x & 0xffffu) + 0.125f * a0[0]) + 0.125f * b0[0]; v[j].y = (bf2f(x.x >> 16) + 0.125f * a0[1]) + 0.125f * b0[1];
                v[j].z = (bf2f(x.y & 0xffffu) + 0.125f * a1[0]) + 0.125f * b1[0]; v[j].w = (bf2f(x.y >> 16) + 0.125f * a1[1]) + 0.125f * b1[1]; }
            if (l + 1 < DEPTH) {
                u32x2* o8 = (u32x2*)((bf16_t*)(F.ws + WS_XB) + (size_t)t * D) + lane;
#pragma unroll
                for (int j = 0; j < 4; ++j) { u32x2 w; w.x = pk2(v[j].x, v[j].y); w.y = pk2(v[j].z, v[j].w); __builtin_nontemporal_store(w, o8 + 64 * j);
                    const float o0 = bf2f(w.x & 0xffffu), o1 = bf2f(w.x >> 16), o2 = bf2f(w.y & 0xffffu), o3 = bf2f(w.y >> 16); s += (o0 * o0 + o1 * o1) + (o2 * o2 + o3 * o3);
                    int q8 = 0; q8 = __builtin_amdgcn_cvt_pk_fp8_f32(cl8(16.f * o0), cl8(16.f * o1), q8, false); q8 = __builtin_amdgcn_cvt_pk_fp8_f32(cl8(16.f * o2), cl8(16.f * o3), q8, true);
                    ((int*)(F.ws + WS_X8 + (size_t)t * D))[lane + 64 * j] = q8; }
                s = wave_sum(s);
                if (lane == 0) ((float*)(F.ws + WS_RS))[t] = 1.0f / sqrtf(s * (1.f / D) + EPS);
            } else {
                f32x4* xo = (f32x4*)(F.out + (size_t)t * D) + lane;
#pragma unroll
                for (int j = 0; j < 4; ++j) __builtin_nontemporal_store(v[j], xo + 64 * j);
            }
        }
    }
}

namespace g8 {
typedef short bf16x8 __attribute__((ext_vector_type(8)));
constexpr int BK = 64, HALF = 128, HTB = HALF * BK * 2, NXCD = 8, WGM = 8;
__device__ __forceinline__ int lds_byte(int r, int c) { const int st = (r >> 4) * 2 + (c >> 5), rr = r & 15, cc = c & 31, ob = rr * 64 + cc * 2; return st * 1024 + (ob ^ (((ob >> 9) & 1) << 5)); }
__device__ __forceinline__ void stage_rc(int b, int& R, int& C) { const int st = b / 1024, sb = b % 1024, swz = sb ^ (((sb >> 9) & 1) << 5); R = (st >> 1) * 16 + swz / 64; C = (st & 1) * 32 + (swz % 64) / 2; }
__device__ __forceinline__ unsigned cvt_pk_bf16(float lo, float hi) { unsigned r; asm volatile("v_cvt_pk_bf16_f32 %0, %1, %2" : "=v"(r) : "v"(lo), "v"(hi)); return r; }
__device__ __forceinline__ int opaque_tid() { int t = threadIdx.x; asm volatile("" : "+v"(t)); return t; }
__device__ __forceinline__ const char* uni(const char* p) { const unsigned long long v = (unsigned long long)p;
    return (const char*)(((unsigned long long)(unsigned)__builtin_amdgcn_readfirstlane((int)(v >> 32)) << 32) | (unsigned)__builtin_amdgcn_readfirstlane((int)v)); }
typedef int i32x8 __attribute__((ext_vector_type(8)));
typedef int i32x4v __attribute__((ext_vector_type(4)));
__device__ __forceinline__ float clamp8(float v) { return fminf(fmaxf(v, -440.f), 440.f); }
__device__ __forceinline__ i32x8 cat8(i32x4v a, i32x4v b) { return __builtin_shufflevector(a, b, 0, 1, 2, 3, 4, 5, 6, 7); }
__device__ __forceinline__ bf16x8 lo8(i32x8 v) { return __builtin_bit_cast(bf16x8, (i32x4v)__builtin_shufflevector(v, v, 0, 1, 2, 3)); }
__device__ __forceinline__ bf16x8 hi8(i32x8 v) { return __builtin_bit_cast(bf16x8, (i32x4v)__builtin_shufflevector(v, v, 4, 5, 6, 7)); }
struct Unit { const char* B; unsigned a00, a01, a10, a11; int pm, pn, e, ti, ce; };
struct DenseSched {
    int nM, nN, nwg, G, c, K; const char* Bbase;
    __device__ __forceinline__ void init(int M, int N, int K_, int G_, int c_, int tid, const void* Bt) { nM = M / 256; nN = N / 256; nwg = nM * nN; G = G_; c = c_; K = K_; Bbase = (const char*)Bt; }
    __device__ __forceinline__ bool next(int i, Unit& u) const {
        const long L = (long)i * G + c; if (L >= nwg) return false;
        int wgid = (int)L; { const int q = nwg / NXCD, r = nwg % NXCD, xcd = wgid % NXCD, off = wgid / NXCD; wgid = (xcd < r ? xcd * (q + 1) : r * (q + 1) + (xcd - r) * q) + off; }
        const int nig = WGM * nN, gid = wgid / nig, fm = gid * WGM, gsz = (nM - fm) < WGM ? (nM - fm) : WGM;
        u.pm = fm + ((wgid % nig) % gsz); u.pn = (wgid % nig) / gsz; u.e = 0; u.ti = 0; u.ce = 0;
        u.B = Bbase + (size_t)u.pn * 256 * K * 2;
        int R[2], C[2]; { const int tid = opaque_tid(); stage_rc(tid * 16, R[0], C[0]); stage_rc(tid * 16 + 8192, R[1], C[1]); }
        u.a00 = (unsigned)((u.pm * 256 + R[0]) * K + C[0]) * 2u; u.a01 = (unsigned)((u.pm * 256 + R[1]) * K + C[1]) * 2u;
        u.a10 = (unsigned)((u.pm * 256 + 128 + R[0]) * K + C[0]) * 2u; u.a11 = (unsigned)((u.pm * 256 + 128 + R[1]) * K + C[1]) * 2u;
        return true;
    }
};
template <bool WAITR>
struct GroupSchedT {
    const unsigned* rnd; mutable int rk;
    int NP, total, G, vb, K; const char* Bbase; size_t Bstride; const int* list; bool gather; LAS int* tab;
    __device__ __forceinline__ void init(LAS int* tab_, const unsigned* cnt, int NP_, int K_, int G_, int bid, const void* Bt, size_t Bstride_, const int* list_, bool gather_) {
        const int tid = opaque_tid(), lane = tid & 63; NP = NP_; K = K_; G = G_; vb = (G_ % 8 == 0) ? (bid % 8) * (G_ / 8) + bid / 8 : bid; rk = 0;
        if (WAITR && G_ % 16 == 0) vb = (vb + G_ / 2) % G_;
        Bbase = (const char*)Bt; Bstride = Bstride_; list = list_; gather = gather_; tab = tab_;
        const int c = lane < NE ? (int)__hip_atomic_load(cnt + lane * 64, RLX_AGENT) : 0;
        int inc = (c + 255) >> 8;
#pragma unroll
        for (int o = 1; o < 64; o <<= 1) { const int v = __shfl_up(inc, o); if (lane >= o) inc += v; }
        total = __builtin_amdgcn_readfirstlane(__shfl(inc, 63)) * NP;
        if (tid < 64) { tab[lane] = inc - ((c + 255) >> 8); tab[64 + lane] = c; }
        __syncthreads();
    }
    __device__ __forceinline__ bool next(int i, Unit& u) const {
        const int L = i * G + vb; if (L >= total) return false;
        const int tid = opaque_tid(), g = L / NP, lane = tid & 63; u.pn = L % NP; u.pm = g;
        if constexpr (WAITR) {
            if (tid < 64) {
                if (i >= rk) {
                    const int expv = min(max(total - lane * G, 0), G); unsigned polls = 0; int cnt;
                    for (;;) {
                        const unsigned c = lane < 16 ? __hip_atomic_load(rnd + lane, RLX_AGENT) : 0xffffffffu;
                        const unsigned long long okm = __ballot(lane >= 16 || (int)c >= expv);
                        cnt = (~okm == 0ull) ? 64 : (int)__builtin_ctzll(~okm);
                        if (cnt > i || ++polls > (1u << 22)) break;
                        __builtin_amdgcn_s_sleep(2);
                    }
                    rk = cnt;
                    __builtin_amdgcn_fence(__ATOMIC_ACQUIRE, "agent");
                    asm volatile("s_waitcnt vmcnt(0)" ::: "memory");
                }
            }
            asm volatile("" ::: "memory"); __builtin_amdgcn_s_barrier(); asm volatile("" ::: "memory");
        }
        int R[2], C[2]; stage_rc(tid * 16, R[0], C[0]); stage_rc(tid * 16 + 8192, R[1], C[1]);
        const int e = __builtin_amdgcn_readfirstlane(__popcll(__ballot(lane < NE && tab[lane] <= g)) - 1);
        u.e = e; u.ti = g - __builtin_amdgcn_readfirstlane(tab[e]); u.ce = __builtin_amdgcn_readfirstlane(tab[64 + e]);
        u.B = Bbase + (size_t)e * Bstride + (size_t)u.pn * 256 * K * 2;
        if (gather) {
            const int* le = list + (size_t)e * T; const int b = u.ti * 256, mx = u.ce - 1;
            const int t00 = le[min(b + R[0], mx)], t01 = le[min(b + R[1], mx)], t10 = le[min(b + 128 + R[0], mx)], t11 = le[min(b + 128 + R[1], mx)];
            u.a00 = (unsigned)(t00 * K + C[0]) * 2u; u.a01 = (unsigned)(t01 * K + C[1]) * 2u; u.a10 = (unsigned)(t10 * K + C[0]) * 2u; u.a11 = (unsigned)(t11 * K + C[1]) * 2u;
        } else {
            u.a00 = (unsigned)((g * 256 + R[0]) * K + C[0]) * 2u; u.a01 = (unsigned)((g * 256 + R[1]) * K + C[1]) * 2u;
            u.a10 = (unsigned)((g * 256 + 128 + R[0]) * K + C[0]) * 2u; u.a11 = (unsigned)((g * 256 + 128 + R[1]) * K + C[1]) * 2u;
        }
        return true;
    }
};

template <class E_, class = void> struct epi_signal_t { static constexpr bool v = false; };
template <class E_> struct epi_signal_t<E_, decltype(void(E_::SIGNAL))> { static constexpr bool v = E_::SIGNAL; };
template <class E_> constexpr bool epi_signal() { return epi_signal_t<E_>::v; }
template <class Epi, class Sched>
__device__ __forceinline__ void gemm_phase(LAS unsigned char* lds, const void* Abase_, int K, const Sched& S, const Epi& E) {
    const int tid = opaque_tid(), wid = __builtin_amdgcn_readfirstlane(tid >> 6), lane = tid & 63, wr = wid >> 2, wc = wid & 3, fr = lane & 15, fq = lane >> 4;
    int nt = K / BK; asm volatile("" : "+s"(nt)); const char* Abase = (const char*)Abase_;
    unsigned voffB[2];
#pragma unroll
    for (int i = 0; i < 2; ++i) { int R, C; stage_rc(tid * 16 + i * 8192, R, C); voffB[i] = (unsigned)(R * K + C) * 2u; }
    const size_t kstep = (size_t)(BK * 2), hstep = (size_t)HALF * K * 2;
    const unsigned ldsw = (unsigned)wid * 1024u;
    const int aoff = lds_byte(wr * 64 + fr, fq * 8), boff = lds_byte(wc * 32 + fr, fq * 8);
#define G8_SA(b, h) (((b) * 2 + (h)) * HTB)
#define G8_SB(b, h) ((4 + (b) * 2 + (h)) * HTB)
#define G8_STAGE(bufoff, gbase, voff) do { const char* _g = uni((const char*)(gbase)); _Pragma("unroll") for (int _i = 0; _i < 2; ++_i) \
        __builtin_amdgcn_global_load_lds((const unsigned*)(_g + (voff)[_i]), (LAS unsigned*)(lds + (bufoff) + ldsw + _i * 8192), 16, 0, 0); } while (0)
#define G8_STAGE_A(bufoff, gbase, o0, o1) do { const char* _g = uni((const char*)(gbase)); \
        __builtin_amdgcn_global_load_lds((const unsigned*)(_g + (o0)), (LAS unsigned*)(lds + (bufoff) + ldsw), 16, 0, 0); \
        __builtin_amdgcn_global_load_lds((const unsigned*)(_g + (o1)), (LAS unsigned*)(lds + (bufoff) + ldsw + 8192), 16, 0, 0); } while (0)
#define G8_LDA(dst, b, h) do { _Pragma("unroll") for (int m = 0; m < 4; ++m) dst[m] = cat8(*(const LAS i32x4v*)(lds + G8_SA(b, h) + aoff + m * 2048), *(const LAS i32x4v*)(lds + G8_SA(b, h) + aoff + m * 2048 + 1024)); } while (0)
#define G8_LDB(dst, b, h) do { _Pragma("unroll") for (int n = 0; n < 2; ++n) dst[n] = cat8(*(const LAS i32x4v*)(lds + G8_SB(b, h) + boff + n * 2048), *(const LAS i32x4v*)(lds + G8_SB(b, h) + boff + n * 2048 + 1024)); } while (0)
#define G8_MMA(ai, bj, At, Bt) do { __builtin_amdgcn_s_setprio(1); _Pragma("unroll") for (int m = 0; m < 4; ++m) _Pragma("unroll") for (int n = 0; n < 2; ++n) { \
        if constexpr (Epi::FP8) acc[ai][bj][m][n] = __builtin_amdgcn_mfma_scale_f32_16x16x128_f8f6f4(Bt[n], At[m], acc[ai][bj][m][n], 0, 0, 0, 0x7F7F7F7F, 0, 0x7F7F7F7F); \
        else { acc[ai][bj][m][n] = __builtin_amdgcn_mfma_f32_16x16x32_bf16(lo8(Bt[n]), lo8(At[m]), acc[ai][bj][m][n], 0, 0, 0); \
               acc[ai][bj][m][n] = __builtin_amdgcn_mfma_f32_16x16x32_bf16(hi8(Bt[n]), hi8(At[m]), acc[ai][bj][m][n], 0, 0, 0); } } __builtin_amdgcn_s_setprio(0); } while (0)
#define G8_WAIT_V(n) asm volatile("s_waitcnt vmcnt(" #n ")" ::: "memory")
#define G8_WAIT_L(n) asm volatile("s_waitcnt lgkmcnt(" #n ")" ::: "memory")
#define G8_BAR __builtin_amdgcn_s_barrier()
#define G8_SCHED __builtin_amdgcn_sched_barrier(0)
    Unit cur, nxt; int ui = 0;
    if (!S.next(0, cur)) return;
    constexpr int FACL = 131072;
#define G8_FAC(u_, par_) __builtin_amdgcn_global_load_lds((const unsigned*)(E.fab + (size_t)(u_).pm * 512 + tid), (LAS unsigned*)(lds + FACL + (par_) * 2048 + wid * 256), 4, 0, 0)
    if constexpr (Epi::RESCALE) G8_FAC(cur, 0);
    f32x4 acc[2][2][4][2];
#pragma unroll
    for (int a = 0; a < 2; ++a)
#pragma unroll
        for (int b = 0; b < 2; ++b)
#pragma unroll
            for (int m = 0; m < 4; ++m)
#pragma unroll
                for (int n = 0; n < 2; ++n) acc[a][b][m][n] = (f32x4){0.f, 0.f, 0.f, 0.f};
    i32x8 At[4], B0[2], B1[2];
    unsigned a00 = cur.a00, a01 = cur.a01, a10 = cur.a10, a11 = cur.a11;
    G8_STAGE(G8_SB(0, 0), cur.B, voffB); G8_STAGE(G8_SB(0, 1), cur.B + hstep, voffB); G8_STAGE_A(G8_SA(0, 0), Abase, a00, a01); G8_STAGE_A(G8_SA(0, 1), Abase, a10, a11);
    if (wr == 1) G8_BAR;
    G8_WAIT_V(2); G8_BAR;
    G8_STAGE(G8_SB(1, 0), cur.B + kstep, voffB); G8_STAGE_A(G8_SA(1, 0), Abase + kstep, a00, a01); G8_STAGE(G8_SB(1, 1), cur.B + hstep + kstep, voffB);
    G8_WAIT_V(6); G8_BAR;
    for (;;) {
        bool has_next = false; const char* curB = cur.B; const char* nB = curB;
        for (int t = 0; t < nt; t += 2) {
            const bool last = (t == nt - 2);
            if (t == nt - 4) { has_next = S.next(ui + 1, nxt); if (has_next) nB = nxt.B;
                if constexpr (Epi::RESCALE) { if (has_next) G8_FAC(nxt, (ui + 1) & 1); } }
            if constexpr (Epi::RESCALE) {
                if (t == 6 || t == 12) { const LAS float* fl = (const LAS float*)(lds + FACL + (ui & 1) * 2048) + (t == 12 ? 1 : 0);
#pragma unroll
                    for (int ai = 0; ai < 2; ++ai)
#pragma unroll
                        for (int m = 0; m < 4; ++m) { const float f = fl[(ai * HALF + wr * 64 + m * 16 + fr) * 2];
#pragma unroll
                            for (int bj = 0; bj < 2; ++bj)
#pragma unroll
                                for (int n = 0; n < 2; ++n) acc[ai][bj][m][n] = acc[ai][bj][m][n] * f; } } }
            const char* a1 = Abase + (size_t)(t + 1) * kstep;
            const char* a2 = last ? Abase : Abase + (size_t)(t + 2) * kstep; const char* b2 = last ? nB : curB + (size_t)(t + 2) * kstep;
            const char* a3 = a2 + kstep; const char* b3 = b2 + kstep;
            G8_LDB(B0, 0, 0); G8_LDB(B1, 0, 1); G8_SCHED; G8_LDA(At, 0, 0); G8_STAGE_A(G8_SA(1, 1), a1, a10, a11);
            if (last && has_next) { a00 = nxt.a00; a01 = nxt.a01; a10 = nxt.a10; a11 = nxt.a11; }
            G8_WAIT_V(8); G8_WAIT_L(0); G8_BAR; G8_MMA(0, 0, At, B0); G8_MMA(0, 1, At, B1); G8_BAR; G8_SCHED;
            G8_LDA(At, 0, 1); G8_STAGE(G8_SB(0, 0), b2, voffB); G8_STAGE(G8_SB(0, 1), b2 + hstep, voffB); G8_STAGE_A(G8_SA(0, 0), a2, a00, a01);
            G8_WAIT_V(8); G8_WAIT_L(0); G8_BAR; G8_MMA(1, 0, At, B0); G8_MMA(1, 1, At, B1); G8_BAR; G8_SCHED;
            G8_LDB(B0, 1, 0); G8_LDB(B1, 1, 1); G8_SCHED; G8_LDA(At, 1, 0); G8_STAGE_A(G8_SA(0, 1), a2, a10, a11);
            G8_WAIT_V(8); G8_WAIT_L(0); G8_BAR; G8_MMA(0, 0, At, B0); G8_MMA(0, 1, At, B1); G8_BAR; G8_SCHED;
            G8_LDA(At, 1, 1); G8_STAGE(G8_SB(1, 0), b3, voffB); G8_STAGE(G8_SB(1, 1), b3 + hstep, voffB); G8_STAGE_A(G8_SA(1, 0), a3, a00, a01);
            G8_WAIT_V(8); G8_WAIT_L(0); G8_BAR; G8_MMA(1, 0, At, B0); G8_MMA(1, 1, At, B1); G8_BAR; G8_SCHED;
        }
        if (wr == 0) G8_BAR;
        if constexpr (!Epi::AFTER_DRAIN) E(acc, cur, wr, wc, fr, fq);
        if constexpr (epi_signal<Epi>()) {
            asm volatile("s_waitcnt vmcnt(0)" ::: "memory"); G8_BAR;
            if (tid == 0) __hip_atomic_fetch_add(E.rnd + ui, 1u, RLX_AGENT);
        }
        if (!has_next) break;
#pragma unroll
        for (int a = 0; a < 2; ++a)
#pragma unroll
            for (int b = 0; b < 2; ++b)
#pragma unroll
                for (int m = 0; m < 4; ++m)
#pragma unroll
                    for (int n = 0; n < 2; ++n) acc[a][b][m][n] = (f32x4){0.f, 0.f, 0.f, 0.f};
        cur = nxt; ++ui;
        if (wr == 1) G8_BAR;
    }
    G8_WAIT_V(0);
    G8_BAR;
    if constexpr (Epi::AFTER_DRAIN) E.fused(acc, cur, wr, wc, fr, fq, lds);
#undef G8_FAC
#undef G8_SA
#undef G8_SB
#undef G8_STAGE
#undef G8_STAGE_A
#undef G8_LDA
#undef G8_LDB
#undef G8_MMA
#undef G8_WAIT_V
#undef G8_WAIT_L
#undef G8_BAR
#undef G8_SCHED
}

template <bool F8>
struct EpiQKVT {
    static constexpr bool AFTER_DRAIN = false, FP8 = F8, RESCALE = false;
    const float* rs; const float* qk_gain_l; bf16_t* base; int mode;
    __device__ __forceinline__ void operator()(const f32x4 (&acc)[2][2][4][2], const Unit& u, int wr, int wc, int fr_, int fq_) const {
        int fr = fr_, fq = fq_; asm volatile("" : "+v"(fr), "+v"(fq));
        int gi; bool isq; bf16_t* dst; const float* g;
        if (mode == 0) { const int H = 4 * u.pn + wc; slice_kind(H, gi, isq); dst = base + (size_t)H * QKV_SLICE; g = qk_gain_l + (gi < 0 ? 0 : gi) * HD; }
        else { const int lyr = u.pn >> 1, Hp = 4 * (u.pn & 1) + wc; gi = Hp < 4 ? 5 : -1; isq = false; dst = base + ((size_t)lyr * 8 + Hp) * TM * HD; g = qk_gain_l + (lyr * 6 + 5) * HD; }
        const float post = isq ? ATTN_SCALE * LOG2E : 1.0f;
        f32x4 gv[2][2];
#pragma unroll
        for (int bj = 0; bj < 2; ++bj)
#pragma unroll
            for (int n = 0; n < 2; ++n) gv[bj][n] = *(const f32x4*)(g + 32 * bj + 8 * fq + 4 * n) * post;
        float rs8[2][4];
#pragma unroll
        for (int ai = 0; ai < 2; ++ai)
#pragma unroll
            for (int m = 0; m < 4; ++m) rs8[ai][m] = rs[u.pm * 256 + ai * HALF + wr * 64 + m * 16 + fr];
#pragma unroll
        for (int ai = 0; ai < 2; ++ai)
#pragma unroll
            for (int m = 0; m < 4; ++m) {
                const int row = u.pm * 256 + ai * HALF + wr * 64 + m * 16 + fr; const float rsv = rs8[ai][m] * (F8 ? 1.0f / 512.0f : 1.0f);
                f32x4 v[2][2]; float ss = 0.f;
#pragma unroll
                for (int bj = 0; bj < 2; ++bj)
#pragma unroll
                    for (int n = 0; n < 2; ++n) { v[bj][n] = acc[ai][bj][m][n] * rsv; ss += (v[bj][n][0] * v[bj][n][0] + v[bj][n][1] * v[bj][n][1]) + (v[bj][n][2] * v[bj][n][2] + v[bj][n][3] * v[bj][n][3]); }
                if (gi >= 0) {
                    ss += __shfl_xor(ss, 16); ss += __shfl_xor(ss, 32);
                    const float r = __builtin_amdgcn_rsqf(ss * (1.f / 64.f) + EPS);
#pragma unroll
                    for (int bj = 0; bj < 2; ++bj)
#pragma unroll
                        for (int n = 0; n < 2; ++n) v[bj][n] = v[bj][n] * r * gv[bj][n];
                }
#pragma unroll
                for (int bj = 0; bj < 2; ++bj) { u32x4 w; w.x = cvt_pk_bf16(v[bj][0][0], v[bj][0][1]); w.y = cvt_pk_bf16(v[bj][0][2], v[bj][0][3]); w.z = cvt_pk_bf16(v[bj][1][0], v[bj][1][1]); w.w = cvt_pk_bf16(v[bj][1][2], v[bj][1][3]);
                    *(u32x4*)(dst + (size_t)row * HD + 32 * bj + 8 * fq) = w; }
            }
    }
};
struct EpiOut {
    static constexpr bool AFTER_DRAIN = false, FP8 = false, RESCALE = true;
    bf16_t* xb; float* ssq; unsigned char* x8; const float* fab; const float* rm;
    __device__ __forceinline__ void operator()(const f32x4 (&acc)[2][2][4][2], const Unit& u, int wr, int wc, int fr_, int fq_) const {
        int fr = fr_, fq = fq_; asm volatile("" : "+v"(fr), "+v"(fq));
        const int col0 = u.pn * 256 + wc * 32 + 8 * fq;
#pragma unroll
        for (int ai = 0; ai < 2; ++ai) {
        float fm8[2][4]; u32x4 xi8[2][4][2];
#pragma unroll
            for (int m = 0; m < 4; ++m) { const int row = u.pm * 256 + ai * HALF + wr * 64 + m * 16 + fr; fm8[ai][m] = rm[row];
#pragma unroll
                for (int bj = 0; bj < 2; ++bj) xi8[ai][m][bj] = *(const u32x4*)(xb + (size_t)row * D + col0 + bj * HALF); }
#pragma unroll
            for (int m = 0; m < 4; ++m) {
                const int row = u.pm * 256 + ai * HALF + wr * 64 + m * 16 + fr; bf16_t* p = xb + (size_t)row * D + col0; float s = 0.f; const float fm = fm8[ai][m];
                u32x4 xi[2]; int qq[2][2];
#pragma unroll
                for (int bj = 0; bj < 2; ++bj) xi[bj] = xi8[ai][m][bj];
#pragma unroll
                for (int bj = 0; bj < 2; ++bj) { const f32x4 a = acc[ai][bj][m][0] * fm, b = acc[ai][bj][m][1] * fm; const u32x4 x = xi[bj];
                    u32x4 w; w.x = cvt_pk_bf16(bf2f(x.x & 0xffffu) + a[0], bf2f(x.x >> 16) + a[1]); w.y = cvt_pk_bf16(bf2f(x.y & 0xffffu) + a[2], bf2f(x.y >> 16) + a[3]);
                    w.z = cvt_pk_bf16(bf2f(x.z & 0xffffu) + b[0], bf2f(x.z >> 16) + b[1]); w.w = cvt_pk_bf16(bf2f(x.w & 0xffffu) + b[2], bf2f(x.w >> 16) + b[3]);
                    *(u32x4*)(p + bj * HALF) = w;
                    const float o0 = bf2f(w.x & 0xffffu), o1 = bf2f(w.x >> 16), o2 = bf2f(w.y & 0xffffu), o3 = bf2f(w.y >> 16), o4 = bf2f(w.z & 0xffffu), o5 = bf2f(w.z >> 16), o6 = bf2f(w.w & 0xffffu), o7 = bf2f(w.w >> 16);
                    s += ((o0 * o0 + o1 * o1) + (o2 * o2 + o3 * o3)) + ((o4 * o4 + o5 * o5) + (o6 * o6 + o7 * o7));
                    int q0 = 0, q1 = 0; q0 = __builtin_amdgcn_cvt_pk_fp8_f32(clamp8(16.f * o0), clamp8(16.f * o1), q0, false); q0 = __builtin_amdgcn_cvt_pk_fp8_f32(clamp8(16.f * o2), clamp8(16.f * o3), q0, true);
                    q1 = __builtin_amdgcn_cvt_pk_fp8_f32(clamp8(16.f * o4), clamp8(16.f * o5), q1, false); q1 = __builtin_amdgcn_cvt_pk_fp8_f32(clamp8(16.f * o6), clamp8(16.f * o7), q1, true);
                    qq[bj][0] = q0; qq[bj][1] = q1; }
                { const bool odd = (fq & 1) != 0;
                  const int s0 = odd ? qq[0][0] : qq[1][0], s1 = odd ? qq[0][1] : qq[1][1];
                  const int r0 = __shfl_xor(s0, 16), r1 = __shfl_xor(s1, 16);
                  u32x4 w; if (odd) { w.x = (unsigned)r0; w.y = (unsigned)r1; w.z = (unsigned)qq[1][0]; w.w = (unsigned)qq[1][1]; } else { w.x = (unsigned)qq[0][0]; w.y = (unsigned)qq[0][1]; w.z = (unsigned)r0; w.w = (unsigned)r1; }
                  *(u32x4*)(x8 + (size_t)row * D + u.pn * 256 + wc * 32 + 8 * (fq & ~1) + (odd ? HALF : 0)) = w; }
                s += __shfl_xor(s, 16); s += __shfl_xor(s, 32);
                if (fq == 0) ssq[row * 16 + u.pn * 4 + wc] = s;
            }
        }
    }
};
struct EpiSwiGLU {
    static constexpr bool AFTER_DRAIN = false, FP8 = true, RESCALE = false;
    static constexpr bool SIGNAL = true;
    const float* rsl; unsigned char* hid; unsigned* rnd;
    __device__ __forceinline__ void operator()(const f32x4 (&acc)[2][2][4][2], const Unit& u, int wr, int wc, int fr_, int fq_) const {
        int fr = fr_, fq = fq_; asm volatile("" : "+v"(fr), "+v"(fq));
        float rs8[2][4];
#pragma unroll
        for (int ai = 0; ai < 2; ++ai)
#pragma unroll
            for (int m = 0; m < 4; ++m) rs8[ai][m] = rsl[(size_t)u.e * T + min(u.ti * 256 + ai * HALF + wr * 64 + m * 16 + fr, u.ce - 1)];
#pragma unroll
        for (int ai = 0; ai < 2; ++ai)
#pragma unroll
            for (int m = 0; m < 4; ++m) {
                const int lr = ai * HALF + wr * 64 + m * 16 + fr; const float rsv = (1.0f / 512.0f) * rs8[ai][m];
                f32x4 h[2];
#pragma unroll
                for (int n = 0; n < 2; ++n) { const f32x4 gt = acc[ai][0][m][n] * rsv, up = acc[ai][1][m][n] * rsv;
#pragma unroll
                    for (int j = 0; j < 4; ++j) h[n][j] = gt[j] * up[j] * __builtin_amdgcn_rcpf(1.0f + __builtin_amdgcn_exp2f(-gt[j] * LOG2E)); }
#pragma unroll
                for (int n = 0; n < 2; ++n)
#pragma unroll
                    for (int j = 0; j < 4; ++j) h[n][j] = fminf(fmaxf(h[n][j] * 8.0f, -440.f), 440.f);
                int w0 = 0, w1 = 0;
                w0 = __builtin_amdgcn_cvt_pk_fp8_f32(h[0][0], h[0][1], w0, false); w0 = __builtin_amdgcn_cvt_pk_fp8_f32(h[0][2], h[0][3], w0, true);
                w1 = __builtin_amdgcn_cvt_pk_fp8_f32(h[1][0], h[1][1], w1, false); w1 = __builtin_amdgcn_cvt_pk_fp8_f32(h[1][2], h[1][3], w1, true);
                { unsigned char* hp = hid + (size_t)(u.pm * 256 + lr) * DE + u.pn * 128 + wc * 32 + 8 * fq; const unsigned long long hv = ((unsigned long long)(unsigned)w1 << 32) | (unsigned long long)(unsigned)w0;
                  asm volatile("global_store_dwordx2 %0, %1, off sc1" :: "v"(hp), "v"(hv) : "memory"); }
            }
    }
};
struct EpiDown {
    static constexpr bool AFTER_DRAIN = false, NB1 = false, FP8 = true, RESCALE = false;
    const float* wl; unsigned char* Y;
    __device__ __forceinline__ void operator()(const f32x4 (&acc)[2][2][4][2], const Unit& u, int wr, int wc, int fr_, int fq_) const {
        int fr = fr_, fq = fq_; asm volatile("" : "+v"(fr), "+v"(fq));
        float wl8[2][4];
#pragma unroll
        for (int ai = 0; ai < 2; ++ai)
#pragma unroll
            for (int m = 0; m < 4; ++m) wl8[ai][m] = wl[(size_t)u.e * T + min(u.ti * 256 + ai * HALF + wr * 64 + m * 16 + fr, u.ce - 1)];
#pragma unroll
        for (int ai = 0; ai < 2; ++ai)
#pragma unroll
            for (int m = 0; m < 4; ++m) {
                const int lr = ai * HALF + wr * 64 + m * 16 + fr; const float w8 = (8.0f / 256.0f) * wl8[ai][m];
                int pw[2][2];
#pragma unroll
                for (int bj = 0; bj < 2; ++bj) { f32x4 a = acc[ai][bj][m][0] * w8, b = acc[ai][bj][m][1] * w8;
#pragma unroll
                    for (int j = 0; j < 4; ++j) { a[j] = fminf(fmaxf(a[j], -400.f), 400.f); b[j] = fminf(fmaxf(b[j], -400.f), 400.f); }
                    int w0 = 0, w1 = 0;
                    w0 = __builtin_amdgcn_cvt_pk_fp8_f32(a[0], a[1], w0, false); w0 = __builtin_amdgcn_cvt_pk_fp8_f32(a[2], a[3], w0, true);
                    w1 = __builtin_amdgcn_cvt_pk_fp8_f32(b[0], b[1], w1, false); w1 = __builtin_amdgcn_cvt_pk_fp8_f32(b[2], b[3], w1, true);
                    pw[bj][0] = w0; pw[bj][1] = w1; }
                { const bool odd = (fq & 1) != 0;
                  const int s0 = odd ? pw[0][0] : pw[1][0], s1 = odd ? pw[0][1] : pw[1][1];
                  const int r0 = __shfl_xor(s0, 16), r1 = __shfl_xor(s1, 16);
                  u32x4 w; if (odd) { w.x = (unsigned)r0; w.y = (unsigned)r1; w.z = (unsigned)pw[1][0]; w.w = (unsigned)pw[1][1]; } else { w.x = (unsigned)pw[0][0]; w.y = (unsigned)pw[0][1]; w.z = (unsigned)r0; w.w = (unsigned)r1; }
                  *(u32x4*)(Y + (size_t)(u.pm * 256 + lr) * D + u.pn * 256 + (odd ? HALF : 0) + wc * 32 + 8 * (fq & ~1)) = w; }
            }
    }
};
struct EpiRouter {
    static constexpr bool AFTER_DRAIN = true, FP8 = false, RESCALE = false;
    const float* ssq1; float* rs1; const float* b_group; const float* b_router; unsigned* cnt; int* list; float* wl; float* rsl; int* route;
    __device__ __forceinline__ void fused(const f32x4 (&acc)[2][2][4][2], const Unit& u, int wr, int wc, int fr_, int fq_, LAS unsigned char* lds) const {
        int fr = fr_, fq = fq_; asm volatile("" : "+v"(fr), "+v"(fq));
        LAS float* lg = (LAS float*)lds;
        LAS int* hist = (LAS int*)(lds + 256 * 65 * 4);
        const int tid = opaque_tid();
        if (tid < 64) hist[tid] = 0;
        if (wc < 2) {
#pragma unroll
            for (int ai = 0; ai < 2; ++ai)
#pragma unroll
                for (int m = 0; m < 4; ++m) { const int row = ai * HALF + wr * 64 + m * 16 + fr;
#pragma unroll
                    for (int n = 0; n < 2; ++n)
#pragma unroll
                        for (int j = 0; j < 4; ++j) lg[row * 65 + 32 * wc + 16 * n + 4 * fq + j] = acc[ai][0][m][n][j]; }
        }
        __syncthreads();
        int ex0 = 0, ex1 = 0, lp0 = 0, lp1 = 0; float w0 = 0.f, w1 = 0.f, rsv = 0.f; const int t = u.pm * 256 + tid;
        if (tid < 256) {
            const f32x4* sq = (const f32x4*)(ssq1 + (size_t)t * 16); const f32x4 a = sq[0], b = sq[1], c = sq[2], d = sq[3];
            const float ss = ((a[0] + a[1]) + (a[2] + a[3])) + ((b[0] + b[1]) + (b[2] + b[3])) + ((c[0] + c[1]) + (c[2] + c[3])) + ((d[0] + d[1]) + (d[2] + d[3]));
            rsv = 1.0f / sqrtf(ss * (1.f / D) + EPS); rs1[t] = rsv;
            const LAS float* my = lg + tid * 65;
            float g[4];
#pragma unroll
            for (int i = 0; i < 4; ++i) g[i] = my[i] * rsv + b_group[i];
            int gi = 0; float gm = g[0];
#pragma unroll
            for (int i = 1; i < 4; ++i) if (g[i] > gm) { gm = g[i]; gi = i; }
            float den = 0.f;
#pragma unroll
            for (int i = 0; i < 4; ++i) den += expf(g[i] - gm);
            const float gtop = 1.0f / den;
            float ev[8];
#pragma unroll
            for (int i = 0; i < 8; ++i) ev[i] = my[4 + gi * 8 + i] * rsv + b_router[gi * 8 + i];
            int i0 = 0; float v0 = ev[0];
#pragma unroll
            for (int i = 1; i < 8; ++i) if (ev[i] > v0) { v0 = ev[i]; i0 = i; }
            int i1 = -1; float v1 = -INFINITY;
#pragma unroll
            for (int i = 0; i < 8; ++i) if (i != i0 && ev[i] > v1) { v1 = ev[i]; i1 = i; }
            const float e1 = expf(v1 - v0); w0 = gtop / (1.f + e1); w1 = gtop * e1 / (1.f + e1);
            ex0 = gi * 8 + i0; ex1 = gi * 8 + i1;
            lp0 = __hip_atomic_fetch_add(hist + ex0, 1, __ATOMIC_RELAXED, __HIP_MEMORY_SCOPE_WORKGROUP);
            lp1 = __hip_atomic_fetch_add(hist + ex1, 1, __ATOMIC_RELAXED, __HIP_MEMORY_SCOPE_WORKGROUP);
        }
        __syncthreads();
        if (tid < NE) { const int c = hist[tid]; hist[32 + tid] = c ? (int)__hip_atomic_fetch_add(cnt + tid * 64, (unsigned)c, RLX_AGENT) : 0; }
        __syncthreads();
        if (tid < 256) {
            const int p0 = hist[32 + ex0] + lp0, p1 = hist[32 + ex1] + lp1;
            list[(size_t)ex0 * T + p0] = t; wl[(size_t)ex0 * T + p0] = w0; rsl[(size_t)ex0 * T + p0] = rsv;
            list[(size_t)ex1 * T + p1] = t; wl[(size_t)ex1 * T + p1] = w1; rsl[(size_t)ex1 * T + p1] = rsv;
            *(int4*)(route + (size_t)t * 4) = make_int4(ex0, p0, ex1, p1);
        }
    }
};
}

__device__ __forceinline__ void phase_memkv_fast(Frame& F) {
    PHASE_IDS(F);
    g8::DenseSched S; S.init(TM, 1024, D, F.G, (int)blockIdx.x, F.tid, F.ws + WS_WMEM);
    g8::EpiQKVT<false> E{(const float*)(F.ws + WS_RSM), in_ptr(4), (bf16_t*)(F.ws + WS_MEMKV), 1};
    g8::gemm_phase(F.lds, F.ws + WS_MB, D, S, E);
}
__device__ __forceinline__ void phase_inproj_fast(Frame& F, int l) {
    PHASE_IDS(F);
    if (l == 0) {
        g8::DenseSched S; S.init(T, INW, D, F.G, (int)blockIdx.x, F.tid, F.ws + WS_WIN);
        g8::EpiQKVT<false> E{(const float*)(F.ws + WS_RS), in_ptr(4), (bf16_t*)(F.ws + WS_QKV), 0};
        g8::gemm_phase(F.lds, F.ws + WS_XB, D, S, E);
    } else {
        g8::DenseSched S; S.init(T, INW, D / 2, F.G, (int)blockIdx.x, F.tid, F.ws + WS_WIN + (size_t)INW * D * 2);
        g8::EpiQKVT<true> E{(const float*)(F.ws + WS_RS), in_ptr(4) + l * 6 * HD, (bf16_t*)(F.ws + WS_QKV), 0};
        g8::gemm_phase(F.lds, F.ws + WS_X8, D / 2, S, E);
    }
}
__device__ __forceinline__ void phase_outproj_fast(Frame& F, int l) {
    PHASE_IDS(F);
    g8::DenseSched S; S.init(T, D, D, F.G, (int)blockIdx.x, F.tid, F.ws + WS_WOUT + (size_t)l * D * D * 2);
    g8::EpiOut E{(bf16_t*)(F.ws + WS_XB), (float*)(F.ws + WS_SSQ1), (unsigned char*)(F.ws + WS_X8), (const float*)(F.ws + WS_FAB), (const float*)(F.ws + WS_RM)};
    g8::gemm_phase(F.lds, F.ws + WS_MIX, D, S, E);
}
__device__ __forceinline__ void phase_router_fast(Frame& F, int l) {
    PHASE_IDS(F);
    g8::DenseSched S; S.init(T, 256, D, F.G, (int)blockIdx.x, F.tid, F.ws + WS_WR + (size_t)l * 256 * D * 2);
    g8::EpiRouter E{(const float*)(F.ws + WS_SSQ1), (float*)(F.ws + WS_RS) + T, in_ptr(12) + l * NGRP, in_ptr(14) + l * NE, F.ctl + CW_CNT + l * NE * 64,
                    (int*)(F.ws + WS_LIST), (float*)(F.ws + WS_WL), (float*)(F.ws + WS_RSL), (int*)(F.ws + WS_ROUTE)};
    g8::gemm_phase(F.lds, F.ws + WS_XB, D, S, E);
}
__device__ __forceinline__ void phase_moe1_fast(Frame& F, int l) {
    PHASE_IDS(F);
    g8::GroupSchedT<false> S; S.rnd = nullptr; S.init((LAS int*)(F.lds + CTRL_BASE), F.ctl + CW_CNT + l * NE * 64, 4, D / 2, F.G, (int)blockIdx.x, F.ws + WS_WGU + (size_t)l * NE * 1024 * D, (size_t)1024 * D, (const int*)(F.ws + WS_LIST), true);
    g8::EpiSwiGLU E{(const float*)(F.ws + WS_RSL), (unsigned char*)(F.ws + WS_MIX), F.ctl + CW_RND + l * 64};
    g8::gemm_phase(F.lds, F.ws + WS_X8, D / 2, S, E);
}
__device__ __forceinline__ void phase_moe2_fast(Frame& F, int l) {
    PHASE_IDS(F);
    g8::GroupSchedT<true> S; S.rnd = F.ctl + CW_RND + l * 64; S.init((LAS int*)(F.lds + CTRL_BASE), F.ctl + CW_CNT + l * NE * 64, 4, DE / 2, F.G, (int)blockIdx.x, F.ws + WS_WD + (size_t)l * NE * D * DE, (size_t)D * DE, (const int*)(F.ws + WS_LIST), false);
    g8::EpiDown E{(const float*)(F.ws + WS_WL), (unsigned char*)(F.ws + WS_QKV)};
    g8::gemm_phase(F.lds, F.ws + WS_MIX, DE / 2, S, E);
}

namespace at {
typedef short bf16x8 __attribute__((ext_vector_type(8)));
typedef short s16x4 __attribute__((ext_vector_type(4)));
typedef short v4i16_t __attribute__((ext_vector_type(4)));
typedef float f32x16 __attribute__((ext_vector_type(16)));
typedef const LAS char* lds_cptr;
constexpr int NSLOT = 3, NPRE = NSLOT - 1, SLOTB = 8192, LDS_K = 0, LDS_V = NSLOT * SLOTB, TB_CS = 576, TB_ROW = 4 * TB_CS, LDS_TBB = 2 * NSLOT * SLOTB, LDS_TBM = LDS_TBB + 16 * TB_ROW, LDS_WS = LDS_TBM + TB_ROW, LDS_QW = LDS_WS + 2048;
static_assert(LDS_QW + 64 <= 131072, "attention LDS map");
constexpr float NEGBIG = -1.0e30f;
__device__ __forceinline__ int crow(int r, int hi) { return (r & 3) + 8 * (r >> 2) + 4 * hi; }
__device__ __forceinline__ void glds16(const void* gsrc, unsigned lds_dst) { unsigned keep;
    asm volatile("s_mov_b32 %0, m0\n\ts_mov_b32 m0, %2\n\ts_nop 0\n\tglobal_load_lds_dwordx4 %1, off\n\ts_mov_b32 m0, %0" : "=&s"(keep) : "v"(gsrc), "s"(lds_dst) : "memory"); }
typedef float f32x2_t __attribute__((ext_vector_type(2))); typedef __bf16 bf16x2_t __attribute__((ext_vector_type(2)));
__device__ __forceinline__ unsigned cvtpk(float lo, float hi) { f32x2_t v = {lo, hi}; bf16x2_t b = __builtin_convertvector(v, bf16x2_t); return __builtin_bit_cast(unsigned, b); }
__device__ __forceinline__ s16x4 vtr(lds_cptr p) { return __builtin_bit_cast(s16x4, __builtin_amdgcn_ds_read_tr16_b64_v4i16((LAS v4i16_t*)p)); }
#define AT_WAIT_BAR(N) asm volatile("s_waitcnt vmcnt(" #N ") lgkmcnt(0)\n\ts_barrier" ::: "memory")

__device__ __forceinline__ void at_dequeue(unsigned* qcnt, int nper, int xq, int pre, int& id_out, int& x_out) {
    int id = pre, x = xq;
    if (id == -2) id = (int)__hip_atomic_fetch_add(qcnt + xq * 64, 1u, RLX_AGENT);
    if (id >= nper) {
        id = -1;
        for (int tries = 0; tries < 8 && id < 0; ++tries) {
            unsigned hv[8];
#pragma unroll
            for (int k = 0; k < 8; ++k) hv[k] = __hip_atomic_load(qcnt + ((xq + k) & 7) * 64, RLX_AGENT);
            int pick = -1;
#pragma unroll
            for (int k = 7; k >= 0; --k) if ((int)hv[k] < nper) pick = k;
            if (pick < 0) break;
            x = (xq + pick) & 7; id = (int)__hip_atomic_fetch_add(qcnt + x * 64, 1u, RLX_AGENT); if (id >= nper) id = -1;
        }
    }
    id_out = id; x_out = x;
}
struct UnitDesc { const bf16_t* Q; const bf16_t* K; const bf16_t* V; int t0, hh16, qb, h, kt0, nt; };

template <int TYPE>
__device__ __forceinline__ void attn_unit(LAS unsigned char* lds, const UnitDesc& u, bf16_t* mixed, float* ssq) {
    const int tid = opaque_tid0(), lane = tid & 63, r32 = lane & 31, hi = lane >> 5; const int wid = __builtin_amdgcn_readfirstlane(tid >> 6);
    const unsigned lds0 = (unsigned)(size_t)lds;
    lds_cptr shm3 = (lds_cptr)lds;
    const int prow = 8 * wid + (lane >> 3);
    const bf16_t* ksrc = u.K + (size_t)(u.kt0 * 64 + prow) * HD + (((lane & 7) ^ ((4 * wid + (lane >> 4)) & 7)) * 8);
    const bf16_t* vsrc = u.V + (size_t)(u.kt0 * 64 + prow) * HD + ((((lane & 7) >> 1) ^ (prow & 2)) * 16) + (lane & 1) * 8;
    const unsigned kdst = lds0 + LDS_K + wid * 1024, vdst = lds0 + LDS_V + wid * 1024;
#define AT_DMA_K(t, slot) glds16(ksrc + (size_t)(t) * 64 * HD, (unsigned)__builtin_amdgcn_readfirstlane(kdst + (slot)))
#define AT_DMA_V(t, slot) glds16(vsrc + (size_t)(t) * 64 * HD, (unsigned)__builtin_amdgcn_readfirstlane(vdst + (slot)))
    lds_cptr ka[4], va[2];
    { const int sw = (r32 >> 1) & 7;
#pragma unroll
      for (int d0 = 0; d0 < 4; ++d0) ka[d0] = shm3 + LDS_K + r32 * 128 + (((2 * d0 + hi) ^ sw) * 16);
      const int q = (lane & 15) >> 2, gb = (lane >> 4) & 1;
#pragma unroll
      for (int d0 = 0; d0 < 2; ++d0) va[d0] = shm3 + LDS_V + (4 * hi + q) * 128 + ((2 * (d0 ^ (q >> 1)) + gb) * 32) + (lane & 3) * 8; }
    const int nt = u.nt;
    const bf16_t* Qw = u.Q + (size_t)(u.qb * 256 + wid * 32 + r32) * HD;
    bf16x8 qr[4];
#pragma unroll
    for (int d0 = 0; d0 < 4; ++d0) qr[d0] = *(const bf16x8*)(Qw + d0 * 16 + hi * 8);
#pragma unroll
    for (int j = 0; j < NPRE; ++j) if (j < nt) { AT_DMA_K(j, j * SLOTB); AT_DMA_V(j, j * SLOTB); }
    lds_cptr tb = shm3; int r0w = 0, qrw = 0;
    lds_cptr tbm = shm3;
    if (TYPE == 1) { const int qc = 32 * (wid & 1) + r32, c0 = min(max(qc - 8, 0), 48); qrw = 4 * u.qb + (wid >> 1); r0w = min(max(qrw - 4, 0), 24);
        const int ib = 4 * hi - qc + 63, cb = (-ib) & 3, im = 4 * hi - c0 + 63, cm = (-im) & 3;
        tb = shm3 + LDS_TBB + cb * TB_CS + (ib + cb) * 4; tbm = shm3 + LDS_TBM + cm * TB_CS + (im + cm) * 4; }
    float lsum = 0.f; f32x16 o[2]; o[0] = f32x16{}; o[1] = f32x16{};
    int sl_cur = 0, sl_n2 = NPRE * SLOTB;
    for (int i = 0; i < nt; ++i) {
        { const int rem = nt - 1 - i, yo = rem < NPRE - 1 ? rem : NPRE - 1; if (yo >= 3) AT_WAIT_BAR(6); else if (yo == 2) AT_WAIT_BAR(4); else if (yo == 1) AT_WAIT_BAR(2); else AT_WAIT_BAR(0); }
        static_assert(NPRE <= 4, "wait ladder");
        if (i + NPRE < nt) { AT_DMA_K(i + NPRE, sl_n2); AT_DMA_V(i + NPRE, sl_n2); }
        bool need = true;
        if (TYPE == 1) { const int kr = u.kt0 + i; need = (kr >= r0w) && (kr < r0w + 8); }
        if (need) {
#pragma unroll
            for (int hf = 0; hf < 2; ++hf) {
                f32x16 p;
                if (TYPE == 1) {
                    const lds_cptr tp = tb + (u.kt0 + i - qrw + 7) * TB_ROW;
#pragma unroll
                    for (int g = 0; g < 4; ++g) { const f32x4 a = *(const LAS f32x4*)(tp + 32 * (g + 4 * hf)) + *(const LAS f32x4*)(tbm + 32 * (g + 4 * hf)); p[4 * g] = a[0]; p[4 * g + 1] = a[1]; p[4 * g + 2] = a[2]; p[4 * g + 3] = a[3]; }
                } else p = f32x16{};
#pragma unroll
                for (int d0 = 0; d0 < 4; ++d0) p = __builtin_amdgcn_mfma_f32_32x32x16_bf16(*(const LAS bf16x8*)(ka[d0] + sl_cur + 4096 * hf), qr[d0], p, 0, 0, 0);
                float s0 = 0.f;
#pragma unroll
                for (int r = 0; r < 16; ++r) { p[r] = __builtin_amdgcn_exp2f(p[r]); s0 += p[r]; }
                lsum += s0;
                const u32x4 pwa = (u32x4){cvtpk(p[0], p[1]), cvtpk(p[2], p[3]), cvtpk(p[4], p[5]), cvtpk(p[6], p[7])}, pwb = (u32x4){cvtpk(p[8], p[9]), cvtpk(p[10], p[11]), cvtpk(p[12], p[13]), cvtpk(p[14], p[15])};
#pragma unroll
                for (int d0 = 0; d0 < 2; ++d0) { const lds_cptr vp = va[d0] + sl_cur + 4096 * hf; const s16x4 l0 = vtr(vp), h0 = vtr(vp + 1024), l1 = vtr(vp + 2048), h1 = vtr(vp + 2048 + 1024);
                    o[d0] = __builtin_amdgcn_mfma_f32_32x32x16_bf16(__builtin_bit_cast(bf16x8, pwa), (bf16x8){l0[0], l0[1], l0[2], l0[3], h0[0], h0[1], h0[2], h0[3]}, o[d0], 0, 0, 0);
                    o[d0] = __builtin_amdgcn_mfma_f32_32x32x16_bf16(__builtin_bit_cast(bf16x8, pwb), (bf16x8){l1[0], l1[1], l1[2], l1[3], h1[0], h1[1], h1[2], h1[3]}, o[d0], 0, 0, 0); }
            }
        }
        sl_n2 = sl_cur;
        sl_cur = (sl_cur == (NSLOT - 1) * SLOTB) ? 0 : sl_cur + SLOTB;
    }
    AT_WAIT_BAR(0);
    int lane2 = lane; asm volatile("" : "+v"(lane2)); const int r32e = lane2 & 31, hie = lane2 >> 5;
    lsum += __shfl_xor(lsum, 32);
    LAS float* wsf = (LAS float*)(lds + LDS_WS) + wid * 64;
    if (hie == 0) wsf[r32e] = lsum;
    asm volatile("s_waitcnt lgkmcnt(0)" ::: "memory");
    LAS bf16_t* stg = (LAS bf16_t*)(lds) + wid * 2048;
#pragma unroll
    for (int r = 0; r < 16; ++r) { const int orow = crow(r, hie); const float rl = __builtin_amdgcn_rcpf(wsf[orow]);
        stg[orow * 64 + r32e] = (bf16_t)f2bf(o[0][r] * rl); stg[orow * 64 + 32 + r32e] = (bf16_t)f2bf(o[1][r] * rl); }
    asm volatile("s_waitcnt lgkmcnt(0)" ::: "memory");
    const int trow0 = u.t0 + wid * 32;
#pragma unroll
    for (int i = 0; i < 4; ++i) { const int row = i * 8 + (lane2 >> 3), ch = lane2 & 7; const u32x4 v = *(const LAS u32x4*)(stg + row * 64 + ch * 8);
        *(u32x4*)(mixed + (size_t)(trow0 + row) * D + u.hh16 * 64 + ch * 8) = v;
        float s = 0.f; { float a;
            a = bf2f(v.x & 0xffffu); s += a * a; a = bf2f(v.x >> 16); s += a * a; a = bf2f(v.y & 0xffffu); s += a * a; a = bf2f(v.y >> 16); s += a * a;
            a = bf2f(v.z & 0xffffu); s += a * a; a = bf2f(v.z >> 16); s += a * a; a = bf2f(v.w & 0xffffu); s += a * a; a = bf2f(v.w >> 16); s += a * a; }
        s += __shfl_xor(s, 1); s += __shfl_xor(s, 2); s += __shfl_xor(s, 4);
        if (ch == 0) ssq[(size_t)(trow0 + row) * 16 + u.hh16] = s; }
    asm volatile("s_waitcnt lgkmcnt(0)\n\ts_barrier" ::: "memory");
#undef AT_DMA_K
#undef AT_DMA_V
}

template <int NQB>
__device__ __forceinline__ void mem_unit(LAS unsigned char* lds, const bf16_t* Qh, const bf16_t* Kh, const bf16_t* Vh, int t0, int hh16, bf16_t* mixed, float* ssq) {
    constexpr int MK = 0, MV = 32768, MSTG = 65536, MWS = 98304;
    const int tid = opaque_tid0(), lane = tid & 63, r32 = lane & 31, hi = lane >> 5; const int wid = __builtin_amdgcn_readfirstlane(tid >> 6);
    const unsigned lds0 = (unsigned)(size_t)lds; lds_cptr shm3 = (lds_cptr)lds;
    const int prow = 8 * wid + (lane >> 3);
    const bf16_t* ksrc = Kh + (size_t)prow * HD + (((lane & 7) ^ ((4 * wid + (lane >> 4)) & 7)) * 8);
    const bf16_t* vsrc = Vh + (size_t)prow * HD + ((((lane & 7) >> 1) ^ (prow & 2)) * 16) + (lane & 1) * 8;
    const bf16_t* Qw = Qh + (size_t)(wid * 32 + r32) * HD + hi * 8;
    bf16x8 qr[4], qn[4];
#pragma unroll
    for (int d0 = 0; d0 < 4; ++d0) { qr[d0] = *(const bf16x8*)(Qw + d0 * 16); qn[d0] = qr[d0]; }
#pragma unroll
    for (int j = 0; j < 4; ++j) { glds16(ksrc + (size_t)j * 64 * HD, (unsigned)__builtin_amdgcn_readfirstlane(lds0 + MK + j * 8192 + wid * 1024));
                                  glds16(vsrc + (size_t)j * 64 * HD, (unsigned)__builtin_amdgcn_readfirstlane(lds0 + MV + j * 8192 + wid * 1024)); }
    lds_cptr ka[4], va[2];
    { const int sw = (r32 >> 1) & 7;
#pragma unroll
      for (int d0 = 0; d0 < 4; ++d0) ka[d0] = shm3 + MK + r32 * 128 + (((2 * d0 + hi) ^ sw) * 16);
      const int q = (lane & 15) >> 2, gb = (lane >> 4) & 1;
#pragma unroll
      for (int d0 = 0; d0 < 2; ++d0) va[d0] = shm3 + MV + (4 * hi + q) * 128 + ((2 * (d0 ^ (q >> 1)) + gb) * 32) + (lane & 3) * 8; }
    LAS float* wsf = (LAS float*)(lds + MWS) + wid * 64;
    LAS bf16_t* stg = (LAS bf16_t*)(lds + MSTG) + wid * 2048;
#pragma unroll
    for (int qb = 0; qb < NQB; ++qb) {
        const bool has_next = qb + 1 < NQB;
        float lsum = 0.f; f32x16 o[2]; o[0] = f32x16{}; o[1] = f32x16{};
#pragma unroll
        for (int i = 0; i < 4; ++i) {
            if (qb == 0) {
                if (i == 0) AT_WAIT_BAR(6); else if (i == 1) AT_WAIT_BAR(4); else if (i == 2) { if (has_next) AT_WAIT_BAR(6); else AT_WAIT_BAR(2); } else { if (has_next) AT_WAIT_BAR(4); else AT_WAIT_BAR(0); }
            }
            if (i == 1 && has_next) {
#pragma unroll
                for (int d0 = 0; d0 < 4; ++d0) qn[d0] = *(const bf16x8*)(Qw + (size_t)(qb + 1) * 256 * HD + d0 * 16); }
#pragma unroll
            for (int hf = 0; hf < 2; ++hf) {
                f32x16 p = f32x16{};
#pragma unroll
                for (int d0 = 0; d0 < 4; ++d0) p = __builtin_amdgcn_mfma_f32_32x32x16_bf16(*(const LAS bf16x8*)(ka[d0] + i * 8192 + 4096 * hf), qr[d0], p, 0, 0, 0);
                float s0 = 0.f;
#pragma unroll
                for (int r = 0; r < 16; ++r) { p[r] = __builtin_amdgcn_exp2f(p[r]); s0 += p[r]; }
                lsum += s0;
                const u32x4 pwa = (u32x4){cvtpk(p[0], p[1]), cvtpk(p[2], p[3]), cvtpk(p[4], p[5]), cvtpk(p[6], p[7])}, pwb = (u32x4){cvtpk(p[8], p[9]), cvtpk(p[10], p[11]), cvtpk(p[12], p[13]), cvtpk(p[14], p[15])};
#pragma unroll
                for (int d0 = 0; d0 < 2; ++d0) { const lds_cptr vp = va[d0] + i * 8192 + 4096 * hf; const s16x4 l0 = vtr(vp), h0 = vtr(vp + 1024), l1 = vtr(vp + 2048), h1 = vtr(vp + 2048 + 1024);
                    o[d0] = __builtin_amdgcn_mfma_f32_32x32x16_bf16(__builtin_bit_cast(bf16x8, pwa), (bf16x8){l0[0], l0[1], l0[2], l0[3], h0[0], h0[1], h0[2], h0[3]}, o[d0], 0, 0, 0);
                    o[d0] = __builtin_amdgcn_mfma_f32_32x32x16_bf16(__builtin_bit_cast(bf16x8, pwb), (bf16x8){l1[0], l1[1], l1[2], l1[3], h1[0], h1[1], h1[2], h1[3]}, o[d0], 0, 0, 0); }
            }
        }
        lsum += __shfl_xor(lsum, 32);
        if (hi == 0) wsf[r32] = lsum;
        asm volatile("s_waitcnt lgkmcnt(0)" ::: "memory");
#pragma unroll
        for (int r = 0; r < 16; ++r) { const int orow = crow(r, hi); const float rl = __builtin_amdgcn_rcpf(wsf[orow]);
            stg[orow * 64 + r32] = (bf16_t)f2bf(o[0][r] * rl); stg[orow * 64 + 32 + r32] = (bf16_t)f2bf(o[1][r] * rl); }
        asm volatile("s_waitcnt lgkmcnt(0)" ::: "memory");
        const int trow0 = t0 + qb * 256 + wid * 32;
#pragma unroll
        for (int i = 0; i < 4; ++i) { const int row = i * 8 + (lane >> 3), ch = lane & 7; const u32x4 v = *(const LAS u32x4*)(stg + row * 64 + ch * 8);
            *(u32x4*)(mixed + (size_t)(trow0 + row) * D + hh16 * 64 + ch * 8) = v;
            { float s = 0.f, a;
              a = bf2f(v.x & 0xffffu); s += a * a; a = bf2f(v.x >> 16); s += a * a; a = bf2f(v.y & 0xffffu); s += a * a; a = bf2f(v.y >> 16); s += a * a;
              a = bf2f(v.z & 0xffffu); s += a * a; a = bf2f(v.z >> 16); s += a * a; a = bf2f(v.w & 0xffffu); s += a * a; a = bf2f(v.w >> 16); s += a * a;
              s += __shfl_xor(s, 1); s += __shfl_xor(s, 2); s += __shfl_xor(s, 4);
              if (ch == 0) ssq[(size_t)(trow0 + row) * 16 + hh16] = s; } }
        asm volatile("s_waitcnt lgkmcnt(0)" ::: "memory");
        if (has_next) {
#pragma unroll
            for (int d0 = 0; d0 < 4; ++d0) qr[d0] = qn[d0]; }
    }
    asm volatile("s_waitcnt lgkmcnt(0)\n\ts_barrier" ::: "memory");
}

__device__ __forceinline__ void nb_unit(LAS unsigned char* lds, const UnitDesc& u, bf16_t* mixed, float* ssq) {
    const int tid = opaque_tid0(), lane = tid & 63, r32 = lane & 31, hi = lane >> 5; const int wid = __builtin_amdgcn_readfirstlane(tid >> 6);
    const unsigned lds0 = (unsigned)(size_t)lds; lds_cptr shm3 = (lds_cptr)lds;
    const int prow = 8 * wid + (lane >> 3);
    const bf16_t* ksrc = u.K + (size_t)(u.kt0 * 64 + prow) * HD + (((lane & 7) ^ ((4 * wid + (lane >> 4)) & 7)) * 8);
    const bf16_t* vsrc = u.V + (size_t)(u.kt0 * 64 + prow) * HD + ((((lane & 7) >> 1) ^ (prow & 2)) * 16) + (lane & 1) * 8;
    const unsigned kdst = lds0 + LDS_K + wid * 1024, vdst = lds0 + LDS_V + wid * 1024;
#define AT_DMA_K(t, slot) glds16(ksrc + (size_t)(t) * 64 * HD, (unsigned)__builtin_amdgcn_readfirstlane(kdst + (slot)))
#define AT_DMA_V(t, slot) glds16(vsrc + (size_t)(t) * 64 * HD, (unsigned)__builtin_amdgcn_readfirstlane(vdst + (slot)))
    const int rp = wid >> 2, jb = wid & 3, cs = min(max(16 * jb - 8, 0), 32);
    const int qrl = 4 * u.qb + 2 * rp + (r32 >> 4), qc = 16 * jb + (r32 & 15), c0 = min(max(qc - 8, 0), 48), r0l = min(max(qrl - 4, 0), 24);
    const int rwa = min(max(4 * u.qb + 2 * rp - 4, 0), 24), rwb = min(max(4 * u.qb + 2 * rp + 1 - 4, 0), 24) + 8;
    lds_cptr ka[4], va[2];
    { const int key = cs + r32, sw = (key >> 1) & 7;
#pragma unroll
      for (int d0 = 0; d0 < 4; ++d0) ka[d0] = shm3 + LDS_K + key * 128 + (((2 * d0 + hi) ^ sw) * 16);
      const int q = (lane & 15) >> 2, gb = (lane >> 4) & 1;
#pragma unroll
      for (int d0 = 0; d0 < 2; ++d0) va[d0] = shm3 + LDS_V + (cs + 4 * hi + q) * 128 + ((2 * (d0 ^ (q >> 1)) + gb) * 32) + (lane & 3) * 8; }
    const int nt = u.nt;
    const bf16_t* Qw = u.Q + (size_t)(qrl * 64 + qc) * HD;
    bf16x8 qr[4];
#pragma unroll
    for (int d0 = 0; d0 < 4; ++d0) qr[d0] = *(const bf16x8*)(Qw + d0 * 16 + hi * 8);
#pragma unroll
    for (int j = 0; j < NPRE; ++j) if (j < nt) { AT_DMA_K(j, j * SLOTB); AT_DMA_V(j, j * SLOTB); }
    lds_cptr tb, tbm;
    { const int ib = cs + 4 * hi - qc + 63, cb = (-ib) & 3, im = cs + 4 * hi - c0 + 63, cm = (-im) & 3;
      tb = shm3 + LDS_TBB + cb * TB_CS + (ib + cb) * 4; tbm = shm3 + LDS_TBM + cm * TB_CS + (im + cm) * 4; }
    float lsum = 0.f; f32x16 o[2]; o[0] = f32x16{}; o[1] = f32x16{};
    int sl_cur = 0, sl_n2 = NPRE * SLOTB;
    for (int i = 0; i < nt; ++i) {
        { const int rem = nt - 1 - i, yo = rem < NPRE - 1 ? rem : NPRE - 1; if (yo >= 3) AT_WAIT_BAR(6); else if (yo == 2) AT_WAIT_BAR(4); else if (yo == 1) AT_WAIT_BAR(2); else AT_WAIT_BAR(0); }
        if (i + NPRE < nt) { AT_DMA_K(i + NPRE, sl_n2); AT_DMA_V(i + NPRE, sl_n2); }
        const int kr = u.kt0 + i;
        if (kr >= rwa && kr < rwb) {
            const int drow = (kr >= r0l && kr < r0l + 8) ? (kr - qrl + 7) : 15;
            const lds_cptr tp = tb + drow * TB_ROW;
            f32x16 p0;
#pragma unroll
            for (int g = 0; g < 4; ++g) { const f32x4 a = *(const LAS f32x4*)(tp + 32 * g) + *(const LAS f32x4*)(tbm + 32 * g); p0[4 * g] = a[0]; p0[4 * g + 1] = a[1]; p0[4 * g + 2] = a[2]; p0[4 * g + 3] = a[3]; }
            bf16x8 kf[4];
#pragma unroll
            for (int j = 0; j < 4; ++j) kf[j] = *(const LAS bf16x8*)(ka[j] + sl_cur);
#pragma unroll
            for (int d0 = 0; d0 < 4; ++d0) p0 = __builtin_amdgcn_mfma_f32_32x32x16_bf16(kf[d0], qr[d0], p0, 0, 0, 0);
            float s0 = 0.f;
#pragma unroll
            for (int r = 0; r < 16; ++r) { p0[r] = __builtin_amdgcn_exp2f(p0[r]); s0 += p0[r]; }
            lsum += s0;
            const u32x4 pw0 = (u32x4){cvtpk(p0[0], p0[1]), cvtpk(p0[2], p0[3]), cvtpk(p0[4], p0[5]), cvtpk(p0[6], p0[7])};
            const u32x4 pw1 = (u32x4){cvtpk(p0[8], p0[9]), cvtpk(p0[10], p0[11]), cvtpk(p0[12], p0[13]), cvtpk(p0[14], p0[15])};
#pragma unroll
            for (int d0 = 0; d0 < 2; ++d0) {
                s16x4 lo[2], hh[2]; const lds_cptr vp = va[d0] + sl_cur;
#pragma unroll
                for (int ks = 0; ks < 2; ++ks) { lo[ks] = vtr(vp + ks * 2048); hh[ks] = vtr(vp + ks * 2048 + 1024); }
                o[d0] = __builtin_amdgcn_mfma_f32_32x32x16_bf16(__builtin_bit_cast(bf16x8, pw0), (bf16x8){lo[0][0], lo[0][1], lo[0][2], lo[0][3], hh[0][0], hh[0][1], hh[0][2], hh[0][3]}, o[d0], 0, 0, 0);
                o[d0] = __builtin_amdgcn_mfma_f32_32x32x16_bf16(__builtin_bit_cast(bf16x8, pw1), (bf16x8){lo[1][0], lo[1][1], lo[1][2], lo[1][3], hh[1][0], hh[1][1], hh[1][2], hh[1][3]}, o[d0], 0, 0, 0);
            }
        }
        sl_n2 = sl_cur;
        sl_cur = (sl_cur == (NSLOT - 1) * SLOTB) ? 0 : sl_cur + SLOTB;
    }
    AT_WAIT_BAR(0);
    int lane2 = lane; asm volatile("" : "+v"(lane2)); const int r32e = lane2 & 31, hie = lane2 >> 5;
    lsum += __shfl_xor(lsum, 32);
    LAS float* wsf = (LAS float*)(lds + LDS_WS) + wid * 64;
    if (hie == 0) wsf[r32e] = lsum;
    asm volatile("s_waitcnt lgkmcnt(0)" ::: "memory");
    LAS bf16_t* stg = (LAS bf16_t*)(lds) + wid * 2048;
#pragma unroll
    for (int r = 0; r < 16; ++r) { const int orow = crow(r, hie); const float rl = __builtin_amdgcn_rcpf(wsf[orow]);
        stg[orow * 64 + r32e] = (bf16_t)f2bf(o[0][r] * rl); stg[orow * 64 + 32 + r32e] = (bf16_t)f2bf(o[1][r] * rl); }
    asm volatile("s_waitcnt lgkmcnt(0)" ::: "memory");
    const int tbase = u.t0 + 2 * rp * 64 + 16 * jb;
#pragma unroll
    for (int i = 0; i < 4; ++i) { const int row = i * 8 + (lane2 >> 3), ch = lane2 & 7; const u32x4 v = *(const LAS u32x4*)(stg + row * 64 + ch * 8);
        *(u32x4*)(mixed + (size_t)(tbase + (row >> 4) * 64 + (row & 15)) * D + u.hh16 * 64 + ch * 8) = v; const int hh16 = u.hh16;
            { float s = 0.f, a;
              a = bf2f(v.x & 0xffffu); s += a * a; a = bf2f(v.x >> 16); s += a * a; a = bf2f(v.y & 0xffffu); s += a * a; a = bf2f(v.y >> 16); s += a * a;
              a = bf2f(v.z & 0xffffu); s += a * a; a = bf2f(v.z >> 16); s += a * a; a = bf2f(v.w & 0xffffu); s += a * a; a = bf2f(v.w >> 16); s += a * a;
              s += __shfl_xor(s, 1); s += __shfl_xor(s, 2); s += __shfl_xor(s, 4);
              if (ch == 0) ssq[(size_t)(tbase + (row >> 4) * 64 + (row & 15)) * 16 + hh16] = s; } }
    asm volatile("s_waitcnt lgkmcnt(0)\n\ts_barrier" ::: "memory");
#undef AT_DMA_K
#undef AT_DMA_V
}
__device__ __forceinline__ void nb_unit2(LAS unsigned char* lds, const UnitDesc& u, bf16_t* mixed, float* ssq) {
    const int tid = opaque_tid0(), lane = tid & 63, r32 = lane & 31, hi = lane >> 5; const int wid = __builtin_amdgcn_readfirstlane(tid >> 6);
    const unsigned lds0 = (unsigned)(size_t)lds; lds_cptr shm3 = (lds_cptr)lds;
    const int prow = 8 * wid + (lane >> 3);
    const bf16_t* ksrc = u.K + (size_t)(u.kt0 * 64 + prow) * HD + (((lane & 7) ^ ((4 * wid + (lane >> 4)) & 7)) * 8);
    const bf16_t* vsrc = u.V + (size_t)(u.kt0 * 64 + prow) * HD + ((((lane & 7) >> 1) ^ (prow & 2)) * 16) + (lane & 1) * 8;
    const unsigned kdst = lds0 + LDS_K + wid * 1024, vdst = lds0 + LDS_V + wid * 1024;
#define AT_DMA_K(t, slot) glds16(ksrc + (size_t)(t) * 64 * HD, (unsigned)__builtin_amdgcn_readfirstlane(kdst + (slot)))
#define AT_DMA_V(t, slot) glds16(vsrc + (size_t)(t) * 64 * HD, (unsigned)__builtin_amdgcn_readfirstlane(vdst + (slot)))
    const int rp = wid >> 2, jb = wid & 3, cs = min(max(16 * jb - 8, 0), 32);
    const int qc = 16 * jb + (r32 & 15), c0 = min(max(qc - 8, 0), 48);
    int qrl[2], r0l[2], rwa[2], rwb[2];
#pragma unroll
    for (int sb = 0; sb < 2; ++sb) { const int base = 8 * u.qb + 4 * sb + 2 * rp; qrl[sb] = base + (r32 >> 4); r0l[sb] = min(max(qrl[sb] - 4, 0), 24);
        rwa[sb] = min(max(base - 4, 0), 24); rwb[sb] = min(max(base + 1 - 4, 0), 24) + 8; }
    lds_cptr ka[4], va[2];
    { const int key = cs + r32, sw = (key >> 1) & 7;
#pragma unroll
      for (int d0 = 0; d0 < 4; ++d0) ka[d0] = shm3 + LDS_K + key * 128 + (((2 * d0 + hi) ^ sw) * 16);
      const int q = (lane & 15) >> 2, gb = (lane >> 4) & 1;
#pragma unroll
      for (int d0 = 0; d0 < 2; ++d0) va[d0] = shm3 + LDS_V + (cs + 4 * hi + q) * 128 + ((2 * (d0 ^ (q >> 1)) + gb) * 32) + (lane & 3) * 8; }
    const int nt = u.nt;
    bf16x8 qr[2][4];
#pragma unroll
    for (int sb = 0; sb < 2; ++sb) { const bf16_t* Qw = u.Q + (size_t)(qrl[sb] * 64 + qc) * HD;
#pragma unroll
        for (int d0 = 0; d0 < 4; ++d0) qr[sb][d0] = *(const bf16x8*)(Qw + d0 * 16 + hi * 8); }
#pragma unroll
    for (int j = 0; j < NPRE; ++j) if (j < nt) { AT_DMA_K(j, j * SLOTB); AT_DMA_V(j, j * SLOTB); }
    lds_cptr tb, tbm;
    { const int ib = cs + 4 * hi - qc + 63, cb = (-ib) & 3, im = cs + 4 * hi - c0 + 63, cm = (-im) & 3;
      tb = shm3 + LDS_TBB + cb * TB_CS + (ib + cb) * 4; tbm = shm3 + LDS_TBM + cm * TB_CS + (im + cm) * 4; }
    float lsum[2] = {0.f, 0.f}; f32x16 o[2][2]; o[0][0] = f32x16{}; o[0][1] = f32x16{}; o[1][0] = f32x16{}; o[1][1] = f32x16{};
    int sl_cur = 0, sl_n2 = NPRE * SLOTB;
    for (int i = 0; i < nt; ++i) {
        { const int rem = nt - 1 - i, yo = rem < NPRE - 1 ? rem : NPRE - 1; if (yo >= 3) AT_WAIT_BAR(6); else if (yo == 2) AT_WAIT_BAR(4); else if (yo == 1) AT_WAIT_BAR(2); else AT_WAIT_BAR(0); }
        if (i + NPRE < nt) { AT_DMA_K(i + NPRE, sl_n2); AT_DMA_V(i + NPRE, sl_n2); }
        const int kr = u.kt0 + i;
        const bool act0 = kr >= rwa[0] && kr < rwb[0], act1 = kr >= rwa[1] && kr < rwb[1];
        if (act0 || act1) {
            bf16x8 kf[4];
#pragma unroll
            for (int j = 0; j < 4; ++j) kf[j] = *(const LAS bf16x8*)(ka[j] + sl_cur);
            s16x4 lo[2][2], hh[2][2];
#pragma unroll
            for (int d0 = 0; d0 < 2; ++d0) { const lds_cptr vp = va[d0] + sl_cur;
#pragma unroll
                for (int ks = 0; ks < 2; ++ks) { lo[d0][ks] = vtr(vp + ks * 2048); hh[d0][ks] = vtr(vp + ks * 2048 + 1024); } }
#pragma unroll
            for (int sb = 0; sb < 2; ++sb) {
                if (sb == 0 ? act0 : act1) {
                    const int drow = (kr >= r0l[sb] && kr < r0l[sb] + 8) ? (kr - qrl[sb] + 7) : 15;
                    const lds_cptr tp = tb + drow * TB_ROW;
                    f32x16 p0;
#pragma unroll
                    for (int g = 0; g < 4; ++g) { const f32x4 a = *(const LAS f32x4*)(tp + 32 * g) + *(const LAS f32x4*)(tbm + 32 * g); p0[4 * g] = a[0]; p0[4 * g + 1] = a[1]; p0[4 * g + 2] = a[2]; p0[4 * g + 3] = a[3]; }
#pragma unroll
                    for (int d0 = 0; d0 < 4; ++d0) p0 = __builtin_amdgcn_mfma_f32_32x32x16_bf16(kf[d0], qr[sb][d0], p0, 0, 0, 0);
                    float s0 = 0.f;
#pragma unroll
                    for (int r = 0; r < 16; ++r) { p0[r] = __builtin_amdgcn_exp2f(p0[r]); s0 += p0[r]; }
                    lsum[sb] += s0;
                    const u32x4 pw0 = (u32x4){cvtpk(p0[0], p0[1]), cvtpk(p0[2], p0[3]), cvtpk(p0[4], p0[5]), cvtpk(p0[6], p0[7])};
                    const u32x4 pw1 = (u32x4){cvtpk(p0[8], p0[9]), cvtpk(p0[10], p0[11]), cvtpk(p0[12], p0[13]), cvtpk(p0[14], p0[15])};
#pragma unroll
                    for (int d0 = 0; d0 < 2; ++d0) {
                        o[sb][d0] = __builtin_amdgcn_mfma_f32_32x32x16_bf16(__builtin_bit_cast(bf16x8, pw0), (bf16x8){lo[d0][0][0], lo[d0][0][1], lo[d0][0][2], lo[d0][0][3], hh[d0][0][0], hh[d0][0][1], hh[d0][0][2], hh[d0][0][3]}, o[sb][d0], 0, 0, 0);
                        o[sb][d0] = __builtin_amdgcn_mfma_f32_32x32x16_bf16(__builtin_bit_cast(bf16x8, pw1), (bf16x8){lo[d0][1][0], lo[d0][1][1], lo[d0][1][2], lo[d0][1][3], hh[d0][1][0], hh[d0][1][1], hh[d0][1][2], hh[d0][1][3]}, o[sb][d0], 0, 0, 0);
                    }
                }
            }
        }
        sl_n2 = sl_cur;
        sl_cur = (sl_cur == (NSLOT - 1) * SLOTB) ? 0 : sl_cur + SLOTB;
    }
    AT_WAIT_BAR(0);
    int lane2 = lane; asm volatile("" : "+v"(lane2)); const int r32e = lane2 & 31, hie = lane2 >> 5;
    LAS float* wsf = (LAS float*)(lds + LDS_WS) + wid * 64;
    LAS bf16_t* stg = (LAS bf16_t*)(lds) + wid * 2048;
#pragma unroll
    for (int sb = 0; sb < 2; ++sb) {
        float ls = lsum[sb]; ls += __shfl_xor(ls, 32);
        if (hie == 0) wsf[r32e] = ls;
        asm volatile("s_waitcnt lgkmcnt(0)" ::: "memory");
#pragma unroll
        for (int r = 0; r < 16; ++r) { const int orow = crow(r, hie); const float rl = __builtin_amdgcn_rcpf(wsf[orow]);
            stg[orow * 64 + r32e] = (bf16_t)f2bf(o[sb][0][r] * rl); stg[orow * 64 + 32 + r32e] = (bf16_t)f2bf(o[sb][1][r] * rl); }
        asm volatile("s_waitcnt lgkmcnt(0)" ::: "memory");
        const int tbase = u.t0 + (4 * sb + 2 * rp) * 64 + 16 * jb;
#pragma unroll
        for (int i = 0; i < 4; ++i) { const int row = i * 8 + (lane2 >> 3), ch = lane2 & 7; const u32x4 v = *(const LAS u32x4*)(stg + row * 64 + ch * 8); const int tok = tbase + (row >> 4) * 64 + (row & 15);
            *(u32x4*)(mixed + (size_t)tok * D + u.hh16 * 64 + ch * 8) = v;
            { float s = 0.f, a;
              a = bf2f(v.x & 0xffffu); s += a * a; a = bf2f(v.x >> 16); s += a * a; a = bf2f(v.y & 0xffffu); s += a * a; a = bf2f(v.y >> 16); s += a * a;
              a = bf2f(v.z & 0xffffu); s += a * a; a = bf2f(v.z >> 16); s += a * a; a = bf2f(v.w & 0xffffu); s += a * a; a = bf2f(v.w >> 16); s += a * a;
              s += __shfl_xor(s, 1); s += __shfl_xor(s, 2); s += __shfl_xor(s, 4);
              if (ch == 0) ssq[(size_t)tok * 16 + u.hh16] = s; } }
        asm volatile("s_waitcnt lgkmcnt(0)" ::: "memory");
    }
    asm volatile("s_waitcnt lgkmcnt(0)\n\ts_barrier" ::: "memory");
#undef AT_DMA_K
#undef AT_DMA_V
}
__device__ __forceinline__ void build_table_b(LAS unsigned char* lds, const float* rpb_lh) {
    const int tid = opaque_tid0();
    for (int e = tid; e < 15 * 127; e += 512) { const int dr = e / 127, idx = e - dr * 127, rel = idx - 63; const float v = (rel >= -15 && rel <= 15) ? rpb_lh[dr * 31 + rel + 15] * LOG2E : 0.f;
#pragma unroll
        for (int c = 0; c < 4; ++c) *(LAS float*)(lds + LDS_TBB + dr * TB_ROW + c * TB_CS + (idx + c) * 4) = v; }
    if (tid >= 256 && tid < 256 + 127) { const int idx = tid - 256;
#pragma unroll
        for (int c = 0; c < 4; ++c) *(LAS float*)(lds + LDS_TBB + 15 * TB_ROW + c * TB_CS + (idx + c) * 4) = NEGBIG; }
    if (tid < 127) { const int j = tid - 63; const float v = (j >= 0 && j < 16) ? 0.f : NEGBIG;
#pragma unroll
        for (int c = 0; c < 4; ++c) *(LAS float*)(lds + LDS_TBM + c * TB_CS + (tid + c) * 4) = v; }
}

template <int TYPE>
__device__ __forceinline__ void attn_type_loop(Frame& F, int l, unsigned xcc, int qset) {
    constexpr int MQB = 2, MUP = 8 / MQB;
    constexpr int NPER = (TYPE == 2) ? 16 * MUP : (TYPE == 1 ? 96 : 192);
    unsigned* qcnt = F.ctl + CW_ATQ + ((qset * 3 + TYPE) * 8) * 64;
    LAS int* qw = (LAS int*)(F.lds + CTRL_BASE + 1024);
    const int tid = opaque_tid0();
    const int xq = (int)xcc & 7; int pre = -2;
    for (;;) {
        if (tid == 0) { int id, x; at_dequeue(qcnt, NPER, xq, pre, id, x); qw[0] = id; qw[1] = x; }
        __syncthreads();
        const int id = qw[0], x = qw[1];
        __syncthreads();
        if (id < 0) break;
        pre = -2; if (tid == 0 && x == xq) pre = (int)__hip_atomic_fetch_add(qcnt + xq * 64, 1u, RLX_AGENT);
        UnitDesc u; int h;
        if (TYPE == 2) { const int lp = id / MUP, b = 4 * x + (((lp >> 2) + x) & 3), q0 = (id % MUP) * MQB; h = (lp + x) & 3;
            mem_unit<MQB>(F.lds, qkv_ptr(F, 36 + h, b * SEQ + q0 * 256), memkv_ptr(F, l, h, b * MEM_LEN), memkv_ptr(F, l, 4 + h, b * MEM_LEN), b * SEQ + q0 * 256, 12 + h, (bf16_t*)(F.ws + WS_MIX), (float*)(F.ws + WS_SSQH));
            continue; }
        else if (TYPE == 1) { const int up = (0x0321 >> (4 * (id & 3))) & 3;
            const int lp = id >> 2, b = 4 * x + ((lp / 6 + x) & 3); h = (lp + x) % 6; u.qb = up; u.h = h; u.t0 = b * SEQ + up * 512; u.hh16 = 6 + h;
            u.Q = qkv_ptr(F, 18 + h, b * SEQ); u.K = qkv_ptr(F, 24 + h, b * SEQ); u.V = qkv_ptr(F, 30 + h, b * SEQ);
            const int lo = min(max(8 * up - 4, 0), 24), hi2 = min(max(8 * up + 7 - 4, 0), 24) + 8; u.kt0 = lo; u.nt = hi2 - lo; }
        else { const int ord = (0x70615243 >> (4 * (id & 7))) & 7;
            const int P = x * 24 + (id >> 3), b = P / 6; h = P % 6; u.qb = ord; u.h = h; u.t0 = b * SEQ + ord * 256;
            if (TYPE == 0) { u.hh16 = h; u.Q = qkv_ptr(F, h, b * SEQ); u.K = qkv_ptr(F, 6 + h, b * SEQ); u.V = qkv_ptr(F, 12 + h, b * SEQ);
                const int lo = max(4 * ord - 16, 0), hi2 = min(4 * ord + 20, 32); u.kt0 = lo; u.nt = hi2 - lo; }
            else { u.hh16 = 6 + h; u.Q = qkv_ptr(F, 18 + h, b * SEQ); u.K = qkv_ptr(F, 24 + h, b * SEQ); u.V = qkv_ptr(F, 30 + h, b * SEQ);
                const int lo = min(max(4 * ord - 4, 0), 24), hi2 = min(max(4 * ord + 3 - 4, 0), 24) + 8; u.kt0 = lo; u.nt = hi2 - lo; } }
        if (TYPE == 1) build_table_b(F.lds, in_ptr(5) + (size_t)(l * 6 + h) * 15 * 31);
        if (TYPE == 1) nb_unit2(F.lds, u, (bf16_t*)(F.ws + WS_MIX), (float*)(F.ws + WS_SSQH)); else attn_unit<TYPE>(F.lds, u, (bf16_t*)(F.ws + WS_MIX), (float*)(F.ws + WS_SSQH));
    }
}
constexpr int SW_TAB = 131072, SW_CS = 1088, SW_STG = SW_TAB + 4 * SW_CS;
static_assert(SW_STG + 8 * 2048 <= CTRL_BASE, "sliding-window LDS map");
__device__ __forceinline__ void sw_unit(LAS unsigned char* lds, int b, int h, int p, int half, const bf16_t* Qh, const bf16_t* Kh, const bf16_t* Vh, bf16_t* PO, float* PL) {
    const int tid = opaque_tid0(), lane = tid & 63, r32 = lane & 31, hi = lane >> 5; const int wid = __builtin_amdgcn_readfirstlane(tid >> 6), pair = wid >> 1, w2 = wid & 1;
    const int dsh = 2 * p, nbsh = 5 - dsh, nblk = 1 << nbsh;
    const unsigned lds0 = (unsigned)(size_t)lds; lds_cptr shm3 = (lds_cptr)lds;
    { const float sd = exp2f(-8.0f * (float)(h + 1) / 6.0f) * LOG2E * (float)(1 << dsh);
      if (tid < 255) { const int rel = tid - 127, a = rel < 0 ? -rel : rel; const float v = a <= 64 ? -sd * (float)a : NEGBIG;
#pragma unroll
          for (int c = 0; c < 4; ++c) *(LAS float*)(lds + SW_TAB + c * SW_CS + (tid + c) * 4) = v; } }
    lds_cptr ka[4], va[2];
    { const int sw = (r32 >> 1) & 7;
#pragma unroll
      for (int d0 = 0; d0 < 4; ++d0) ka[d0] = shm3 + r32 * 128 + (((2 * d0 + hi) ^ sw) * 16);
      const int q = (lane & 15) >> 2, gb = (lane >> 4) & 1;
#pragma unroll
      for (int d0 = 0; d0 < 2; ++d0) va[d0] = shm3 + 8192 + (4 * hi + q) * 128 + ((2 * (d0 ^ (q >> 1)) + gb) * 32) + (lane & 3) * 8; }
    lds_cptr tb0; { const int idx0 = 63 - 32 * w2 - r32 + 4 * hi, c = (-idx0) & 3; tb0 = shm3 + SW_TAB + c * SW_CS + (idx0 + c) * 4; }
    const int G0 = 16 * half;
    const int prow = 8 * wid + (lane >> 3);
    const int kcol = ((lane & 7) ^ ((4 * wid + (lane >> 4)) & 7)) * 8, vcol = ((((lane & 7) >> 1) ^ (prow & 2)) * 16) + (lane & 1) * 8;
#define SW_DMA(lam) do { int tau_ = G0 - 1 + (lam); tau_ = tau_ < 0 ? 0 : (tau_ > 31 ? 31 : tau_); const int r_ = tau_ >> nbsh, n_ = tau_ & (nblk - 1); \
        const size_t ro_ = (size_t)((((n_ * 64 + prow) << dsh) + r_)) * HD; const unsigned d_ = lds0 + ((lam) & 7) * 16384 + wid * 1024; \
        glds16(Kh + ro_ + kcol, (unsigned)__builtin_amdgcn_readfirstlane(d_)); glds16(Vh + ro_ + vcol, (unsigned)__builtin_amdgcn_readfirstlane(d_ + 8192)); } while (0)
#define SW_QLOAD(dst, s) do { const int G_ = G0 + 4 * (s) + pair, r_ = G_ >> nbsh, n_ = G_ & (nblk - 1); const bf16_t* qw_ = Qh + (size_t)((((n_ * 64 + 32 * w2 + r32) << dsh) + r_)) * HD; \
        _Pragma("unroll") for (int d0 = 0; d0 < 4; ++d0) dst[d0] = *(const bf16x8*)(qw_ + d0 * 16 + hi * 8); } while (0)
    bf16x8 qr[4], qn[4];
    SW_QLOAD(qr, 0);
#pragma unroll
    for (int d0 = 0; d0 < 4; ++d0) qn[d0] = qr[d0];
#pragma unroll
    for (int lam = 0; lam < 8; ++lam) SW_DMA(lam);
    float lsum = 0.f; f32x16 o[2]; o[0] = f32x16{}; o[1] = f32x16{};
#define SW_EPI(s) do { const int G_ = G0 + 4 * (s) + pair, r_ = G_ >> nbsh, n_ = G_ & (nblk - 1); \
        lsum += __shfl_xor(lsum, 32); \
        if (hi == 0) PL[(size_t)p * PL_SLICE + ((size_t)b * SEQ + (((n_ * 64 + 32 * w2 + r32) << dsh) + r_)) * 8 + h] = lsum; \
        LAS bf16_t* stg_ = (LAS bf16_t*)(lds + SW_STG + wid * 2048); \
        _Pragma("unroll") for (int d0 = 0; d0 < 2; ++d0) { \
            _Pragma("unroll") for (int r = 0; r < 16; ++r) stg_[crow(r, hi) * 32 + r32] = (bf16_t)f2bf(o[d0][r]); \
            asm volatile("s_waitcnt lgkmcnt(0)" ::: "memory"); \
            _Pragma("unroll") for (int i2 = 0; i2 < 2; ++i2) { const int row = i2 * 16 + (lane >> 2), ch = lane & 3; const u32x4 v = *(const LAS u32x4*)(stg_ + row * 32 + ch * 8); \
                __builtin_nontemporal_store(v, (u32x4*)(PO + (size_t)p * PO_SLICE + ((size_t)b * SEQ + (((n_ * 64 + 32 * w2 + row) << dsh) + r_)) * 384 + h * 64 + d0 * 32 + ch * 8)); } \
            asm volatile("s_waitcnt lgkmcnt(0)" ::: "memory"); } \
        lsum = 0.f; o[0] = f32x16{}; o[1] = f32x16{}; } while (0)
#define SW_WAIT(sig) do { if ((sig) == 0) AT_WAIT_BAR(8); else if ((sig) == 3 || (sig) == 6 || (sig) == 9) AT_WAIT_BAR(4); else if ((sig) == 10) AT_WAIT_BAR(2); else if ((sig) == 11) AT_WAIT_BAR(0); else AT_WAIT_BAR(6); } while (0)
#pragma unroll
    for (int sig = 0; sig < 12; ++sig) {
        const int s = sig / 3, t = sig - 3 * s;
        SW_WAIT(sig);
        if (t == 0 && s > 0) { SW_EPI(s - 1);
#pragma unroll
            for (int d0 = 0; d0 < 4; ++d0) qr[d0] = qn[d0]; }
        if (t == 2 && s < 3) SW_QLOAD(qn, s + 1);
        if (t == 1) { if (4 * s + 8 <= 17) SW_DMA(4 * s + 8); }
        if (t == 2) { if (4 * s + 9 <= 17) SW_DMA(4 * s + 9); }
        if (t == 0 && s > 0) { if (4 * s + 6 <= 17) SW_DMA(4 * s + 6); if (4 * s + 7 <= 17) SW_DMA(4 * s + 7); }
        const int G = G0 + 4 * s + pair, n = G & (nblk - 1);
        if (!(t == 0 && n == 0) && !(t == 2 && n == nblk - 1)) {
            const int slo = ((4 * s + t + pair) & 7) * 16384;
            const bool do0 = !(t == 0 && w2 == 1), do1 = !(t == 2 && w2 == 0);
            const lds_cptr tp = tb0 + t * 256;
            if (do0) {
                f32x16 p0;
#pragma unroll
                for (int gq = 0; gq < 4; ++gq) { const f32x4 a = *(const LAS f32x4*)(tp + 32 * gq); p0[4 * gq] = a[0]; p0[4 * gq + 1] = a[1]; p0[4 * gq + 2] = a[2]; p0[4 * gq + 3] = a[3]; }
#pragma unroll
                for (int d0 = 0; d0 < 4; ++d0) p0 = __builtin_amdgcn_mfma_f32_32x32x16_bf16(*(const LAS bf16x8*)(ka[d0] + slo), qr[d0], p0, 0, 0, 0);
                float s0 = 0.f;
#pragma unroll
                for (int r = 0; r < 16; ++r) { p0[r] = __builtin_amdgcn_exp2f(p0[r]); s0 += p0[r]; }
                lsum += s0;
                const u32x4 pw0 = (u32x4){cvtpk(p0[0], p0[1]), cvtpk(p0[2], p0[3]), cvtpk(p0[4], p0[5]), cvtpk(p0[6], p0[7])}, pw1 = (u32x4){cvtpk(p0[8], p0[9]), cvtpk(p0[10], p0[11]), cvtpk(p0[12], p0[13]), cvtpk(p0[14], p0[15])};
#pragma unroll
                for (int d0 = 0; d0 < 2; ++d0) { const lds_cptr vp = va[d0] + slo; const s16x4 l0 = vtr(vp), h0 = vtr(vp + 1024), l1 = vtr(vp + 2048), h1 = vtr(vp + 2048 + 1024);
                    o[d0] = __builtin_amdgcn_mfma_f32_32x32x16_bf16(__builtin_bit_cast(bf16x8, pw0), (bf16x8){l0[0], l0[1], l0[2], l0[3], h0[0], h0[1], h0[2], h0[3]}, o[d0], 0, 0, 0);
                    o[d0] = __builtin_amdgcn_mfma_f32_32x32x16_bf16(__builtin_bit_cast(bf16x8, pw1), (bf16x8){l1[0], l1[1], l1[2], l1[3], h1[0], h1[1], h1[2], h1[3]}, o[d0], 0, 0, 0); }
            }
            if (do1) {
                f32x16 p1;
#pragma unroll
                for (int gq = 0; gq < 4; ++gq) { const f32x4 a = *(const LAS f32x4*)(tp + 32 * (gq + 4)); p1[4 * gq] = a[0]; p1[4 * gq + 1] = a[1]; p1[4 * gq + 2] = a[2]; p1[4 * gq + 3] = a[3]; }
#pragma unroll
                for (int d0 = 0; d0 < 4; ++d0) p1 = __builtin_amdgcn_mfma_f32_32x32x16_bf16(*(const LAS bf16x8*)(ka[d0] + slo + 4096), qr[d0], p1, 0, 0, 0);
                float s1 = 0.f;
#pragma unroll
                for (int r = 0; r < 16; ++r) { p1[r] = __builtin_amdgcn_exp2f(p1[r]); s1 += p1[r]; }
                lsum += s1;
                const u32x4 pw2 = (u32x4){cvtpk(p1[0], p1[1]), cvtpk(p1[2], p1[3]), cvtpk(p1[4], p1[5]), cvtpk(p1[6], p1[7])}, pw3 = (u32x4){cvtpk(p1[8], p1[9]), cvtpk(p1[10], p1[11]), cvtpk(p1[12], p1[13]), cvtpk(p1[14], p1[15])};
#pragma unroll
                for (int d0 = 0; d0 < 2; ++d0) { const lds_cptr vp = va[d0] + slo + 4096; const s16x4 l0 = vtr(vp), h0 = vtr(vp + 1024), l1 = vtr(vp + 2048), h1 = vtr(vp + 2048 + 1024);
                    o[d0] = __builtin_amdgcn_mfma_f32_32x32x16_bf16(__builtin_bit_cast(bf16x8, pw2), (bf16x8){l0[0], l0[1], l0[2], l0[3], h0[0], h0[1], h0[2], h0[3]}, o[d0], 0, 0, 0);
                    o[d0] = __builtin_amdgcn_mfma_f32_32x32x16_bf16(__builtin_bit_cast(bf16x8, pw3), (bf16x8){l1[0], l1[1], l1[2], l1[3], h1[0], h1[1], h1[2], h1[3]}, o[d0], 0, 0, 0); }
            }
        }
    }
    AT_WAIT_BAR(0);
    SW_EPI(3);
    asm volatile("s_waitcnt lgkmcnt(0)\n\ts_barrier" ::: "memory");
#undef SW_DMA
#undef SW_QLOAD
#undef SW_EPI
#undef SW_WAIT
}
__device__ __forceinline__ void sa_loop(Frame& F, int l, unsigned xcc, int qset) {
    constexpr int NPER = 144;
    unsigned* qcnt = F.ctl + CW_ATQ + ((qset * 3 + 0) * 8) * 64;
    LAS int* qw = (LAS int*)(F.lds + CTRL_BASE + 1024);
    const int tid = opaque_tid0();
    const int xq = (int)xcc & 7; int pre = -2;
    for (;;) {
        if (tid == 0) { int id, x; at_dequeue(qcnt, NPER, xq, pre, id, x); qw[0] = id; qw[1] = x; }
        __syncthreads();
        const int id = qw[0], x = qw[1];
        __syncthreads();
        if (id < 0) break;
        pre = -2; if (tid == 0 && x == xq) pre = (int)__hip_atomic_fetch_add(qcnt + xq * 64, 1u, RLX_AGENT);
        const int lp = id / 6, b = 4 * x + ((lp / 6 + x) & 3), h = (lp + x) % 6, p = (id % 6) >> 1, half = id & 1;
        sw_unit(F.lds, b, h, p, half, qkv_ptr(F, h, b * SEQ), qkv_ptr(F, 6 + h, b * SEQ), qkv_ptr(F, 12 + h, b * SEQ), (bf16_t*)(F.ws + WS_PO), (float*)(F.ws + WS_PL));
    }
}
}

__device__ __forceinline__ void moe_weights_beside(Frame& F, int l, int qset) {
    PHASE_IDS(F);
    if ((blockIdx.x & 31) >= 8) return;
    LAS float* scr = (LAS float*)(F.lds + F.wave * 16384);
    LAS int* qw = (LAS int*)(F.lds + CTRL_BASE + 1024);
    constexpr int I_G = 16 * 16, I_D = 8 * 32, PER_E = 2 * I_G + I_D, NIT = NE * PER_E, BATCH_IT = 64;
    unsigned* head = F.ctl + CW_WQ + qset * 64;
    for (;;) {
        if (F.tid == 0) qw[2] = (int)__hip_atomic_fetch_add(head, 1u, RLX_AGENT);
        __syncthreads();
        const int bt = qw[2];
        __syncthreads();
        if (bt * BATCH_IT >= NIT) break;
        auto dec = [&](int j) { const int it = bt * BATCH_IT + j; const int e = it / PER_E; int r = it % PER_E; const size_t le = (size_t)l * NE + e;
            if (r < I_G) return TrItem{in_ptr(15) + le * D * DE, in_ptr(10) + l * D, (bf16_t*)(F.ws + WS_WGU + le * 1024 * D), D, DE, 6, r};
            r -= I_G;
            if (r < I_G) return TrItem{in_ptr(16) + le * D * DE, in_ptr(10) + l * D, (bf16_t*)(F.ws + WS_WGU + le * 1024 * D), D, DE, 7, r};
            r -= I_G;
            return TrItem{in_ptr(17) + le * DE * D, (const float*)nullptr, (bf16_t*)(F.ws + WS_WD + le * D * DE), DE, D, 5, r}; };
        float wa[32], wb[32];
        TrItem d0 = dec(F.wave); tr_load(d0, F.lane, wa);
#pragma unroll
        for (int jj = 0; jj < BATCH_IT / NWAVES; jj += 2) {
            TrItem d1 = dec(F.wave + (jj + 1) * NWAVES); tr_load(d1, F.lane, wb);
            tr_finish(d0, F.lane, wa, scr);
            if (jj + 2 < BATCH_IT / NWAVES) { d0 = dec(F.wave + (jj + 2) * NWAVES); tr_load(d0, F.lane, wa); }
            tr_finish(d1, F.lane, wb, scr);
        }
    }
    __syncthreads();
}
__device__ __forceinline__ void phase_attn_fast(Frame& F, int l, int qset) {
    if (qset < 2) moe_weights_beside(F, l, qset);
    PHASE_IDS(F);
    const unsigned xcc = xb_xcc_id();
    at::sa_loop(F, l, xcc, qset);
    if (PROBE_ID == 100 && l == 0) { __syncthreads(); at::sa_loop(F, l, xcc, 2); }
    at::attn_type_loop<1>(F, l, xcc, qset);
    if (PROBE_ID == 101 && l == 0) { __syncthreads(); at::attn_type_loop<1>(F, l, xcc, 2); }
    at::attn_type_loop<2>(F, l, xcc, qset);
    if (PROBE_ID == 102 && l == 0) { __syncthreads(); at::attn_type_loop<2>(F, l, xcc, 2); }
}

__device__ __forceinline__ bool in_ph(int lo, int hi, int k) { asm volatile("" : "+s"(lo), "+s"(hi)); return lo <= k && k < hi; }
constexpr int PH_TOTAL = 2 + 8 * DEPTH - 1;
__global__ void __launch_bounds__(NWAVES * 64, 2) fwd(Args args) {
    extern __shared__ __attribute__((aligned(16))) unsigned char lds[];
    Frame F;
    F.lds = (LAS unsigned char*)lds; PHASE_IDS(F);
    F.G = gridDim.x; F.ngw = F.G * NWAVES;
    F.out = args.out; F.ws = args.ws; F.ctl = (unsigned*)(args.ws + WS_CTL);
    volatile LAS unsigned* MISC = (volatile LAS unsigned*)(F.lds + MISC_OFF);
    if (F.tid < 32) MISC[F.tid] = 0u;
    __syncthreads();
    const int lo = args.ph_lo, hi = args.ph_hi;
    XcdBarrier bar; bar.bar = F.ctl + CW_BAR; bar.x = 0; bar.st = nullptr;
    if (hi - lo > 1) bar = xcd_barrier_post(F.ctl + CW_BAR, MISC + 8);
#define IN(k) in_ph(lo, hi, (k))
#define SEAM(k) do { if (IN(k) && IN((k) + 1)) xcd_barrier(bar); else __syncthreads(); } while (0)
#define RUN(k, code) do { if (IN(k)) { code; if (PROBE_ID == (k)) { xcd_barrier(bar); code; } } SEAM(k); } while (0)
    RUN(0, { phase_weights(F); phase_x0(F); });
    RUN(1, { phase_memkv_fast(F); phase_inproj_fast(F, 0); });
    { const int l = 0, pb = 2;
      if (IN(pb + 0)) { phase_attn_fast(F, l, 0); if (PROBE_ID == pb + 0) { xcd_barrier(bar); phase_attn_fast(F, l, 2); } } SEAM(pb + 0);
      RUN(pb + 1, { phase_groupnorm(F); });
      RUN(pb + 2, { phase_outproj_fast(F, l); });
      RUN(pb + 3, { phase_router_fast(F, l); });
      RUN(pb + 4, { phase_moe1_fast(F, l); phase_moe2_fast(F, l); });
      RUN(pb + 6, { phase_combine(F, l); });
      RUN(pb + 7, { phase_inproj_fast(F, 1); });
    }
    { const int l = 1, pb = 10;
      if (IN(pb + 0)) { phase_attn_fast(F, l, 1); if (PROBE_ID == pb + 0) { xcd_barrier(bar); phase_attn_fast(F, l, 3); } } SEAM(pb + 0);
      RUN(pb + 1, { phase_groupnorm(F); });
      RUN(pb + 2, { phase_outproj_fast(F, l); });
      RUN(pb + 3, { phase_router_fast(F, l); });
      RUN(pb + 4, { phase_moe1_fast(F, l); phase_moe2_fast(F, l); });
      RUN(pb + 6, { phase_combine(F, l); });
    }
#undef IN
#undef SEAM
#undef RUN
}

extern "C" void kernel_launch(void* const* d_in, const int* in_sizes, int n_in, void* d_out, int out_size, void* d_ws, size_t ws_size, hipStream_t stream) {
    static int grid = 0;
    if (grid == 0) {
        if (n_in != 18 || in_sizes[0] != T * D || out_size != T * D || ws_size < WS_END) { fprintf(stderr, "kernel_launch: unexpected shapes (n_in %d, in0 %d, out %d, ws %zu < %zu); nothing launched\n", n_in, n_in > 0 ? in_sizes[0] : -1, out_size, ws_size, (size_t)WS_END); grid = -1; return; }
        int dev = 0, cus = 0, per_cu = 0;
        if (hipGetDevice(&dev) != hipSuccess || hipDeviceGetAttribute(&cus, hipDeviceAttributeMultiprocessorCount, dev) != hipSuccess) { grid = -1; return; }
        if (hipFuncSetAttribute((const void*)fwd, hipFuncAttributeMaxDynamicSharedMemorySize, LDS_BYTES) != hipSuccess) { fprintf(stderr, "kernel_launch: hipFuncSetAttribute failed\n"); grid = -1; return; }
        if (hipOccupancyMaxActiveBlocksPerMultiprocessor(&per_cu, (const void*)fwd, NWAVES * 64, LDS_BYTES) != hipSuccess || per_cu < 1) fprintf(stderr, "kernel_launch: occupancy query reports %d\n", per_cu);
        (void)hipGetLastError();
        grid = cus;
    }
    if (grid < 0) return;
    if (hipMemsetAsync((char*)d_ws + WS_CTL, 0, CTL_ZERO_BYTES, stream) != hipSuccess) { fprintf(stderr, "kernel_launch: memset failed\n"); return; }
    Args a{};
    for (int i = 0; i < 18; ++i) a.in[i] = (const float*)d_in[i];
    a.out = (float*)d_out; a.ws = (unsigned char*)d_ws;
#if MK_ONE_LAUNCH
    a.ph_lo = 0; a.ph_hi = PH_TOTAL;
    hipLaunchKernelGGL(fwd, dim3(grid), dim3(NWAVES * 64), LDS_BYTES, stream, a);
#else
    for (int p = 0; p < PH_TOTAL; ++p) { a.ph_lo = p; a.ph_hi = p + 1; hipLaunchKernelGGL(fwd, dim3(grid), dim3(NWAVES * 64), LDS_BYTES, stream, a); }
#endif
    const hipError_t le = hipPeekAtLastError();
    if (le != hipSuccess) fprintf(stderr, "kernel_launch: launch failed: %s\n", hipGetErrorName(le));
}
```
